# Optimizing an MI355X kernel written in HIP

```python
import math
import jax, jax.numpy as jnp
from jax import lax
import numpy as np

D_MODEL = 2048
BATCH = 8
SEQ = 4096
DEPTH = 4

N_MEM = 256
D_MIX = D_MODEL
GROUP_W = D_MIX // 4
GLA_HEADS = 4
GLA_DV = GROUP_W // GLA_HEADS
GLA_DK = GLA_DV // 2
GLA_QK = GLA_HEADS * GLA_DK
GLA_V = GLA_HEADS * GLA_DV
GLA_RANK = 16
GLA_GATE_NORM = 16.0
GLA_CHUNK = 64
FNET_GROUPS = 4
FNET_CH = GROUP_W // FNET_GROUPS
HY_W = GROUP_W
HY_ORDER = 2
HY_BANDS = 16
HY_EMB = 2 * HY_BANDS + 1
HY_FFN = 64
HY_DECAY_SLOW = -math.log(1e-2) / 1.5
HY_DECAY_FAST = -math.log(1e-2) / 0.3
SC_W = GROUP_W
SHORT_W = 3
IN_SPLITS = (GLA_QK, GLA_QK, GLA_V, GLA_V, 2 * GLA_RANK, GROUP_W, 3 * HY_W, 3 * SC_W)
D_IN = 2 * GLA_QK + 2 * GLA_V + 2 * GLA_RANK + GROUP_W + 3 * HY_W + 3 * SC_W
XA_HEADS = 4
XA_HD = D_MODEL // XA_HEADS
D_FF = ((8 * D_MODEL // 3 + 255) // 256) * 256
EPS = 1e-6

kernel_name = 'hybrid_parallel_group_encoder'


def rms_norm(x, g):
    xf = x.astype(jnp.float32)
    y = xf * lax.rsqrt(jnp.mean(xf * xf, axis=-1, keepdims=True) + EPS)
    return (y * g.astype(jnp.float32)).astype(x.dtype)


def short_conv(u, w):
    up = jnp.pad(u, ((0, 0), (1, 1), (0, 0)))
    return up[:, :-2] * w[0] + up[:, 1:-1] * w[1] + up[:, 2:] * w[2]


def gla_direction(q, k, v, gk, strict):
    bsz, seq, heads, dk = q.shape
    dv = v.shape[-1]
    n = seq // GLA_CHUNK
    rs = lambda t: t.reshape(bsz, n, GLA_CHUNK, heads, t.shape[-1])
    q, k, v, gk = rs(q), rs(k), rs(v), rs(gk)
    b = jnp.cumsum(gk, axis=2)
    b_last = b[:, :, -1]
    b_ref = b[:, :, GLA_CHUNK // 2:GLA_CHUNK // 2 + 1]
    scores = jnp.einsum('bnihk,bnjhk->bnhij', q * jnp.exp(b - b_ref), k * jnp.exp(b_ref - b))
    mask = jnp.tril(jnp.ones((GLA_CHUNK, GLA_CHUNK), dtype=bool), k=-1 if strict else 0)
    scores = jnp.where(mask, scores, 0.0)
    o_intra = jnp.einsum('bnhij,bnjhv->bnihv', scores, v)
    u = jnp.einsum('bnchk,bnchv->bnhkv', k * jnp.exp(b_last[:, :, None] - b), v)
    decay = jnp.exp(b_last)

    def step(state, inp):
        d, un = inp
        return state * d[..., None] + un, state

    init = jnp.zeros((bsz, heads, dk, dv), dtype=jnp.float32)
    _, states = lax.scan(step, init, (jnp.moveaxis(decay, 1, 0), jnp.moveaxis(u, 1, 0)))
    states = jnp.moveaxis(states, 0, 1)
    o_inter = jnp.einsum('bnchk,bnhkv->bnchv', q * jnp.exp(b), states)
    return (o_intra + o_inter).reshape(bsz, seq, heads, dv)


def gla_mixer(q, k, v, g, lr, gk_w, gk_b, norm_g):
    f32 = jnp.float32
    bsz, seq, _ = q.shape
    heads = lambda t, d: t.astype(f32).reshape(bsz, seq, GLA_HEADS, d)
    q = heads(q, GLA_DK) * GLA_DK ** -0.5
    k = heads(k, GLA_DK)
    v = heads(v, GLA_DV)
    lr = lr.astype(f32)
    gk_fwd = jax.nn.log_sigmoid(lr[..., :GLA_RANK] @ gk_w[0].astype(f32) + gk_b[0].astype(f32)) / GLA_GATE_NORM
    gk_bwd = jax.nn.log_sigmoid(lr[..., GLA_RANK:] @ gk_w[1].astype(f32) + gk_b[1].astype(f32)) / GLA_GATE_NORM
    gk_fwd = gk_fwd.reshape(bsz, seq, GLA_HEADS, GLA_DK)
    gk_bwd = gk_bwd.reshape(bsz, seq, GLA_HEADS, GLA_DK)
    flip = lambda t: jnp.flip(t, axis=1)
    o = gla_direction(q, k, v, gk_fwd, False) + flip(gla_direction(flip(q), flip(k), flip(v), flip(gk_bwd), True))
    o = rms_norm(o, norm_g) * jax.nn.silu(heads(g, GLA_DV))
    return o.reshape(bsz, seq, GLA_V)


def fnet_mixer(u):
    bsz, seq, _ = u.shape
    uf = u.astype(jnp.float32).reshape(bsz, seq, FNET_GROUPS, FNET_CH)
    return jnp.fft.fftn(uf, axes=(1, 3), norm='ortho').real.reshape(bsz, seq, GROUP_W)


def hyena_position_features(seq):
    pos = jnp.arange(seq, dtype=jnp.float32)
    t = pos / seq
    f = jnp.linspace(1e-4, HY_BANDS - 1, HY_BANDS, dtype=jnp.float32)
    ang = (2.0 * math.pi * t)[:, None] * f[None, :]
    return jnp.concatenate([t[:, None], jnp.cos(ang), -jnp.sin(ang)], axis=-1)


def hyena_filters(feats, w1, b1, w2, b2, w3, freq, decay):
    f32 = jnp.float32
    seq = feats.shape[0]
    freq = freq.astype(f32)
    h = jnp.sin(freq * (feats @ w1.astype(f32) + b1.astype(f32)))
    h = jnp.sin(freq * (h @ w2.astype(f32) + b2.astype(f32)))
    h = h @ w3.astype(f32)
    window = jnp.exp(-feats[:, :1] * jnp.abs(decay.astype(f32).reshape(-1)))
    h = (h * window).reshape(seq, HY_ORDER, 2, HY_W)
    h_fwd, h_bwd = h[:, :, 0], h[:, :, 1]
    two_sided = jnp.concatenate([h_fwd, jnp.zeros_like(h_fwd[:1]), h_bwd[:0:-1]], axis=0)
    return jnp.moveaxis(jnp.fft.rfft(two_sided, axis=0), 1, 0)


def long_conv(z, filt, skip):
    seq = z.shape[1]
    zf = jnp.fft.rfft(z, n=2 * seq, axis=1)
    y = jnp.fft.irfft(zf * filt[None], n=2 * seq, axis=1)[:, :seq]
    return y + z * skip.astype(jnp.float32)


def hyena_mixer(u, conv_w, filt, skip):
    u = short_conv(u, conv_w).astype(jnp.float32)
    v, x1, x2 = jnp.split(u, 3, axis=-1)
    z = x1 * long_conv(v, filt[0], skip[0])
    return x2 * long_conv(z, filt[1], skip[1])


def shortconv_mixer(u, conv_w):
    b, c, h = jnp.split(u, 3, axis=-1)
    return b * short_conv(c * h, conv_w)


def cross_attention(h, mem_n, w_q, w_kv, w_o):
    bsz, seq, _ = h.shape
    n_mem = mem_n.shape[1]
    q = (h @ w_q).reshape(bsz, seq, XA_HEADS, XA_HD)
    k, v = jnp.split(mem_n @ w_kv, 2, axis=-1)
    k = k.reshape(bsz, n_mem, XA_HEADS, XA_HD)
    v = v.reshape(bsz, n_mem, XA_HEADS, XA_HD)
    s = jnp.einsum('bshd,bmhd->bhsm', q, k).astype(jnp.float32) * XA_HD ** -0.5
    p = jax.nn.softmax(s, axis=-1).astype(v.dtype)
    o = jnp.einsum('bhsm,bmhd->bshd', p, v).reshape(bsz, seq, D_MODEL)
    return o @ w_o


def swiglu(h, w_gate_up, w_down):
    gate, up = jnp.split(h @ w_gate_up, 2, axis=-1)
    return (jax.nn.silu(gate) * up) @ w_down


def setup_inputs(seed: int = 0) -> dict:
    key = jax.random.key(seed)
    ks = jax.random.split(key, 32)
    nrm = lambda k, shape, scale: jax.random.normal(k, shape, dtype=jnp.float32) * scale
    gain = lambda k, shape: 1.0 + 0.02 * jax.random.normal(k, shape, dtype=jnp.float32)
    decay_base = jnp.linspace(HY_DECAY_SLOW, HY_DECAY_FAST, HY_W, dtype=jnp.float32)
    return {
        'x': nrm(ks[0], (BATCH, SEQ, D_MODEL), 1.0),
        'mem': nrm(ks[1], (BATCH, N_MEM, D_MODEL), 1.0),
        'norm_g': gain(ks[2], (DEPTH, 3, D_MODEL)),
        'w_in': nrm(ks[3], (DEPTH, D_MODEL, D_IN), D_MODEL ** -0.5),
        'gla_gk_w': nrm(ks[4], (DEPTH, 2, GLA_RANK, GLA_QK), GLA_RANK ** -0.5),
        'gla_gk_b': nrm(ks[5], (DEPTH, 2, GLA_QK), 0.1),
        'gla_norm_g': gain(ks[6], (DEPTH, GLA_DV)),
        'hy_conv_w': nrm(ks[7], (DEPTH, SHORT_W, 3 * HY_W), SHORT_W ** -0.5),
        'hy_ffn_w1': nrm(ks[8], (DEPTH, HY_EMB, HY_FFN), HY_EMB ** -0.5),
        'hy_ffn_b1': nrm(ks[9], (DEPTH, HY_FFN), 0.02),
        'hy_ffn_w2': nrm(ks[10], (DEPTH, HY_FFN, HY_FFN), HY_FFN ** -0.5),
        'hy_ffn_b2': nrm(ks[11], (DEPTH, HY_FFN), 0.02),
        'hy_ffn_w3': nrm(ks[12], (DEPTH, HY_FFN, HY_ORDER * 2 * HY_W), 0.1 * HY_FFN ** -0.5),
        'hy_sin_freq': gain(ks[13], (DEPTH, HY_FFN)),
        'hy_decay': decay_base * gain(ks[14], (DEPTH, HY_ORDER, 2, HY_W)),
        'hy_skip': nrm(ks[15], (DEPTH, HY_ORDER, HY_W), 1.0),
        'sc_conv_w': nrm(ks[16], (DEPTH, SHORT_W, SC_W), SHORT_W ** -0.5),
        'grp_norm_g': gain(ks[17], (DEPTH, 3, GROUP_W)),
        'w_out': nrm(ks[18], (DEPTH, D_MIX, D_MODEL), D_MIX ** -0.5),
        'mem_norm_g': gain(ks[19], (D_MODEL,)),
        'w_xq': nrm(ks[20], (DEPTH, D_MODEL, D_MODEL), D_MODEL ** -0.5),
        'w_xkv': nrm(ks[21], (DEPTH, D_MODEL, 2 * D_MODEL), D_MODEL ** -0.5),
        'w_xo': nrm(ks[22], (DEPTH, D_MODEL, D_MODEL), D_MODEL ** -0.5),
        'w_gate_up': nrm(ks[23], (DEPTH, D_MODEL, 2 * D_FF), D_MODEL ** -0.5),
        'w_down': nrm(ks[24], (DEPTH, D_FF, D_MODEL), D_FF ** -0.5),
        'final_norm_g': gain(ks[25], (D_MODEL,)),
    }


def reference(x, mem, norm_g, w_in, gla_gk_w, gla_gk_b, gla_norm_g, hy_conv_w, hy_ffn_w1, hy_ffn_b1,
              hy_ffn_w2, hy_ffn_b2, hy_ffn_w3, hy_sin_freq, hy_decay, hy_skip, sc_conv_w, grp_norm_g,
              w_out, mem_norm_g, w_xq, w_xkv, w_xo, w_gate_up, w_down, final_norm_g):
    feats = hyena_position_features(x.shape[1])
    mem_n = rms_norm(mem, mem_norm_g)
    split_at = np.cumsum(IN_SPLITS)[:-1].tolist()
    for l in range(DEPTH):
        h = rms_norm(x, norm_g[l, 0])
        q, k, v, g, lr, u_f, u_h, u_s = jnp.split(h @ w_in[l], split_at, axis=-1)
        y_a = gla_mixer(q, k, v, g, lr, gla_gk_w[l], gla_gk_b[l], gla_norm_g[l])
        y_b = rms_norm(fnet_mixer(u_f), grp_norm_g[l, 0])
        filt = hyena_filters(feats, hy_ffn_w1[l], hy_ffn_b1[l], hy_ffn_w2[l], hy_ffn_b2[l],
                             hy_ffn_w3[l], hy_sin_freq[l], hy_decay[l])
        y_c = rms_norm(hyena_mixer(u_h, hy_conv_w[l], filt, hy_skip[l]), grp_norm_g[l, 1])
        y_d = rms_norm(shortconv_mixer(u_s, sc_conv_w[l]), grp_norm_g[l, 2])
        mix = jnp.concatenate([y_a.astype(x.dtype), y_b.astype(x.dtype), y_c.astype(x.dtype), y_d.astype(x.dtype)], axis=-1)
        x = x + mix @ w_out[l]
        x = x + cross_attention(rms_norm(x, norm_g[l, 1]), mem_n, w_xq[l], w_xkv[l], w_xo[l])
        x = x + swiglu(rms_norm(x, norm_g[l, 2]), w_gate_up[l], w_down[l])
    return rms_norm(x, final_norm_g)
```

```cpp
#include <hip/hip_runtime.h>
#include <cstdio>
#include <cstdint>

namespace pg8 {
#define PG8_LAS __attribute__((address_space(3)))
#define PG8_GAS __attribute__((address_space(1)))
typedef unsigned short bf16_t;
typedef short bf16x8 __attribute__((ext_vector_type(8)));
typedef float f32x4 __attribute__((ext_vector_type(4)));
typedef unsigned u32x4 __attribute__((ext_vector_type(4)));
constexpr int BM = 256, BK = 64, HALF = 128, HTB = HALF * BK * 2  , STAGE_BYTES = 8 * HTB, NXCD = 8, WGM = 4;

__host__ __device__ __forceinline__ int lds_byte(int r, int c) { const int st = (r >> 4) * 2 + (c >> 5), rr = r & 15, cc = c & 31, ob = rr * 64 + cc * 2; return st * 1024 + (ob ^ (((ob >> 9) & 1) << 5)); }
__host__ __device__ __forceinline__ void stage_rc(int b, int& R, int& C) { const int st = b / 1024, sb = b % 1024, swz = sb ^ (((sb >> 9) & 1) << 5); R = (st >> 1) * 16 + swz / 64; C = (st & 1) * 32 + (swz % 64) / 2; }
__host__ __device__ __forceinline__ int perm32(int rho) { const int n = rho >> 4, i = rho & 15; return 8 * (i >> 2) + 4 * n + (i & 3); }

struct Unit { size_t aoff, boff; int pm, pn; };
struct Gemm { const bf16_t* A; const bf16_t* Bt; int lda, ldb, K; };

struct TileOrder {
    int nM, nN, nwg, G, c, bdiv, bmul; size_t atile, btile;
    __device__ void init(int nM_, int nN_, int G_, int c_, int lda, int ldb, int bdiv_ = 1 << 30, int bmul_ = 0) { nM = nM_; nN = nN_; nwg = nM * nN; G = G_; c = c_; bdiv = bdiv_; bmul = bmul_; atile = (size_t)BM * lda * 2; btile = (size_t)BM * ldb * 2; }
    __device__ bool next(int i, Unit& u) const {
        const long L = (long)i * G + c; if (L >= nwg) return false;
        int wgid = (int)L; { const int q = nwg / NXCD, r = nwg % NXCD, xcd = wgid % NXCD, off = wgid / NXCD; wgid = (xcd < r ? xcd * (q + 1) : r * (q + 1) + (xcd - r) * q) + off; }
        const int nig = WGM * nN, gid = wgid / nig, fm = gid * WGM, gsz = (nM - fm) < WGM ? (nM - fm) : WGM;
        u.pm = fm + ((wgid % nig) % gsz); u.pn = (wgid % nig) / gsz;
        u.aoff = (size_t)u.pm * atile; u.boff = (size_t)((u.pm / bdiv) * bmul + u.pn) * btile; return true;
    }
    __device__ __forceinline__ void a_ready(const Unit&) const {}
    __device__ __forceinline__ void done(const Unit&) const {}
};
template <int MODE> struct PairOrder {
    int G, c;
    __device__ bool next(int i, Unit& u) const {
        const long L = (long)i * G + c; if (L >= 256) return false;
        const int bh = (int)L >> 3, j = (int)L & 7, b = bh >> 2, h = bh & 3;
        if (MODE == 0) { u.aoff = ((size_t)(b * 256) * 4096 + h * 512) * 2; u.boff = ((size_t)(j * 256) * 2048 + h * 512) * 2; u.pm = b * 4 + h; u.pn = j; }
        else           { u.aoff = ((size_t)(j * 256) * 2048 + h * 512) * 2; u.boff = ((size_t)(b * 256) * 4096 + 2048 + h * 512) * 2; u.pm = b * 8 + j; u.pn = h; }
        return true;
    }
    __device__ __forceinline__ void a_ready(const Unit&) const {}
    __device__ __forceinline__ void done(const Unit&) const {}
};

struct FnetAOrder {
    int G, c;
    __device__ bool next(int i, Unit& u) const {
        const long L = (long)i * G + c; if (L >= 512) return false;
        const int combo = (int)L >> 5, rest = (int)L & 31, b = combo >> 1, gp = combo & 1, pml = rest >> 4, pn = rest & 15;
        u.aoff = (size_t)pml * 256 * 256 * 2; u.boff = ((size_t)(b * 4096 + pn * 256) * 3840 + 1792 + gp * 256) * 2; u.pm = b * 4 + gp * 2 + pml; u.pn = pn; return true;
    }
    __device__ __forceinline__ void a_ready(const Unit&) const {}
    __device__ __forceinline__ void done(const Unit&) const {}
};

__device__ __forceinline__ unsigned cvt_pk_bf16(float lo, float hi) { unsigned r; asm volatile("v_cvt_pk_bf16_f32 %0, %1, %2" : "=v"(r) : "v"(lo), "v"(hi)); return r; }

struct RstdTab { const PG8_LAS float* tab; const PG8_GAS float* RS; int pm0, pm1, pm2, pm3;
    __device__ __forceinline__ int slot(int pm) const { return !tab ? -2 : pm == pm0 ? 0 : pm == pm1 ? 1 : pm == pm2 ? 2 : pm == pm3 ? 3 : -1; }
    __device__ __forceinline__ void rows(const Unit& u, int wr, int fr, int fq, float (&rs)[2][4]) const {
        const int sl = slot(u.pm);
        if (sl == -2) {
#pragma unroll
            for (int ai = 0; ai < 2; ++ai)
#pragma unroll
                for (int m = 0; m < 4; ++m) rs[ai][m] = 1.0f;
        } else if (sl >= 0) {
#pragma unroll
            for (int ai = 0; ai < 2; ++ai)
#pragma unroll
                for (int m = 0; m < 4; ++m) rs[ai][m] = tab[sl * 256 + ai * HALF + wr * 64 + m * 16 + fr];
        } else {
#pragma unroll
            for (int ai = 0; ai < 2; ++ai)
#pragma unroll
                for (int m = 0; m < 4; ++m) { const PG8_GAS float* p = RS + (size_t)(u.pm * BM + ai * HALF + wr * 64 + m * 16 + fr) * 32 + fq * 8;
                    const f32x4 a = *(const PG8_GAS f32x4*)p, b = *(const PG8_GAS f32x4*)(p + 4);
                    float t = ((a[0] + a[1]) + (a[2] + a[3])) + ((b[0] + b[1]) + (b[2] + b[3])); t += __shfl_xor(t, 16); t += __shfl_xor(t, 32);
                    rs[ai][m] = rsqrtf(t * (1.0f / 2048.0f) + 1e-6f); }
        }
    }
};
struct EpiBf16 {
    static constexpr bool PERM = true, AFTER_DRAIN = false;
    PG8_GAS bf16_t* O; int ldc; RstdTab R;
    __device__ __forceinline__ void operator()(const f32x4 (&acc)[2][2][4][2], const Unit& u, int wr, int wc, int fr, int fq) const {
        const int row0 = u.pm * BM + wr * 64 + fr, col0 = u.pn * BM + wc * 32 + 8 * fq;
        float rs[2][4]; R.rows(u, wr, fr, fq, rs);
#pragma unroll
        for (int ai = 0; ai < 2; ++ai)
#pragma unroll
            for (int m = 0; m < 4; ++m) { PG8_GAS bf16_t* rowp = O + (size_t)(row0 + ai * HALF + m * 16) * ldc + col0;
#pragma unroll
                for (int bj = 0; bj < 2; ++bj) { const f32x4 v0 = acc[ai][bj][m][0] * rs[ai][m], v1 = acc[ai][bj][m][1] * rs[ai][m];
                    u32x4 w; w.x = cvt_pk_bf16(v0[0], v0[1]); w.y = cvt_pk_bf16(v0[2], v0[3]); w.z = cvt_pk_bf16(v1[0], v1[1]); w.w = cvt_pk_bf16(v1[2], v1[3]);
                    *(PG8_GAS u32x4*)(rowp + bj * HALF) = w; } }
    }
};
struct EpiBf16T {
    static constexpr bool PERM = true, AFTER_DRAIN = false;
    PG8_GAS bf16_t* O; int ldc; RstdTab R;
    __device__ __forceinline__ void operator()(const f32x4 (&acc)[2][2][4][2], const Unit& u, int wr, int wc, int fr, int fq) const {
        const int row0 = u.pm * BM + wr * 64 + fr, col0 = u.pn * BM + wc * 32 + 8 * fq;
        const int sl = R.slot(u.pn); f32x4 cs[2][2];
#pragma unroll
        for (int bj = 0; bj < 2; ++bj) { const int cl = bj * HALF + wc * 32 + 8 * fq;
            if (sl >= 0) { cs[bj][0] = *(const PG8_LAS f32x4*)(R.tab + sl * 256 + cl); cs[bj][1] = *(const PG8_LAS f32x4*)(R.tab + sl * 256 + cl + 4); }
            else {
#pragma unroll
                for (int e = 0; e < 8; ++e) { const PG8_GAS float* p = R.RS + (size_t)(u.pn * BM + cl + e) * 32; float t = 0.f;
#pragma unroll
                    for (int j = 0; j < 32; ++j) t += p[j];
                    cs[bj][e >> 2][e & 3] = rsqrtf(t * (1.0f / 2048.0f) + 1e-6f); } } }
#pragma unroll
        for (int ai = 0; ai < 2; ++ai)
#pragma unroll
            for (int m = 0; m < 4; ++m) { PG8_GAS bf16_t* rowp = O + (size_t)(row0 + ai * HALF + m * 16) * ldc + col0;
#pragma unroll
                for (int bj = 0; bj < 2; ++bj) { const f32x4 v0 = acc[ai][bj][m][0] * cs[bj][0], v1 = acc[ai][bj][m][1] * cs[bj][1];
                    u32x4 w; w.x = cvt_pk_bf16(v0[0], v0[1]); w.y = cvt_pk_bf16(v0[2], v0[3]); w.z = cvt_pk_bf16(v1[0], v1[1]); w.w = cvt_pk_bf16(v1[2], v1[3]);
                    *(PG8_GAS u32x4*)(rowp + bj * HALF) = w; } }
    }
};
struct EpiFnetA {
    static constexpr bool PERM = true, AFTER_DRAIN = false;
    PG8_GAS bf16_t* O;
    __device__ __forceinline__ void operator()(const f32x4 (&acc)[2][2][4][2], const Unit& u, int wr, int wc, int fr, int fq) const {
        const int col0 = u.pn * BM + wc * 32 + 8 * fq;
#pragma unroll
        for (int ai = 0; ai < 2; ++ai)
#pragma unroll
            for (int m = 0; m < 4; ++m) { PG8_GAS bf16_t* rowp = O + (size_t)(u.pm * 128 + wr * 64 + m * 16 + fr) * 8192 + ai * 4096 + col0;
#pragma unroll
                for (int bj = 0; bj < 2; ++bj) { const f32x4 v0 = acc[ai][bj][m][0], v1 = acc[ai][bj][m][1];
                    u32x4 w; w.x = cvt_pk_bf16(v0[0], v0[1]); w.y = cvt_pk_bf16(v0[2], v0[3]); w.z = cvt_pk_bf16(v1[0], v1[1]); w.w = cvt_pk_bf16(v1[2], v1[3]);
                    *(PG8_GAS u32x4*)(rowp + bj * HALF) = w; } }
    }
};
struct EpiF32 {
    static constexpr bool PERM = false, AFTER_DRAIN = false;
    PG8_GAS float* C; int ldc;
    __device__ __forceinline__ void operator()(const f32x4 (&acc)[2][2][4][2], const Unit& u, int wr, int wc, int fr, int fq) const {
        const int row0 = u.pm * BM + wr * 64 + fr, col0 = u.pn * BM + wc * 32 + 4 * fq;
#pragma unroll
        for (int ai = 0; ai < 2; ++ai)
#pragma unroll
            for (int m = 0; m < 4; ++m) { PG8_GAS float* rowp = C + (size_t)(row0 + ai * HALF + m * 16) * ldc + col0;
#pragma unroll
                for (int bj = 0; bj < 2; ++bj)
#pragma unroll
                    for (int n = 0; n < 2; ++n) *(PG8_GAS f32x4*)(rowp + bj * HALF + n * 16) = acc[ai][bj][m][n]; }
    }
};
struct EpiRes {
    static constexpr bool PERM = true, AFTER_DRAIN = false;
    const PG8_GAS float* Xs32; int ldc; PG8_GAS bf16_t* XB; PG8_GAS float* RS;
    __device__ __forceinline__ void operator()(const f32x4 (&acc)[2][2][4][2], const Unit& u, int wr, int wc, int fr, int fq) const {
        const int row0 = u.pm * BM + wr * 64 + fr, col0 = u.pn * BM + wc * 32 + 8 * fq;
#pragma unroll
        for (int ai = 0; ai < 2; ++ai) {
            f32x4 xv[4][2][2];
            if (Xs32) {
#pragma unroll
                for (int m = 0; m < 4; ++m) { const PG8_GAS float* rowp = Xs32 + (size_t)(row0 + ai * HALF + m * 16) * ldc + col0;
#pragma unroll
                    for (int bj = 0; bj < 2; ++bj)
#pragma unroll
                        for (int n = 0; n < 2; ++n) xv[m][bj][n] = __builtin_nontemporal_load((const PG8_GAS f32x4*)(rowp + bj * HALF + n * 4)); }
            } else {
                u32x4 xr[4][2];
#pragma unroll
                for (int m = 0; m < 4; ++m)
#pragma unroll
                    for (int bj = 0; bj < 2; ++bj) xr[m][bj] = *(const PG8_GAS u32x4*)(XB + (size_t)(row0 + ai * HALF + m * 16) * ldc + col0 + bj * HALF);
#pragma unroll
                for (int m = 0; m < 4; ++m)
#pragma unroll
                    for (int bj = 0; bj < 2; ++bj) { const u32x4 r = xr[m][bj];
                        xv[m][bj][0] = (f32x4){__builtin_bit_cast(float, r.x << 16), __builtin_bit_cast(float, r.x & 0xffff0000u), __builtin_bit_cast(float, r.y << 16), __builtin_bit_cast(float, r.y & 0xffff0000u)};
                        xv[m][bj][1] = (f32x4){__builtin_bit_cast(float, r.z << 16), __builtin_bit_cast(float, r.z & 0xffff0000u), __builtin_bit_cast(float, r.w << 16), __builtin_bit_cast(float, r.w & 0xffff0000u)}; }
            }
#pragma unroll
            for (int m = 0; m < 4; ++m) { const int row = row0 + ai * HALF + m * 16; float ss = 0.f;
#pragma unroll
                for (int bj = 0; bj < 2; ++bj) { const f32x4 y0 = xv[m][bj][0] + acc[ai][bj][m][0], y1 = xv[m][bj][1] + acc[ai][bj][m][1];
                    ss += ((y0[0] * y0[0] + y0[1] * y0[1]) + (y0[2] * y0[2] + y0[3] * y0[3])) + ((y1[0] * y1[0] + y1[1] * y1[1]) + (y1[2] * y1[2] + y1[3] * y1[3]));
                    u32x4 w; w.x = cvt_pk_bf16(y0[0], y0[1]); w.y = cvt_pk_bf16(y0[2], y0[3]); w.z = cvt_pk_bf16(y1[0], y1[1]); w.w = cvt_pk_bf16(y1[2], y1[3]);
                    *(PG8_GAS u32x4*)(XB + (size_t)row * ldc + col0 + bj * HALF) = w; }
                ss += __shfl_xor(ss, 16); ss += __shfl_xor(ss, 32); if (fq == 0) RS[(size_t)row * 32 + u.pn * 4 + wc] = ss; }
            asm volatile("" ::: "memory"); }
    }
};
struct EpiSoftmax {
    static constexpr bool PERM = true, AFTER_DRAIN = false;
    PG8_GAS bf16_t* O; int ldc; PG8_LAS float* T1; PG8_LAS float* T2; RstdTab R;
    typedef float f32x2 __attribute__((ext_vector_type(2)));
    static __device__ __forceinline__ f32x2 ex2(float x0, float x1, float c1, float m2) { const f32x2 t = (f32x2){x0, x1} * c1 - m2; f32x2 e; e.x = __builtin_amdgcn_exp2f(t.x); e.y = __builtin_amdgcn_exp2f(t.y); return e; }
    __device__ __forceinline__ void operator()(const f32x4 (&acc)[2][2][4][2], const Unit& u, int wr, int wc, int fr, int fq) const {
        const int row0 = u.pm * BM + wr * 64 + fr, col0 = u.pn * BM + wc * 32 + 8 * fq;
        float m2[2][4]; float rs[2][4]; R.rows(u, wr, fr, fq, rs);
#pragma unroll
        for (int ai = 0; ai < 2; ++ai)
#pragma unroll
            for (int m = 0; m < 4; ++m) { float a = -3.0e38f;
#pragma unroll
                for (int bj = 0; bj < 2; ++bj)
#pragma unroll
                    for (int n = 0; n < 2; ++n) { const f32x4 v = acc[ai][bj][m][n]; a = fmaxf(a, fmaxf(fmaxf(v[0], v[1]), fmaxf(v[2], v[3]))); }
                a = fmaxf(a, __shfl_xor(a, 16)); a = fmaxf(a, __shfl_xor(a, 32));
                if (fq == 0) T1[(ai * HALF + wr * 64 + m * 16 + fr) * 4 + wc] = a * rs[ai][m]; }
        asm volatile("s_waitcnt lgkmcnt(0)" ::: "memory"); __builtin_amdgcn_s_barrier(); asm volatile("" ::: "memory");
#pragma unroll
        for (int ai = 0; ai < 2; ++ai)
#pragma unroll
            for (int m = 0; m < 4; ++m) { const f32x4 t = *(const PG8_LAS f32x4*)(T1 + (ai * HALF + wr * 64 + m * 16 + fr) * 4); const float c1 = rs[ai][m] * 1.4426950408889634f;
                m2[ai][m] = fmaxf(fmaxf(t[0], t[1]), fmaxf(t[2], t[3])) * 1.4426950408889634f; f32x2 a2 = (f32x2){0.f, 0.f};
#pragma unroll
                for (int bj = 0; bj < 2; ++bj)
#pragma unroll
                    for (int n = 0; n < 2; ++n) { const f32x4 v = acc[ai][bj][m][n]; a2 += ex2(v[0], v[1], c1, m2[ai][m]) + ex2(v[2], v[3], c1, m2[ai][m]); }
                float a = a2.x + a2.y; a += __shfl_xor(a, 16); a += __shfl_xor(a, 32);
                if (fq == 0) T2[(ai * HALF + wr * 64 + m * 16 + fr) * 4 + wc] = a; }
        asm volatile("s_waitcnt lgkmcnt(0)" ::: "memory"); __builtin_amdgcn_s_barrier(); asm volatile("" ::: "memory");
#pragma unroll
        for (int ai = 0; ai < 2; ++ai)
#pragma unroll
            for (int m = 0; m < 4; ++m) { const f32x4 t = *(const PG8_LAS f32x4*)(T2 + (ai * HALF + wr * 64 + m * 16 + fr) * 4); const float inv = 1.0f / ((t[0] + t[1]) + (t[2] + t[3])), mm = m2[ai][m], c1 = rs[ai][m] * 1.4426950408889634f;
                PG8_GAS bf16_t* rowp = O + (size_t)(row0 + ai * HALF + m * 16) * ldc + col0;
#pragma unroll
                for (int bj = 0; bj < 2; ++bj) { const f32x4 v0 = acc[ai][bj][m][0], v1 = acc[ai][bj][m][1];
                    const f32x2 p0 = ex2(v0[0], v0[1], c1, mm) * inv, p1 = ex2(v0[2], v0[3], c1, mm) * inv, p2 = ex2(v1[0], v1[1], c1, mm) * inv, p3 = ex2(v1[2], v1[3], c1, mm) * inv;
                    u32x4 w; w.x = cvt_pk_bf16(p0.x, p0.y); w.y = cvt_pk_bf16(p1.x, p1.y); w.z = cvt_pk_bf16(p2.x, p2.y); w.w = cvt_pk_bf16(p3.x, p3.y);
                    *(PG8_GAS u32x4*)(rowp + bj * HALF) = w; } }
    }
};
__device__ __forceinline__ float silu_f(float g) { return g * __builtin_amdgcn_rcpf(1.0f + __expf(-g)); }
struct EpiSwiglu {
    static constexpr bool PERM = true, AFTER_DRAIN = false;
    PG8_GAS bf16_t* H; int ldc; RstdTab R;
    typedef float f32x2 __attribute__((ext_vector_type(2)));
    static __device__ __forceinline__ void quad(f32x4 G, f32x4 U, float a, float q, unsigned& w0, unsigned& w1) {
        const f32x2 G01 = (f32x2){G[0], G[1]}, G23 = (f32x2){G[2], G[3]}, U01 = (f32x2){U[0], U[1]}, U23 = (f32x2){U[2], U[3]};
        const f32x2 t01 = __builtin_elementwise_min(G01 * a, (f32x2){30.f, 30.f}), t23 = __builtin_elementwise_min(G23 * a, (f32x2){30.f, 30.f});
        f32x2 e01, e23; e01.x = __builtin_amdgcn_exp2f(t01.x); e01.y = __builtin_amdgcn_exp2f(t01.y); e23.x = __builtin_amdgcn_exp2f(t23.x); e23.y = __builtin_amdgcn_exp2f(t23.y);
        const f32x2 d01 = e01 + 1.0f, d23 = e23 + 1.0f, pp = d01 * d23;
        const float r = __builtin_amdgcn_rcpf(pp.x * pp.y);
        const f32x2 rp = (f32x2){pp.y, pp.x} * r;
        const f32x2 i01 = rp * d23, i23 = rp * d01;
        const f32x2 h01 = (G01 * U01) * (i01 * q), h23 = (G23 * U23) * (i23 * q);
        w0 = cvt_pk_bf16(h01.x, h01.y); w1 = cvt_pk_bf16(h23.x, h23.y);
    }
    __device__ __forceinline__ void operator()(const f32x4 (&acc)[2][2][4][2], const Unit& u, int wr, int wc, int fr, int fq) const {
        const int row0 = u.pm * BM + wr * 64 + fr, col0 = u.pn * HALF + wc * 32 + 8 * fq;
        float rs[2][4]; R.rows(u, wr, fr, fq, rs);
#pragma unroll
        for (int ai = 0; ai < 2; ++ai)
#pragma unroll
            for (int m = 0; m < 4; ++m) { PG8_GAS bf16_t* rowp = H + (size_t)(row0 + ai * HALF + m * 16) * ldc + col0;
                const float a = rs[ai][m] * -1.4426950408889634f, q = rs[ai][m] * rs[ai][m];
                const f32x4 g0 = acc[ai][0][m][0], g1 = acc[ai][0][m][1], u0 = acc[ai][1][m][0], u1 = acc[ai][1][m][1];
                u32x4 w; unsigned wa, wb, wc2, wd; quad(g0, u0, a, q, wa, wb); quad(g1, u1, a, q, wc2, wd); w.x = wa; w.y = wb; w.z = wc2; w.w = wd;
                *(PG8_GAS u32x4*)rowp = w; }
    }
};

template <class Epi, class Sched, bool ALIGN_EPI = false, bool SP2 = false>
__device__ __forceinline__ void gemm_phase(PG8_LAS unsigned char* lds, const Gemm g, const Sched& S, const Epi& E, int tid_in) {
    int tid = tid_in; asm volatile("" : "+v"(tid));
    const int wid = __builtin_amdgcn_readfirstlane(tid >> 6), lane = tid & 63, wr = wid >> 2, wc = wid & 3, fr = lane & 15, fq = lane >> 4;
    const int K = g.K, nt = K / BK;
    unsigned voffA[2], voffB[2];
#pragma unroll
    for (int i = 0; i < 2; ++i) { int R, C; stage_rc(tid * 16 + i * 8192, R, C); const int Rb = Epi::PERM ? ((R & ~31) + perm32(R & 31)) : R;
        voffA[i] = (unsigned)(R * g.lda + C) * 2u; voffB[i] = (unsigned)(Rb * g.ldb + C) * 2u; }
    const size_t kstep = (size_t)(BK * 2);
    const size_t hstepA = (size_t)HALF * g.lda * 2, hstepB = (size_t)HALF * g.ldb * 2;
    const unsigned ldsw = (unsigned)wid * 1024u;
    const int aoff = lds_byte(wr * 64 + fr, fq * 8), boff = lds_byte(wc * 32 + fr, fq * 8);
#define PG8_SA(b, h) (((b) * 2 + (h)) * HTB)
#define PG8_SB(b, h) ((4 + (b) * 2 + (h)) * HTB)
#define PG8_STAGE(bufoff, gbase, voff) do { _Pragma("unroll") for (int _i = 0; _i < 2; ++_i) \
        __builtin_amdgcn_global_load_lds((const unsigned*)((const char*)(gbase) + (voff)[_i]), (PG8_LAS unsigned*)(lds + (bufoff) + ldsw + _i * 8192), 16, 0, 0); } while (0)
#define PG8_LDA(dst, b, h) do { _Pragma("unroll") for (int m = 0; m < 4; ++m) _Pragma("unroll") for (int k = 0; k < 2; ++k) dst[m][k] = *(const PG8_LAS bf16x8*)(lds + PG8_SA(b, h) + aoff + m * 2048 + k * 1024); } while (0)
#define PG8_LDB(dst, b, h) do { _Pragma("unroll") for (int n = 0; n < 2; ++n) _Pragma("unroll") for (int k = 0; k < 2; ++k) dst[n][k] = *(const PG8_LAS bf16x8*)(lds + PG8_SB(b, h) + boff + n * 2048 + k * 1024); } while (0)
#define PG8_MMA(ai, bj, At, Bt) do { __builtin_amdgcn_s_setprio(1); _Pragma("unroll") for (int m = 0; m < 4; ++m) _Pragma("unroll") for (int n = 0; n < 2; ++n) _Pragma("unroll") for (int k = 0; k < 2; ++k) \
        acc[ai][bj][m][n] = __builtin_amdgcn_mfma_f32_16x16x32_bf16(Bt[n][k], At[m][k], acc[ai][bj][m][n], 0, 0, 0); __builtin_amdgcn_s_setprio(0); } while (0)
#define PG8_WAIT_V(n) asm volatile("s_waitcnt vmcnt(" #n ")" ::: "memory")
#define PG8_WAIT_L(n) asm volatile("s_waitcnt lgkmcnt(" #n ")" ::: "memory")
#define PG8_BAR __builtin_amdgcn_s_barrier()
#define PG8_SCHED __builtin_amdgcn_sched_barrier(0)
    Unit cur, nxt; int ui = 0;
    if (!S.next(0, cur)) return;
    f32x4 acc[2][2][4][2];
#pragma unroll
    for (int a = 0; a < 2; ++a)
#pragma unroll
        for (int b = 0; b < 2; ++b)
#pragma unroll
            for (int m = 0; m < 4; ++m)
#pragma unroll
                for (int n = 0; n < 2; ++n) acc[a][b][m][n] = (f32x4){0.f, 0.f, 0.f, 0.f};
    bf16x8 At[4][2], B0[2][2], B1[2][2];
    const char* cA = (const char*)g.A + cur.aoff; const char* cB = (const char*)g.Bt + cur.boff;
    S.a_ready(cur);
    if constexpr (SP2) {
        PG8_STAGE(PG8_SB(0, 0), cB, voffB); PG8_STAGE(PG8_SB(0, 1), cB + hstepB, voffB); PG8_STAGE(PG8_SA(0, 0), cA, voffA); PG8_STAGE(PG8_SA(0, 1), cA + hstepA, voffA);
        if (wr == 1) PG8_BAR;
        PG8_WAIT_V(2); PG8_BAR;
        PG8_STAGE(PG8_SB(1, 0), cB + kstep, voffB); PG8_STAGE(PG8_SA(1, 0), cA + kstep, voffA); PG8_STAGE(PG8_SB(1, 1), cB + hstepB + kstep, voffB);
        PG8_WAIT_V(6); PG8_BAR;
    } else {
        PG8_STAGE(PG8_SB(0, 0), cB, voffB); PG8_STAGE(PG8_SA(0, 0), cA, voffA); PG8_STAGE(PG8_SB(0, 1), cB + hstepB, voffB); PG8_STAGE(PG8_SA(0, 1), cA + hstepA, voffA);
        if (wr == 1) PG8_BAR;
        PG8_WAIT_V(4); PG8_BAR;
        PG8_STAGE(PG8_SB(1, 0), cB + kstep, voffB); PG8_STAGE(PG8_SA(1, 0), cA + kstep, voffA); PG8_STAGE(PG8_SB(1, 1), cB + hstepB + kstep, voffB);
        PG8_WAIT_V(6); PG8_BAR;
    }
    for (;;) {
        const bool has_next = S.next(ui + 1, nxt);
        const char* nA = has_next ? (const char*)g.A + nxt.aoff : cA; const char* nB = has_next ? (const char*)g.Bt + nxt.boff : cB;
        for (int t = 0; t < nt; t += 2) {
            const bool last = (t == nt - 2);
            const char* a1 = cA + (size_t)(t + 1) * kstep;
            const char* a2 = last ? nA : cA + (size_t)(t + 2) * kstep; const char* b2 = last ? nB : cB + (size_t)(t + 2) * kstep;
            const char* a3 = a2 + kstep; const char* b3 = b2 + kstep;
            if (last && has_next) S.a_ready(nxt);
            if constexpr (SP2) {
            PG8_LDB(B0, 0, 0); PG8_LDB(B1, 0, 1); PG8_SCHED; PG8_LDA(At, 0, 0); PG8_STAGE(PG8_SA(1, 1), a1 + hstepA, voffA);
            PG8_WAIT_V(8); PG8_WAIT_L(0); PG8_BAR; PG8_MMA(0, 0, At, B0); PG8_MMA(0, 1, At, B1); PG8_BAR; PG8_SCHED;
            PG8_LDA(At, 0, 1); PG8_STAGE(PG8_SB(0, 0), b2, voffB); PG8_STAGE(PG8_SB(0, 1), b2 + hstepB, voffB); PG8_STAGE(PG8_SA(0, 0), a2, voffA);
            PG8_WAIT_V(8); PG8_WAIT_L(0); PG8_BAR; PG8_MMA(1, 0, At, B0); PG8_MMA(1, 1, At, B1); PG8_BAR; PG8_SCHED;
            PG8_LDB(B0, 1, 0); PG8_LDB(B1, 1, 1); PG8_SCHED; PG8_LDA(At, 1, 0); PG8_STAGE(PG8_SA(0, 1), a2 + hstepA, voffA);
            PG8_WAIT_V(8); PG8_WAIT_L(0); PG8_BAR; PG8_MMA(0, 0, At, B0); PG8_MMA(0, 1, At, B1); PG8_BAR; PG8_SCHED;
            PG8_LDA(At, 1, 1); PG8_STAGE(PG8_SB(1, 0), b3, voffB); PG8_STAGE(PG8_SB(1, 1), b3 + hstepB, voffB); PG8_STAGE(PG8_SA(1, 0), a3, voffA);
            PG8_WAIT_V(8); PG8_WAIT_L(0); PG8_BAR; PG8_MMA(1, 0, At, B0); PG8_MMA(1, 1, At, B1); PG8_BAR; PG8_SCHED;
            } else {
            PG8_LDB(B0, 0, 0); PG8_SCHED; PG8_LDA(At, 0, 0); PG8_STAGE(PG8_SA(1, 1), a1 + hstepA, voffA);
            PG8_WAIT_L(8); PG8_BAR; PG8_WAIT_L(0); PG8_MMA(0, 0, At, B0); PG8_BAR; PG8_SCHED;
            PG8_LDB(B1, 0, 1); PG8_STAGE(PG8_SB(0, 0), b2, voffB);
            PG8_BAR; PG8_WAIT_L(0); PG8_MMA(0, 1, At, B1); PG8_BAR;
            PG8_LDA(At, 0, 1); PG8_STAGE(PG8_SA(0, 0), a2, voffA);
            PG8_BAR; PG8_WAIT_L(0); PG8_MMA(1, 0, At, B0); PG8_BAR; PG8_SCHED;
            PG8_STAGE(PG8_SB(0, 1), b2 + hstepB, voffB);
            PG8_WAIT_V(6); PG8_BAR; PG8_MMA(1, 1, At, B1); PG8_BAR;
            PG8_LDB(B0, 1, 0); PG8_SCHED; PG8_LDA(At, 1, 0); PG8_STAGE(PG8_SA(0, 1), a2 + hstepA, voffA);
            PG8_WAIT_L(8); PG8_BAR; PG8_WAIT_L(0); PG8_MMA(0, 0, At, B0); PG8_BAR; PG8_SCHED;
            PG8_LDB(B1, 1, 1); PG8_STAGE(PG8_SB(1, 0), b3, voffB);
            PG8_BAR; PG8_WAIT_L(0); PG8_MMA(0, 1, At, B1); PG8_BAR;
            PG8_LDA(At, 1, 1); PG8_STAGE(PG8_SA(1, 0), a3, voffA);
            PG8_BAR; PG8_WAIT_L(0); PG8_MMA(1, 0, At, B0); PG8_BAR; PG8_SCHED;
            PG8_STAGE(PG8_SB(1, 1), b3 + hstepB, voffB);
            PG8_WAIT_V(6); PG8_BAR; PG8_MMA(1, 1, At, B1); PG8_BAR;
            }
        }
        if constexpr (ALIGN_EPI) { if (wr == 0) PG8_BAR; }
        if constexpr (!Epi::AFTER_DRAIN) { E(acc, cur, wr, wc, fr, fq); S.done(cur); }
        if (!has_next) break;
#pragma unroll
        for (int a = 0; a < 2; ++a)
#pragma unroll
            for (int b = 0; b < 2; ++b)
#pragma unroll
                for (int m = 0; m < 4; ++m)
#pragma unroll
                    for (int n = 0; n < 2; ++n) acc[a][b][m][n] = (f32x4){0.f, 0.f, 0.f, 0.f};
        cur = nxt; cA = nA; cB = nB; ++ui;
        if constexpr (ALIGN_EPI) { if (wr == 1) PG8_BAR; }
    }
    PG8_WAIT_V(0);
    if constexpr (!ALIGN_EPI) { if (wr == 0) PG8_BAR; }
    PG8_BAR;
    if constexpr (Epi::AFTER_DRAIN) { E.fused(acc, cur, wr, wc, fr, fq, lds, wid, lane); S.done(cur); }
#undef PG8_SA
#undef PG8_SB
#undef PG8_STAGE
#undef PG8_LDA
#undef PG8_LDB
#undef PG8_MMA
#undef PG8_WAIT_V
#undef PG8_WAIT_L
#undef PG8_BAR
#undef PG8_SCHED
}
}

constexpr int NB = 8, SEQ = 4096, DM = 2048, NL = 4, MTOK = NB * SEQ, NMEM = 256;
constexpr int DIN = 5152, NPROJ = 3840, NWIN = 5376, DFF = 5632;
constexpr int PQ = 0, PK = 256, PV = 512, PG = 1024, PLR = 1536, PUF = 1792, PUS = 2304, WUH = 3840;
constexpr float EPS = 1e-6f;
constexpr int NWAVES = 8, NTHR = 512;

constexpr size_t MiB = 1u << 20;
constexpr size_t WS_CTL = 0, CTL_ZERO_BYTES = 1 * MiB;
constexpr size_t WS_WIN = 1 * MiB, WS_WOUT = 23 * MiB, WS_WQB = 31 * MiB, WS_WKV = 39 * MiB, WS_WXO = 55 * MiB, WS_WGU = 63 * MiB, WS_WD = 107 * MiB;
constexpr size_t WS_KVB = 129 * MiB, WS_MT = 145 * MiB, WS_VWO = 177 * MiB, WS_MEMN = 209 * MiB;
constexpr size_t WS_XB = 217 * MiB, WS_PROJ = 345 * MiB, WS_MIX = 697 * MiB, WS_OF = 825 * MiB, WS_FU = 889 * MiB, WS_FILT = 1017 * MiB, WS_UT = 1049 * MiB, WS_YT = 1145 * MiB;
constexpr size_t WS_FU2 = 889 * MiB, WS_FY = 953 * MiB, WS_C2 = 1177 * MiB, WS_S2 = 1186 * MiB, WS_FE = 1194 * MiB, WS_FO = 1211 * MiB, WS_Y2K = 1227 * MiB, WS_A1 = 1241 * MiB;
constexpr int FK1 = 2176;
constexpr size_t WS_GS = 825 * MiB, WS_GU = 1242 * MiB, WS_GD = 1370 * MiB;
constexpr size_t WS_RSS = 1371 * MiB;
constexpr size_t WS_END = 1375 * MiB;
constexpr int CW_BAR = 4096;

constexpr int RING_OFF = 0, RING_BYTES = 131072;
constexpr int LDSCTL_OFF = RING_BYTES, MISC_OFF = LDSCTL_OFF + 320;
constexpr int LDS_BYTES = 147456;

#define GAS __attribute__((address_space(1)))
#define LAS __attribute__((address_space(3)))
typedef unsigned short bf16;
typedef unsigned v4u __attribute__((ext_vector_type(4)));
typedef unsigned v2u __attribute__((ext_vector_type(2)));
typedef float f32x4 __attribute__((ext_vector_type(4)));
typedef GAS unsigned gu32;
#define LDS_WAIT() asm volatile("s_waitcnt lgkmcnt(0)" ::: "memory")
__device__ __forceinline__ unsigned f2bf(float f) { unsigned u = __builtin_bit_cast(unsigned, f); return (u + 0x7fffu + ((u >> 16) & 1u)) >> 16; }
__device__ __forceinline__ unsigned pk2(float lo, float hi) { return f2bf(lo) | (f2bf(hi) << 16); }
__device__ __forceinline__ float bf2f(bf16 h) { return __builtin_bit_cast(float, ((unsigned)h) << 16); }
__device__ __forceinline__ float bflo(unsigned w) { return __builtin_bit_cast(float, w << 16); }
__device__ __forceinline__ float bfhi(unsigned w) { return __builtin_bit_cast(float, w & 0xffff0000u); }

#define XB_TMO      128
#define XB_XCNT(j)  (256  + 64 * (j))
#define XB_XSUB(j)  (1280 + 64 * (j))
#define XB_XGEN(j)  (2304 + 64 * (j))
#define XB_TOP      3328
#define XB_TOPGEN   3392
#define XCD_BAR_WORDS 3456
#define XB_SPIN_CAP (1u << 18)

__device__ __forceinline__ unsigned xb_ld(unsigned* p)              { return __hip_atomic_load(p, __ATOMIC_RELAXED, __HIP_MEMORY_SCOPE_AGENT); }
__device__ __forceinline__ unsigned xb_add(unsigned* p, unsigned v) { return __hip_atomic_fetch_add(p, v, __ATOMIC_RELAXED, __HIP_MEMORY_SCOPE_AGENT); }
__device__ __forceinline__ unsigned xb_xcc_id() { return (unsigned)__builtin_amdgcn_s_getreg((3 << 11) | 20) & 0xFu; }
#define XB_SPIN(cond, bar) do { unsigned _sp = 0; while (cond) { __builtin_amdgcn_s_sleep(1); \
    if ((++_sp & 255u) == 0u) { if (xb_ld(&(bar)[XB_TMO])) break; if (_sp > XB_SPIN_CAP) { atomicAdd(&(bar)[XB_TMO], 1u); break; } } } } while (0)

struct XcdBarrier { unsigned* bar; unsigned x; volatile LAS unsigned* st; };

__device__ __forceinline__ XcdBarrier xcd_barrier_post(unsigned* bar, volatile LAS unsigned* st, int tid) {
    XcdBarrier b; b.bar = bar; b.x = xb_xcc_id(); b.st = st;
    if (tid == 0) (void)xb_add(&bar[XB_XCNT(b.x)], 1u);
    return b;
}
__device__ __forceinline__ void xcd_barrier_complete(unsigned* bar, unsigned x, unsigned& nloc, unsigned& nx) {
    const unsigned G = gridDim.x * gridDim.y * gridDim.z;
    unsigned sum, cnt, mine, sp = 0u;
    for (;;) {
        sum = 0u; cnt = 0u; mine = 0u;
#pragma unroll
        for (unsigned j = 0; j < 16; ++j) { const unsigned c = xb_ld(&bar[XB_XCNT(j)]); sum += c; cnt += (c > 0u) ? 1u : 0u; mine = (j == x) ? c : mine; }
        if (sum == G) break;
        __builtin_amdgcn_s_sleep(1);
        if ((++sp & 255u) == 0u) { if (xb_ld(&bar[XB_TMO])) break; if (sp > XB_SPIN_CAP) { atomicAdd(&bar[XB_TMO], 1u); break; } }
    }
    nloc = mine > 0u ? mine : 1u; nx = cnt > 0u ? cnt : 1u;
}
__device__ __forceinline__ void xcd_barrier(const XcdBarrier& b, int tid) {
    asm volatile("s_waitcnt vmcnt(0)" ::: "memory");
    __syncthreads();
    if (tid == 0) {
        unsigned* bar = b.bar;
        __builtin_amdgcn_s_waitcnt(0);
        unsigned nloc = b.st[0], nx = b.st[1];
        if (nloc == 0u) { xcd_barrier_complete(bar, b.x, nloc, nx); b.st[0] = nloc; b.st[1] = nx; }
        const unsigned old = xb_add(&bar[XB_XSUB(b.x)], 1u);
        const unsigned gen = old / nloc;
        if (old + 1u == (gen + 1u) * nloc) {
            __builtin_amdgcn_fence(__ATOMIC_RELEASE, "agent");
            asm volatile("s_waitcnt vmcnt(0)" ::: "memory");
            const unsigned og = xb_add(&bar[XB_TOP], 1u);
            const unsigned tg = og / nx;
            if (og + 1u == (tg + 1u) * nx) xb_add(&bar[XB_TOPGEN], 1u);
            else XB_SPIN(xb_ld(&bar[XB_TOPGEN]) == tg, bar);
            __builtin_amdgcn_fence(__ATOMIC_ACQUIRE, "agent");
            xb_add(&bar[XB_XGEN(b.x)], 1u);
            asm volatile("s_waitcnt vmcnt(0)" ::: "memory");
        } else {
            XB_SPIN(xb_ld(&bar[XB_XGEN(b.x)]) == gen, bar);
            __builtin_amdgcn_fence(__ATOMIC_ACQUIRE, "agent");
            asm volatile("s_waitcnt vmcnt(0)" ::: "memory");
        }
    }
    __syncthreads();
}

__device__ __forceinline__ float wave_sum(float v) {
#pragma unroll
    for (int o = 1; o < 64; o <<= 1) v += __shfl_xor(v, o);
    return v;
}
__device__ __forceinline__ float wave_max(float v) {
#pragma unroll
    for (int o = 1; o < 64; o <<= 1) v = fmaxf(v, __shfl_xor(v, o));
    return v;
}
__device__ __forceinline__ float block_sum(float v, LAS float* red, int wave, int lane) {
    v = wave_sum(v); if (lane == 0) red[wave] = v; __syncthreads();
    float s = 0.f;
#pragma unroll
    for (int i = 0; i < 8; ++i) s += red[i];
    __syncthreads(); return s;
}
__device__ __forceinline__ float log_sigmoid_f(float x) { return fminf(x, 0.f) - __logf(1.0f + __expf(-fabsf(x))); }

struct Params {
    const float* in[26]; float* out; unsigned char* ws;
    int step_lo, step_hi, pad0, pad1;
};
__device__ __forceinline__ int opaque_i(int x) { asm volatile("" : "+v"(x)); return __builtin_amdgcn_readfirstlane(x); }
template <class T> __device__ __forceinline__ T* opaque_p(T* p) { const unsigned long long v = (unsigned long long)p; const unsigned lo = (unsigned)opaque_i((int)(unsigned)v), hi = (unsigned)opaque_i((int)(unsigned)(v >> 32)); return (T*)(((unsigned long long)hi << 32) | lo); }
__device__ __forceinline__ const float* pin(const Params& P, int i) { return P.in[opaque_i(i)]; }

struct TrItem { const float* src; int ldsrc, nsrc0, k0, lddst, nd0; bf16* dst; const float* gain; float sc; };
__device__ __forceinline__ void tr_load(const TrItem& t, f32x4 (&v)[8], int lane) {
    const int lr = lane >> 3, lc = (lane & 7) * 4;
#pragma unroll
    for (int i = 0; i < 8; ++i) v[i] = *(const GAS f32x4*)(t.src + (size_t)(t.k0 + 8 * i + lr) * t.ldsrc + t.nsrc0 + lc);
}
__device__ __forceinline__ void tr_finish(const TrItem& t, const f32x4 (&v)[8], LAS float* scr, int lane) {
    const int lr = lane >> 3, lc = (lane & 7) * 4;
#pragma unroll
    for (int i = 0; i < 8; ++i) { const int kk = 8 * i + lr; const float gs = (t.gain ? t.gain[t.k0 + kk] : 1.f) * t.sc; LAS float* d = scr + kk * 33 + lc; d[0] = v[i].x * gs; d[1] = v[i].y * gs; d[2] = v[i].z * gs; d[3] = v[i].w * gs; }
    LDS_WAIT(); asm volatile("" ::: "memory");
    const int c = lane & 7;
#pragma unroll
    for (int j = 0; j < 4; ++j) { const int n = (lane >> 3) + 8 * j; const LAS float* s = scr + (8 * c) * 33 + n;
        v4u o; o.x = pk2(s[0 * 33], s[1 * 33]); o.y = pk2(s[2 * 33], s[3 * 33]); o.z = pk2(s[4 * 33], s[5 * 33]); o.w = pk2(s[6 * 33], s[7 * 33]);
        *(GAS v4u*)(t.dst + (size_t)(t.nd0 + n) * t.lddst + t.k0 + 8 * c) = o; }
    LDS_WAIT(); asm volatile("" ::: "memory");
}
__device__ __forceinline__ void norm_row(const float* xrow, bf16* orow, float* xcopy, int lane) {
    const GAS f32x4* xr = (const GAS f32x4*)xrow + lane;
    f32x4 v[8]; float s = 0.f;
#pragma unroll
    for (int j = 0; j < 8; ++j) { v[j] = xr[64 * j]; s += (v[j].x * v[j].x + v[j].y * v[j].y) + (v[j].z * v[j].z + v[j].w * v[j].w); }
    const float rstd = rsqrtf(wave_sum(s) * (1.f / DM) + EPS);
    GAS v2u* o8 = (GAS v2u*)orow + lane;
#pragma unroll
    for (int j = 0; j < 8; ++j) { v2u w; w.x = pk2(v[j].x * rstd, v[j].y * rstd); w.y = pk2(v[j].z * rstd, v[j].w * rstd); o8[64 * j] = w; }
    if (xcopy) { GAS f32x4* xc = (GAS f32x4*)xcopy + lane;
#pragma unroll
        for (int j = 0; j < 8; ++j) xc[64 * j] = v[j]; }
}
__device__ __forceinline__ void final_norm_row(const bf16* xrow, float* orow, const float* g, int lane) {
    const GAS v4u* xr = (const GAS v4u*)xrow + lane; float v[4][8]; float s = 0.f;
#pragma unroll
    for (int j = 0; j < 4; ++j) { const v4u r = xr[64 * j]; v[j][0] = bflo(r.x); v[j][1] = bfhi(r.x); v[j][2] = bflo(r.y); v[j][3] = bfhi(r.y); v[j][4] = bflo(r.z); v[j][5] = bfhi(r.z); v[j][6] = bflo(r.w); v[j][7] = bfhi(r.w);
#pragma unroll
        for (int e = 0; e < 8; ++e) s += v[j][e] * v[j][e]; }
    const float rstd = rsqrtf(wave_sum(s) * (1.f / DM) + EPS);
#pragma unroll
    for (int j = 0; j < 4; ++j) { const int c0 = (64 * j + lane) * 8; const f32x4 g0 = *(const GAS f32x4*)(g + c0), g1 = *(const GAS f32x4*)(g + c0 + 4);
        *(GAS f32x4*)(orow + c0) = (f32x4){v[j][0] * rstd * g0.x, v[j][1] * rstd * g0.y, v[j][2] * rstd * g0.z, v[j][3] * rstd * g0.w};
        *(GAS f32x4*)(orow + c0 + 4) = (f32x4){v[j][4] * rstd * g1.x, v[j][5] * rstd * g1.y, v[j][6] * rstd * g1.z, v[j][7] * rstd * g1.w}; }
}
__device__ __forceinline__ void norm_row_gain_f32(const float* xrow, float* orow, const float* g, int lane) {
    const GAS f32x4* xr = (const GAS f32x4*)xrow + lane; const GAS f32x4* gr = (const GAS f32x4*)g + lane;
    f32x4 v[8]; float s = 0.f;
#pragma unroll
    for (int j = 0; j < 8; ++j) { v[j] = xr[64 * j]; s += (v[j].x * v[j].x + v[j].y * v[j].y) + (v[j].z * v[j].z + v[j].w * v[j].w); }
    const float rstd = rsqrtf(wave_sum(s) * (1.f / DM) + EPS);
    GAS f32x4* o = (GAS f32x4*)orow + lane;
#pragma unroll
    for (int j = 0; j < 8; ++j) o[64 * j] = v[j] * rstd * gr[64 * j];
}
__device__ __forceinline__ void norm_row_gain_bf16(const float* xrow, bf16* orow, const float* g, int lane) {
    const GAS f32x4* xr = (const GAS f32x4*)xrow + lane; const GAS f32x4* gr = (const GAS f32x4*)g + lane;
    f32x4 v[8]; float s = 0.f;
#pragma unroll
    for (int j = 0; j < 8; ++j) { v[j] = xr[64 * j]; s += (v[j].x * v[j].x + v[j].y * v[j].y) + (v[j].z * v[j].z + v[j].w * v[j].w); }
    const float rstd = rsqrtf(wave_sum(s) * (1.f / DM) + EPS);
    GAS v2u* o8 = (GAS v2u*)orow + lane;
#pragma unroll
    for (int j = 0; j < 8; ++j) { const f32x4 y = v[j] * rstd * gr[64 * j]; v2u w; w.x = pk2(y.x, y.y); w.y = pk2(y.z, y.w); o8[64 * j] = w; }
}

__device__ __forceinline__ void phase_a(const Params& P, unsigned char* ws, float* xres, int l, LAS unsigned char* lds, int tid, int lane, int wave, int bid, int G) {
    bf16* WinT = (bf16*)(ws + WS_WIN); bf16* WoutT = (bf16*)(ws + WS_WOUT); bf16* WqB = (bf16*)(ws + WS_WQB); bf16* WkvT = (bf16*)(ws + WS_WKV);
    bf16* WxoT = (bf16*)(ws + WS_WXO); bf16* WguT = (bf16*)(ws + WS_WGU); bf16* WdT = (bf16*)(ws + WS_WD);
    const float* g0 = pin(P, 2) + (size_t)(l * 3 + 0) * DM; const float* g1 = g0 + DM; const float* g2 = g1 + DM;
    const float* w_in = pin(P, 3) + (size_t)l * DM * DIN;
    const float* w_out = pin(P, 18) + (size_t)l * DM * DM;
    const float* w_xq = pin(P, 20) + (size_t)l * DM * DM;
    const float* w_xkv = pin(P, 21) + (size_t)l * DM * 2 * DM;
    const float* w_xo = pin(P, 22) + (size_t)l * DM * DM;
    const float* w_gu = pin(P, 23) + (size_t)l * DM * 2 * DFF;
    const float* w_dn = pin(P, 24) + (size_t)l * DFF * DM;
    const int gw = bid * NWAVES + wave, NGW = G * NWAVES, gt = bid * NTHR + tid, NGT = G * NTHR;
    LAS float* scr = (LAS float*)(lds + wave * 16384);
    constexpr int I1 = 49 * 32, I2 = 112 * 32, I3 = 64 * 32, I4 = 128 * 32, I5 = 64 * 32, I6 = 352 * 32, I7 = 64 * 88, ITOT = I1 + I2 + I3 + I4 + I5 + I6 + I7;
    auto mk_item = [&](int it) -> TrItem {
        int r = it; TrItem t; t.gain = nullptr; t.sc = 1.f;
        if (r < I1) { const int kb = r / 49, nb = r % 49; t.src = w_in; t.ldsrc = DIN; t.nsrc0 = 32 * nb; t.k0 = 64 * kb; t.dst = WinT; t.lddst = DM; t.nd0 = 32 * nb; t.gain = g0; t.sc = nb < 8 ? 0.125f : 1.f; }
        else if ((r -= I1) < I2) { const int kb = r / 112, nb = r % 112; t.src = w_in; t.ldsrc = DIN; t.nsrc0 = 1568 + 32 * nb; t.k0 = 64 * kb; t.dst = WinT; t.lddst = DM; t.gain = g0; const int cc = 32 * nb;
            t.nd0 = cc < 512 ? PUF + cc : cc < 2048 ? WUH + (cc - 512) : PUS + (cc - 2048); }
        else if ((r -= I2) < I3) { const int kb = r / 64, nb = r % 64; t.src = w_out; t.ldsrc = DM; t.nsrc0 = 32 * nb; t.k0 = 64 * kb; t.dst = WoutT; t.lddst = DM; t.nd0 = 32 * nb; }
        else if ((r -= I3) < I4) { const int kb = r / 128, nb = r % 128; t.src = w_xkv; t.ldsrc = 2 * DM; t.nsrc0 = 32 * nb; t.k0 = 64 * kb; t.dst = WkvT; t.lddst = DM; t.nd0 = 32 * nb; }
        else if ((r -= I4) < I5) { const int kb = r / 64, nb = r % 64; t.src = w_xo; t.ldsrc = DM; t.nsrc0 = 32 * nb; t.k0 = 64 * kb; t.dst = WxoT; t.lddst = DM; t.nd0 = 32 * nb; }
        else if ((r -= I5) < I6) { const int kb = r / 352, nb = r % 352, c0 = 32 * nb; t.src = w_gu; t.ldsrc = 2 * DFF; t.nsrc0 = c0; t.k0 = 64 * kb; t.dst = WguT; t.lddst = DM; t.gain = g2;
            t.nd0 = c0 < DFF ? (c0 / 128) * 256 + (c0 % 128) : ((c0 - DFF) / 128) * 256 + 128 + ((c0 - DFF) % 128); }
        else { r -= I6; const int kb = r / 64, nb = r % 64; t.src = w_dn; t.ldsrc = DM; t.nsrc0 = 32 * nb; t.k0 = 64 * kb; t.dst = WdT; t.lddst = DFF; t.nd0 = 32 * nb; }
        return t; };
    { f32x4 va[8], vb[8]; int it = gw;
      if (it < ITOT) { TrItem ta = mk_item(it); tr_load(ta, va, lane);
          for (;;) { const int itb = it + NGW; const bool hb = itb < ITOT; TrItem tb = ta; if (hb) { tb = mk_item(itb); tr_load(tb, vb, lane); }
              tr_finish(ta, va, scr, lane); if (!hb) break;
              const int ita = itb + NGW; const bool ha = ita < ITOT; if (ha) { ta = mk_item(ita); tr_load(ta, va, lane); }
              tr_finish(tb, vb, scr, lane); if (!ha) break; it = ita; } } }
    for (int i0 = gt; i0 < DM * DM / 8; i0 += 4 * NGT) { f32x4 a[4], b[4]; float sg[4];
#pragma unroll
        for (int j = 0; j < 4; ++j) { const int i1 = i0 + j * NGT, i = i1 < DM * DM / 8 ? i1 : DM * DM / 8 - 1; sg[j] = g1[i >> 8];
            a[j] = *(const GAS f32x4*)(w_xq + (size_t)i * 8); b[j] = *(const GAS f32x4*)(w_xq + (size_t)i * 8 + 4); }
        asm volatile("" ::: "memory");
#pragma unroll
        for (int j = 0; j < 4; ++j) { const int i = i0 + j * NGT; const float s = sg[j] * 0.044194173824159216f;
            v4u o; o.x = pk2(a[j].x * s, a[j].y * s); o.y = pk2(a[j].z * s, a[j].w * s); o.z = pk2(b[j].x * s, b[j].y * s); o.w = pk2(b[j].z * s, b[j].w * s);
            if (i < DM * DM / 8) *(GAS v4u*)(WqB + (size_t)i * 8) = o; } }
    __syncthreads();
    { float* filtT = (float*)(ws + WS_FILT);
      const float* w1 = pin(P, 8) + (size_t)l * 33 * 64; const float* b1 = pin(P, 9) + l * 64; const float* w2 = pin(P, 10) + (size_t)l * 64 * 64; const float* b2 = pin(P, 11) + l * 64;
      const float* w3 = pin(P, 12) + (size_t)l * 64 * 2048; const float* fr = pin(P, 13) + l * 64; const float* dec = pin(P, 14) + (size_t)l * 2048;
      LAS float* ft = (LAS float*)lds; LAS float* h1 = ft + 16 * 34; LAS float* h2 = h1 + 16 * 64;
      LAS float* w1s = h2 + 16 * 64; LAS float* w2s = w1s + 33 * 64;
      for (int i = tid; i < 33 * 64; i += NTHR) w1s[i] = w1[i];
      for (int i = tid; i < 64 * 64; i += NTHR) w2s[i] = w2[i];
      __syncthreads();
      for (int pg = bid; pg < SEQ / 16; pg += G) {
          if (tid < 256) { const int p = tid >> 4, i = tid & 15; const float t = (float)(pg * 16 + p) * (1.0f / SEQ);
              const float f = 1e-4f + (float)i * ((15.0f - 1e-4f) / 15.0f); const float rev = t * f; ft[p * 34 + 1 + i] = __builtin_amdgcn_cosf(rev); ft[p * 34 + 17 + i] = -__builtin_amdgcn_sinf(rev);
              if (i == 0) ft[p * 34] = t; }
          __syncthreads();
#pragma unroll
          for (int e = 0; e < 2; ++e) { const int o = tid + 512 * e, p = o >> 6, j = o & 63; float a = b1[j];
#pragma unroll 11
              for (int i = 0; i < 33; ++i) a += ft[p * 34 + i] * w1s[i * 64 + j];
              h1[p * 64 + j] = __builtin_amdgcn_sinf(fr[j] * a * 0.15915494309189535f); }
          __syncthreads();
#pragma unroll
          for (int e = 0; e < 2; ++e) { const int o = tid + 512 * e, p = o >> 6, j = o & 63; float a = b2[j];
#pragma unroll 16
              for (int i = 0; i < 64; ++i) a += h1[p * 64 + i] * w2s[i * 64 + j];
              h2[j * 16 + p] = __builtin_amdgcn_sinf(fr[j] * a * 0.15915494309189535f); }
          __syncthreads();
#pragma unroll 1
          for (int q = 0; q < 4; ++q) { const int n = tid + 512 * q; float a[16];
#pragma unroll
              for (int p = 0; p < 16; ++p) a[p] = 0.f;
#pragma unroll 1
              for (int j0 = 0; j0 < 64; j0 += 16) { float wv[16];
#pragma unroll
                  for (int jj = 0; jj < 16; ++jj) wv[jj] = w3[(j0 + jj) * 2048 + n];
#pragma unroll
                  for (int jj = 0; jj < 16; ++jj) { const LAS f32x4* hp = (const LAS f32x4*)(h2 + (j0 + jj) * 16); const f32x4 ha = hp[0], hb = hp[1], hc = hp[2], hd = hp[3]; const float w = wv[jj];
                      a[0] += ha.x * w; a[1] += ha.y * w; a[2] += ha.z * w; a[3] += ha.w * w; a[4] += hb.x * w; a[5] += hb.y * w; a[6] += hb.z * w; a[7] += hb.w * w;
                      a[8] += hc.x * w; a[9] += hc.y * w; a[10] += hc.z * w; a[11] += hc.w * w; a[12] += hd.x * w; a[13] += hd.y * w; a[14] += hd.z * w; a[15] += hd.w * w; } }
              const float dc = fabsf(dec[n]);
#pragma unroll
              for (int p4 = 0; p4 < 4; ++p4) { f32x4 o;
                  o.x = a[4 * p4 + 0] * __expf(-(float)(pg * 16 + 4 * p4 + 0) * (1.0f / SEQ) * dc); o.y = a[4 * p4 + 1] * __expf(-(float)(pg * 16 + 4 * p4 + 1) * (1.0f / SEQ) * dc);
                  o.z = a[4 * p4 + 2] * __expf(-(float)(pg * 16 + 4 * p4 + 2) * (1.0f / SEQ) * dc); o.w = a[4 * p4 + 3] * __expf(-(float)(pg * 16 + 4 * p4 + 3) * (1.0f / SEQ) * dc);
                  *(GAS f32x4*)(filtT + (size_t)n * SEQ + pg * 16 + 4 * p4) = o; } }
          __syncthreads();
      } }
    if (l == 0) { bf16* xb = (bf16*)(ws + WS_XB); float* rss = (float*)(ws + WS_RSS); const float* xin = pin(P, 0);
      for (int m = gw; m < MTOK; m += NGW) { const GAS f32x4* xr = (const GAS f32x4*)(xin + (size_t)m * DM) + lane; f32x4 v[8]; float ss = 0.f;
#pragma unroll
          for (int j = 0; j < 8; ++j) { v[j] = xr[64 * j]; ss += (v[j].x * v[j].x + v[j].y * v[j].y) + (v[j].z * v[j].z + v[j].w * v[j].w); }
          ss = wave_sum(ss); GAS v2u* o8 = (GAS v2u*)(xb + (size_t)m * DM) + lane;
#pragma unroll
          for (int j = 0; j < 8; ++j) { v2u w; w.x = pk2(v[j].x, v[j].y); w.y = pk2(v[j].z, v[j].w); o8[64 * j] = w; }
          if (lane < 32) rss[(size_t)m * 32 + lane] = lane == 0 ? ss : 0.f; } }
    if (l == 0) {
        typedef float f32x2 __attribute__((ext_vector_type(2)));
        __syncthreads();
        LAS f32x2* tw = (LAS f32x2*)lds;
        for (int i = tid; i < 4096; i += NTHR) { const float rv = (float)i * (1.0f / 4096.0f); tw[i] = (f32x2){__builtin_amdgcn_cosf(rv) * 0.001381067932f, __builtin_amdgcn_sinf(rv) * 0.001381067932f}; }
        __syncthreads();
        bf16* C2 = (bf16*)(ws + WS_C2); bf16* S2 = (bf16*)(ws + WS_S2);
        for (int i = gt; i < 2048 * (FK1 / 8); i += NGT) { const int srow = i / (FK1 / 8), t0 = (i % (FK1 / 8)) * 8; float cv[8];
#pragma unroll
            for (int e = 0; e < 8; ++e) cv[e] = (t0 + e) <= 2048 ? tw[(srow * (t0 + e)) & 4095].x : 0.f;
            v4u oc; oc.x = pk2(cv[0], cv[1]); oc.y = pk2(cv[2], cv[3]); oc.z = pk2(cv[4], cv[5]); oc.w = pk2(cv[6], cv[7]);
            *(GAS v4u*)(C2 + (size_t)srow * FK1 + t0) = oc; }
        for (int i = gt; i < 2048 * 256; i += NGT) { const int srow = i >> 8, t0 = (i & 255) * 8; float sv[8];
#pragma unroll
            for (int e = 0; e < 8; ++e) sv[e] = tw[(srow * (t0 + e)) & 4095].y;
            v4u os; os.x = pk2(sv[0], sv[1]); os.y = pk2(sv[2], sv[3]); os.z = pk2(sv[4], sv[5]); os.w = pk2(sv[6], sv[7]);
            *(GAS v4u*)(S2 + (size_t)srow * 2048 + t0) = os; }
        bf16* A1 = (bf16*)(ws + WS_A1);
        for (int i = gt; i < 512 * 256; i += NGT) { const int r = i >> 8, k = i & 255, gl = r >> 8, ri = (r >> 7) & 1, cp = r & 127, kg = k >> 7, cc = k & 127;
            float v = 0.f; if (kg == gl) { const float rv = (float)((cc * cp) & 127) * (1.0f / 128.0f); v = ri == 0 ? __builtin_amdgcn_cosf(rv) : -__builtin_amdgcn_sinf(rv); }
            A1[i] = (bf16)f2bf(v); }
        __syncthreads();
    }
    if (l == 0) { bf16* memn = (bf16*)(ws + WS_MEMN);
      for (int m = gw; m < NB * NMEM; m += NGW) norm_row_gain_bf16(pin(P, 1) + (size_t)m * DM, memn + (size_t)m * DM, pin(P, 19), lane); }
}


typedef short gbf16x8 __attribute__((ext_vector_type(8)));
constexpr int GP = 72;
__device__ __forceinline__ f32x4 mma16(const LAS bf16* A, const LAS bf16* Bt, int K, int lane, f32x4 acc) {
    const int r = lane & 15, q = lane >> 4;
#pragma unroll
    for (int k0 = 0; k0 < 64; k0 += 32) { if (k0 < K) {
        const gbf16x8 a = *(const LAS gbf16x8*)(A + r * GP + k0 + 8 * q), b = *(const LAS gbf16x8*)(Bt + r * GP + k0 + 8 * q);
        acc = __builtin_amdgcn_mfma_f32_16x16x32_bf16(a, b, acc, 0, 0, 0); } }
    return acc;
}
constexpr int RP = 72;
__device__ __forceinline__ v4u gla_ld64(const bf16* proj, int tok0, int col0, int tid) { return *(const GAS v4u*)(proj + (size_t)(tok0 + (tid >> 3)) * NPROJ + col0 + (tid & 7) * 8); }
__device__ __forceinline__ v4u gla_ld128(const bf16* proj, int tok0, int col0, int id) { return *(const GAS v4u*)(proj + (size_t)(tok0 + (id >> 4)) * NPROJ + col0 + (id & 15) * 8); }
__device__ __forceinline__ void gla_st64(LAS bf16* raw, v4u v, int tid) { *(LAS v4u*)(raw + (tid >> 3) * RP + (tid & 7) * 8) = v; }
__device__ __forceinline__ void gla_st_vT(LAS bf16* vT, v4u v, int id) {
    const int i = id >> 4, c0 = (id & 15) * 8; const unsigned w[4] = {v.x, v.y, v.z, v.w};
#pragma unroll
    for (int e = 0; e < 8; ++e) vT[(c0 + e) * GP + i] = (bf16)((e & 1) ? (w[e >> 1] >> 16) : (w[e >> 1] & 0xffffu));
}
constexpr int LRP = 40;
__device__ __forceinline__ void gla_cumsum_lds(const LAS bf16* lrraw, const LAS float* gwl, const float* gkb_, int h, int dir, LAS float* bL, LAS float* tot, int tid) {
    const GAS float* gkb = (const GAS float*)gkb_;
    const int k = tid & 63, seg = tid >> 6;
    const float bias = gkb[dir * 256 + h * 64 + k];
    float w[16];
#pragma unroll
    for (int r = 0; r < 16; ++r) w[r] = gwl[(dir * 16 + r) * 64 + k];
    float c[8];
#pragma unroll
    for (int e = 0; e < 8; ++e) { const LAS v4u* lp = (const LAS v4u*)(lrraw + (8 * seg + e) * LRP + dir * 16); const v4u a = lp[0], b = lp[1];
        float pre = bias;
        pre += bflo(a.x) * w[0] + bfhi(a.x) * w[1] + bflo(a.y) * w[2] + bfhi(a.y) * w[3] + bflo(a.z) * w[4] + bfhi(a.z) * w[5] + bflo(a.w) * w[6] + bfhi(a.w) * w[7];
        pre += bflo(b.x) * w[8] + bfhi(b.x) * w[9] + bflo(b.y) * w[10] + bfhi(b.y) * w[11] + bflo(b.z) * w[12] + bfhi(b.z) * w[13] + bflo(b.w) * w[14] + bfhi(b.w) * w[15];
        c[e] = log_sigmoid_f(pre) * (1.f / 16.f); }
    if (dir == 0) {
#pragma unroll
        for (int e = 1; e < 8; ++e) c[e] += c[e - 1];
        tot[seg * 64 + k] = c[7];
    } else {
#pragma unroll
        for (int e = 6; e >= 0; --e) c[e] += c[e + 1];
        tot[seg * 64 + k] = c[0];
    }
    __syncthreads();
    float off = 0.f;
#pragma unroll
    for (int s2 = 0; s2 < 8; ++s2) { const float tv = tot[s2 * 64 + k]; if (dir == 0 ? (s2 < seg) : (s2 > seg)) off += tv; }
#pragma unroll
    for (int e = 0; e < 8; ++e) bL[(8 * seg + e) * 64 + k] = c[e] + off;
    __syncthreads();
}
__device__ __forceinline__ v4u gla_ld_lr(const bf16* proj, int tok0, int tid) { return *(const GAS v4u*)(proj + (size_t)(tok0 + ((tid & 255) >> 2)) * NPROJ + PLR + (tid & 3) * 8); }
__device__ __forceinline__ void gla_st_lr(LAS bf16* lrraw, v4u v, int tid) { if (tid < 256) *(LAS v4u*)(lrraw + (tid >> 2) * LRP + (tid & 3) * 8) = v; }
__device__ __forceinline__ void gla_stage_gkw(const float* gkw_, int h, LAS float* gwl, int tid) {
    const GAS float* gkw = (const GAS float*)gkw_;
#pragma unroll
    for (int e = 0; e < 4; ++e) { const int i = tid + 512 * e, dr = i >> 6, k = i & 63; gwl[i] = gkw[dr * 256 + h * 64 + k]; }
}
__device__ __forceinline__ void gla_g1(const bf16* proj, const float* gkw, const float* gkb, bf16* GU_, float* GD_, LAS unsigned char* lds, int tid, int lane, int wave, int bid, int G) {
    GAS bf16* GU = (GAS bf16*)GU_; GAS float* GD = (GAS float*)GD_;
    LAS bf16* vT = (LAS bf16*)lds; LAS bf16* kdT = (LAS bf16*)(lds + 18432); LAS float* bL = (LAS float*)(lds + 27648); LAS float* tot = (LAS float*)(lds + 44032);
    LAS bf16* kraw = (LAS bf16*)(lds + 46080); LAS bf16* lrraw = (LAS bf16*)(lds + 55296); LAS float* gwl = (LAS float*)(lds + 60416);
    int unit = bid; if (unit >= 2048) return;
    int hcur = -1; v4u rk, rlr, rv0, rv1;
    { const int bh = unit >> 6, n = unit & 63, h = bh & 3, tok0 = (bh >> 2) * SEQ + n * 64;
      rk = gla_ld64(proj, tok0, PK + h * 64, tid); rlr = gla_ld_lr(proj, tok0, tid);
      rv0 = gla_ld128(proj, tok0, PV + h * 128, tid); rv1 = gla_ld128(proj, tok0, PV + h * 128, tid + 512); }
    for (;;) { const int bh = unit >> 6, h = bh & 3;
        gla_st64(kraw, rk, tid); gla_st_lr(lrraw, rlr, tid); gla_st_vT(vT, rv0, tid); gla_st_vT(vT, rv1, tid + 512);
        if (h != hcur) { gla_stage_gkw(gkw, h, gwl, tid); hcur = h; }
        __syncthreads();
        const int nunit = unit + G; const bool more = nunit < 2048;
        if (more) { const int bh2 = nunit >> 6, n2 = nunit & 63, h2 = bh2 & 3, tok2 = (bh2 >> 2) * SEQ + n2 * 64;
            rk = gla_ld64(proj, tok2, PK + h2 * 64, tid); rlr = gla_ld_lr(proj, tok2, tid);
            rv0 = gla_ld128(proj, tok2, PV + h2 * 128, tid); rv1 = gla_ld128(proj, tok2, PV + h2 * 128, tid + 512); }
        for (int dir = 0; dir < 2; ++dir) {
            gla_cumsum_lds(lrraw, gwl, gkb, h, dir, bL, tot, tid);
            { const int k = tid & 63, seg = tid >> 6; const float bl = bL[(dir ? 0 : 63) * 64 + k]; unsigned w[4];
#pragma unroll
              for (int e = 0; e < 4; ++e) { const int i0 = 8 * seg + 2 * e;
                  const float k0 = bf2f(kraw[i0 * RP + k]) * __expf(bl - bL[i0 * 64 + k]);
                  const float k1 = bf2f(kraw[(i0 + 1) * RP + k]) * __expf(bl - bL[(i0 + 1) * 64 + k]);
                  w[e] = pk2(k0, k1); }
              *(LAS v4u*)(kdT + k * GP + 8 * seg) = (v4u){w[0], w[1], w[2], w[3]};
              if (seg == 0) GD[(size_t)(unit * 2 + dir) * 64 + k] = __expf(bl); }
            __syncthreads();
            { GAS bf16* U = GU + (size_t)(unit * 2 + dir) * 8192; const int r = lane & 15, q = lane >> 4;
#pragma unroll
              for (int kt = 0; kt < 4; ++kt) { f32x4 acc = (f32x4){0.f, 0.f, 0.f, 0.f};
                  acc = mma16(vT + 16 * wave * GP, kdT + 16 * kt * GP, 64, lane, acc);
#pragma unroll
                  for (int j = 0; j < 4; ++j) U[(16 * wave + 4 * q + j) * 64 + 16 * kt + r] = (bf16)f2bf(acc[j]); } }
            __syncthreads();
        }
        if (!more) break; unit = nunit;
    }
}
__device__ __forceinline__ void gla_g3(const bf16* proj, const float* gkw, const float* gkb, const float* gnorm_, const bf16* GS_, bf16* mix_, LAS unsigned char* lds, int tid, int lane, int wave, int bid, int G) {
    const GAS float* gnorm = (const GAS float*)gnorm_; const GAS bf16* GS = (const GAS bf16*)GS_; GAS bf16* mix = (GAS bf16*)mix_; const GAS bf16* gproj = (const GAS bf16*)proj;
    LAS bf16* vT = (LAS bf16*)lds; LAS bf16* ST = (LAS bf16*)(lds + 18432); LAS bf16* qd = (LAS bf16*)(lds + 36864); LAS bf16* kd = (LAS bf16*)(lds + 46080);
    LAS bf16* qb = (LAS bf16*)(lds + 55296); LAS bf16* Pm = (LAS bf16*)(lds + 64512); LAS float* bL = (LAS float*)(lds + 73728); LAS float* tot = (LAS float*)(lds + 90112); LAS float* rs = (LAS float*)(lds + 92160);
    LAS bf16* qraw = (LAS bf16*)(lds + 92672); LAS bf16* kraw = (LAS bf16*)(lds + 101888); LAS bf16* lrraw = (LAS bf16*)(lds + 111104); LAS float* gwl = (LAS float*)(lds + 116224);
    const int r = lane & 15, q = lane >> 4, wr = wave >> 1, wc = wave & 1;
    int unit = bid; if (unit >= 2048) return;
    int hcur = -1; v4u rq, rk, rlr, rv0, rv1, rs0a, rs0b, rs1a, rs1b; unsigned short rg[16];
#define G3_LOAD(UNIT) do { const int bh_ = (UNIT) >> 6, n_ = (UNIT) & 63, h_ = bh_ & 3, tok_ = (bh_ >> 2) * SEQ + n_ * 64; \
        rq = gla_ld64(proj, tok_, PQ + h_ * 64, tid); rk = gla_ld64(proj, tok_, PK + h_ * 64, tid); rlr = gla_ld_lr(proj, tok_, tid); \
        rv0 = gla_ld128(proj, tok_, PV + h_ * 128, tid); rv1 = gla_ld128(proj, tok_, PV + h_ * 128, tid + 512); \
        { const GAS bf16* S0_ = GS + (size_t)((UNIT) * 2) * 8192; rs0a = *(const GAS v4u*)(S0_ + tid * 8); rs0b = *(const GAS v4u*)(S0_ + 4096 + tid * 8); rs1a = *(const GAS v4u*)(S0_ + 8192 + tid * 8); rs1b = *(const GAS v4u*)(S0_ + 12288 + tid * 8); } \
        _Pragma("unroll") for (int j_ = 0; j_ < 4; ++j_) _Pragma("unroll") for (int ct_ = 0; ct_ < 4; ++ct_) rg[j_ * 4 + ct_] = gproj[(size_t)(tok_ + 16 * wr + 4 * q + j_) * NPROJ + PG + h_ * 128 + 64 * wc + 16 * ct_ + r]; } while (0)
    G3_LOAD(unit);
    for (;;) { const int bh = unit >> 6, n = unit & 63, bb = bh >> 2, h = bh & 3, tok0 = bb * SEQ + n * 64;
        gla_st64(qraw, rq, tid); gla_st64(kraw, rk, tid); gla_st_lr(lrraw, rlr, tid); gla_st_vT(vT, rv0, tid); gla_st_vT(vT, rv1, tid + 512);
        if (h != hcur) { gla_stage_gkw(gkw, h, gwl, tid); hcur = h; }
        const v4u s0a = rs0a, s0b = rs0b, s1a = rs1a, s1b = rs1b; unsigned short gcur[16];
#pragma unroll
        for (int e = 0; e < 16; ++e) gcur[e] = rg[e];
        __syncthreads();
        const int nunit = unit + G; const bool more = nunit < 2048;
        if (more) G3_LOAD(nunit);
        f32x4 acc[4];
#pragma unroll
        for (int ct = 0; ct < 4; ++ct) acc[ct] = (f32x4){0.f, 0.f, 0.f, 0.f};
        for (int dir = 0; dir < 2; ++dir) {
            gla_cumsum_lds(lrraw, gwl, gkb, h, dir, bL, tot, tid);
            { const int i = tid >> 3, kg = (tid & 7) * 8;
              const v4u qv = *(const LAS v4u*)(qraw + i * RP + kg), kv = *(const LAS v4u*)(kraw + i * RP + kg);
              const f32x4 b0 = *(const LAS f32x4*)(bL + i * 64 + kg), b1 = *(const LAS f32x4*)(bL + i * 64 + kg + 4), r0 = *(const LAS f32x4*)(bL + 32 * 64 + kg), r1 = *(const LAS f32x4*)(bL + 32 * 64 + kg + 4);
              const unsigned qw[4] = {qv.x, qv.y, qv.z, qv.w}, kw[4] = {kv.x, kv.y, kv.z, kv.w}; unsigned oqd[4], okd[4], oqb[4];
#pragma unroll
              for (int e2 = 0; e2 < 4; ++e2) { const float bva = e2 < 2 ? b0[2 * e2] : b1[2 * e2 - 4], bvb = e2 < 2 ? b0[2 * e2 + 1] : b1[2 * e2 - 3], bra = e2 < 2 ? r0[2 * e2] : r1[2 * e2 - 4], brb = e2 < 2 ? r0[2 * e2 + 1] : r1[2 * e2 - 3];
                  const float qa = bflo(qw[e2]), qbv = bfhi(qw[e2]), ka = bflo(kw[e2]), kb = bfhi(kw[e2]);
                  oqd[e2] = pk2(qa * __expf(bva - bra), qbv * __expf(bvb - brb)); okd[e2] = pk2(ka * __expf(bra - bva), kb * __expf(brb - bvb)); oqb[e2] = pk2(qa * __expf(bva), qbv * __expf(bvb)); }
              *(LAS v4u*)(qd + i * GP + kg) = (v4u){oqd[0], oqd[1], oqd[2], oqd[3]}; *(LAS v4u*)(kd + i * GP + kg) = (v4u){okd[0], okd[1], okd[2], okd[3]}; *(LAS v4u*)(qb + i * GP + kg) = (v4u){oqb[0], oqb[1], oqb[2], oqb[3]};
              *(LAS v4u*)(ST + (tid >> 3) * GP + (tid & 7) * 8) = dir ? s1a : s0a; *(LAS v4u*)(ST + (64 + (tid >> 3)) * GP + (tid & 7) * 8) = dir ? s1b : s0b; }
            __syncthreads();
#pragma unroll
            for (int e = 0; e < 2; ++e) { const int jt = wc * 2 + e; f32x4 s = (f32x4){0.f, 0.f, 0.f, 0.f};
                s = mma16(qd + 16 * wr * GP, kd + 16 * jt * GP, 64, lane, s);
#pragma unroll
                for (int j = 0; j < 4; ++j) { const int i = 16 * wr + 4 * q + j, jj = 16 * jt + r; const bool keep = dir == 0 ? (jj <= i) : (jj > i);
                    Pm[i * GP + jj] = (bf16)f2bf(keep ? s[j] : 0.f); } }
            __syncthreads();
#pragma unroll
            for (int ct = 0; ct < 4; ++ct) { const int v0 = 64 * wc + 16 * ct;
                acc[ct] = mma16(Pm + 16 * wr * GP, vT + v0 * GP, 64, lane, acc[ct]);
                acc[ct] = mma16(qb + 16 * wr * GP, ST + v0 * GP, 64, lane, acc[ct]); }
            __syncthreads();
        }
        float ss[4];
#pragma unroll
        for (int j = 0; j < 4; ++j) { float a = 0.f;
#pragma unroll
            for (int ct = 0; ct < 4; ++ct) a += acc[ct][j] * acc[ct][j];
            a += __shfl_xor(a, 1); a += __shfl_xor(a, 2); a += __shfl_xor(a, 4); a += __shfl_xor(a, 8); ss[j] = a; }
        if (r == 0) {
#pragma unroll
            for (int j = 0; j < 4; ++j) rs[(16 * wr + 4 * q + j) * 2 + wc] = ss[j]; }
        __syncthreads();
#pragma unroll
        for (int j = 0; j < 4; ++j) { const int i = 16 * wr + 4 * q + j; const float rstd = rsqrtf((rs[i * 2] + rs[i * 2 + 1]) * (1.f / 128.f) + EPS);
#pragma unroll
            for (int ct = 0; ct < 4; ++ct) { const int v = 64 * wc + 16 * ct + r; const float gate = bf2f(gcur[j * 4 + ct]);
                mix[(size_t)(tok0 + i) * DM + h * 128 + v] = (bf16)f2bf(acc[ct][j] * rstd * gnorm[v] * pg8::silu_f(gate)); } }
        __syncthreads();
        if (!more) break; unit = nunit;
    }
#undef G3_LOAD
}

__device__ __forceinline__ void gla_g2(const bf16* GU_, const float* GD_, bf16* GS_, int tid, int bid, int G) {
    typedef float f32x2 __attribute__((ext_vector_type(2)));
    const GAS unsigned* GU = (const GAS unsigned*)GU_; const GAS float* GD = (const GAS float*)GD_; GAS unsigned* GS = (GAS unsigned*)GS_;
    for (int it = bid * NTHR + tid; it < 32 * 2 * 4096; it += G * NTHR) { const int e2 = it & 4095, dir = (it >> 12) & 1, bh = it >> 13, k = (2 * e2) & 63;
        float S0 = 0.f, S1 = 0.f;
#pragma unroll 1
        for (int nb = 0; nb < 64; nb += 16) { unsigned u[16]; f32x2 d[16];
#pragma unroll
            for (int j = 0; j < 16; ++j) { const int nv = nb + j, n = dir ? 63 - nv : nv; const size_t ud = (size_t)((bh * 64 + n) * 2 + dir);
                u[j] = GU[ud * 4096 + e2]; d[j] = *(const GAS f32x2*)(GD + ud * 64 + k); }
            asm volatile("" ::: "memory");
#pragma unroll
            for (int j = 0; j < 16; ++j) { const int nv = nb + j, n = dir ? 63 - nv : nv; const size_t ud = (size_t)((bh * 64 + n) * 2 + dir);
                GS[ud * 4096 + e2] = pk2(S0, S1); S0 = S0 * d[j].x + bflo(u[j]); S1 = S1 * d[j].y + bfhi(u[j]); } }
    }
}
__device__ __forceinline__ float sconv3(const bf16* proj, int b, int t, int col, const float* w, int wld, int wc) {
    const bf16* p = proj + (size_t)(b * SEQ + t) * NPROJ + col;
    float a = w[wld + wc] * bf2f(p[0]);
    if (t > 0) a += w[wc] * bf2f(p[-NPROJ]);
    if (t < SEQ - 1) a += w[2 * wld + wc] * bf2f(p[NPROJ]);
    return a;
}


typedef float f32x16 __attribute__((ext_vector_type(16)));
typedef short hbf16x8 __attribute__((ext_vector_type(8)));
constexpr int HY_PITCH = 4360, HY_ZOFF = 96;
constexpr int HY_ZBYTES = 8 * HY_PITCH * 2;
constexpr int HY_HRN = 8200;
constexpr int HY_LDS_BYTES = HY_ZBYTES + 2 * HY_HRN * 2;

__device__ __forceinline__ hbf16x8 hy_afrag(LAS const unsigned char* hrb, int m0) {
    const int p = m0 + 4096, odd = p & 1;
    const LAS unsigned* src = (const LAS unsigned*)(hrb + odd * (HY_HRN * 2) + (p + odd) * 2);
    v4u w; w.x = src[0]; w.y = src[1]; w.z = src[2]; w.w = src[3];
    return __builtin_bit_cast(hbf16x8, w);
}
__device__ __forceinline__ void hy_fill_hr(const float* filtT_, int order, int c, LAS unsigned char* hrb, int tid) {
    const GAS float* filtT = (const GAS float*)filtT_;
    const GAS float* hf = filtT + (size_t)(order * 1024 + c) * SEQ; const GAS float* hb = filtT + (size_t)(order * 1024 + 512 + c) * SEQ;
    LAS bf16* c0 = (LAS bf16*)hrb; LAS bf16* c1 = c0 + HY_HRN;
    asm volatile("" : "+v"(tid));
    float v[16];
#pragma unroll
    for (int k = 0; k < 16; ++k) { const int m = tid + 512 * k - 4096, am = m < 0 ? -m : m; v[k] = (m <= 0 ? hf : hb)[am > 4095 ? 4095 : am]; }
#pragma unroll
    for (int k = 0; k < 16; ++k) { const int q = tid + 512 * k; const float v0 = q == 0 ? 0.f : v[k]; c0[q] = (bf16)f2bf(v0); c1[q + 1] = (bf16)f2bf(v0); }
    if (tid < 8) { c0[8192 + tid] = 0; if (tid < 7) c1[8193 + tid] = 0; }
    if (tid == 0) c1[0] = 0;
}
__device__ __forceinline__ void hy_conv(LAS const unsigned char* zbb, LAS const unsigned char* hrb, int w, int lane, f32x4 (&acc)[8][2]) {
    const int n = lane & 15, b = n >> 1, il = n & 1, kq = lane >> 4, i = n;
#pragma unroll
    for (int p = 0; p < 8; ++p)
#pragma unroll
        for (int hh = 0; hh < 2; ++hh) acc[p][hh] = (f32x4){0.f, 0.f, 0.f, 0.f};
    const LAS unsigned char* zl = zbb + (b * HY_PITCH + HY_ZOFF + 32 * il + 8 * kq) * 2 - 64;
    const int mb = -32 * (16 * w + 1) - i + 8 * kq;
    hbf16x8 A[16][2];
#pragma unroll
    for (int d = 0; d <= 14; ++d) { A[(1 + d) & 15][0] = hy_afrag(hrb, mb - 32 * d); A[(1 + d) & 15][1] = hy_afrag(hrb, mb - 32 * d - 16); }
    hbf16x8 b0 = *(const LAS hbf16x8*)zl;
#pragma unroll 1
    for (int c = 0; c < 9; ++c) {
#pragma unroll
        for (int u = 0; u < 16; ++u) { const int s = 16 * c + u;
            if (s <= 128) {
                hbf16x8 nb0 = b0;
                if (s < 128) {
                    A[(16 - u) & 15][0] = hy_afrag(hrb, mb + 32 * (s + 1)); A[(16 - u) & 15][1] = hy_afrag(hrb, mb + 32 * (s + 1) - 16);
                    nb0 = *(const LAS hbf16x8*)(zl + (s + 1) * 64); }
#pragma unroll
                for (int hh = 0; hh < 2; ++hh)
#pragma unroll
                    for (int p = 0; p < 8; ++p) acc[p][hh] = __builtin_amdgcn_mfma_f32_16x16x32_bf16(A[(17 - u + 2 * p) & 15][hh], b0, acc[p][hh], 0, 0, 0);
                b0 = nb0; } }
    }
}
__device__ __forceinline__ v2u hy_conv4_fin(v2u v, bf16 l, bf16 r, int t0, float w0, float w1, float w2) {
    const float xl = t0 > 0 ? bf2f(l) : 0.f, xr = t0 < SEQ - 4 ? bf2f(r) : 0.f;
    const float x0 = bflo(v.x), x1 = bfhi(v.x), x2 = bflo(v.y), x3 = bfhi(v.y);
    v2u o; o.x = pk2(w0 * xl + w1 * x0 + w2 * x1, w0 * x0 + w1 * x1 + w2 * x2); o.y = pk2(w0 * x1 + w1 * x2 + w2 * x3, w0 * x2 + w1 * x3 + w2 * xr); return o;
}
__device__ __forceinline__ void hy_toeplitz_phase(const bf16* uT, const float* cw_, const float* filtT, const float* skip_, bf16* yT, LAS unsigned char* lds, int tid, int lane, int wave, int bid, int G) {
    const GAS float* skip = (const GAS float*)skip_; const GAS float* cw = (const GAS float*)cw_; const GAS bf16* ur = (const GAS bf16*)uT;
    LAS unsigned char* zbb = lds; LAS unsigned char* hrb = lds + HY_ZBYTES;
    for (int i = tid; i < HY_ZBYTES / 4; i += NTHR) ((LAS unsigned*)zbb)[i] = 0u;
    __syncthreads();
    const int w = wave;
    for (int c = bid; c < 512; c += G) {
        { const float w0 = cw[c], w1 = cw[1536 + c], w2 = cw[3072 + c];
#pragma unroll 8
          for (int bb = 0; bb < 8; ++bb) { const int q = tid; const GAS bf16* src = ur + (size_t)c * MTOK + bb * SEQ + q * 8;
              const v4u v = *(const GAS v4u*)src; const float xlr = bf2f(src[q > 0 ? -1 : 0]), xrr = bf2f(src[q < 511 ? 8 : 7]); const float xl = q > 0 ? xlr : 0.f, xr = q < 511 ? xrr : 0.f;
              const float x[10] = {xl, bflo(v.x), bfhi(v.x), bflo(v.y), bfhi(v.y), bflo(v.z), bfhi(v.z), bflo(v.w), bfhi(v.w), xr};
              v4u o; o.x = pk2(w0 * x[0] + w1 * x[1] + w2 * x[2], w0 * x[1] + w1 * x[2] + w2 * x[3]); o.y = pk2(w0 * x[2] + w1 * x[3] + w2 * x[4], w0 * x[3] + w1 * x[4] + w2 * x[5]);
              o.z = pk2(w0 * x[4] + w1 * x[5] + w2 * x[6], w0 * x[5] + w1 * x[6] + w2 * x[7]); o.w = pk2(w0 * x[6] + w1 * x[7] + w2 * x[8], w0 * x[7] + w1 * x[8] + w2 * x[9]);
              *(LAS v4u*)(zbb + (bb * HY_PITCH + HY_ZOFF + q * 8) * 2) = o; } }
        hy_fill_hr(filtT, 0, c, hrb, tid);
        __syncthreads();
        f32x4 acc[8][2];
        hy_conv(zbb, hrb, w, lane, acc);
        { unsigned zp[8][2][2];
        int ln = lane; asm volatile("" : "+v"(ln)); const int n = ln & 15, b = n >> 1, il = n & 1, kq = ln >> 4;
        { const float sk = skip[c]; const float a0 = cw[512 + c], a1 = cw[1536 + 512 + c], a2 = cw[3072 + 512 + c];
          const int tb = 32 * (16 * w + il) + 4 * kq; const GAS bf16* xb0 = ur + (size_t)(512 + c) * MTOK + b * SEQ + tb;
#pragma unroll
          for (int gh = 0; gh < 2; ++gh) { v2u rv[8]; bf16 rl[8], rr[8];
#pragma unroll
            for (int k = 0; k < 8; ++k) { const int off = 64 * (4 * gh + (k >> 1)) + 16 * (k & 1); rv[k] = *(const GAS v2u*)(xb0 + off); rl[k] = xb0[off - 1]; rr[k] = xb0[off + 4]; }
            asm volatile("" ::: "memory");
#pragma unroll
            for (int k = 0; k < 8; ++k) { const int g = 4 * gh + (k >> 1), rq = k & 1, t0 = tb + 64 * g + 16 * rq;
                const v2u xv = hy_conv4_fin(rv[k], rl[k], rr[k], t0, a0, a1, a2);
                const v2u vv = *(const LAS v2u*)(zbb + (b * HY_PITCH + HY_ZOFF + t0) * 2);
                const float z0 = bflo(xv.x) * (acc[g][rq][0] + bflo(vv.x) * sk), z1 = bfhi(xv.x) * (acc[g][rq][1] + bfhi(vv.x) * sk);
                const float z2 = bflo(xv.y) * (acc[g][rq][2] + bflo(vv.y) * sk), z3 = bfhi(xv.y) * (acc[g][rq][3] + bfhi(vv.y) * sk);
                zp[g][rq][0] = pk2(z0, z1); zp[g][rq][1] = pk2(z2, z3); } } }
        __syncthreads();
#pragma unroll
        for (int g = 0; g < 8; ++g)
#pragma unroll
            for (int rq = 0; rq < 2; ++rq) { const int t0 = 32 * (16 * w + 2 * g + il) + 16 * rq + 4 * kq;
                *(LAS v2u*)(zbb + (b * HY_PITCH + HY_ZOFF + t0) * 2) = (v2u){zp[g][rq][0], zp[g][rq][1]}; } }
        hy_fill_hr(filtT, 1, c, hrb, tid);
        __syncthreads();
        hy_conv(zbb, hrb, w, lane, acc);
        { int ln = lane; asm volatile("" : "+v"(ln)); const int n = ln & 15, b = n >> 1, il = n & 1, kq = ln >> 4; const float sk = skip[512 + c]; const float a0 = cw[1024 + c], a1 = cw[1536 + 1024 + c], a2 = cw[3072 + 1024 + c];
          const int tb = 32 * (16 * w + il) + 4 * kq; const GAS bf16* xb0 = ur + (size_t)(1024 + c) * MTOK + b * SEQ + tb;
#pragma unroll
          for (int gh = 0; gh < 2; ++gh) { v2u rv[8]; bf16 rl[8], rr[8];
#pragma unroll
            for (int k = 0; k < 8; ++k) { const int off = 64 * (4 * gh + (k >> 1)) + 16 * (k & 1); rv[k] = *(const GAS v2u*)(xb0 + off); rl[k] = xb0[off - 1]; rr[k] = xb0[off + 4]; }
            asm volatile("" ::: "memory");
#pragma unroll
            for (int k = 0; k < 8; ++k) { const int g = 4 * gh + (k >> 1), rq = k & 1, t0 = tb + 64 * g + 16 * rq;
                const v2u xv = hy_conv4_fin(rv[k], rl[k], rr[k], t0, a0, a1, a2);
                const v2u zv = *(const LAS v2u*)(zbb + (b * HY_PITCH + HY_ZOFF + t0) * 2);
                const float z0 = bflo(zv.x), z1 = bfhi(zv.x), z2 = bflo(zv.y), z3 = bfhi(zv.y);
                const float o0 = bflo(xv.x) * (acc[g][rq][0] + z0 * sk), o1 = bfhi(xv.x) * (acc[g][rq][1] + z1 * sk);
                const float o2 = bflo(xv.y) * (acc[g][rq][2] + z2 * sk), o3 = bfhi(xv.y) * (acc[g][rq][3] + z3 * sk);
                *(GAS v2u*)(yT + (size_t)c * MTOK + b * SEQ + t0) = (v2u){pk2(o0, o1), pk2(o2, o3)}; } } }
        __syncthreads();
    }
}
__device__ __forceinline__ void hy_transpose_out(const bf16* yT, const float* gC, bf16* mix, LAS unsigned char* lds, int tid, int lane, int wave, int bid, int G) {
    constexpr int TQ = 516;
    LAS bf16* T = (LAS bf16*)lds;
    const f32x4 g0 = *(const GAS f32x4*)(gC + lane * 8), g1 = *(const GAS f32x4*)(gC + lane * 8 + 4);
    for (int tile = bid; tile < MTOK / 64; tile += G) { const int tok0 = tile * 64;
        v4u rv[8];
#pragma unroll
        for (int pass = 0; pass < 8; ++pass) { const int c = (tid >> 3) + 64 * pass, sg = tid & 7; rv[pass] = *(const GAS v4u*)(yT + (size_t)c * MTOK + tok0 + 8 * sg); }
#pragma unroll
        for (int pass = 0; pass < 8; ++pass) { const int c = (tid >> 3) + 64 * pass, sg = tid & 7; const unsigned w[4] = {rv[pass].x, rv[pass].y, rv[pass].z, rv[pass].w};
#pragma unroll
            for (int e = 0; e < 8; ++e) T[(8 * sg + e) * TQ + c] = (bf16)((e & 1) ? (w[e >> 1] >> 16) : (w[e >> 1] & 0xffffu)); }
        __syncthreads();
#pragma unroll 1
        for (int k = 0; k < 8; ++k) { const int s = wave * 8 + k; float y[8]; float ss = 0.f;
            const v2u ya = *(const LAS v2u*)(T + s * TQ + lane * 8), yb = *(const LAS v2u*)(T + s * TQ + lane * 8 + 4);
            y[0] = bflo(ya.x); y[1] = bfhi(ya.x); y[2] = bflo(ya.y); y[3] = bfhi(ya.y); y[4] = bflo(yb.x); y[5] = bfhi(yb.x); y[6] = bflo(yb.y); y[7] = bfhi(yb.y);
#pragma unroll
            for (int e = 0; e < 8; ++e) ss += y[e] * y[e];
            const float rstd = rsqrtf(wave_sum(ss) * (1.f / 512.f) + EPS);
            v4u o; o.x = pk2(y[0] * rstd * g0.x, y[1] * rstd * g0.y); o.y = pk2(y[2] * rstd * g0.z, y[3] * rstd * g0.w);
            o.z = pk2(y[4] * rstd * g1.x, y[5] * rstd * g1.y); o.w = pk2(y[6] * rstd * g1.z, y[7] * rstd * g1.w);
            *(GAS v4u*)(mix + (size_t)(tok0 + s) * DM + 1024 + lane * 8) = o; }
        __syncthreads();
    }
}

__device__ __forceinline__ void phase_c_misc(const Params& P, unsigned char* ws, float* xres, int l, LAS unsigned char* lds, int tid, int lane, int wave, int bid, int G) {
    const bf16* proj = (const bf16*)(ws + WS_PROJ); bf16* mix = (bf16*)(ws + WS_MIX);
    { const bf16* FU2 = (const bf16*)(ws + WS_FU2); bf16* FE = (bf16*)(ws + WS_FE); bf16* FO = (bf16*)(ws + WS_FO); float* Y2K = (float*)(ws + WS_Y2K);
      const int gw = bid * NWAVES + wave, NGW = G * NWAVES;
      for (int col = gw; col < 4096; col += NGW) { const bf16* ur = FU2 + (size_t)col * 8192; const bf16* ui = ur + 4096; float alt = 0.f;
          v4u fa[4], fc[4], fma_[4], fmc[4]; bf16 fr0[4], fi0[4];
#pragma unroll
          for (int j = 0; j < 4; ++j) { const int t0 = 8 * (lane + 64 * j);
              fa[j] = *(const GAS v4u*)(ur + t0); fc[j] = *(const GAS v4u*)(ui + t0);
              fma_[j] = *(const GAS v4u*)(ur + 4096 - t0 - 8); fmc[j] = *(const GAS v4u*)(ui + 4096 - t0 - 8);
              fr0[j] = ur[t0 ? 4096 - t0 : 0]; fi0[j] = ui[t0 ? 4096 - t0 : 0]; }
          asm volatile("" ::: "memory");
#pragma unroll
          for (int j = 0; j < 4; ++j) { const int t0 = 8 * (lane + 64 * j);
              const v4u a = fa[j], c = fc[j], ma = fma_[j], mc = fmc[j]; const float m0r = t0 ? bf2f(fr0[j]) : 0.f, m0i = t0 ? bf2f(fi0[j]) : 0.f;
              float er[8], oi[8];
              const unsigned aw[4] = {a.x, a.y, a.z, a.w}, cw[4] = {c.x, c.y, c.z, c.w}, maw[4] = {ma.x, ma.y, ma.z, ma.w}, mcw[4] = {mc.x, mc.y, mc.z, mc.w};
#pragma unroll
              for (int e = 0; e < 8; ++e) { const float xr = (e & 1) ? bfhi(aw[e >> 1]) : bflo(aw[e >> 1]), xi = (e & 1) ? bfhi(cw[e >> 1]) : bflo(cw[e >> 1]);
                  float mr, mi; if (e == 0) { mr = m0r; mi = m0i; } else { const int q = 8 - e; mr = (q & 1) ? bfhi(maw[q >> 1]) : bflo(maw[q >> 1]); mi = (q & 1) ? bfhi(mcw[q >> 1]) : bflo(mcw[q >> 1]); }
                  er[e] = xr + mr; oi[e] = (t0 + e) ? xi - mi : 0.f; alt += (e & 1) ? -er[e] : er[e]; }
              v4u oe, oo; oe.x = pk2(er[0], er[1]); oe.y = pk2(er[2], er[3]); oe.z = pk2(er[4], er[5]); oe.w = pk2(er[6], er[7]);
              oo.x = pk2(oi[0], oi[1]); oo.y = pk2(oi[2], oi[3]); oo.z = pk2(oi[4], oi[5]); oo.w = pk2(oi[6], oi[7]);
              *(GAS v4u*)(FE + (size_t)col * FK1 + t0) = oe; *(GAS v4u*)(FO + (size_t)col * 2048 + t0) = oo; }
          const float e2k = bf2f(ur[2048]);
          if (lane < 16) { v4u z = (v4u){0u, 0u, 0u, 0u}; if (lane == 0) z.x = f2bf(e2k); *(GAS v4u*)(FE + (size_t)col * FK1 + 2048 + 8 * lane) = z; }
          alt = wave_sum(alt) + e2k;
          if (lane == 0) Y2K[col] = alt * 0.001381067932f; } }
    { const float* cw = pin(P, 16) + (size_t)l * 3 * 512; const float* gD = pin(P, 17) + (size_t)(l * 3 + 2) * 512;
      const int gw = bid * NWAVES + wave, NGW = G * NWAVES, c0 = lane * 8;
      float w0[8], w1[8], w2[8], gd[8];
#pragma unroll
      for (int e = 0; e < 8; ++e) { w0[e] = cw[c0 + e]; w1[e] = cw[512 + c0 + e]; w2[e] = cw[1024 + c0 + e]; gd[e] = gD[c0 + e]; }
      for (int tk0 = gw; tk0 < MTOK; tk0 += 2 * NGW) {
          v4u vb[2], vc[2], vh[2], vcm[2], vhm[2], vcp[2], vhp[2];
#pragma unroll
          for (int h = 0; h < 2; ++h) { const int tk = tk0 + h * NGW, token = tk < MTOK ? tk : MTOK - 1, t = token & (SEQ - 1);
              const bf16* p = proj + (size_t)token * NPROJ + PUS + c0; const int om = t > 0 ? -NPROJ : 0, op = t < SEQ - 1 ? NPROJ : 0;
              vb[h] = *(const GAS v4u*)p; vc[h] = *(const GAS v4u*)(p + 512); vh[h] = *(const GAS v4u*)(p + 1024);
              vcm[h] = *(const GAS v4u*)(p + 512 + om); vhm[h] = *(const GAS v4u*)(p + 1024 + om); vcp[h] = *(const GAS v4u*)(p + 512 + op); vhp[h] = *(const GAS v4u*)(p + 1024 + op); }
#pragma unroll
          for (int h = 0; h < 2; ++h) { const int token = tk0 + h * NGW, t = token & (SEQ - 1); const float km = t > 0 ? 1.f : 0.f, kp = t < SEQ - 1 ? 1.f : 0.f;
              float y[8]; float ss = 0.f;
#pragma unroll
              for (int e2 = 0; e2 < 4; ++e2) {
                  const float a0 = km * w0[2 * e2] * bflo(vcm[h][e2]) * bflo(vhm[h][e2]) + w1[2 * e2] * bflo(vc[h][e2]) * bflo(vh[h][e2]) + kp * w2[2 * e2] * bflo(vcp[h][e2]) * bflo(vhp[h][e2]);
                  const float a1 = km * w0[2 * e2 + 1] * bfhi(vcm[h][e2]) * bfhi(vhm[h][e2]) + w1[2 * e2 + 1] * bfhi(vc[h][e2]) * bfhi(vh[h][e2]) + kp * w2[2 * e2 + 1] * bfhi(vcp[h][e2]) * bfhi(vhp[h][e2]);
                  y[2 * e2] = bflo(vb[h][e2]) * a0; y[2 * e2 + 1] = bfhi(vb[h][e2]) * a1; ss += y[2 * e2] * y[2 * e2] + y[2 * e2 + 1] * y[2 * e2 + 1]; }
              const float rstd = rsqrtf(wave_sum(ss) * (1.f / 512.f) + EPS);
              v4u o; o.x = pk2(y[0] * rstd * gd[0], y[1] * rstd * gd[1]); o.y = pk2(y[2] * rstd * gd[2], y[3] * rstd * gd[3]); o.z = pk2(y[4] * rstd * gd[4], y[5] * rstd * gd[5]); o.w = pk2(y[6] * rstd * gd[6], y[7] * rstd * gd[7]);
              if (token < MTOK) *(GAS v4u*)(mix + (size_t)token * DM + 1536 + c0) = o; } } }
    __syncthreads();
    gla_g1(proj, pin(P, 4) + (size_t)l * 2 * 16 * 256, pin(P, 5) + (size_t)l * 512, (bf16*)(ws + WS_GU), (float*)(ws + WS_GD), lds, tid, lane, wave, bid, G);
}

__device__ __forceinline__ void phase_d(const Params& P, unsigned char* ws, float* xres, int l, LAS unsigned char* lds, int tid, int lane, int wave, int bid, int G) {
    if (!(P.pad1 & 2)) gla_g3((const bf16*)(ws + WS_PROJ), pin(P, 4) + (size_t)l * 2 * 16 * 256, pin(P, 5) + (size_t)l * 512, pin(P, 6) + (size_t)l * 128, (const bf16*)(ws + WS_GS), (bf16*)(ws + WS_MIX), lds, tid, lane, wave, bid, G);
}
__device__ __forceinline__ void phase_e(const Params& P, unsigned char* ws, float* xres, int l, LAS unsigned char* lds, int tid, int lane, int wave, int bid, int G) {
    hy_transpose_out((const bf16*)(ws + WS_YT), pin(P, 17) + (size_t)(l * 3 + 1) * 512, (bf16*)(ws + WS_MIX), lds, tid, lane, wave, bid, G);
    { const float* FY = (const float*)(ws + WS_FY); const float* gB = pin(P, 17) + (size_t)(l * 3 + 0) * 512; bf16* mix = (bf16*)(ws + WS_MIX);
      const int gw = bid * NWAVES + wave, NGW = G * NWAVES;
      const f32x4 g0 = *(const GAS f32x4*)(gB + lane * 8), g1 = *(const GAS f32x4*)(gB + lane * 8 + 4);
      const float* Y2K = (const float*)(ws + WS_Y2K);
      for (int it0 = gw; it0 < MTOK; it0 += 2 * NGW) {
          f32x4 a0[2], a1[2], c0[2], c1[2];
#pragma unroll
          for (int h = 0; h < 2; ++h) { const int i2 = it0 + h * NGW, it = i2 < MTOK ? i2 : MTOK - 1, b = it >> 12, sp = it & (SEQ - 1);
              const int sf = sp < 2048 ? sp : 4096 - sp, sfc = sf > 2047 ? 2047 : sf;
              const float* src = FY + (size_t)sfc * 4096 + b * 512 + lane * 8; const float* srb = src + (size_t)2048 * 4096;
              a0[h] = *(const GAS f32x4*)src; a1[h] = *(const GAS f32x4*)srb; c0[h] = *(const GAS f32x4*)(src + 4); c1[h] = *(const GAS f32x4*)(srb + 4); }
#pragma unroll
          for (int h = 0; h < 2; ++h) { const int it = it0 + h * NGW, b = it >> 12, sp = it & (SEQ - 1); const float sg = sp < 2048 ? 1.f : -1.f;
              f32x4 a = a0[h] + a1[h] * sg, c = c0[h] + c1[h] * sg;
              if (sp == 2048) { a = *(const GAS f32x4*)(Y2K + (b & 7) * 512 + lane * 8); c = *(const GAS f32x4*)(Y2K + (b & 7) * 512 + lane * 8 + 4); }
              const float ss = (a.x * a.x + a.y * a.y) + (a.z * a.z + a.w * a.w) + (c.x * c.x + c.y * c.y) + (c.z * c.z + c.w * c.w);
              const float rstd = rsqrtf(wave_sum(ss) * (1.f / 512.f) + EPS);
              v4u o; o.x = pk2(a.x * rstd * g0.x, a.y * rstd * g0.y); o.y = pk2(a.z * rstd * g0.z, a.w * rstd * g0.w); o.z = pk2(c.x * rstd * g1.x, c.y * rstd * g1.y); o.w = pk2(c.z * rstd * g1.z, c.w * rstd * g1.w);
              if (it < MTOK) *(GAS v4u*)(mix + (size_t)it * DM + 512 + lane * 8) = o; } } }
}
__device__ __forceinline__ void phase_softmax(const float* sc, bf16* Pm, int lane, int wave, int bid, int G) {
    const int gw = bid * NWAVES + wave, NGW = G * NWAVES;
    for (int it = gw; it < MTOK * 4; it += NGW) {
        const f32x4 v = *((const GAS f32x4*)(sc + (size_t)it * 256) + lane);
        const float m = wave_max(fmaxf(fmaxf(v.x, v.y), fmaxf(v.z, v.w)));
        const float e0 = __expf(v.x - m), e1 = __expf(v.y - m), e2 = __expf(v.z - m), e3 = __expf(v.w - m);
        const float inv = 1.0f / wave_sum((e0 + e1) + (e2 + e3));
        v2u w; w.x = pk2(e0 * inv, e1 * inv); w.y = pk2(e2 * inv, e3 * inv);
        *((GAS v2u*)(Pm + (size_t)it * 256) + lane) = w;
    }
}

#ifndef EPIRES_XB
#define EPIRES_XB (GAS bf16*)xb
#endif
#ifndef GEMM_ALIGN
#define GEMM_ALIGN false
#endif
#ifndef GEMM_SP2
#define GEMM_SP2 true
#endif
constexpr int NPH = 11, NSTEPS = NL * NPH + 1;
template <class Sched, bool COLS = false> __device__ __forceinline__ pg8::RstdTab build_rstd(const Sched& S, const float* RS, LAS float* tab, int tid) {
    pg8::RstdTab T; T.tab = tab; T.RS = (const GAS float*)RS; T.pm0 = T.pm1 = T.pm2 = T.pm3 = -1; int n = 0; pg8::Unit u;
    for (int i = 0; S.next(i, u); ++i) { const int pm = COLS ? u.pn : u.pm;
        if (pm != T.pm0 && pm != T.pm1 && pm != T.pm2 && pm != T.pm3) { if (n == 0) T.pm0 = pm; else if (n == 1) T.pm1 = pm; else if (n == 2) T.pm2 = pm; else if (n == 3) T.pm3 = pm; ++n; } }
    const int row = tid >> 1, half = tid & 1;
#pragma unroll
    for (int sl = 0; sl < 4; ++sl) { const int pm = sl == 0 ? T.pm0 : sl == 1 ? T.pm1 : sl == 2 ? T.pm2 : T.pm3;
        if (pm >= 0) { const GAS float* p = (const GAS float*)RS + (size_t)(pm * 256 + row) * 32 + half * 16;
            const f32x4 a = *(const GAS f32x4*)p, b = *(const GAS f32x4*)(p + 4), c = *(const GAS f32x4*)(p + 8), d = *(const GAS f32x4*)(p + 12);
            float t = (((a.x + a.y) + (a.z + a.w)) + ((b.x + b.y) + (b.z + b.w))) + (((c.x + c.y) + (c.z + c.w)) + ((d.x + d.y) + (d.z + d.w)));
            t += __shfl_xor(t, 1);
            if (half == 0) tab[sl * 256 + row] = rsqrtf(t * (1.0f / DM) + EPS); } }
    __syncthreads();
    return T;
}
#define IN(st) (lo <= (st) && (st) < hi)
#define SEAM(stp_) do { if ((stp_) + 1 < hi) { XcdBarrier b2_; b2_.bar = opaque_p(bar.bar); b2_.x = (unsigned)opaque_i((int)bar.x); b2_.st = bar.st; xcd_barrier(b2_, tid); } } while (0)
#define OPAQ() int tid = wave0 * 64 + (int)__builtin_amdgcn_mbcnt_hi(~0u, __builtin_amdgcn_mbcnt_lo(~0u, 0u)); asm volatile("" : "+v"(tid)); const int bid = opaque_i(bid0), G = opaque_i(G0); unsigned char* ws = opaque_p(ws0); float* xres = opaque_p(out0); const unsigned ldsa = (unsigned)opaque_i((int)(unsigned)(size_t)lds0)
#define LOCALS() OPAQ(); LAS unsigned char* lds = (LAS unsigned char*)(size_t)ldsa; const int lane = tid & 63, wave = __builtin_amdgcn_readfirstlane(tid >> 6); \
        bf16* xb = (bf16*)(ws + WS_XB); bf16* proj = (bf16*)(ws + WS_PROJ); bf16* mix = (bf16*)(ws + WS_MIX); (void)lds; (void)lane; (void)wave; (void)xb; (void)proj; (void)mix
template <int L> __device__ __forceinline__ void layer_body(const Params& P, const XcdBarrier& bar, int lo, int hi, int wave0, int bid0, int G0, unsigned char* ws0, float* out0, LAS unsigned char* lds0) {
    constexpr int l = L; const int s0 = l * NPH;
        if (s0 + NPH <= lo || s0 >= hi) return;
        if (IN(s0 + 0)) { LOCALS(); phase_a(P, ws, xres, l, lds, tid, lane, wave, bid, G); SEAM(s0 + 0); }
        if (IN(s0 + 1)) { LOCALS();
            { pg8::Gemm g{xb, (const bf16*)(ws + WS_WIN), DM, DM, DM}; pg8::TileOrder S; S.init(MTOK / 256, NPROJ / 256, G, bid, DM, DM);
            pg8::EpiBf16 E{(GAS bf16*)proj, NPROJ, build_rstd(S, (const float*)(ws + WS_RSS), (LAS float*)(lds + LDSCTL_OFF + 1024 + 8192), tid)}; pg8::gemm_phase<pg8::EpiBf16, pg8::TileOrder, GEMM_ALIGN, GEMM_SP2>(lds + RING_OFF, g, S, E, tid);
            }
            { pg8::Gemm g{(const bf16*)(ws + WS_MEMN), (const bf16*)(ws + WS_WKV), DM, DM, DM}; pg8::TileOrder S; S.init(NB * NMEM / 256, 2 * DM / 256, G, (bid + G / 2) % G, DM, DM);
            pg8::EpiBf16 E{(GAS bf16*)(ws + WS_KVB), 2 * DM, pg8::RstdTab{nullptr, nullptr, -1, -1, -1, -1}}; pg8::gemm_phase<pg8::EpiBf16, pg8::TileOrder, GEMM_ALIGN, GEMM_SP2>(lds + RING_OFF, g, S, E, tid); }
            { pg8::Gemm g{(const bf16*)(ws + WS_WIN) + (size_t)WUH * DM, xb, DM, DM, DM}; pg8::TileOrder S; S.init(1536 / 256, MTOK / 256, G, bid, DM, DM);
              pg8::EpiBf16T E{(GAS bf16*)(ws + WS_UT), MTOK, build_rstd<pg8::TileOrder, true>(S, (const float*)(ws + WS_RSS), (LAS float*)(lds + LDSCTL_OFF + 1024 + 8192), tid)};
              pg8::gemm_phase<pg8::EpiBf16T, pg8::TileOrder, GEMM_ALIGN, GEMM_SP2>(lds + RING_OFF, g, S, E, tid); }
            SEAM(s0 + 1); }
        if (IN(s0 + 2)) { LOCALS();
            { pg8::Gemm g{(const bf16*)(ws + WS_KVB), (const bf16*)(ws + WS_WQB), 2 * DM, DM, 512}; pg8::PairOrder<0> S{G, bid};
            pg8::EpiBf16 E{(GAS bf16*)(ws + WS_MT), DM, pg8::RstdTab{nullptr, nullptr, -1, -1, -1, -1}}; pg8::gemm_phase<pg8::EpiBf16, pg8::PairOrder<0>, GEMM_ALIGN, GEMM_SP2>(lds + RING_OFF, g, S, E, tid); }
            { pg8::Gemm g{(const bf16*)(ws + WS_WXO), (const bf16*)(ws + WS_KVB), DM, 2 * DM, 512}; pg8::PairOrder<1> S{G, bid};
            pg8::EpiBf16 E{(GAS bf16*)(ws + WS_VWO), 1024, pg8::RstdTab{nullptr, nullptr, -1, -1, -1, -1}}; pg8::gemm_phase<pg8::EpiBf16, pg8::PairOrder<1>, GEMM_ALIGN, GEMM_SP2>(lds + RING_OFF, g, S, E, tid); }
            { pg8::Gemm g{(const bf16*)(ws + WS_A1), proj, 256, NPROJ, 256}; pg8::FnetAOrder S{G, bid};
            pg8::EpiFnetA E{(GAS bf16*)(ws + WS_FU2)}; pg8::gemm_phase<pg8::EpiFnetA, pg8::FnetAOrder, GEMM_ALIGN, GEMM_SP2>(lds + RING_OFF, g, S, E, tid); }
            SEAM(s0 + 2); }
        if (IN(s0 + 3)) { LOCALS(); phase_c_misc(P, ws, xres, l, lds, tid, lane, wave, bid, G); SEAM(s0 + 3); }
        if (IN(s0 + 4)) { LOCALS();
            { pg8::Gemm g{(const bf16*)(ws + WS_C2), (const bf16*)(ws + WS_FE), FK1, FK1, FK1}; pg8::TileOrder S; S.init(8, 16, G, bid, FK1, FK1);
              pg8::EpiF32 E{(GAS float*)(ws + WS_FY), 4096}; pg8::gemm_phase<pg8::EpiF32, pg8::TileOrder, GEMM_ALIGN, GEMM_SP2>(lds + RING_OFF, g, S, E, tid); }
            { pg8::Gemm g{(const bf16*)(ws + WS_S2), (const bf16*)(ws + WS_FO), 2048, 2048, 2048}; pg8::TileOrder S; S.init(8, 16, G, (bid + G / 2) % G, 2048, 2048);
              pg8::EpiF32 E{(GAS float*)(ws + WS_FY) + (size_t)2048 * 4096, 4096}; pg8::gemm_phase<pg8::EpiF32, pg8::TileOrder, GEMM_ALIGN, GEMM_SP2>(lds + RING_OFF, g, S, E, tid); }
            gla_g2((const bf16*)(ws + WS_GU), (const float*)(ws + WS_GD), (bf16*)(ws + WS_GS), tid, bid, G);
            __syncthreads();
            hy_toeplitz_phase((const bf16*)(ws + WS_UT), pin(P, 7) + (size_t)l * 3 * 1536, (const float*)(ws + WS_FILT), pin(P, 15) + (size_t)l * 1024, (bf16*)(ws + WS_YT), lds, tid, lane, wave, bid, G);
            SEAM(s0 + 4); }
        if (IN(s0 + 5)) { LOCALS(); phase_d(P, ws, xres, l, lds, tid, lane, wave, bid, G); __syncthreads(); phase_e(P, ws, xres, l, lds, tid, lane, wave, bid, G); SEAM(s0 + 5); }
        if (IN(s0 + 6)) { LOCALS();
            pg8::Gemm g{mix, (const bf16*)(ws + WS_WOUT), DM, DM, DM}; pg8::TileOrder S; S.init(MTOK / 256, DM / 256, G, bid, DM, DM);
            pg8::EpiRes E{l == 0 ? (const GAS float*)pin(P, 0) : (const GAS float*)nullptr, DM, (GAS bf16*)xb, (GAS float*)(ws + WS_RSS)}; pg8::gemm_phase<pg8::EpiRes, pg8::TileOrder, GEMM_ALIGN, GEMM_SP2>(lds + RING_OFF, g, S, E, tid);
            SEAM(s0 + 6); }
        if (IN(s0 + 7)) { LOCALS();
            pg8::Gemm g{xb, (const bf16*)(ws + WS_MT), DM, DM, DM}; pg8::TileOrder S; S.init(MTOK / 256, 4, G, bid, DM, DM, 16, 4);
            pg8::EpiSoftmax E{(GAS bf16*)mix, 1024, (LAS float*)(lds + LDSCTL_OFF + 1024), (LAS float*)(lds + LDSCTL_OFF + 1024 + 4096), build_rstd(S, (const float*)(ws + WS_RSS), (LAS float*)(lds + LDSCTL_OFF + 1024 + 8192), tid)}; pg8::gemm_phase<pg8::EpiSoftmax, pg8::TileOrder, true, GEMM_SP2>(lds + RING_OFF, g, S, E, tid);
            SEAM(s0 + 7); }
        if (IN(s0 + 8)) { LOCALS();
            pg8::Gemm g{mix, (const bf16*)(ws + WS_VWO), 1024, 1024, 1024}; pg8::TileOrder S; S.init(MTOK / 256, DM / 256, G, bid, 1024, 1024, 16, 8);
            pg8::EpiRes E{(const GAS float*)nullptr, DM, (GAS bf16*)xb, (GAS float*)(ws + WS_RSS)}; pg8::gemm_phase<pg8::EpiRes, pg8::TileOrder, GEMM_ALIGN, GEMM_SP2>(lds + RING_OFF, g, S, E, tid);
            SEAM(s0 + 8); }
        if (IN(s0 + 9)) { LOCALS();
            pg8::Gemm g{xb, (const bf16*)(ws + WS_WGU), DM, DM, DM}; pg8::TileOrder S; S.init(MTOK / 256, 2 * DFF / 256, G, bid, DM, DM);
            pg8::EpiSwiglu E{(GAS bf16*)proj, DFF, build_rstd(S, (const float*)(ws + WS_RSS), (LAS float*)(lds + LDSCTL_OFF + 1024 + 8192), tid)}; pg8::gemm_phase<pg8::EpiSwiglu, pg8::TileOrder, GEMM_ALIGN, GEMM_SP2>(lds + RING_OFF, g, S, E, tid);
            SEAM(s0 + 9); }
        if (IN(s0 + 10)) { LOCALS();
            pg8::Gemm g{proj, (const bf16*)(ws + WS_WD), DFF, DFF, DFF}; pg8::TileOrder S; S.init(MTOK / 256, DM / 256, G, bid, DFF, DFF);
            pg8::EpiRes E{(const GAS float*)nullptr, DM, (GAS bf16*)xb, (GAS float*)(ws + WS_RSS)}; pg8::gemm_phase<pg8::EpiRes, pg8::TileOrder, GEMM_ALIGN, GEMM_SP2>(lds + RING_OFF, g, S, E, tid);
            SEAM(s0 + 10); }
    }
__global__ void __launch_bounds__(NTHR, 2) fwd_kernel(Params P) {
    extern __shared__ __attribute__((aligned(16))) unsigned char lds_raw[];
    LAS unsigned char* lds = (LAS unsigned char*)lds_raw; LAS unsigned char* const lds0 = lds;
    const int tid = threadIdx.x, lane = tid & 63, wave = __builtin_amdgcn_readfirstlane(tid >> 6), bid = blockIdx.x, G = gridDim.x;
    volatile LAS unsigned* MISC = (volatile LAS unsigned*)(lds + MISC_OFF);
    for (int u = tid; u < (LDS_BYTES - LDSCTL_OFF) / 4; u += NTHR) ((LAS unsigned*)(lds + LDSCTL_OFF))[u] = 0u;
    __syncthreads();
    unsigned char* ws = P.ws;
    XcdBarrier bar = xcd_barrier_post((unsigned*)(ws + WS_CTL) + CW_BAR + P.pad0 * XCD_BAR_WORDS, MISC + 8, tid);
    const int lo = P.step_lo, hi = P.step_hi;
    const int wave0 = wave, bid0 = bid, G0 = G; unsigned char* const ws0 = ws; float* const out0 = P.out;
    layer_body<0>(P, bar, lo, hi, wave0, bid0, G0, ws0, out0, lds0);
    layer_body<1>(P, bar, lo, hi, wave0, bid0, G0, ws0, out0, lds0);
    layer_body<2>(P, bar, lo, hi, wave0, bid0, G0, ws0, out0, lds0);
    layer_body<3>(P, bar, lo, hi, wave0, bid0, G0, ws0, out0, lds0);
    if (IN(NL * NPH)) { LOCALS(); const int gw = bid * NWAVES + wave, NGW = G * NWAVES;
        const float* gfin = pin(P, 25); f32x4 gg[4][2];
#pragma unroll
        for (int j = 0; j < 4; ++j) { const int c0 = (64 * j + lane) * 8; gg[j][0] = *(const GAS f32x4*)(gfin + c0); gg[j][1] = *(const GAS f32x4*)(gfin + c0 + 4); }
        for (int m0 = gw; m0 < MTOK; m0 += 2 * NGW) { v4u r[2][4];
#pragma unroll
            for (int h = 0; h < 2; ++h) { const int m1 = m0 + h * NGW, m = m1 < MTOK ? m1 : MTOK - 1; const GAS v4u* xr = (const GAS v4u*)(xb + (size_t)m * DM) + lane;
#pragma unroll
                for (int j = 0; j < 4; ++j) r[h][j] = xr[64 * j]; }
            asm volatile("" ::: "memory");
#pragma unroll
            for (int h = 0; h < 2; ++h) { const int m = m0 + h * NGW; float v[4][8]; float ss = 0.f;
#pragma unroll
                for (int j = 0; j < 4; ++j) { const v4u q = r[h][j]; v[j][0] = bflo(q.x); v[j][1] = bfhi(q.x); v[j][2] = bflo(q.y); v[j][3] = bfhi(q.y); v[j][4] = bflo(q.z); v[j][5] = bfhi(q.z); v[j][6] = bflo(q.w); v[j][7] = bfhi(q.w);
#pragma unroll
                    for (int e = 0; e < 8; ++e) ss += v[j][e] * v[j][e]; }
                const float rstd = rsqrtf(wave_sum(ss) * (1.f / DM) + EPS);
                if (m < MTOK) { float* orow = xres + (size_t)m * DM;
#pragma unroll
                    for (int j = 0; j < 4; ++j) { const int c0 = (64 * j + lane) * 8; const f32x4 g0 = gg[j][0], g1 = gg[j][1];
                        *(GAS f32x4*)(orow + c0) = (f32x4){v[j][0] * rstd * g0.x, v[j][1] * rstd * g0.y, v[j][2] * rstd * g0.z, v[j][3] * rstd * g0.w};
                        *(GAS f32x4*)(orow + c0 + 4) = (f32x4){v[j][4] * rstd * g1.x, v[j][5] * rstd * g1.y, v[j][6] * rstd * g1.z, v[j][7] * rstd * g1.w}; } } } } }
#undef IN
#undef SEAM
}

#ifndef MK_SPLIT
#define MK_SPLIT 0
#endif
extern "C" void kernel_launch(void* const* d_in, const int* in_sizes, int n_in, void* d_out, int out_size, void* d_ws, size_t ws_size, hipStream_t stream) {
    static int grid = 0;
    if (grid == 0) {
        if (n_in != 26 || in_sizes[0] != MTOK * DM || out_size != MTOK * DM || ws_size < WS_END) { fprintf(stderr, "kernel_launch: unexpected shapes (n_in %d, in0 %d, out %d, ws %zu); nothing launched\n", n_in, n_in > 0 ? in_sizes[0] : -1, out_size, ws_size); grid = -1; return; }
        int dev = 0, cus = 0, per_cu = 0;
        if (hipGetDevice(&dev) != hipSuccess || hipDeviceGetAttribute(&cus, hipDeviceAttributeMultiprocessorCount, dev) != hipSuccess) { grid = -1; return; }
        if (hipFuncSetAttribute((const void*)fwd_kernel, hipFuncAttributeMaxDynamicSharedMemorySize, LDS_BYTES) != hipSuccess) { fprintf(stderr, "kernel_launch: hipFuncSetAttribute failed\n"); grid = -1; return; }
        if (hipOccupancyMaxActiveBlocksPerMultiprocessor(&per_cu, (const void*)fwd_kernel, NTHR, LDS_BYTES) != hipSuccess || per_cu < 1) { fprintf(stderr, "kernel_launch: occupancy query says %d\n", per_cu); }
        (void)hipGetLastError();
        grid = cus;
    }
    if (grid < 0) return;
    if (hipMemsetAsync((char*)d_ws + WS_CTL, 0, CTL_ZERO_BYTES, stream) != hipSuccess) return;
    Params p{};
    for (int i = 0; i < 26; ++i) p.in[i] = (const float*)d_in[i];
    p.out = (float*)d_out; p.ws = (unsigned char*)d_ws;
#if defined(PROBE_PH)
#ifndef PROBE_FLAGS
#define PROBE_FLAGS 0
#endif
    { int lo = 0; int li = 0;
      for (int l = 0; l < NL; ++l) { const int gk = l * NPH + PROBE_PH;
          p.pad0 = li++; p.step_lo = lo; p.step_hi = gk + 1; hipLaunchKernelGGL(fwd_kernel, dim3(grid), dim3(NTHR), LDS_BYTES, stream, p);
          p.pad0 = li++; p.step_lo = gk; p.step_hi = gk + 1; p.pad1 = PROBE_FLAGS; hipLaunchKernelGGL(fwd_kernel, dim3(grid), dim3(NTHR), LDS_BYTES, stream, p); p.pad1 = 0;
          lo = gk + 1; }
      p.pad0 = li++; p.step_lo = lo; p.step_hi = NSTEPS; hipLaunchKernelGGL(fwd_kernel, dim3(grid), dim3(NTHR), LDS_BYTES, stream, p); }
#elif MK_SPLIT
    for (int st = 0; st < NSTEPS; ++st) { p.pad0 = st; p.step_lo = st; p.step_hi = st + 1; hipLaunchKernelGGL(fwd_kernel, dim3(grid), dim3(NTHR), LDS_BYTES, stream, p); }
#else
    p.step_lo = 0; p.step_hi = NSTEPS; hipLaunchKernelGGL(fwd_kernel, dim3(grid), dim3(NTHR), LDS_BYTES, stream, p);
#endif
}
```

```cpp
#include <hip/hip_runtime.h>
#include <cstdio>
#include <cstdint>

namespace pg8 {
#define PG8_LAS __attribute__((address_space(3)))
#define PG8_GAS __attribute__((address_space(1)))
typedef unsigned short bf16_t;
typedef short bf16x8 __attribute__((ext_vector_type(8)));
typedef float f32x4 __attribute__((ext_vector_type(4)));
typedef unsigned u32x4 __attribute__((ext_vector_type(4)));
constexpr int BM = 256, BK = 64, HALF = 128, HTB = HALF * BK * 2  , STAGE_BYTES = 8 * HTB, NXCD = 8, WGM = 4;

__host__ __device__ __forceinline__ int lds_byte(int r, int c) { const int st = (r >> 4) * 2 + (c >> 5), rr = r & 15, cc = c & 31, ob = rr * 64 + cc * 2; return st * 1024 + (ob ^ (((ob >> 9) & 1) << 5)); }
__host__ __device__ __forceinline__ void stage_rc(int b, int& R, int& C) { const int st = b / 1024, sb = b % 1024, swz = sb ^ (((sb >> 9) & 1) << 5); R = (st >> 1) * 16 + swz / 64; C = (st & 1) * 32 + (swz % 64) / 2; }
__host__ __device__ __forceinline__ int perm32(int rho) { const int n = rho >> 4, i = rho & 15; return 8 * (i >> 2) + 4 * n + (i & 3); }

struct Unit { size_t aoff, boff; int pm, pn; };
struct Gemm { const bf16_t* A; const bf16_t* Bt; int lda, ldb, K; };

struct TileOrder {
    int nM, nN, nwg, G, c, bdiv, bmul; size_t atile, btile;
    __device__ void init(int nM_, int nN_, int G_, int c_, int lda, int ldb, int bdiv_ = 1 << 30, int bmul_ = 0) { nM = nM_; nN = nN_; nwg = nM * nN; G = G_; c = c_; bdiv = bdiv_; bmul = bmul_; atile = (size_t)BM * lda * 2; btile = (size_t)BM * ldb * 2; }
    __device__ bool next(int i, Unit& u) const {
        const long L = (long)i * G + c; if (L >= nwg) return false;
        int wgid = (int)L; { const int q = nwg / NXCD, r = nwg % NXCD, xcd = wgid % NXCD, off = wgid / NXCD; wgid = (xcd < r ? xcd * (q + 1) : r * (q + 1) + (xcd - r) * q) + off; }
        const int nig = WGM * nN, gid = wgid / nig, fm = gid * WGM, gsz = (nM - fm) < WGM ? (nM - fm) : WGM;
        u.pm = fm + ((wgid % nig) % gsz); u.pn = (wgid % nig) / gsz;
        u.aoff = (size_t)u.pm * atile; u.boff = (size_t)((u.pm / bdiv) * bmul + u.pn) * btile; return true;
    }
    __device__ __forceinline__ void a_ready(const Unit&) const {}
    __device__ __forceinline__ void done(const Unit&) const {}
};
template <int MODE> struct PairOrder {
    int G, c;
    __device__ bool next(int i, Unit& u) const {
        const long L = (long)i * G + c; if (L >= 256) return false;
        const int bh = (int)L >> 3, j = (int)L & 7, b = bh >> 2, h = bh & 3;
        if (MODE == 0) { u.aoff = ((size_t)(b * 256) * 4096 + h * 512) * 2; u.boff = ((size_t)(j * 256) * 2048 + h * 512) * 2; u.pm = b * 4 + h; u.pn = j; }
        else           { u.aoff = ((size_t)(j * 256) * 2048 + h * 512) * 2; u.boff = ((size_t)(b * 256) * 4096 + 2048 + h * 512) * 2; u.pm = b * 8 + j; u.pn = h; }
        return true;
    }
    __device__ __forceinline__ void a_ready(const Unit&) const {}
    __device__ __forceinline__ void done(const Unit&) const {}
};

struct FnetAOrder {
    int G, c;
    __device__ bool next(int i, Unit& u) const {
        const long L = (long)i * G + c; if (L >= 512) return false;
        const int combo = (int)L >> 5, rest = (int)L & 31, b = combo >> 1, gp = combo & 1, pml = rest >> 4, pn = rest & 15;
        u.aoff = (size_t)pml * 256 * 256 * 2; u.boff = ((size_t)(b * 4096 + pn * 256) * 3840 + 1792 + gp * 256) * 2; u.pm = b * 4 + gp * 2 + pml; u.pn = pn; return true;
    }
    __device__ __forceinline__ void a_ready(const Unit&) const {}
    __device__ __forceinline__ void done(const Unit&) const {}
};

__device__ __forceinline__ unsigned cvt_pk_bf16(float lo, float hi) { unsigned r; asm volatile("v_cvt_pk_bf16_f32 %0, %1, %2" : "=v"(r) : "v"(lo), "v"(hi)); return r; }

struct RstdTab { const PG8_LAS float* tab; const PG8_GAS float* RS; int pm0, pm1, pm2, pm3;
    __device__ __forceinline__ int slot(int pm) const { return !tab ? -2 : pm == pm0 ? 0 : pm == pm1 ? 1 : pm == pm2 ? 2 : pm == pm3 ? 3 : -1; }
    __device__ __forceinline__ void rows(const Unit& u, int wr, int fr, int fq, float (&rs)[2][4]) const {
        const int sl = slot(u.pm);
        if (sl == -2) {
#pragma unroll
            for (int ai = 0; ai < 2; ++ai)
#pragma unroll
                for (int m = 0; m < 4; ++m) rs[ai][m] = 1.0f;
        } else if (sl >= 0) {
#pragma unroll
            for (int ai = 0; ai < 2; ++ai)
#pragma unroll
                for (int m = 0; m < 4; ++m) rs[ai][m] = tab[sl * 256 + ai * HALF + wr * 64 + m * 16 + fr];
        } else {
#pragma unroll
            for (int ai = 0; ai < 2; ++ai)
#pragma unroll
                for (int m = 0; m < 4; ++m) { const PG8_GAS float* p = RS + (size_t)(u.pm * BM + ai * HALF + wr * 64 + m * 16 + fr) * 32 + fq * 8;
                    const f32x4 a = *(const PG8_GAS f32x4*)p, b = *(const PG8_GAS f32x4*)(p + 4);
                    float t = ((a[0] + a[1]) + (a[2] + a[3])) + ((b[0] + b[1]) + (b[2] + b[3])); t += __shfl_xor(t, 16); t += __shfl_xor(t, 32);
                    rs[ai][m] = rsqrtf(t * (1.0f / 2048.0f) + 1e-6f); }
        }
    }
};
struct EpiBf16 {
    static constexpr bool PERM = true, AFTER_DRAIN = false;
    PG8_GAS bf16_t* O; int ldc; RstdTab R;
    __device__ __forceinline__ void operator()(const f32x4 (&acc)[2][2][4][2], const Unit& u, int wr, int wc, int fr, int fq) const {
        const int row0 = u.pm * BM + wr * 64 + fr, col0 = u.pn * BM + wc * 32 + 8 * fq;
        float rs[2][4]; R.rows(u, wr, fr, fq, rs);
#pragma unroll
        for (int ai = 0; ai < 2; ++ai)
#pragma unroll
            for (int m = 0; m < 4; ++m) { PG8_GAS bf16_t* rowp = O + (size_t)(row0 + ai * HALF + m * 16) * ldc + col0;
#pragma unroll
                for (int bj = 0; bj < 2; ++bj) { const f32x4 v0 = acc[ai][bj][m][0] * rs[ai][m], v1 = acc[ai][bj][m][1] * rs[ai][m];
                    u32x4 w; w.x = cvt_pk_bf16(v0[0], v0[1]); w.y = cvt_pk_bf16(v0[2], v0[3]); w.z = cvt_pk_bf16(v1[0], v1[1]); w.w = cvt_pk_bf16(v1[2], v1[3]);
                    *(PG8_GAS u32x4*)(rowp + bj * HALF) = w; } }
    }
};
struct EpiBf16T {
    static constexpr bool PERM = true, AFTER_DRAIN = false;
    PG8_GAS bf16_t* O; int ldc; RstdTab R;
    __device__ __forceinline__ void operator()(const f32x4 (&acc)[2][2][4][2], const Unit& u, int wr, int wc, int fr, int fq) const {
        const int row0 = u.pm * BM + wr * 64 + fr, col0 = u.pn * BM + wc * 32 + 8 * fq;
        const int sl = R.slot(u.pn); f32x4 cs[2][2];
#pragma unroll
        for (int bj = 0; bj < 2; ++bj) { const int cl = bj * HALF + wc * 32 + 8 * fq;
            if (sl >= 0) { cs[bj][0] = *(const PG8_LAS f32x4*)(R.tab + sl * 256 + cl); cs[bj][1] = *(const PG8_LAS f32x4*)(R.tab + sl * 256 + cl + 4); }
            else {
#pragma unroll
                for (int e = 0; e < 8; ++e) { const PG8_GAS float* p = R.RS + (size_t)(u.pn * BM + cl + e) * 32; float t = 0.f;
#pragma unroll
                    for (int j = 0; j < 32; ++j) t += p[j];
                    cs[bj][e >> 2][e & 3] = rsqrtf(t * (1.0f / 2048.0f) + 1e-6f); } } }
#pragma unroll
        for (int ai = 0; ai < 2; ++ai)
#pragma unroll
            for (int m = 0; m < 4; ++m) { PG8_GAS bf16_t* rowp = O + (size_t)(row0 + ai * HALF + m * 16) * ldc + col0;
#pragma unroll
                for (int bj = 0; bj < 2; ++bj) { const f32x4 v0 = acc[ai][bj][m][0] * cs[bj][0], v1 = acc[ai][bj][m][1] * cs[bj][1];
                    u32x4 w; w.x = cvt_pk_bf16(v0[0], v0[1]); w.y = cvt_pk_bf16(v0[2], v0[3]); w.z = cvt_pk_bf16(v1[0], v1[1]); w.w = cvt_pk_bf16(v1[2], v1[3]);
                    *(PG8_GAS u32x4*)(rowp + bj * HALF) = w; } }
    }
};
struct EpiFnetA {
    static constexpr bool PERM = true, AFTER_DRAIN = false;
    PG8_GAS bf16_t* O;
    __device__ __forceinline__ void operator()(const f32x4 (&acc)[2][2][4][2], const Unit& u, int wr, int wc, int fr, int fq) const {
        const int col0 = u.pn * BM + wc * 32 + 8 * fq;
#pragma unroll
        for (int ai = 0; ai < 2; ++ai)
#pragma unroll
            for (int m = 0; m < 4; ++m) { PG8_GAS bf16_t* rowp = O + (size_t)(u.pm * 128 + wr * 64 + m * 16 + fr) * 8192 + ai * 4096 + col0;
#pragma unroll
                for (int bj = 0; bj < 2; ++bj) { const f32x4 v0 = acc[ai][bj][m][0], v1 = acc[ai][bj][m][1];
                    u32x4 w; w.x = cvt_pk_bf16(v0[0], v0[1]); w.y = cvt_pk_bf16(v0[2], v0[3]); w.z = cvt_pk_bf16(v1[0], v1[1]); w.w = cvt_pk_bf16(v1[2], v1[3]);
                    *(PG8_GAS u32x4*)(rowp + bj * HALF) = w; } }
    }
};
struct EpiF32 {
    static constexpr bool PERM = false, AFTER_DRAIN = false;
    PG8_GAS float* C; int ldc;
    __device__ __forceinline__ void operator()(const f32x4 (&acc)[2][2][4][2], const Unit& u, int wr, int wc, int fr, int fq) const {
        const int row0 = u.pm * BM + wr * 64 + fr, col0 = u.pn * BM + wc * 32 + 4 * fq;
#pragma unroll
        for (int ai = 0; ai < 2; ++ai)
#pragma unroll
            for (int m = 0; m < 4; ++m) { PG8_GAS float* rowp = C + (size_t)(row0 + ai * HALF + m * 16) * ldc + col0;
#pragma unroll
                for (int bj = 0; bj < 2; ++bj)
#pragma unroll
                    for (int n = 0; n < 2; ++n) *(PG8_GAS f32x4*)(rowp + bj * HALF + n * 16) = acc[ai][bj][m][n]; }
    }
};
struct EpiRes {
    static constexpr bool PERM = true, AFTER_DRAIN = false;
    const PG8_GAS float* Xs32; int ldc; PG8_GAS bf16_t* XB; PG8_GAS float* RS;
    __device__ __forceinline__ void operator()(const f32x4 (&acc)[2][2][4][2], const Unit& u, int wr, int wc, int fr, int fq) const {
        const int row0 = u.pm * BM + wr * 64 + fr, col0 = u.pn * BM + wc * 32 + 8 * fq;
#pragma unroll
        for (int ai = 0; ai < 2; ++ai) {
            f32x4 xv[4][2][2];
            if (Xs32) {
#pragma unroll
                for (int m = 0; m < 4; ++m) { const PG8_GAS float* rowp = Xs32 + (size_t)(row0 + ai * HALF + m * 16) * ldc + col0;
#pragma unroll
                    for (int bj = 0; bj < 2; ++bj)
#pragma unroll
                        for (int n = 0; n < 2; ++n) xv[m][bj][n] = __builtin_nontemporal_load((const PG8_GAS f32x4*)(rowp + bj * HALF + n * 4)); }
            } else {
                u32x4 xr[4][2];
#pragma unroll
                for (int m = 0; m < 4; ++m)
#pragma unroll
                    for (int bj = 0; bj < 2; ++bj) xr[m][bj] = *(const PG8_GAS u32x4*)(XB + (size_t)(row0 + ai * HALF + m * 16) * ldc + col0 + bj * HALF);
#pragma unroll
                for (int m = 0; m < 4; ++m)
#pragma unroll
                    for (int bj = 0; bj < 2; ++bj) { const u32x4 r = xr[m][bj];
                        xv[m][bj][0] = (f32x4){__builtin_bit_cast(float, r.x << 16), __builtin_bit_cast(float, r.x & 0xffff0000u), __builtin_bit_cast(float, r.y << 16), __builtin_bit_cast(float, r.y & 0xffff0000u)};
                        xv[m][bj][1] = (f32x4){__builtin_bit_cast(float, r.z << 16), __builtin_bit_cast(float, r.z & 0xffff0000u), __builtin_bit_cast(float, r.w << 16), __builtin_bit_cast(float, r.w & 0xffff0000u)}; }
            }
#pragma unroll
            for (int m = 0; m < 4; ++m) { const int row = row0 + ai * HALF + m * 16; float ss = 0.f;
#pragma unroll
                for (int bj = 0; bj < 2; ++bj) { const f32x4 y0 = xv[m][bj][0] + acc[ai][bj][m][0], y1 = xv[m][bj][1] + acc[ai][bj][m][1];
                    ss += ((y0[0] * y0[0] + y0[1] * y0[1]) + (y0[2] * y0[2] + y0[3] * y0[3])) + ((y1[0] * y1[0] + y1[1] * y1[1]) + (y1[2] * y1[2] + y1[3] * y1[3]));
                    u32x4 w; w.x = cvt_pk_bf16(y0[0], y0[1]); w.y = cvt_pk_bf16(y0[2], y0[3]); w.z = cvt_pk_bf16(y1[0], y1[1]); w.w = cvt_pk_bf16(y1[2], y1[3]);
                    *(PG8_GAS u32x4*)(XB + (size_t)row * ldc + col0 + bj * HALF) = w; }
                ss += __shfl_xor(ss, 16); ss += __shfl_xor(ss, 32); if (fq == 0) RS[(size_t)row * 32 + u.pn * 4 + wc] = ss; }
            asm volatile("" ::: "memory"); }
    }
};
struct EpiSoftmax {
    static constexpr bool PERM = true, AFTER_DRAIN = false;
    PG8_GAS bf16_t* O; int ldc; PG8_LAS float* T1; PG8_LAS float* T2; RstdTab R;
    typedef float f32x2 __attribute__((ext_vector_type(2)));
    static __device__ __forceinline__ f32x2 ex2(float x0, float x1, float c1, float m2) { const f32x2 t = (f32x2){x0, x1} * c1 - m2; f32x2 e; e.x = __builtin_amdgcn_exp2f(t.x); e.y = __builtin_amdgcn_exp2f(t.y); return e; }
    __device__ __forceinline__ void operator()(const f32x4 (&acc)[2][2][4][2], const Unit& u, int wr, int wc, int fr, int fq) const {
        const int row0 = u.pm * BM + wr * 64 + fr, col0 = u.pn * BM + wc * 32 + 8 * fq;
        float m2[2][4]; float rs[2][4]; R.rows(u, wr, fr, fq, rs);
#pragma unroll
        for (int ai = 0; ai < 2; ++ai)
#pragma unroll
            for (int m = 0; m < 4; ++m) { float a = -3.0e38f;
#pragma unroll
                for (int bj = 0; bj < 2; ++bj)
#pragma unroll
                    for (int n = 0; n < 2; ++n) { const f32x4 v = acc[ai][bj][m][n]; a = fmaxf(a, fmaxf(fmaxf(v[0], v[1]), fmaxf(v[2], v[3]))); }
                a = fmaxf(a, __shfl_xor(a, 16)); a = fmaxf(a, __shfl_xor(a, 32));
                if (fq == 0) T1[(ai * HALF + wr * 64 + m * 16 + fr) * 4 + wc] = a * rs[ai][m]; }
        asm volatile("s_waitcnt lgkmcnt(0)" ::: "memory"); __builtin_amdgcn_s_barrier(); asm volatile("" ::: "memory");
#pragma unroll
        for (int ai = 0; ai < 2; ++ai)
#pragma unroll
            for (int m = 0; m < 4; ++m) { const f32x4 t = *(const PG8_LAS f32x4*)(T1 + (ai * HALF + wr * 64 + m * 16 + fr) * 4); const float c1 = rs[ai][m] * 1.4426950408889634f;
                m2[ai][m] = fmaxf(fmaxf(t[0], t[1]), fmaxf(t[2], t[3])) * 1.4426950408889634f; f32x2 a2 = (f32x2){0.f, 0.f};
#pragma unroll
                for (int bj = 0; bj < 2; ++bj)
#pragma unroll
                    for (int n = 0; n < 2; ++n) { const f32x4 v = acc[ai][bj][m][n]; a2 += ex2(v[0], v[1], c1, m2[ai][m]) + ex2(v[2], v[3], c1, m2[ai][m]); }
                float a = a2.x + a2.y; a += __shfl_xor(a, 16); a += __shfl_xor(a, 32);
                if (fq == 0) T2[(ai * HALF + wr * 64 + m * 16 + fr) * 4 + wc] = a; }
        asm volatile("s_waitcnt lgkmcnt(0)" ::: "memory"); __builtin_amdgcn_s_barrier(); asm volatile("" ::: "memory");
#pragma unroll
        for (int ai = 0; ai < 2; ++ai)
#pragma unroll
            for (int m = 0; m < 4; ++m) { const f32x4 t = *(const PG8_LAS f32x4*)(T2 + (ai * HALF + wr * 64 + m * 16 + fr) * 4); const float inv = 1.0f / ((t[0] + t[1]) + (t[2] + t[3])), mm = m2[ai][m], c1 = rs[ai][m] * 1.4426950408889634f;
                PG8_GAS bf16_t* rowp = O + (size_t)(row0 + ai * HALF + m * 16) * ldc + col0;
#pragma unroll
                for (int bj = 0; bj < 2; ++bj) { const f32x4 v0 = acc[ai][bj][m][0], v1 = acc[ai][bj][m][1];
                    const f32x2 p0 = ex2(v0[0], v0[1], c1, mm) * inv, p1 = ex2(v0[2], v0[3], c1, mm) * inv, p2 = ex2(v1[0], v1[1], c1, mm) * inv, p3 = ex2(v1[2], v1[3], c1, mm) * inv;
                    u32x4 w; w.x = cvt_pk_bf16(p0.x, p0.y); w.y = cvt_pk_bf16(p1.x, p1.y); w.z = cvt_pk_bf16(p2.x, p2.y); w.w = cvt_pk_bf16(p3.x, p3.y);
                    *(PG8_GAS u32x4*)(rowp + bj * HALF) = w; } }
    }
};
__device__ __forceinline__ float silu_f(float g) { return g * __builtin_amdgcn_rcpf(1.0f + __expf(-g)); }
struct EpiSwiglu {
    static constexpr bool PERM = true, AFTER_DRAIN = false;
    PG8_GAS bf16_t* H; int ldc; RstdTab R;
    typedef float f32x2 __attribute__((ext_vector_type(2)));
    static __device__ __forceinline__ void quad(f32x4 G, f32x4 U, float a, float q, unsigned& w0, unsigned& w1) {
        const f32x2 G01 = (f32x2){G[0], G[1]}, G23 = (f32x2){G[2], G[3]}, U01 = (f32x2){U[0], U[1]}, U23 = (f32x2){U[2], U[3]};
        const f32x2 t01 = __builtin_elementwise_min(G01 * a, (f32x2){30.f, 30.f}), t23 = __builtin_elementwise_min(G23 * a, (f32x2){30.f, 30.f});
        f32x2 e01, e23; e01.x = __builtin_amdgcn_exp2f(t01.x); e01.y = __builtin_amdgcn_exp2f(t01.y); e23.x = __builtin_amdgcn_exp2f(t23.x); e23.y = __builtin_amdgcn_exp2f(t23.y);
        const f32x2 d01 = e01 + 1.0f, d23 = e23 + 1.0f, pp = d01 * d23;
        const float r = __builtin_amdgcn_rcpf(pp.x * pp.y);
        const f32x2 rp = (f32x2){pp.y, pp.x} * r;
        const f32x2 i01 = rp * d23, i23 = rp * d01;
        const f32x2 h01 = (G01 * U01) * (i01 * q), h23 = (G23 * U23) * (i23 * q);
        w0 = cvt_pk_bf16(h01.x, h01.y); w1 = cvt_pk_bf16(h23.x, h23.y);
    }
    __device__ __forceinline__ void operator()(const f32x4 (&acc)[2][2][4][2], const Unit& u, int wr, int wc, int fr, int fq) const {
        const int row0 = u.pm * BM + wr * 64 + fr, col0 = u.pn * HALF + wc * 32 + 8 * fq;
        float rs[2][4]; R.rows(u, wr, fr, fq, rs);
#pragma unroll
        for (int ai = 0; ai < 2; ++ai)
#pragma unroll
            for (int m = 0; m < 4; ++m) { PG8_GAS bf16_t* rowp = H + (size_t)(row0 + ai * HALF + m * 16) * ldc + col0;
                const float a = rs[ai][m] * -1.4426950408889634f, q = rs[ai][m] * rs[ai][m];
                const f32x4 g0 = acc[ai][0][m][0], g1 = acc[ai][0][m][1], u0 = acc[ai][1][m][0], u1 = acc[ai][1][m][1];
                u32x4 w; unsigned wa, wb, wc2, wd; quad(g0, u0, a, q, wa, wb); quad(g1, u1, a, q, wc2, wd); w.x = wa; w.y = wb; w.z = wc2; w.w = wd;
                *(PG8_GAS u32x4*)rowp = w; }
    }
};

template <class Epi, class Sched, bool ALIGN_EPI = false, bool SP2 = false>
__device__ __forceinline__ void gemm_phase(PG8_LAS unsigned char* lds, const Gemm g, const Sched& S, const Epi& E, int tid_in) {
    int tid = tid_in; asm volatile("" : "+v"(tid));
    const int wid = __builtin_amdgcn_readfirstlane(tid >> 6), lane = tid & 63, wr = wid >> 2, wc = wid & 3, fr = lane & 15, fq = lane >> 4;
    const int K = g.K, nt = K / BK;
    unsigned voffA[2], voffB[2];
#pragma unroll
    for (int i = 0; i < 2; ++i) { int R, C; stage_rc(tid * 16 + i * 8192, R, C); const int Rb = Epi::PERM ? ((R & ~31) + perm32(R & 31)) : R;
        voffA[i] = (unsigned)(R * g.lda + C) * 2u; voffB[i] = (unsigned)(Rb * g.ldb + C) * 2u; }
    const size_t kstep = (size_t)(BK * 2);
    const size_t hstepA = (size_t)HALF * g.lda * 2, hstepB = (size_t)HALF * g.ldb * 2;
    const unsigned ldsw = (unsigned)wid * 1024u;
    const int aoff = lds_byte(wr * 64 + fr, fq * 8), boff = lds_byte(wc * 32 + fr, fq * 8);
#define PG8_SA(b, h) (((b) * 2 + (h)) * HTB)
#define PG8_SB(b, h) ((4 + (b) * 2 + (h)) * HTB)
#define PG8_STAGE(bufoff, gbase, voff) do { _Pragma("unroll") for (int _i = 0; _i < 2; ++_i) \
        __builtin_amdgcn_global_load_lds((const unsigned*)((const char*)(gbase) + (voff)[_i]), (PG8_LAS unsigned*)(lds + (bufoff) + ldsw + _i * 8192), 16, 0, 0); } while (0)
#define PG8_LDA(dst, b, h) do { _Pragma("unroll") for (int m = 0; m < 4; ++m) _Pragma("unroll") for (int k = 0; k < 2; ++k) dst[m][k] = *(const PG8_LAS bf16x8*)(lds + PG8_SA(b, h) + aoff + m * 2048 + k * 1024); } while (0)
#define PG8_LDB(dst, b, h) do { _Pragma("unroll") for (int n = 0; n < 2; ++n) _Pragma("unroll") for (int k = 0; k < 2; ++k) dst[n][k] = *(const PG8_LAS bf16x8*)(lds + PG8_SB(b, h) + boff + n * 2048 + k * 1024); } while (0)
#define PG8_MMA(ai, bj, At, Bt) do { __builtin_amdgcn_s_setprio(1); _Pragma("unroll") for (int m = 0; m < 4; ++m) _Pragma("unroll") for (int n = 0; n < 2; ++n) _Pragma("unroll") for (int k = 0; k < 2; ++k) \
        acc[ai][bj][m][n] = __builtin_amdgcn_mfma_f32_16x16x32_bf16(Bt[n][k], At[m][k], acc[ai][bj][m][n], 0, 0, 0); __builtin_amdgcn_s_setprio(0); } while (0)
#define PG8_WAIT_V(n) asm volatile("s_waitcnt vmcnt(" #n ")" ::: "memory")
#define PG8_WAIT_L(n) asm volatile("s_waitcnt lgkmcnt(" #n ")" ::: "memory")
#define PG8_BAR __builtin_amdgcn_s_barrier()
#define PG8_SCHED __builtin_amdgcn_sched_barrier(0)
    Unit cur, nxt; int ui = 0;
    if (!S.next(0, cur)) return;
    f32x4 acc[2][2][4][2];
#pragma unroll
    for (int a = 0; a < 2; ++a)
#pragma unroll
        for (int b = 0; b < 2; ++b)
#pragma unroll
            for (int m = 0; m < 4; ++m)
#pragma unroll
                for (int n = 0; n < 2; ++n) acc[a][b][m][n] = (f32x4){0.f, 0.f, 0.f, 0.f};
    bf16x8 At[4][2], B0[2][2], B1[2][2];
    const char* cA = (const char*)g.A + cur.aoff; const char* cB = (const char*)g.Bt + cur.boff;
    S.a_ready(cur);
    if constexpr (SP2) {
        PG8_STAGE(PG8_SB(0, 0), cB, voffB); PG8_STAGE(PG8_SB(0, 1), cB + hstepB, voffB); PG8_STAGE(PG8_SA(0, 0), cA, voffA); PG8_STAGE(PG8_SA(0, 1), cA + hstepA, voffA);
        if (wr == 1) PG8_BAR;
        PG8_WAIT_V(2); PG8_BAR;
        PG8_STAGE(PG8_SB(1, 0), cB + kstep, voffB); PG8_STAGE(PG8_SA(1, 0), cA + kstep, voffA); PG8_STAGE(PG8_SB(1, 1), cB + hstepB + kstep, voffB);
        PG8_WAIT_V(6); PG8_BAR;
    } else {
        PG8_STAGE(PG8_SB(0, 0), cB, voffB); PG8_STAGE(PG8_SA(0, 0), cA, voffA); PG8_STAGE(PG8_SB(0, 1), cB + hstepB, voffB); PG8_STAGE(PG8_SA(0, 1), cA + hstepA, voffA);
        if (wr == 1) PG8_BAR;
        PG8_WAIT_V(4); PG8_BAR;
        PG8_STAGE(PG8_SB(1, 0), cB + kstep, voffB); PG8_STAGE(PG8_SA(1, 0), cA + kstep, voffA); PG8_STAGE(PG8_SB(1, 1), cB + hstepB + kstep, voffB);
        PG8_WAIT_V(6); PG8_BAR;
    }
    for (;;) {
        const bool has_next = S.next(ui + 1, nxt);
        const char* nA = has_next ? (const char*)g.A + nxt.aoff : cA; const char* nB = has_next ? (const char*)g.Bt + nxt.boff : cB;
        for (int t = 0; t < nt; t += 2) {
            const bool last = (t == nt - 2);
            const char* a1 = cA + (size_t)(t + 1) * kstep;
            const char* a2 = last ? nA : cA + (size_t)(t + 2) * kstep; const char* b2 = last ? nB : cB + (size_t)(t + 2) * kstep;
            const char* a3 = a2 + kstep; const char* b3 = b2 + kstep;
            if (last && has_next) S.a_ready(nxt);
            if constexpr (SP2) {
            PG8_LDB(B0, 0, 0); PG8_LDB(B1, 0, 1); PG8_SCHED; PG8_LDA(At, 0, 0); PG8_STAGE(PG8_SA(1, 1), a1 + hstepA, voffA);
            PG8_WAIT_V(8); PG8_WAIT_L(0); PG8_BAR; PG8_MMA(0, 0, At, B0); PG8_MMA(0, 1, At, B1); PG8_BAR; PG8_SCHED;
            PG8_LDA(At, 0, 1); PG8_STAGE(PG8_SB(0, 0), b2, voffB); PG8_STAGE(PG8_SB(0, 1), b2 + hstepB, voffB); PG8_STAGE(PG8_SA(0, 0), a2, voffA);
            PG8_WAIT_V(8); PG8_WAIT_L(0); PG8_BAR; PG8_MMA(1, 0, At, B0); PG8_MMA(1, 1, At, B1); PG8_BAR; PG8_SCHED;
            PG8_LDB(B0, 1, 0); PG8_LDB(B1, 1, 1); PG8_SCHED; PG8_LDA(At, 1, 0); PG8_STAGE(PG8_SA(0, 1), a2 + hstepA, voffA);
            PG8_WAIT_V(8); PG8_WAIT_L(0); PG8_BAR; PG8_MMA(0, 0, At, B0); PG8_MMA(0, 1, At, B1); PG8_BAR; PG8_SCHED;
            PG8_LDA(At, 1, 1); PG8_STAGE(PG8_SB(1, 0), b3, voffB); PG8_STAGE(PG8_SB(1, 1), b3 + hstepB, voffB); PG8_STAGE(PG8_SA(1, 0), a3, voffA);
            PG8_WAIT_V(8); PG8_WAIT_L(0); PG8_BAR; PG8_MMA(1, 0, At, B0); PG8_MMA(1, 1, At, B1); PG8_BAR; PG8_SCHED;
            } else {
            PG8_LDB(B0, 0, 0); PG8_SCHED; PG8_LDA(At, 0, 0); PG8_STAGE(PG8_SA(1, 1), a1 + hstepA, voffA);
            PG8_WAIT_L(8); PG8_BAR; PG8_WAIT_L(0); PG8_MMA(0, 0, At, B0); PG8_BAR; PG8_SCHED;
            PG8_LDB(B1, 0, 1); PG8_STAGE(PG8_SB(0, 0), b2, voffB);
            PG8_BAR; PG8_WAIT_L(0); PG8_MMA(0, 1, At, B1); PG8_BAR;
            PG8_LDA(At, 0, 1); PG8_STAGE(PG8_SA(0, 0), a2, voffA);
            PG8_BAR; PG8_WAIT_L(0); PG8_MMA(1, 0, At, B0); PG8_BAR; PG8_SCHED;
            PG8_STAGE(PG8_SB(0, 1), b2 + hstepB, voffB);
            PG8_WAIT_V(6); PG8_BAR; PG8_MMA(1, 1, At, B1); PG8_BAR;
            PG8_LDB(B0, 1, 0); PG8_SCHED; PG8_LDA(At, 1, 0); PG8_STAGE(PG8_SA(0, 1), a2 + hstepA, voffA);
            PG8_WAIT_L(8); PG8_BAR; PG8_WAIT_L(0); PG8_MMA(0, 0, At, B0); PG8_BAR; PG8_SCHED;
            PG8_LDB(B1, 1, 1); PG8_STAGE(PG8_SB(1, 0), b3, voffB);
            PG8_BAR; PG8_WAIT_L(0); PG8_MMA(0, 1, At, B1); PG8_BAR;
            PG8_LDA(At, 1, 1); PG8_STAGE(PG8_SA(1, 0), a3, voffA);
            PG8_BAR; PG8_WAIT_L(0); PG8_MMA(1, 0, At, B0); PG8_BAR; PG8_SCHED;
            PG8_STAGE(PG8_SB(1, 1), b3 + hstepB, voffB);
            PG8_WAIT_V(6); PG8_BAR; PG8_MMA(1, 1, At, B1); PG8_BAR;
            }
        }
        if constexpr (ALIGN_EPI) { if (wr == 0) PG8_BAR; }
        if constexpr (!Epi::AFTER_DRAIN) { E(acc, cur, wr, wc, fr, fq); S.done(cur); }
        if (!has_next) break;
#pragma unroll
        for (int a = 0; a < 2; ++a)
#pragma unroll
            for (int b = 0; b < 2; ++b)
#pragma unroll
                for (int m = 0; m < 4; ++m)
#pragma unroll
                    for (int n = 0; n < 2; ++n) acc[a][b][m][n] = (f32x4){0.f, 0.f, 0.f, 0.f};
        cur = nxt; cA = nA; cB = nB; ++ui;
        if constexpr (ALIGN_EPI) { if (wr == 1) PG8_BAR; }
    }
    PG8_WAIT_V(0);
    if constexpr (!ALIGN_EPI) { if (wr == 0) PG8_BAR; }
    PG8_BAR;
    if constexpr (Epi::AFTER_DRAIN) { E.fused(acc, cur, wr, wc, fr, fq, lds, wid, lane); S.done(cur); }
#undef PG8_SA
#undef PG8_SB
#undef PG8_STAGE
#undef PG8_LDA
#undef PG8_LDB
#undef PG8_MMA
#undef PG8_WAIT_V
#undef PG8_WAIT_L
#undef PG8_BAR
#undef PG8_SCHED
}
}

constexpr int NB = 8, SEQ = 4096, DM = 2048, NL = 4, MTOK = NB * SEQ, NMEM = 256;
constexpr int DIN = 5152, NPROJ = 3840, NWIN = 5376, DFF = 5632;
constexpr int PQ = 0, PK = 256, PV = 512, PG = 1024, PLR = 1536, PUF = 1792, PUS = 2304, WUH = 3840;
constexpr float EPS = 1e-6f;
constexpr int NWAVES = 8, NTHR = 512;

constexpr size_t MiB = 1u << 20;
constexpr size_t WS_CTL = 0, CTL_ZERO_BYTES = 1 * MiB;
constexpr size_t WS_WIN = 1 * MiB, WS_WOUT = 23 * MiB, WS_WQB = 31 * MiB, WS_WKV = 39 * MiB, WS_WXO = 55 * MiB, WS_WGU = 63 * MiB, WS_WD = 107 * MiB;
constexpr size_t WS_KVB = 129 * MiB, WS_MT = 145 * MiB, WS_VWO = 177 * MiB, WS_MEMN = 209 * MiB;
constexpr size_t WS_XB = 217 * MiB, WS_PROJ = 345 * MiB, WS_MIX = 697 * MiB, WS_OF = 825 * MiB, WS_FU = 889 * MiB, WS_FILT = 1017 * MiB, WS_UT = 1049 * MiB, WS_YT = 1145 * MiB;
constexpr size_t WS_FU2 = 889 * MiB, WS_FY = 953 * MiB, WS_C2 = 1177 * MiB, WS_S2 = 1186 * MiB, WS_FE = 1194 * MiB, WS_FO = 1211 * MiB, WS_Y2K = 1227 * MiB, WS_A1 = 1241 * MiB;
constexpr int FK1 = 2176;
constexpr size_t WS_GS = 825 * MiB, WS_GU = 1242 * MiB, WS_GD = 1370 * MiB;
constexpr size_t WS_RSS = 1371 * MiB;
constexpr size_t WS_END = 1375 * MiB;
constexpr int CW_BAR = 4096;

constexpr int RING_OFF = 0, RING_BYTES = 131072;
constexpr int LDSCTL_OFF = RING_BYTES, MISC_OFF = LDSCTL_OFF + 320;
constexpr int LDS_BYTES = 147456;

#define GAS __attribute__((address_space(1)))
#define LAS __attribute__((address_space(3)))
typedef unsigned short bf16;
typedef unsigned v4u __attribute__((ext_vector_type(4)));
typedef unsigned v2u __attribute__((ext_vector_type(2)));
typedef float f32x4 __attribute__((ext_vector_type(4)));
typedef GAS unsigned gu32;
#define LDS_WAIT() asm volatile("s_waitcnt lgkmcnt(0)" ::: "memory")
__device__ __forceinline__ unsigned f2bf(float f) { unsigned u = __builtin_bit_cast(unsigned, f); return (u + 0x7fffu + ((u >> 16) & 1u)) >> 16; }
__device__ __forceinline__ unsigned pk2(float lo, float hi) { return f2bf(lo) | (f2bf(hi) << 16); }
__device__ __forceinline__ float bf2f(bf16 h) { return __builtin_bit_cast(float, ((unsigned)h) << 16); }
__device__ __forceinline__ float bflo(unsigned w) { return __builtin_bit_cast(float, w << 16); }
__device__ __forceinline__ float bfhi(unsigned w) { return __builtin_bit_cast(float, w & 0xffff0000u); }

#define XB_TMO      128
#define XB_XCNT(j)  (256  + 64 * (j))
#define XB_XSUB(j)  (1280 + 64 * (j))
#define XB_XGEN(j)  (2304 + 64 * (j))
#define XB_TOP      3328
#define XB_TOPGEN   3392
#define XCD_BAR_WORDS 3456
#define XB_SPIN_CAP (1u << 18)

__device__ __forceinline__ unsigned xb_ld(unsigned* p)              { return __hip_atomic_load(p, __ATOMIC_RELAXED, __HIP_MEMORY_SCOPE_AGENT); }
__device__ __forceinline__ unsigned xb_add(unsigned* p, unsigned v) { return __hip_atomic_fetch_add(p, v, __ATOMIC_RELAXED, __HIP_MEMORY_SCOPE_AGENT); }
__device__ __forceinline__ unsigned xb_xcc_id() { return (unsigned)__builtin_amdgcn_s_getreg((3 << 11) | 20) & 0xFu; }
#define XB_SPIN(cond, bar) do { unsigned _sp = 0; while (cond) { __builtin_amdgcn_s_sleep(1); \
    if ((++_sp & 255u) == 0u) { if (xb_ld(&(bar)[XB_TMO])) break; if (_sp > XB_SPIN_CAP) { atomicAdd(&(bar)[XB_TMO], 1u); break; } } } } while (0)

struct XcdBarrier { unsigned* bar; unsigned x; volatile LAS unsigned* st; };

__device__ __forceinline__ XcdBarrier xcd_barrier_post(unsigned* bar, volatile LAS unsigned* st, int tid) {
    XcdBarrier b; b.bar = bar; b.x = xb_xcc_id(); b.st = st;
    if (tid == 0) (void)xb_add(&bar[XB_XCNT(b.x)], 1u);
    return b;
}
__device__ __forceinline__ void xcd_barrier_complete(unsigned* bar, unsigned x, unsigned& nloc, unsigned& nx) {
    const unsigned G = gridDim.x * gridDim.y * gridDim.z;
    unsigned sum, cnt, mine, sp = 0u;
    for (;;) {
        sum = 0u; cnt = 0u; mine = 0u;
#pragma unroll
        for (unsigned j = 0; j < 16; ++j) { const unsigned c = xb_ld(&bar[XB_XCNT(j)]); sum += c; cnt += (c > 0u) ? 1u : 0u; mine = (j == x) ? c : mine; }
        if (sum == G) break;
        __builtin_amdgcn_s_sleep(1);
        if ((++sp & 255u) == 0u) { if (xb_ld(&bar[XB_TMO])) break; if (sp > XB_SPIN_CAP) { atomicAdd(&bar[XB_TMO], 1u); break; } }
    }
    nloc = mine > 0u ? mine : 1u; nx = cnt > 0u ? cnt : 1u;
}
__device__ __forceinline__ void xcd_barrier(const XcdBarrier& b, int tid) {
    asm volatile("s_waitcnt vmcnt(0)" ::: "memory");
    __syncthreads();
    if (tid == 0) {
        unsigned* bar = b.bar;
        __builtin_amdgcn_s_waitcnt(0);
        unsigned nloc = b.st[0], nx = b.st[1];
        if (nloc == 0u) { xcd_barrier_complete(bar, b.x, nloc, nx); b.st[0] = nloc; b.st[1] = nx; }
        const unsigned old = xb_add(&bar[XB_XSUB(b.x)], 1u);
        const unsigned gen = old / nloc;
        if (old + 1u == (gen + 1u) * nloc) {
            __builtin_amdgcn_fence(__ATOMIC_RELEASE, "agent");
            asm volatile("s_waitcnt vmcnt(0)" ::: "memory");
            const unsigned og = xb_add(&bar[XB_TOP], 1u);
            const unsigned tg = og / nx;
            if (og + 1u == (tg + 1u) * nx) xb_add(&bar[XB_TOPGEN], 1u);
            else XB_SPIN(xb_ld(&bar[XB_TOPGEN]) == tg, bar);
            __builtin_amdgcn_fence(__ATOMIC_ACQUIRE, "agent");
            xb_add(&bar[XB_XGEN(b.x)], 1u);
            asm volatile("s_waitcnt vmcnt(0)" ::: "memory");
        } else {
            XB_SPIN(xb_ld(&bar[XB_XGEN(b.x)]) == gen, bar);
            __builtin_amdgcn_fence(__ATOMIC_ACQUIRE, "agent");
            asm volatile("s_waitcnt vmcnt(0)" ::: "memory");
        }
    }
    __syncthreads();
}

__device__ __forceinline__ float wave_sum(float v) {
#pragma unroll
    for (int o = 1; o < 64; o <<= 1) v += __shfl_xor(v, o);
    return v;
}
__device__ __forceinline__ float wave_max(float v) {
#pragma unroll
    for (int o = 1; o < 64; o <<= 1) v = fmaxf(v, __shfl_xor(v, o));
    return v;
}
__device__ __forceinline__ float block_sum(float v, LAS float* red, int wave, int lane) {
    v = wave_sum(v); if (lane == 0) red[wave] = v; __syncthreads();
    float s = 0.f;
#pragma unroll
    for (int i = 0; i < 8; ++i) s += red[i];
    __syncthreads(); return s;
}
__device__ __forceinline__ float log_sigmoid_f(float x) { return fminf(x, 0.f) - __logf(1.0f + __expf(-fabsf(x))); }

struct Params {
    const float* in[26]; float* out; unsigned char* ws;
    int step_lo, step_hi, pad0, pad1;
};
__device__ __forceinline__ int opaque_i(int x) { asm volatile("" : "+v"(x)); return __builtin_amdgcn_readfirstlane(x); }
template <class T> __device__ __forceinline__ T* opaque_p(T* p) { const unsigned long long v = (unsigned long long)p; const unsigned lo = (unsigned)opaque_i((int)(unsigned)v), hi = (unsigned)opaque_i((int)(unsigned)(v >> 32)); return (T*)(((unsigned long long)hi << 32) | lo); }
__device__ __forceinline__ const float* pin(const Params& P, int i) { return P.in[opaque_i(i)]; }

struct TrItem { const float* src; int ldsrc, nsrc0, k0, lddst, nd0; bf16* dst; const float* gain; float sc; };
__device__ __forceinline__ void tr_load(const TrItem& t, f32x4 (&v)[8], int lane) {
    const int lr = lane >> 3, lc = (lane & 7) * 4;
#pragma unroll
    for (int i = 0; i < 8; ++i) v[i] = *(const GAS f32x4*)(t.src + (size_t)(t.k0 + 8 * i + lr) * t.ldsrc + t.nsrc0 + lc);
}
__device__ __forceinline__ void tr_finish(const TrItem& t, const f32x4 (&v)[8], LAS float* scr, int lane) {
    const int lr = lane >> 3, lc = (lane & 7) * 4;
#pragma unroll
    for (int i = 0; i < 8; ++i) { const int kk = 8 * i + lr; const float gs = (t.gain ? t.gain[t.k0 + kk] : 1.f) * t.sc; LAS float* d = scr + kk * 33 + lc; d[0] = v[i].x * gs; d[1] = v[i].y * gs; d[2] = v[i].z * gs; d[3] = v[i].w * gs; }
    LDS_WAIT(); asm volatile("" ::: "memory");
    const int c = lane & 7;
#pragma unroll
    for (int j = 0; j < 4; ++j) { const int n = (lane >> 3) + 8 * j; const LAS float* s = scr + (8 * c) * 33 + n;
        v4u o; o.x = pk2(s[0 * 33], s[1 * 33]); o.y = pk2(s[2 * 33], s[3 * 33]); o.z = pk2(s[4 * 33], s[5 * 33]); o.w = pk2(s[6 * 33], s[7 * 33]);
        *(GAS v4u*)(t.dst + (size_t)(t.nd0 + n) * t.lddst + t.k0 + 8 * c) = o; }
    LDS_WAIT(); asm volatile("" ::: "memory");
}
__device__ __forceinline__ void norm_row(const float* xrow, bf16* orow, float* xcopy, int lane) {
    const GAS f32x4* xr = (const GAS f32x4*)xrow + lane;
    f32x4 v[8]; float s = 0.f;
#pragma unroll
    for (int j = 0; j < 8; ++j) { v[j] = xr[64 * j]; s += (v[j].x * v[j].x + v[j].y * v[j].y) + (v[j].z * v[j].z + v[j].w * v[j].w); }
    const float rstd = rsqrtf(wave_sum(s) * (1.f / DM) + EPS);
    GAS v2u* o8 = (GAS v2u*)orow + lane;
#pragma unroll
    for (int j = 0; j < 8; ++j) { v2u w; w.x = pk2(v[j].x * rstd, v[j].y * rstd); w.y = pk2(v[j].z * rstd, v[j].w * rstd); o8[64 * j] = w; }
    if (xcopy) { GAS f32x4* xc = (GAS f32x4*)xcopy + lane;
#pragma unroll
        for (int j = 0; j < 8; ++j) xc[64 * j] = v[j]; }
}
__device__ __forceinline__ void final_norm_row(const bf16* xrow, float* orow, const float* g, int lane) {
    const GAS v4u* xr = (const GAS v4u*)xrow + lane; float v[4][8]; float s = 0.f;
#pragma unroll
    for (int j = 0; j < 4; ++j) { const v4u r = xr[64 * j]; v[j][0] = bflo(r.x); v[j][1] = bfhi(r.x); v[j][2] = bflo(r.y); v[j][3] = bfhi(r.y); v[j][4] = bflo(r.z); v[j][5] = bfhi(r.z); v[j][6] = bflo(r.w); v[j][7] = bfhi(r.w);
#pragma unroll
        for (int e = 0; e < 8; ++e) s += v[j][e] * v[j][e]; }
    const float rstd = rsqrtf(wave_sum(s) * (1.f / DM) + EPS);
#pragma unroll
    for (int j = 0; j < 4; ++j) { const int c0 = (64 * j + lane) * 8; const f32x4 g0 = *(const GAS f32x4*)(g + c0), g1 = *(const GAS f32x4*)(g + c0 + 4);
        *(GAS f32x4*)(orow + c0) = (f32x4){v[j][0] * rstd * g0.x, v[j][1] * rstd * g0.y, v[j][2] * rstd * g0.z, v[j][3] * rstd * g0.w};
        *(GAS f32x4*)(orow + c0 + 4) = (f32x4){v[j][4] * rstd * g1.x, v[j][5] * rstd * g1.y, v[j][6] * rstd * g1.z, v[j][7] * rstd * g1.w}; }
}
__device__ __forceinline__ void norm_row_gain_f32(const float* xrow, float* orow, const float* g, int lane) {
    const GAS f32x4* xr = (const GAS f32x4*)xrow + lane; const GAS f32x4* gr = (const GAS f32x4*)g + lane;
    f32x4 v[8]; float s = 0.f;
#pragma unroll
    for (int j = 0; j < 8; ++j) { v[j] = xr[64 * j]; s += (v[j].x * v[j].x + v[j].y * v[j].y) + (v[j].z * v[j].z + v[j].w * v[j].w); }
    const float rstd = rsqrtf(wave_sum(s) * (1.f / DM) + EPS);
    GAS f32x4* o = (GAS f32x4*)orow + lane;
#pragma unroll
    for (int j = 0; j < 8; ++j) o[64 * j] = v[j] * rstd * gr[64 * j];
}
__device__ __forceinline__ void norm_row_gain_bf16(const float* xrow, bf16* orow, const float* g, int lane) {
    const GAS f32x4* xr = (const GAS f32x4*)xrow + lane; const GAS f32x4* gr = (const GAS f32x4*)g + lane;
    f32x4 v[8]; float s = 0.f;
#pragma unroll
    for (int j = 0; j < 8; ++j) { v[j] = xr[64 * j]; s += (v[j].x * v[j].x + v[j].y * v[j].y) + (v[j].z * v[j].z + v[j].w * v[j].w); }
    const float rstd = rsqrtf(wave_sum(s) * (1.f / DM) + EPS);
    GAS v2u* o8 = (GAS v2u*)orow + lane;
#pragma unroll
    for (int j = 0; j < 8; ++j) { const f32x4 y = v[j] * rstd * gr[64 * j]; v2u w; w.x = pk2(y.x, y.y); w.y = pk2(y.z, y.w); o8[64 * j] = w; }
}

__device__ __forceinline__ void phase_a(const Params& P, unsigned char* ws, float* xres, int l, LAS unsigned char* lds, int tid, int lane, int wave, int bid, int G) {
    bf16* WinT = (bf16*)(ws + WS_WIN); bf16* WoutT = (bf16*)(ws + WS_WOUT); bf16* WqB = (bf16*)(ws + WS_WQB); bf16* WkvT = (bf16*)(ws + WS_WKV);
    bf16* WxoT = (bf16*)(ws + WS_WXO); bf16* WguT = (bf16*)(ws + WS_WGU); bf16* WdT = (bf16*)(ws + WS_WD);
    const float* g0 = pin(P, 2) + (size_t)(l * 3 + 0) * DM; const float* g1 = g0 + DM; const float* g2 = g1 + DM;
    const float* w_in = pin(P, 3) + (size_t)l * DM * DIN;
    const float* w_out = pin(P, 18) + (size_t)l * DM * DM;
    const float* w_xq = pin(P, 20) + (size_t)l * DM * DM;
    const float* w_xkv = pin(P, 21) + (size_t)l * DM * 2 * DM;
    const float* w_xo = pin(P, 22) + (size_t)l * DM * DM;
    const float* w_gu = pin(P, 23) + (size_t)l * DM * 2 * DFF;
    const float* w_dn = pin(P, 24) + (size_t)l * DFF * DM;
    const int gw = bid * NWAVES + wave, NGW = G * NWAVES, gt = bid * NTHR + tid, NGT = G * NTHR;
    LAS float* scr = (LAS float*)(lds + wave * 16384);
    constexpr int I1 = 49 * 32, I2 = 112 * 32, I3 = 64 * 32, I4 = 128 * 32, I5 = 64 * 32, I6 = 352 * 32, I7 = 64 * 88, ITOT = I1 + I2 + I3 + I4 + I5 + I6 + I7;
    auto mk_item = [&](int it) -> TrItem {
        int r = it; TrItem t; t.gain = nullptr; t.sc = 1.f;
        if (r < I1) { const int kb = r / 49, nb = r % 49; t.src = w_in; t.ldsrc = DIN; t.nsrc0 = 32 * nb; t.k0 = 64 * kb; t.dst = WinT; t.lddst = DM; t.nd0 = 32 * nb; t.gain = g0; t.sc = nb < 8 ? 0.125f : 1.f; }
        else if ((r -= I1) < I2) { const int kb = r / 112, nb = r % 112; t.src = w_in; t.ldsrc = DIN; t.nsrc0 = 1568 + 32 * nb; t.k0 = 64 * kb; t.dst = WinT; t.lddst = DM; t.gain = g0; const int cc = 32 * nb;
            t.nd0 = cc < 512 ? PUF + cc : cc < 2048 ? WUH + (cc - 512) : PUS + (cc - 2048); }
        else if ((r -= I2) < I3) { const int kb = r / 64, nb = r % 64; t.src = w_out; t.ldsrc = DM; t.nsrc0 = 32 * nb; t.k0 = 64 * kb; t.dst = WoutT; t.lddst = DM; t.nd0 = 32 * nb; }
        else if ((r -= I3) < I4) { const int kb = r / 128, nb = r % 128; t.src = w_xkv; t.ldsrc = 2 * DM; t.nsrc0 = 32 * nb; t.k0 = 64 * kb; t.dst = WkvT; t.lddst = DM; t.nd0 = 32 * nb; }
        else if ((r -= I4) < I5) { const int kb = r / 64, nb = r % 64; t.src = w_xo; t.ldsrc = DM; t.nsrc0 = 32 * nb; t.k0 = 64 * kb; t.dst = WxoT; t.lddst = DM; t.nd0 = 32 * nb; }
        else if ((r -= I5) < I6) { const int kb = r / 352, nb = r % 352, c0 = 32 * nb; t.src = w_gu; t.ldsrc = 2 * DFF; t.nsrc0 = c0; t.k0 = 64 * kb; t.dst = WguT; t.lddst = DM; t.gain = g2;
            t.nd0 = c0 < DFF ? (c0 / 128) * 256 + (c0 % 128) : ((c0 - DFF) / 128) * 256 + 128 + ((c0 - DFF) % 128); }
        else { r -= I6; const int kb = r / 64, nb = r % 64; t.src = w_dn; t.ldsrc = DM; t.nsrc0 = 32 * nb; t.k0 = 64 * kb; t.dst = WdT; t.lddst = DFF; t.nd0 = 32 * nb; }
        return t; };
    { f32x4 va[8], vb[8]; int it = gw;
      if (it < ITOT) { TrItem ta = mk_item(it); tr_load(ta, va, lane);
          for (;;) { const int itb = it + NGW; const bool hb = itb < ITOT; TrItem tb = ta; if (hb) { tb = mk_item(itb); tr_load(tb, vb, lane); }
              tr_finish(ta, va, scr, lane); if (!hb) break;
              const int ita = itb + NGW; const bool ha = ita < ITOT; if (ha) { ta = mk_item(ita); tr_load(ta, va, lane); }
              tr_finish(tb, vb, scr, lane); if (!ha) break; it = ita; } } }
    for (int i = gt; i < DM * DM / 8; i += NGT) { const int k = i >> 8; const float s = g1[k] * 0.044194173824159216f;
        const f32x4 a = *(const GAS f32x4*)(w_xq + (size_t)i * 8), b = *(const GAS f32x4*)(w_xq + (size_t)i * 8 + 4);
        v4u o; o.x = pk2(a.x * s, a.y * s); o.y = pk2(a.z * s, a.w * s); o.z = pk2(b.x * s, b.y * s); o.w = pk2(b.z * s, b.w * s);
        *(GAS v4u*)(WqB + (size_t)i * 8) = o; }
    __syncthreads();
    { float* filtT = (float*)(ws + WS_FILT);
      const float* w1 = pin(P, 8) + (size_t)l * 33 * 64; const float* b1 = pin(P, 9) + l * 64; const float* w2 = pin(P, 10) + (size_t)l * 64 * 64; const float* b2 = pin(P, 11) + l * 64;
      const float* w3 = pin(P, 12) + (size_t)l * 64 * 2048; const float* fr = pin(P, 13) + l * 64; const float* dec = pin(P, 14) + (size_t)l * 2048;
      LAS float* ft = (LAS float*)lds; LAS float* h1 = ft + 16 * 34; LAS float* h2 = h1 + 16 * 64;
      LAS float* w1s = h2 + 16 * 64; LAS float* w2s = w1s + 33 * 64;
      for (int i = tid; i < 33 * 64; i += NTHR) w1s[i] = w1[i];
      for (int i = tid; i < 64 * 64; i += NTHR) w2s[i] = w2[i];
      __syncthreads();
      for (int pg = bid; pg < SEQ / 16; pg += G) {
          if (tid < 256) { const int p = tid >> 4, i = tid & 15; const float t = (float)(pg * 16 + p) * (1.0f / SEQ);
              const float f = 1e-4f + (float)i * ((15.0f - 1e-4f) / 15.0f); const float rev = t * f; ft[p * 34 + 1 + i] = __builtin_amdgcn_cosf(rev); ft[p * 34 + 17 + i] = -__builtin_amdgcn_sinf(rev);
              if (i == 0) ft[p * 34] = t; }
          __syncthreads();
#pragma unroll
          for (int e = 0; e < 2; ++e) { const int o = tid + 512 * e, p = o >> 6, j = o & 63; float a = b1[j];
#pragma unroll 11
              for (int i = 0; i < 33; ++i) a += ft[p * 34 + i] * w1s[i * 64 + j];
              h1[p * 64 + j] = __builtin_amdgcn_sinf(fr[j] * a * 0.15915494309189535f); }
          __syncthreads();
#pragma unroll
          for (int e = 0; e < 2; ++e) { const int o = tid + 512 * e, p = o >> 6, j = o & 63; float a = b2[j];
#pragma unroll 16
              for (int i = 0; i < 64; ++i) a += h1[p * 64 + i] * w2s[i * 64 + j];
              h2[j * 16 + p] = __builtin_amdgcn_sinf(fr[j] * a * 0.15915494309189535f); }
          __syncthreads();
#pragma unroll 1
          for (int q = 0; q < 4; ++q) { const int n = tid + 512 * q; float a[16];
#pragma unroll
              for (int p = 0; p < 16; ++p) a[p] = 0.f;
#pragma unroll 1
              for (int j0 = 0; j0 < 64; j0 += 16) { float wv[16];
#pragma unroll
                  for (int jj = 0; jj < 16; ++jj) wv[jj] = w3[(j0 + jj) * 2048 + n];
#pragma unroll
                  for (int jj = 0; jj < 16; ++jj) { const LAS f32x4* hp = (const LAS f32x4*)(h2 + (j0 + jj) * 16); const f32x4 ha = hp[0], hb = hp[1], hc = hp[2], hd = hp[3]; const float w = wv[jj];
                      a[0] += ha.x * w; a[1] += ha.y * w; a[2] += ha.z * w; a[3] += ha.w * w; a[4] += hb.x * w; a[5] += hb.y * w; a[6] += hb.z * w; a[7] += hb.w * w;
                      a[8] += hc.x * w; a[9] += hc.y * w; a[10] += hc.z * w; a[11] += hc.w * w; a[12] += hd.x * w; a[13] += hd.y * w; a[14] += hd.z * w; a[15] += hd.w * w; } }
              const float dc = fabsf(dec[n]);
#pragma unroll
              for (int p4 = 0; p4 < 4; ++p4) { f32x4 o;
                  o.x = a[4 * p4 + 0] * __expf(-(float)(pg * 16 + 4 * p4 + 0) * (1.0f / SEQ) * dc); o.y = a[4 * p4 + 1] * __expf(-(float)(pg * 16 + 4 * p4 + 1) * (1.0f / SEQ) * dc);
                  o.z = a[4 * p4 + 2] * __expf(-(float)(pg * 16 + 4 * p4 + 2) * (1.0f / SEQ) * dc); o.w = a[4 * p4 + 3] * __expf(-(float)(pg * 16 + 4 * p4 + 3) * (1.0f / SEQ) * dc);
                  *(GAS f32x4*)(filtT + (size_t)n * SEQ + pg * 16 + 4 * p4) = o; } }
          __syncthreads();
      } }
    if (l == 0) { bf16* xb = (bf16*)(ws + WS_XB); float* rss = (float*)(ws + WS_RSS); const float* xin = pin(P, 0);
      for (int m = gw; m < MTOK; m += NGW) { const GAS f32x4* xr = (const GAS f32x4*)(xin + (size_t)m * DM) + lane; f32x4 v[8]; float ss = 0.f;
#pragma unroll
          for (int j = 0; j < 8; ++j) { v[j] = xr[64 * j]; ss += (v[j].x * v[j].x + v[j].y * v[j].y) + (v[j].z * v[j].z + v[j].w * v[j].w); }
          ss = wave_sum(ss); GAS v2u* o8 = (GAS v2u*)(xb + (size_t)m * DM) + lane;
#pragma unroll
          for (int j = 0; j < 8; ++j) { v2u w; w.x = pk2(v[j].x, v[j].y); w.y = pk2(v[j].z, v[j].w); o8[64 * j] = w; }
          if (lane < 32) rss[(size_t)m * 32 + lane] = lane == 0 ? ss : 0.f; } }
    if (l == 0) {
        typedef float f32x2 __attribute__((ext_vector_type(2)));
        __syncthreads();
        LAS f32x2* tw = (LAS f32x2*)lds;
        for (int i = tid; i < 4096; i += NTHR) { const float rv = (float)i * (1.0f / 4096.0f); tw[i] = (f32x2){__builtin_amdgcn_cosf(rv) * 0.001381067932f, __builtin_amdgcn_sinf(rv) * 0.001381067932f}; }
        __syncthreads();
        bf16* C2 = (bf16*)(ws + WS_C2); bf16* S2 = (bf16*)(ws + WS_S2);
        for (int i = gt; i < 2048 * (FK1 / 8); i += NGT) { const int srow = i / (FK1 / 8), t0 = (i % (FK1 / 8)) * 8; float cv[8];
#pragma unroll
            for (int e = 0; e < 8; ++e) cv[e] = (t0 + e) <= 2048 ? tw[(srow * (t0 + e)) & 4095].x : 0.f;
            v4u oc; oc.x = pk2(cv[0], cv[1]); oc.y = pk2(cv[2], cv[3]); oc.z = pk2(cv[4], cv[5]); oc.w = pk2(cv[6], cv[7]);
            *(GAS v4u*)(C2 + (size_t)srow * FK1 + t0) = oc; }
        for (int i = gt; i < 2048 * 256; i += NGT) { const int srow = i >> 8, t0 = (i & 255) * 8; float sv[8];
#pragma unroll
            for (int e = 0; e < 8; ++e) sv[e] = tw[(srow * (t0 + e)) & 4095].y;
            v4u os; os.x = pk2(sv[0], sv[1]); os.y = pk2(sv[2], sv[3]); os.z = pk2(sv[4], sv[5]); os.w = pk2(sv[6], sv[7]);
            *(GAS v4u*)(S2 + (size_t)srow * 2048 + t0) = os; }
        bf16* A1 = (bf16*)(ws + WS_A1);
        for (int i = gt; i < 512 * 256; i += NGT) { const int r = i >> 8, k = i & 255, gl = r >> 8, ri = (r >> 7) & 1, cp = r & 127, kg = k >> 7, cc = k & 127;
            float v = 0.f; if (kg == gl) { const float rv = (float)((cc * cp) & 127) * (1.0f / 128.0f); v = ri == 0 ? __builtin_amdgcn_cosf(rv) : -__builtin_amdgcn_sinf(rv); }
            A1[i] = (bf16)f2bf(v); }
        __syncthreads();
    }
    if (l == 0) { bf16* memn = (bf16*)(ws + WS_MEMN);
      for (int m = gw; m < NB * NMEM; m += NGW) norm_row_gain_bf16(pin(P, 1) + (size_t)m * DM, memn + (size_t)m * DM, pin(P, 19), lane); }
}


typedef short gbf16x8 __attribute__((ext_vector_type(8)));
constexpr int GP = 72;
__device__ __forceinline__ f32x4 mma16(const LAS bf16* A, const LAS bf16* Bt, int K, int lane, f32x4 acc) {
    const int r = lane & 15, q = lane >> 4;
#pragma unroll
    for (int k0 = 0; k0 < 64; k0 += 32) { if (k0 < K) {
        const gbf16x8 a = *(const LAS gbf16x8*)(A + r * GP + k0 + 8 * q), b = *(const LAS gbf16x8*)(Bt + r * GP + k0 + 8 * q);
        acc = __builtin_amdgcn_mfma_f32_16x16x32_bf16(a, b, acc, 0, 0, 0); } }
    return acc;
}
constexpr int RP = 72;
__device__ __forceinline__ v4u gla_ld64(const bf16* proj, int tok0, int col0, int tid) { return *(const GAS v4u*)(proj + (size_t)(tok0 + (tid >> 3)) * NPROJ + col0 + (tid & 7) * 8); }
__device__ __forceinline__ v4u gla_ld128(const bf16* proj, int tok0, int col0, int id) { return *(const GAS v4u*)(proj + (size_t)(tok0 + (id >> 4)) * NPROJ + col0 + (id & 15) * 8); }
__device__ __forceinline__ void gla_st64(LAS bf16* raw, v4u v, int tid) { *(LAS v4u*)(raw + (tid >> 3) * RP + (tid & 7) * 8) = v; }
__device__ __forceinline__ void gla_st_vT(LAS bf16* vT, v4u v, int id) {
    const int i = id >> 4, c0 = (id & 15) * 8; const unsigned w[4] = {v.x, v.y, v.z, v.w};
#pragma unroll
    for (int e = 0; e < 8; ++e) vT[(c0 + e) * GP + i] = (bf16)((e & 1) ? (w[e >> 1] >> 16) : (w[e >> 1] & 0xffffu));
}
constexpr int LRP = 40;
__device__ __forceinline__ void gla_cumsum_lds(const LAS bf16* lrraw, const LAS float* gwl, const float* gkb_, int h, int dir, LAS float* bL, LAS float* tot, int tid) {
    const GAS float* gkb = (const GAS float*)gkb_;
    const int k = tid & 63, seg = tid >> 6;
    const float bias = gkb[dir * 256 + h * 64 + k];
    float w[16];
#pragma unroll
    for (int r = 0; r < 16; ++r) w[r] = gwl[(dir * 16 + r) * 64 + k];
    float c[8];
#pragma unroll
    for (int e = 0; e < 8; ++e) { const LAS v4u* lp = (const LAS v4u*)(lrraw + (8 * seg + e) * LRP + dir * 16); const v4u a = lp[0], b = lp[1];
        float pre = bias;
        pre += bflo(a.x) * w[0] + bfhi(a.x) * w[1] + bflo(a.y) * w[2] + bfhi(a.y) * w[3] + bflo(a.z) * w[4] + bfhi(a.z) * w[5] + bflo(a.w) * w[6] + bfhi(a.w) * w[7];
        pre += bflo(b.x) * w[8] + bfhi(b.x) * w[9] + bflo(b.y) * w[10] + bfhi(b.y) * w[11] + bflo(b.z) * w[12] + bfhi(b.z) * w[13] + bflo(b.w) * w[14] + bfhi(b.w) * w[15];
        c[e] = log_sigmoid_f(pre) * (1.f / 16.f); }
    if (dir == 0) {
#pragma unroll
        for (int e = 1; e < 8; ++e) c[e] += c[e - 1];
        tot[seg * 64 + k] = c[7];
    } else {
#pragma unroll
        for (int e = 6; e >= 0; --e) c[e] += c[e + 1];
        tot[seg * 64 + k] = c[0];
    }
    __syncthreads();
    float off = 0.f;
#pragma unroll
    for (int s2 = 0; s2 < 8; ++s2) { const float tv = tot[s2 * 64 + k]; if (dir == 0 ? (s2 < seg) : (s2 > seg)) off += tv; }
#pragma unroll
    for (int e = 0; e < 8; ++e) bL[(8 * seg + e) * 64 + k] = c[e] + off;
    __syncthreads();
}
__device__ __forceinline__ v4u gla_ld_lr(const bf16* proj, int tok0, int tid) { return *(const GAS v4u*)(proj + (size_t)(tok0 + ((tid & 255) >> 2)) * NPROJ + PLR + (tid & 3) * 8); }
__device__ __forceinline__ void gla_st_lr(LAS bf16* lrraw, v4u v, int tid) { if (tid < 256) *(LAS v4u*)(lrraw + (tid >> 2) * LRP + (tid & 3) * 8) = v; }
__device__ __forceinline__ void gla_stage_gkw(const float* gkw_, int h, LAS float* gwl, int tid) {
    const GAS float* gkw = (const GAS float*)gkw_;
#pragma unroll
    for (int e = 0; e < 4; ++e) { const int i = tid + 512 * e, dr = i >> 6, k = i & 63; gwl[i] = gkw[dr * 256 + h * 64 + k]; }
}
__device__ __forceinline__ void gla_g1(const bf16* proj, const float* gkw, const float* gkb, bf16* GU_, float* GD_, LAS unsigned char* lds, int tid, int lane, int wave, int bid, int G) {
    GAS bf16* GU = (GAS bf16*)GU_; GAS float* GD = (GAS float*)GD_;
    LAS bf16* vT = (LAS bf16*)lds; LAS bf16* kdT = (LAS bf16*)(lds + 18432); LAS float* bL = (LAS float*)(lds + 27648); LAS float* tot = (LAS float*)(lds + 44032);
    LAS bf16* kraw = (LAS bf16*)(lds + 46080); LAS bf16* lrraw = (LAS bf16*)(lds + 55296); LAS float* gwl = (LAS float*)(lds + 60416);
    int unit = bid; if (unit >= 2048) return;
    int hcur = -1; v4u rk, rlr, rv0, rv1;
    { const int bh = unit >> 6, n = unit & 63, h = bh & 3, tok0 = (bh >> 2) * SEQ + n * 64;
      rk = gla_ld64(proj, tok0, PK + h * 64, tid); rlr = gla_ld_lr(proj, tok0, tid);
      rv0 = gla_ld128(proj, tok0, PV + h * 128, tid); rv1 = gla_ld128(proj, tok0, PV + h * 128, tid + 512); }
    for (;;) { const int bh = unit >> 6, h = bh & 3;
        gla_st64(kraw, rk, tid); gla_st_lr(lrraw, rlr, tid); gla_st_vT(vT, rv0, tid); gla_st_vT(vT, rv1, tid + 512);
        if (h != hcur) { gla_stage_gkw(gkw, h, gwl, tid); hcur = h; }
        __syncthreads();
        const int nunit = unit + G; const bool more = nunit < 2048;
        if (more) { const int bh2 = nunit >> 6, n2 = nunit & 63, h2 = bh2 & 3, tok2 = (bh2 >> 2) * SEQ + n2 * 64;
            rk = gla_ld64(proj, tok2, PK + h2 * 64, tid); rlr = gla_ld_lr(proj, tok2, tid);
            rv0 = gla_ld128(proj, tok2, PV + h2 * 128, tid); rv1 = gla_ld128(proj, tok2, PV + h2 * 128, tid + 512); }
        for (int dir = 0; dir < 2; ++dir) {
            gla_cumsum_lds(lrraw, gwl, gkb, h, dir, bL, tot, tid);
            { const int k = tid & 63, seg = tid >> 6; const float bl = bL[(dir ? 0 : 63) * 64 + k]; unsigned w[4];
#pragma unroll
              for (int e = 0; e < 4; ++e) { const int i0 = 8 * seg + 2 * e;
                  const float k0 = bf2f(kraw[i0 * RP + k]) * __expf(bl - bL[i0 * 64 + k]);
                  const float k1 = bf2f(kraw[(i0 + 1) * RP + k]) * __expf(bl - bL[(i0 + 1) * 64 + k]);
                  w[e] = pk2(k0, k1); }
              *(LAS v4u*)(kdT + k * GP + 8 * seg) = (v4u){w[0], w[1], w[2], w[3]};
              if (seg == 0) GD[(size_t)(unit * 2 + dir) * 64 + k] = __expf(bl); }
            __syncthreads();
            { GAS bf16* U = GU + (size_t)(unit * 2 + dir) * 8192; const int r = lane & 15, q = lane >> 4;
#pragma unroll
              for (int kt = 0; kt < 4; ++kt) { f32x4 acc = (f32x4){0.f, 0.f, 0.f, 0.f};
                  acc = mma16(vT + 16 * wave * GP, kdT + 16 * kt * GP, 64, lane, acc);
#pragma unroll
                  for (int j = 0; j < 4; ++j) U[(16 * wave + 4 * q + j) * 64 + 16 * kt + r] = (bf16)f2bf(acc[j]); } }
            __syncthreads();
        }
        if (!more) break; unit = nunit;
    }
}
__device__ __forceinline__ void gla_g3(const bf16* proj, const float* gkw, const float* gkb, const float* gnorm_, const bf16* GS_, bf16* mix_, LAS unsigned char* lds, int tid, int lane, int wave, int bid, int G) {
    const GAS float* gnorm = (const GAS float*)gnorm_; const GAS bf16* GS = (const GAS bf16*)GS_; GAS bf16* mix = (GAS bf16*)mix_; const GAS bf16* gproj = (const GAS bf16*)proj;
    LAS bf16* vT = (LAS bf16*)lds; LAS bf16* ST = (LAS bf16*)(lds + 18432); LAS bf16* qd = (LAS bf16*)(lds + 36864); LAS bf16* kd = (LAS bf16*)(lds + 46080);
    LAS bf16* qb = (LAS bf16*)(lds + 55296); LAS bf16* Pm = (LAS bf16*)(lds + 64512); LAS float* bL = (LAS float*)(lds + 73728); LAS float* tot = (LAS float*)(lds + 90112); LAS float* rs = (LAS float*)(lds + 92160);
    LAS bf16* qraw = (LAS bf16*)(lds + 92672); LAS bf16* kraw = (LAS bf16*)(lds + 101888); LAS bf16* lrraw = (LAS bf16*)(lds + 111104); LAS float* gwl = (LAS float*)(lds + 116224);
    const int r = lane & 15, q = lane >> 4, wr = wave >> 1, wc = wave & 1;
    int unit = bid; if (unit >= 2048) return;
    int hcur = -1; v4u rq, rk, rlr, rv0, rv1, rs0a, rs0b, rs1a, rs1b; unsigned short rg[16];
#define G3_LOAD(UNIT) do { const int bh_ = (UNIT) >> 6, n_ = (UNIT) & 63, h_ = bh_ & 3, tok_ = (bh_ >> 2) * SEQ + n_ * 64; \
        rq = gla_ld64(proj, tok_, PQ + h_ * 64, tid); rk = gla_ld64(proj, tok_, PK + h_ * 64, tid); rlr = gla_ld_lr(proj, tok_, tid); \
        rv0 = gla_ld128(proj, tok_, PV + h_ * 128, tid); rv1 = gla_ld128(proj, tok_, PV + h_ * 128, tid + 512); \
        { const GAS bf16* S0_ = GS + (size_t)((UNIT) * 2) * 8192; rs0a = *(const GAS v4u*)(S0_ + tid * 8); rs0b = *(const GAS v4u*)(S0_ + 4096 + tid * 8); rs1a = *(const GAS v4u*)(S0_ + 8192 + tid * 8); rs1b = *(const GAS v4u*)(S0_ + 12288 + tid * 8); } \
        _Pragma("unroll") for (int j_ = 0; j_ < 4; ++j_) _Pragma("unroll") for (int ct_ = 0; ct_ < 4; ++ct_) rg[j_ * 4 + ct_] = gproj[(size_t)(tok_ + 16 * wr + 4 * q + j_) * NPROJ + PG + h_ * 128 + 64 * wc + 16 * ct_ + r]; } while (0)
    G3_LOAD(unit);
    for (;;) { const int bh = unit >> 6, n = unit & 63, bb = bh >> 2, h = bh & 3, tok0 = bb * SEQ + n * 64;
        gla_st64(qraw, rq, tid); gla_st64(kraw, rk, tid); gla_st_lr(lrraw, rlr, tid); gla_st_vT(vT, rv0, tid); gla_st_vT(vT, rv1, tid + 512);
        if (h != hcur) { gla_stage_gkw(gkw, h, gwl, tid); hcur = h; }
        const v4u s0a = rs0a, s0b = rs0b, s1a = rs1a, s1b = rs1b; unsigned short gcur[16];
#pragma unroll
        for (int e = 0; e < 16; ++e) gcur[e] = rg[e];
        __syncthreads();
        const int nunit = unit + G; const bool more = nunit < 2048;
        if (more) G3_LOAD(nunit);
        f32x4 acc[4];
#pragma unroll
        for (int ct = 0; ct < 4; ++ct) acc[ct] = (f32x4){0.f, 0.f, 0.f, 0.f};
        for (int dir = 0; dir < 2; ++dir) {
            gla_cumsum_lds(lrraw, gwl, gkb, h, dir, bL, tot, tid);
            { const int i = tid >> 3, kg = (tid & 7) * 8;
              const v4u qv = *(const LAS v4u*)(qraw + i * RP + kg), kv = *(const LAS v4u*)(kraw + i * RP + kg);
              const f32x4 b0 = *(const LAS f32x4*)(bL + i * 64 + kg), b1 = *(const LAS f32x4*)(bL + i * 64 + kg + 4), r0 = *(const LAS f32x4*)(bL + 32 * 64 + kg), r1 = *(const LAS f32x4*)(bL + 32 * 64 + kg + 4);
              const unsigned qw[4] = {qv.x, qv.y, qv.z, qv.w}, kw[4] = {kv.x, kv.y, kv.z, kv.w}; unsigned oqd[4], okd[4], oqb[4];
#pragma unroll
              for (int e2 = 0; e2 < 4; ++e2) { const float bva = e2 < 2 ? b0[2 * e2] : b1[2 * e2 - 4], bvb = e2 < 2 ? b0[2 * e2 + 1] : b1[2 * e2 - 3], bra = e2 < 2 ? r0[2 * e2] : r1[2 * e2 - 4], brb = e2 < 2 ? r0[2 * e2 + 1] : r1[2 * e2 - 3];
                  const float qa = bflo(qw[e2]), qbv = bfhi(qw[e2]), ka = bflo(kw[e2]), kb = bfhi(kw[e2]);
                  oqd[e2] = pk2(qa * __expf(bva - bra), qbv * __expf(bvb - brb)); okd[e2] = pk2(ka * __expf(bra - bva), kb * __expf(brb - bvb)); oqb[e2] = pk2(qa * __expf(bva), qbv * __expf(bvb)); }
              *(LAS v4u*)(qd + i * GP + kg) = (v4u){oqd[0], oqd[1], oqd[2], oqd[3]}; *(LAS v4u*)(kd + i * GP + kg) = (v4u){okd[0], okd[1], okd[2], okd[3]}; *(LAS v4u*)(qb + i * GP + kg) = (v4u){oqb[0], oqb[1], oqb[2], oqb[3]};
              *(LAS v4u*)(ST + (tid >> 3) * GP + (tid & 7) * 8) = dir ? s1a : s0a; *(LAS v4u*)(ST + (64 + (tid >> 3)) * GP + (tid & 7) * 8) = dir ? s1b : s0b; }
            __syncthreads();
#pragma unroll
            for (int e = 0; e < 2; ++e) { const int jt = wc * 2 + e; f32x4 s = (f32x4){0.f, 0.f, 0.f, 0.f};
                s = mma16(qd + 16 * wr * GP, kd + 16 * jt * GP, 64, lane, s);
#pragma unroll
                for (int j = 0; j < 4; ++j) { const int i = 16 * wr + 4 * q + j, jj = 16 * jt + r; const bool keep = dir == 0 ? (jj <= i) : (jj > i);
                    Pm[i * GP + jj] = (bf16)f2bf(keep ? s[j] : 0.f); } }
            __syncthreads();
#pragma unroll
            for (int ct = 0; ct < 4; ++ct) { const int v0 = 64 * wc + 16 * ct;
                acc[ct] = mma16(Pm + 16 * wr * GP, vT + v0 * GP, 64, lane, acc[ct]);
                acc[ct] = mma16(qb + 16 * wr * GP, ST + v0 * GP, 64, lane, acc[ct]); }
            __syncthreads();
        }
        float ss[4];
#pragma unroll
        for (int j = 0; j < 4; ++j) { float a = 0.f;
#pragma unroll
            for (int ct = 0; ct < 4; ++ct) a += acc[ct][j] * acc[ct][j];
            a += __shfl_xor(a, 1); a += __shfl_xor(a, 2); a += __shfl_xor(a, 4); a += __shfl_xor(a, 8); ss[j] = a; }
        if (r == 0) {
#pragma unroll
            for (int j = 0; j < 4; ++j) rs[(16 * wr + 4 * q + j) * 2 + wc] = ss[j]; }
        __syncthreads();
#pragma unroll
        for (int j = 0; j < 4; ++j) { const int i = 16 * wr + 4 * q + j; const float rstd = rsqrtf((rs[i * 2] + rs[i * 2 + 1]) * (1.f / 128.f) + EPS);
#pragma unroll
            for (int ct = 0; ct < 4; ++ct) { const int v = 64 * wc + 16 * ct + r; const float gate = bf2f(gcur[j * 4 + ct]);
                mix[(size_t)(tok0 + i) * DM + h * 128 + v] = (bf16)f2bf(acc[ct][j] * rstd * gnorm[v] * pg8::silu_f(gate)); } }
        __syncthreads();
        if (!more) break; unit = nunit;
    }
#undef G3_LOAD
}

__device__ __forceinline__ void gla_g2(const bf16* GU_, const float* GD_, bf16* GS_, int tid, int bid, int G) {
    typedef float f32x2 __attribute__((ext_vector_type(2)));
    const GAS unsigned* GU = (const GAS unsigned*)GU_; const GAS float* GD = (const GAS float*)GD_; GAS unsigned* GS = (GAS unsigned*)GS_;
    for (int it = bid * NTHR + tid; it < 32 * 2 * 4096; it += G * NTHR) { const int e2 = it & 4095, dir = (it >> 12) & 1, bh = it >> 13, k = (2 * e2) & 63;
        float S0 = 0.f, S1 = 0.f;
#pragma unroll 1
        for (int nb = 0; nb < 64; nb += 16) { unsigned u[16]; f32x2 d[16];
#pragma unroll
            for (int j = 0; j < 16; ++j) { const int nv = nb + j, n = dir ? 63 - nv : nv; const size_t ud = (size_t)((bh * 64 + n) * 2 + dir);
                u[j] = GU[ud * 4096 + e2]; d[j] = *(const GAS f32x2*)(GD + ud * 64 + k); }
            asm volatile("" ::: "memory");
#pragma unroll
            for (int j = 0; j < 16; ++j) { const int nv = nb + j, n = dir ? 63 - nv : nv; const size_t ud = (size_t)((bh * 64 + n) * 2 + dir);
                GS[ud * 4096 + e2] = pk2(S0, S1); S0 = S0 * d[j].x + bflo(u[j]); S1 = S1 * d[j].y + bfhi(u[j]); } }
    }
}
__device__ __forceinline__ float sconv3(const bf16* proj, int b, int t, int col, const float* w, int wld, int wc) {
    const bf16* p = proj + (size_t)(b * SEQ + t) * NPROJ + col;
    float a = w[wld + wc] * bf2f(p[0]);
    if (t > 0) a += w[wc] * bf2f(p[-NPROJ]);
    if (t < SEQ - 1) a += w[2 * wld + wc] * bf2f(p[NPROJ]);
    return a;
}


typedef float f32x16 __attribute__((ext_vector_type(16)));
typedef short hbf16x8 __attribute__((ext_vector_type(8)));
constexpr int HY_PITCH = 4360, HY_ZOFF = 96;
constexpr int HY_ZBYTES = 8 * HY_PITCH * 2;
constexpr int HY_HRN = 8200;
constexpr int HY_LDS_BYTES = HY_ZBYTES + 2 * HY_HRN * 2;

__device__ __forceinline__ hbf16x8 hy_afrag(LAS const unsigned char* hrb, int m0) {
    const int p = m0 + 4096, odd = p & 1;
    const LAS unsigned* src = (const LAS unsigned*)(hrb + odd * (HY_HRN * 2) + (p + odd) * 2);
    v4u w; w.x = src[0]; w.y = src[1]; w.z = src[2]; w.w = src[3];
    return __builtin_bit_cast(hbf16x8, w);
}
__device__ __forceinline__ void hy_fill_hr(const float* filtT_, int order, int c, LAS unsigned char* hrb, int tid) {
    const GAS float* filtT = (const GAS float*)filtT_;
    const GAS float* hf = filtT + (size_t)(order * 1024 + c) * SEQ; const GAS float* hb = filtT + (size_t)(order * 1024 + 512 + c) * SEQ;
    LAS bf16* c0 = (LAS bf16*)hrb; LAS bf16* c1 = c0 + HY_HRN;
    asm volatile("" : "+v"(tid));
    float v[16];
#pragma unroll
    for (int k = 0; k < 16; ++k) { const int m = tid + 512 * k - 4096, am = m < 0 ? -m : m; v[k] = (m <= 0 ? hf : hb)[am > 4095 ? 4095 : am]; }
#pragma unroll
    for (int k = 0; k < 16; ++k) { const int q = tid + 512 * k; const float v0 = q == 0 ? 0.f : v[k]; c0[q] = (bf16)f2bf(v0); c1[q + 1] = (bf16)f2bf(v0); }
    if (tid < 8) { c0[8192 + tid] = 0; if (tid < 7) c1[8193 + tid] = 0; }
    if (tid == 0) c1[0] = 0;
}
__device__ __forceinline__ void hy_conv(LAS const unsigned char* zbb, LAS const unsigned char* hrb, int w, int lane, f32x4 (&acc)[8][2]) {
    const int n = lane & 15, b = n >> 1, il = n & 1, kq = lane >> 4, i = n;
#pragma unroll
    for (int p = 0; p < 8; ++p)
#pragma unroll
        for (int hh = 0; hh < 2; ++hh) acc[p][hh] = (f32x4){0.f, 0.f, 0.f, 0.f};
    const LAS unsigned char* zl = zbb + (b * HY_PITCH + HY_ZOFF + 32 * il + 8 * kq) * 2 - 64;
    const int mb = -32 * (16 * w + 1) - i + 8 * kq;
    hbf16x8 A[16][2];
#pragma unroll
    for (int d = 0; d <= 14; ++d) { A[(1 + d) & 15][0] = hy_afrag(hrb, mb - 32 * d); A[(1 + d) & 15][1] = hy_afrag(hrb, mb - 32 * d - 16); }
    hbf16x8 b0 = *(const LAS hbf16x8*)zl;
#pragma unroll 1
    for (int c = 0; c < 9; ++c) {
#pragma unroll
        for (int u = 0; u < 16; ++u) { const int s = 16 * c + u;
            if (s <= 128) {
                hbf16x8 nb0 = b0;
                if (s < 128) {
                    A[(16 - u) & 15][0] = hy_afrag(hrb, mb + 32 * (s + 1)); A[(16 - u) & 15][1] = hy_afrag(hrb, mb + 32 * (s + 1) - 16);
                    nb0 = *(const LAS hbf16x8*)(zl + (s + 1) * 64); }
#pragma unroll
                for (int hh = 0; hh < 2; ++hh)
#pragma unroll
                    for (int p = 0; p < 8; ++p) acc[p][hh] = __builtin_amdgcn_mfma_f32_16x16x32_bf16(A[(17 - u + 2 * p) & 15][hh], b0, acc[p][hh], 0, 0, 0);
                b0 = nb0; } }
    }
}
__device__ __forceinline__ v2u hy_conv4_fin(v2u v, bf16 l, bf16 r, int t0, float w0, float w1, float w2) {
    const float xl = t0 > 0 ? bf2f(l) : 0.f, xr = t0 < SEQ - 4 ? bf2f(r) : 0.f;
    const float x0 = bflo(v.x), x1 = bfhi(v.x), x2 = bflo(v.y), x3 = bfhi(v.y);
    v2u o; o.x = pk2(w0 * xl + w1 * x0 + w2 * x1, w0 * x0 + w1 * x1 + w2 * x2); o.y = pk2(w0 * x1 + w1 * x2 + w2 * x3, w0 * x2 + w1 * x3 + w2 * xr); return o;
}
__device__ __forceinline__ void hy_toeplitz_phase(const bf16* uT, const float* cw_, const float* filtT, const float* skip_, bf16* yT, LAS unsigned char* lds, int tid, int lane, int wave, int bid, int G) {
    const GAS float* skip = (const GAS float*)skip_; const GAS float* cw = (const GAS float*)cw_; const GAS bf16* ur = (const GAS bf16*)uT;
    LAS unsigned char* zbb = lds; LAS unsigned char* hrb = lds + HY_ZBYTES;
    for (int i = tid; i < HY_ZBYTES / 4; i += NTHR) ((LAS unsigned*)zbb)[i] = 0u;
    __syncthreads();
    const int w = wave;
    for (int c = bid; c < 512; c += G) {
        { const float w0 = cw[c], w1 = cw[1536 + c], w2 = cw[3072 + c];
#pragma unroll 8
          for (int bb = 0; bb < 8; ++bb) { const int q = tid; const GAS bf16* src = ur + (size_t)c * MTOK + bb * SEQ + q * 8;
              const v4u v = *(const GAS v4u*)src; const float xlr = bf2f(src[q > 0 ? -1 : 0]), xrr = bf2f(src[q < 511 ? 8 : 7]); const float xl = q > 0 ? xlr : 0.f, xr = q < 511 ? xrr : 0.f;
              const float x[10] = {xl, bflo(v.x), bfhi(v.x), bflo(v.y), bfhi(v.y), bflo(v.z), bfhi(v.z), bflo(v.w), bfhi(v.w), xr};
              v4u o; o.x = pk2(w0 * x[0] + w1 * x[1] + w2 * x[2], w0 * x[1] + w1 * x[2] + w2 * x[3]); o.y = pk2(w0 * x[2] + w1 * x[3] + w2 * x[4], w0 * x[3] + w1 * x[4] + w2 * x[5]);
              o.z = pk2(w0 * x[4] + w1 * x[5] + w2 * x[6], w0 * x[5] + w1 * x[6] + w2 * x[7]); o.w = pk2(w0 * x[6] + w1 * x[7] + w2 * x[8], w0 * x[7] + w1 * x[8] + w2 * x[9]);
              *(LAS v4u*)(zbb + (bb * HY_PITCH + HY_ZOFF + q * 8) * 2) = o; } }
        hy_fill_hr(filtT, 0, c, hrb, tid);
        __syncthreads();
        f32x4 acc[8][2];
        hy_conv(zbb, hrb, w, lane, acc);
        { unsigned zp[8][2][2];
        int ln = lane; asm volatile("" : "+v"(ln)); const int n = ln & 15, b = n >> 1, il = n & 1, kq = ln >> 4;
        { const float sk = skip[c]; const float a0 = cw[512 + c], a1 = cw[1536 + 512 + c], a2 = cw[3072 + 512 + c];
          const int tb = 32 * (16 * w + il) + 4 * kq; const GAS bf16* xb0 = ur + (size_t)(512 + c) * MTOK + b * SEQ + tb;
#pragma unroll
          for (int gh = 0; gh < 2; ++gh) { v2u rv[8]; bf16 rl[8], rr[8];
#pragma unroll
            for (int k = 0; k < 8; ++k) { const int off = 64 * (4 * gh + (k >> 1)) + 16 * (k & 1); rv[k] = *(const GAS v2u*)(xb0 + off); rl[k] = xb0[off - 1]; rr[k] = xb0[off + 4]; }
            asm volatile("" ::: "memory");
#pragma unroll
            for (int k = 0; k < 8; ++k) { const int g = 4 * gh + (k >> 1), rq = k & 1, t0 = tb + 64 * g + 16 * rq;
                const v2u xv = hy_conv4_fin(rv[k], rl[k], rr[k], t0, a0, a1, a2);
                const v2u vv = *(const LAS v2u*)(zbb + (b * HY_PITCH + HY_ZOFF + t0) * 2);
                const float z0 = bflo(xv.x) * (acc[g][rq][0] + bflo(vv.x) * sk), z1 = bfhi(xv.x) * (acc[g][rq][1] + bfhi(vv.x) * sk);
                const float z2 = bflo(xv.y) * (acc[g][rq][2] + bflo(vv.y) * sk), z3 = bfhi(xv.y) * (acc[g][rq][3] + bfhi(vv.y) * sk);
                zp[g][rq][0] = pk2(z0, z1); zp[g][rq][1] = pk2(z2, z3); } } }
        __syncthreads();
#pragma unroll
        for (int g = 0; g < 8; ++g)
#pragma unroll
            for (int rq = 0; rq < 2; ++rq) { const int t0 = 32 * (16 * w + 2 * g + il) + 16 * rq + 4 * kq;
                *(LAS v2u*)(zbb + (b * HY_PITCH + HY_ZOFF + t0) * 2) = (v2u){zp[g][rq][0], zp[g][rq][1]}; } }
        hy_fill_hr(filtT, 1, c, hrb, tid);
        __syncthreads();
        hy_conv(zbb, hrb, w, lane, acc);
        { int ln = lane; asm volatile("" : "+v"(ln)); const int n = ln & 15, b = n >> 1, il = n & 1, kq = ln >> 4; const float sk = skip[512 + c]; const float a0 = cw[1024 + c], a1 = cw[1536 + 1024 + c], a2 = cw[3072 + 1024 + c];
          const int tb = 32 * (16 * w + il) + 4 * kq; const GAS bf16* xb0 = ur + (size_t)(1024 + c) * MTOK + b * SEQ + tb;
#pragma unroll
          for (int gh = 0; gh < 2; ++gh) { v2u rv[8]; bf16 rl[8], rr[8];
#pragma unroll
            for (int k = 0; k < 8; ++k) { const int off = 64 * (4 * gh + (k >> 1)) + 16 * (k & 1); rv[k] = *(const GAS v2u*)(xb0 + off); rl[k] = xb0[off - 1]; rr[k] = xb0[off + 4]; }
            asm volatile("" ::: "memory");
#pragma unroll
            for (int k = 0; k < 8; ++k) { const int g = 4 * gh + (k >> 1), rq = k & 1, t0 = tb + 64 * g + 16 * rq;
                const v2u xv = hy_conv4_fin(rv[k], rl[k], rr[k], t0, a0, a1, a2);
                const v2u zv = *(const LAS v2u*)(zbb + (b * HY_PITCH + HY_ZOFF + t0) * 2);
                const float z0 = bflo(zv.x), z1 = bfhi(zv.x), z2 = bflo(zv.y), z3 = bfhi(zv.y);
                const float o0 = bflo(xv.x) * (acc[g][rq][0] + z0 * sk), o1 = bfhi(xv.x) * (acc[g][rq][1] + z1 * sk);
                const float o2 = bflo(xv.y) * (acc[g][rq][2] + z2 * sk), o3 = bfhi(xv.y) * (acc[g][rq][3] + z3 * sk);
                *(GAS v2u*)(yT + (size_t)c * MTOK + b * SEQ + t0) = (v2u){pk2(o0, o1), pk2(o2, o3)}; } } }
        __syncthreads();
    }
}
__device__ __forceinline__ void hy_transpose_out(const bf16* yT, const float* gC, bf16* mix, LAS unsigned char* lds, int tid, int lane, int wave, int bid, int G) {
    constexpr int TP = 66;
    LAS bf16* T = (LAS bf16*)lds;
    for (int tile = bid; tile < MTOK / 64; tile += G) { const int tok0 = tile * 64;
#pragma unroll
        for (int pass = 0; pass < 8; ++pass) { const int c = (tid >> 3) + 64 * pass, sg = tid & 7;
            const v4u v = *(const GAS v4u*)(yT + (size_t)c * MTOK + tok0 + 8 * sg);
            LAS unsigned* d = (LAS unsigned*)(T + c * TP + 8 * sg); d[0] = v.x; d[1] = v.y; d[2] = v.z; d[3] = v.w; }
        __syncthreads();
#pragma unroll 1
        for (int k = 0; k < 8; ++k) { const int s = wave * 8 + k; float y[8]; float ss = 0.f;
#pragma unroll
            for (int e = 0; e < 8; ++e) { y[e] = bf2f(T[(lane * 8 + e) * TP + s]); ss += y[e] * y[e]; }
            const float rstd = rsqrtf(wave_sum(ss) * (1.f / 512.f) + EPS);
            const f32x4 g0 = *(const GAS f32x4*)(gC + lane * 8), g1 = *(const GAS f32x4*)(gC + lane * 8 + 4);
            v4u o; o.x = pk2(y[0] * rstd * g0.x, y[1] * rstd * g0.y); o.y = pk2(y[2] * rstd * g0.z, y[3] * rstd * g0.w);
            o.z = pk2(y[4] * rstd * g1.x, y[5] * rstd * g1.y); o.w = pk2(y[6] * rstd * g1.z, y[7] * rstd * g1.w);
            *(GAS v4u*)(mix + (size_t)(tok0 + s) * DM + 1024 + lane * 8) = o; }
        __syncthreads();
    }
}

__device__ __forceinline__ void phase_c_misc(const Params& P, unsigned char* ws, float* xres, int l, LAS unsigned char* lds, int tid, int lane, int wave, int bid, int G) {
    const bf16* proj = (const bf16*)(ws + WS_PROJ); bf16* mix = (bf16*)(ws + WS_MIX);
    { const bf16* FU2 = (const bf16*)(ws + WS_FU2); bf16* FE = (bf16*)(ws + WS_FE); bf16* FO = (bf16*)(ws + WS_FO); float* Y2K = (float*)(ws + WS_Y2K);
      const int gw = bid * NWAVES + wave, NGW = G * NWAVES;
      for (int col = gw; col < 4096; col += NGW) { const bf16* ur = FU2 + (size_t)col * 8192; const bf16* ui = ur + 4096; float alt = 0.f;
#pragma unroll
          for (int j = 0; j < 4; ++j) { const int t0 = 8 * (lane + 64 * j);
              const v4u a = *(const GAS v4u*)(ur + t0), c = *(const GAS v4u*)(ui + t0);
              const v4u ma = *(const GAS v4u*)(ur + 4096 - t0 - 8), mc = *(const GAS v4u*)(ui + 4096 - t0 - 8);
              const float m0rr = bf2f(ur[t0 ? 4096 - t0 : 0]), m0ir = bf2f(ui[t0 ? 4096 - t0 : 0]); const float m0r = t0 ? m0rr : 0.f, m0i = t0 ? m0ir : 0.f;
              float er[8], oi[8];
              const unsigned aw[4] = {a.x, a.y, a.z, a.w}, cw[4] = {c.x, c.y, c.z, c.w}, maw[4] = {ma.x, ma.y, ma.z, ma.w}, mcw[4] = {mc.x, mc.y, mc.z, mc.w};
#pragma unroll
              for (int e = 0; e < 8; ++e) { const float xr = (e & 1) ? bfhi(aw[e >> 1]) : bflo(aw[e >> 1]), xi = (e & 1) ? bfhi(cw[e >> 1]) : bflo(cw[e >> 1]);
                  float mr, mi; if (e == 0) { mr = m0r; mi = m0i; } else { const int q = 8 - e; mr = (q & 1) ? bfhi(maw[q >> 1]) : bflo(maw[q >> 1]); mi = (q & 1) ? bfhi(mcw[q >> 1]) : bflo(mcw[q >> 1]); }
                  er[e] = xr + mr; oi[e] = (t0 + e) ? xi - mi : 0.f; alt += (e & 1) ? -er[e] : er[e]; }
              v4u oe, oo; oe.x = pk2(er[0], er[1]); oe.y = pk2(er[2], er[3]); oe.z = pk2(er[4], er[5]); oe.w = pk2(er[6], er[7]);
              oo.x = pk2(oi[0], oi[1]); oo.y = pk2(oi[2], oi[3]); oo.z = pk2(oi[4], oi[5]); oo.w = pk2(oi[6], oi[7]);
              *(GAS v4u*)(FE + (size_t)col * FK1 + t0) = oe; *(GAS v4u*)(FO + (size_t)col * 2048 + t0) = oo; }
          const float e2k = bf2f(ur[2048]);
          if (lane < 16) { v4u z = (v4u){0u, 0u, 0u, 0u}; if (lane == 0) z.x = f2bf(e2k); *(GAS v4u*)(FE + (size_t)col * FK1 + 2048 + 8 * lane) = z; }
          alt = wave_sum(alt) + e2k;
          if (lane == 0) Y2K[col] = alt * 0.001381067932f; } }
    { const float* cw = pin(P, 16) + (size_t)l * 3 * 512; const float* gD = pin(P, 17) + (size_t)(l * 3 + 2) * 512;
      const int gw = bid * NWAVES + wave, NGW = G * NWAVES, c0 = lane * 8;
      float w0[8], w1[8], w2[8], gd[8];
#pragma unroll
      for (int e = 0; e < 8; ++e) { w0[e] = cw[c0 + e]; w1[e] = cw[512 + c0 + e]; w2[e] = cw[1024 + c0 + e]; gd[e] = gD[c0 + e]; }
      for (int tk0 = gw; tk0 < MTOK; tk0 += 2 * NGW) {
          v4u vb[2], vc[2], vh[2], vcm[2], vhm[2], vcp[2], vhp[2];
#pragma unroll
          for (int h = 0; h < 2; ++h) { const int tk = tk0 + h * NGW, token = tk < MTOK ? tk : MTOK - 1, t = token & (SEQ - 1);
              const bf16* p = proj + (size_t)token * NPROJ + PUS + c0; const int om = t > 0 ? -NPROJ : 0, op = t < SEQ - 1 ? NPROJ : 0;
              vb[h] = *(const GAS v4u*)p; vc[h] = *(const GAS v4u*)(p + 512); vh[h] = *(const GAS v4u*)(p + 1024);
              vcm[h] = *(const GAS v4u*)(p + 512 + om); vhm[h] = *(const GAS v4u*)(p + 1024 + om); vcp[h] = *(const GAS v4u*)(p + 512 + op); vhp[h] = *(const GAS v4u*)(p + 1024 + op); }
#pragma unroll
          for (int h = 0; h < 2; ++h) { const int token = tk0 + h * NGW, t = token & (SEQ - 1); const float km = t > 0 ? 1.f : 0.f, kp = t < SEQ - 1 ? 1.f : 0.f;
              float y[8]; float ss = 0.f;
#pragma unroll
              for (int e2 = 0; e2 < 4; ++e2) {
                  const float a0 = km * w0[2 * e2] * bflo(vcm[h][e2]) * bflo(vhm[h][e2]) + w1[2 * e2] * bflo(vc[h][e2]) * bflo(vh[h][e2]) + kp * w2[2 * e2] * bflo(vcp[h][e2]) * bflo(vhp[h][e2]);
                  const float a1 = km * w0[2 * e2 + 1] * bfhi(vcm[h][e2]) * bfhi(vhm[h][e2]) + w1[2 * e2 + 1] * bfhi(vc[h][e2]) * bfhi(vh[h][e2]) + kp * w2[2 * e2 + 1] * bfhi(vcp[h][e2]) * bfhi(vhp[h][e2]);
                  y[2 * e2] = bflo(vb[h][e2]) * a0; y[2 * e2 + 1] = bfhi(vb[h][e2]) * a1; ss += y[2 * e2] * y[2 * e2] + y[2 * e2 + 1] * y[2 * e2 + 1]; }
              const float rstd = rsqrtf(wave_sum(ss) * (1.f / 512.f) + EPS);
              v4u o; o.x = pk2(y[0] * rstd * gd[0], y[1] * rstd * gd[1]); o.y = pk2(y[2] * rstd * gd[2], y[3] * rstd * gd[3]); o.z = pk2(y[4] * rstd * gd[4], y[5] * rstd * gd[5]); o.w = pk2(y[6] * rstd * gd[6], y[7] * rstd * gd[7]);
              if (token < MTOK) *(GAS v4u*)(mix + (size_t)token * DM + 1536 + c0) = o; } } }
    __syncthreads();
    gla_g1(proj, pin(P, 4) + (size_t)l * 2 * 16 * 256, pin(P, 5) + (size_t)l * 512, (bf16*)(ws + WS_GU), (float*)(ws + WS_GD), lds, tid, lane, wave, bid, G);
}

__device__ __forceinline__ void phase_d(const Params& P, unsigned char* ws, float* xres, int l, LAS unsigned char* lds, int tid, int lane, int wave, int bid, int G) {
    if (!(P.pad1 & 2)) gla_g3((const bf16*)(ws + WS_PROJ), pin(P, 4) + (size_t)l * 2 * 16 * 256, pin(P, 5) + (size_t)l * 512, pin(P, 6) + (size_t)l * 128, (const bf16*)(ws + WS_GS), (bf16*)(ws + WS_MIX), lds, tid, lane, wave, bid, G);
}
__device__ __forceinline__ void phase_e(const Params& P, unsigned char* ws, float* xres, int l, LAS unsigned char* lds, int tid, int lane, int wave, int bid, int G) {
    hy_transpose_out((const bf16*)(ws + WS_YT), pin(P, 17) + (size_t)(l * 3 + 1) * 512, (bf16*)(ws + WS_MIX), lds, tid, lane, wave, bid, G);
    { const bf16* FY = (const bf16*)(ws + WS_FY); const float* gB = pin(P, 17) + (size_t)(l * 3 + 0) * 512; bf16* mix = (bf16*)(ws + WS_MIX);
      const int gw = bid * NWAVES + wave, NGW = G * NWAVES;
      const f32x4 g0 = *(const GAS f32x4*)(gB + lane * 8), g1 = *(const GAS f32x4*)(gB + lane * 8 + 4);
      const float* Y2K = (const float*)(ws + WS_Y2K);
      for (int it0 = gw; it0 < MTOK; it0 += 2 * NGW) {
          v4u ya[2], yb[2];
#pragma unroll
          for (int h = 0; h < 2; ++h) { const int i2 = it0 + h * NGW, it = i2 < MTOK ? i2 : MTOK - 1, b = it >> 12, sp = it & (SEQ - 1);
              const int sf = sp < 2048 ? sp : 4096 - sp, sfc = sf > 2047 ? 2047 : sf;
              const bf16* src = FY + (size_t)sfc * 4096 + b * 512 + lane * 8; const bf16* srb = src + (size_t)2048 * 4096;
              ya[h] = *(const GAS v4u*)src; yb[h] = *(const GAS v4u*)srb; }
#pragma unroll
          for (int h = 0; h < 2; ++h) { const int it = it0 + h * NGW, b = it >> 12, sp = it & (SEQ - 1); const float sg = sp < 2048 ? 1.f : -1.f;
              f32x4 a = (f32x4){bflo(ya[h].x), bfhi(ya[h].x), bflo(ya[h].y), bfhi(ya[h].y)} + (f32x4){bflo(yb[h].x), bfhi(yb[h].x), bflo(yb[h].y), bfhi(yb[h].y)} * sg;
              f32x4 c = (f32x4){bflo(ya[h].z), bfhi(ya[h].z), bflo(ya[h].w), bfhi(ya[h].w)} + (f32x4){bflo(yb[h].z), bfhi(yb[h].z), bflo(yb[h].w), bfhi(yb[h].w)} * sg;
              if (sp == 2048) { a = *(const GAS f32x4*)(Y2K + (b & 7) * 512 + lane * 8); c = *(const GAS f32x4*)(Y2K + (b & 7) * 512 + lane * 8 + 4); }
              const float ss = (a.x * a.x + a.y * a.y) + (a.z * a.z + a.w * a.w) + (c.x * c.x + c.y * c.y) + (c.z * c.z + c.w * c.w);
              const float rstd = rsqrtf(wave_sum(ss) * (1.f / 512.f) + EPS);
              v4u o; o.x = pk2(a.x * rstd * g0.x, a.y * rstd * g0.y); o.y = pk2(a.z * rstd * g0.z, a.w * rstd * g0.w); o.z = pk2(c.x * rstd * g1.x, c.y * rstd * g1.y); o.w = pk2(c.z * rstd * g1.z, c.w * rstd * g1.w);
              if (it < MTOK) *(GAS v4u*)(mix + (size_t)it * DM + 512 + lane * 8) = o; } } }
}
__device__ __forceinline__ void phase_softmax(const float* sc, bf16* Pm, int lane, int wave, int bid, int G) {
    const int gw = bid * NWAVES + wave, NGW = G * NWAVES;
    for (int it = gw; it < MTOK * 4; it += NGW) {
        const f32x4 v = *((const GAS f32x4*)(sc + (size_t)it * 256) + lane);
        const float m = wave_max(fmaxf(fmaxf(v.x, v.y), fmaxf(v.z, v.w)));
        const float e0 = __expf(v.x - m), e1 = __expf(v.y - m), e2 = __expf(v.z - m), e3 = __expf(v.w - m);
        const float inv = 1.0f / wave_sum((e0 + e1) + (e2 + e3));
        v2u w; w.x = pk2(e0 * inv, e1 * inv); w.y = pk2(e2 * inv, e3 * inv);
        *((GAS v2u*)(Pm + (size_t)it * 256) + lane) = w;
    }
}

#ifndef EPIRES_XB
#define EPIRES_XB (GAS bf16*)xb
#endif
#ifndef GEMM_ALIGN
#define GEMM_ALIGN false
#endif
#ifndef GEMM_SP2
#define GEMM_SP2 true
#endif
constexpr int NPH = 11, NSTEPS = NL * NPH + 1;
template <class Sched, bool COLS = false> __device__ __forceinline__ pg8::RstdTab build_rstd(const Sched& S, const float* RS, LAS float* tab, int tid) {
    pg8::RstdTab T; T.tab = tab; T.RS = (const GAS float*)RS; T.pm0 = T.pm1 = T.pm2 = T.pm3 = -1; int n = 0; pg8::Unit u;
    for (int i = 0; S.next(i, u); ++i) { const int pm = COLS ? u.pn : u.pm;
        if (pm != T.pm0 && pm != T.pm1 && pm != T.pm2 && pm != T.pm3) { if (n == 0) T.pm0 = pm; else if (n == 1) T.pm1 = pm; else if (n == 2) T.pm2 = pm; else if (n == 3) T.pm3 = pm; ++n; } }
    const int row = tid >> 1, half = tid & 1;
#pragma unroll
    for (int sl = 0; sl < 4; ++sl) { const int pm = sl == 0 ? T.pm0 : sl == 1 ? T.pm1 : sl == 2 ? T.pm2 : T.pm3;
        if (pm >= 0) { const GAS float* p = (const GAS float*)RS + (size_t)(pm * 256 + row) * 32 + half * 16;
            const f32x4 a = *(const GAS f32x4*)p, b = *(const GAS f32x4*)(p + 4), c = *(const GAS f32x4*)(p + 8), d = *(const GAS f32x4*)(p + 12);
            float t = (((a.x + a.y) + (a.z + a.w)) + ((b.x + b.y) + (b.z + b.w))) + (((c.x + c.y) + (c.z + c.w)) + ((d.x + d.y) + (d.z + d.w)));
            t += __shfl_xor(t, 1);
            if (half == 0) tab[sl * 256 + row] = rsqrtf(t * (1.0f / DM) + EPS); } }
    __syncthreads();
    return T;
}
#define IN(st) (lo <= (st) && (st) < hi)
#define SEAM(stp_) do { if ((stp_) + 1 < hi) { XcdBarrier b2_; b2_.bar = opaque_p(bar.bar); b2_.x = (unsigned)opaque_i((int)bar.x); b2_.st = bar.st; xcd_barrier(b2_, tid); } } while (0)
#define OPAQ() int tid = wave0 * 64 + (int)__builtin_amdgcn_mbcnt_hi(~0u, __builtin_amdgcn_mbcnt_lo(~0u, 0u)); asm volatile("" : "+v"(tid)); const int bid = opaque_i(bid0), G = opaque_i(G0); unsigned char* ws = opaque_p(ws0); float* xres = opaque_p(out0); const unsigned ldsa = (unsigned)opaque_i((int)(unsigned)(size_t)lds0)
#define LOCALS() OPAQ(); LAS unsigned char* lds = (LAS unsigned char*)(size_t)ldsa; const int lane = tid & 63, wave = __builtin_amdgcn_readfirstlane(tid >> 6); \
        bf16* xb = (bf16*)(ws + WS_XB); bf16* proj = (bf16*)(ws + WS_PROJ); bf16* mix = (bf16*)(ws + WS_MIX); (void)lds; (void)lane; (void)wave; (void)xb; (void)proj; (void)mix
template <int L> __device__ __forceinline__ void layer_body(const Params& P, const XcdBarrier& bar, int lo, int hi, int wave0, int bid0, int G0, unsigned char* ws0, float* out0, LAS unsigned char* lds0) {
    constexpr int l = L; const int s0 = l * NPH;
        if (s0 + NPH <= lo || s0 >= hi) return;
        if (IN(s0 + 0)) { LOCALS(); phase_a(P, ws, xres, l, lds, tid, lane, wave, bid, G); SEAM(s0 + 0); }
        if (IN(s0 + 1)) { LOCALS();
            { pg8::Gemm g{xb, (const bf16*)(ws + WS_WIN), DM, DM, DM}; pg8::TileOrder S; S.init(MTOK / 256, NPROJ / 256, G, bid, DM, DM);
            pg8::EpiBf16 E{(GAS bf16*)proj, NPROJ, build_rstd(S, (const float*)(ws + WS_RSS), (LAS float*)(lds + LDSCTL_OFF + 1024 + 8192), tid)}; pg8::gemm_phase<pg8::EpiBf16, pg8::TileOrder, GEMM_ALIGN, GEMM_SP2>(lds + RING_OFF, g, S, E, tid);
            }
            { pg8::Gemm g{(const bf16*)(ws + WS_MEMN), (const bf16*)(ws + WS_WKV), DM, DM, DM}; pg8::TileOrder S; S.init(NB * NMEM / 256, 2 * DM / 256, G, (bid + G / 2) % G, DM, DM);
            pg8::EpiBf16 E{(GAS bf16*)(ws + WS_KVB), 2 * DM, pg8::RstdTab{nullptr, nullptr, -1, -1, -1, -1}}; pg8::gemm_phase<pg8::EpiBf16, pg8::TileOrder, GEMM_ALIGN, GEMM_SP2>(lds + RING_OFF, g, S, E, tid); }
            { pg8::Gemm g{(const bf16*)(ws + WS_WIN) + (size_t)WUH * DM, xb, DM, DM, DM}; pg8::TileOrder S; S.init(1536 / 256, MTOK / 256, G, bid, DM, DM);
              pg8::EpiBf16T E{(GAS bf16*)(ws + WS_UT), MTOK, build_rstd<pg8::TileOrder, true>(S, (const float*)(ws + WS_RSS), (LAS float*)(lds + LDSCTL_OFF + 1024 + 8192), tid)};
              pg8::gemm_phase<pg8::EpiBf16T, pg8::TileOrder, GEMM_ALIGN, GEMM_SP2>(lds + RING_OFF, g, S, E, tid); }
            SEAM(s0 + 1); }
        if (IN(s0 + 2)) { LOCALS();
            { pg8::Gemm g{(const bf16*)(ws + WS_KVB), (const bf16*)(ws + WS_WQB), 2 * DM, DM, 512}; pg8::PairOrder<0> S{G, bid};
            pg8::EpiBf16 E{(GAS bf16*)(ws + WS_MT), DM, pg8::RstdTab{nullptr, nullptr, -1, -1, -1, -1}}; pg8::gemm_phase<pg8::EpiBf16, pg8::PairOrder<0>, GEMM_ALIGN, GEMM_SP2>(lds + RING_OFF, g, S, E, tid); }
            { pg8::Gemm g{(const bf16*)(ws + WS_WXO), (const bf16*)(ws + WS_KVB), DM, 2 * DM, 512}; pg8::PairOrder<1> S{G, bid};
            pg8::EpiBf16 E{(GAS bf16*)(ws + WS_VWO), 1024, pg8::RstdTab{nullptr, nullptr, -1, -1, -1, -1}}; pg8::gemm_phase<pg8::EpiBf16, pg8::PairOrder<1>, GEMM_ALIGN, GEMM_SP2>(lds + RING_OFF, g, S, E, tid); }
            { pg8::Gemm g{(const bf16*)(ws + WS_A1), proj, 256, NPROJ, 256}; pg8::FnetAOrder S{G, bid};
            pg8::EpiFnetA E{(GAS bf16*)(ws + WS_FU2)}; pg8::gemm_phase<pg8::EpiFnetA, pg8::FnetAOrder, GEMM_ALIGN, GEMM_SP2>(lds + RING_OFF, g, S, E, tid); }
            SEAM(s0 + 2); }
        if (IN(s0 + 3)) { LOCALS(); phase_c_misc(P, ws, xres, l, lds, tid, lane, wave, bid, G); SEAM(s0 + 3); }
        if (IN(s0 + 4)) { LOCALS();
            { pg8::Gemm g{(const bf16*)(ws + WS_C2), (const bf16*)(ws + WS_FE), FK1, FK1, FK1}; pg8::TileOrder S; S.init(8, 16, G, bid, FK1, FK1);
              pg8::EpiBf16 E{(GAS bf16*)(ws + WS_FY), 4096, pg8::RstdTab{nullptr, nullptr, -1, -1, -1, -1}}; pg8::gemm_phase<pg8::EpiBf16, pg8::TileOrder, GEMM_ALIGN, GEMM_SP2>(lds + RING_OFF, g, S, E, tid); }
            { pg8::Gemm g{(const bf16*)(ws + WS_S2), (const bf16*)(ws + WS_FO), 2048, 2048, 2048}; pg8::TileOrder S; S.init(8, 16, G, (bid + G / 2) % G, 2048, 2048);
              pg8::EpiBf16 E{(GAS bf16*)(ws + WS_FY) + (size_t)2048 * 4096, 4096, pg8::RstdTab{nullptr, nullptr, -1, -1, -1, -1}}; pg8::gemm_phase<pg8::EpiBf16, pg8::TileOrder, GEMM_ALIGN, GEMM_SP2>(lds + RING_OFF, g, S, E, tid); }
            gla_g2((const bf16*)(ws + WS_GU), (const float*)(ws + WS_GD), (bf16*)(ws + WS_GS), tid, bid, G);
            __syncthreads();
            hy_toeplitz_phase((const bf16*)(ws + WS_UT), pin(P, 7) + (size_t)l * 3 * 1536, (const float*)(ws + WS_FILT), pin(P, 15) + (size_t)l * 1024, (bf16*)(ws + WS_YT), lds, tid, lane, wave, bid, G);
            SEAM(s0 + 4); }
        if (IN(s0 + 5)) { LOCALS(); phase_d(P, ws, xres, l, lds, tid, lane, wave, bid, G); __syncthreads(); phase_e(P, ws, xres, l, lds, tid, lane, wave, bid, G); SEAM(s0 + 5); }
        if (IN(s0 + 6)) { LOCALS();
            pg8::Gemm g{mix, (const bf16*)(ws + WS_WOUT), DM, DM, DM}; pg8::TileOrder S; S.init(MTOK / 256, DM / 256, G, bid, DM, DM);
            pg8::EpiRes E{l == 0 ? (const GAS float*)pin(P, 0) : (const GAS float*)nullptr, DM, (GAS bf16*)xb, (GAS float*)(ws + WS_RSS)}; pg8::gemm_phase<pg8::EpiRes, pg8::TileOrder, GEMM_ALIGN, GEMM_SP2>(lds + RING_OFF, g, S, E, tid);
            SEAM(s0 + 6); }
        if (IN(s0 + 7)) { LOCALS();
            pg8::Gemm g{xb, (const bf16*)(ws + WS_MT), DM, DM, DM}; pg8::TileOrder S; S.init(MTOK / 256, 4, G, bid, DM, DM, 16, 4);
            pg8::EpiSoftmax E{(GAS bf16*)mix, 1024, (LAS float*)(lds + LDSCTL_OFF + 1024), (LAS float*)(lds + LDSCTL_OFF + 1024 + 4096), build_rstd(S, (const float*)(ws + WS_RSS), (LAS float*)(lds + LDSCTL_OFF + 1024 + 8192), tid)}; pg8::gemm_phase<pg8::EpiSoftmax, pg8::TileOrder, true, GEMM_SP2>(lds + RING_OFF, g, S, E, tid);
            SEAM(s0 + 7); }
        if (IN(s0 + 8)) { LOCALS();
            pg8::Gemm g{mix, (const bf16*)(ws + WS_VWO), 1024, 1024, 1024}; pg8::TileOrder S; S.init(MTOK / 256, DM / 256, G, bid, 1024, 1024, 16, 8);
            pg8::EpiRes E{(const GAS float*)nullptr, DM, (GAS bf16*)xb, (GAS float*)(ws + WS_RSS)}; pg8::gemm_phase<pg8::EpiRes, pg8::TileOrder, GEMM_ALIGN, GEMM_SP2>(lds + RING_OFF, g, S, E, tid);
            SEAM(s0 + 8); }
        if (IN(s0 + 9)) { LOCALS();
            pg8::Gemm g{xb, (const bf16*)(ws + WS_WGU), DM, DM, DM}; pg8::TileOrder S; S.init(MTOK / 256, 2 * DFF / 256, G, bid, DM, DM);
            pg8::EpiSwiglu E{(GAS bf16*)proj, DFF, build_rstd(S, (const float*)(ws + WS_RSS), (LAS float*)(lds + LDSCTL_OFF + 1024 + 8192), tid)}; pg8::gemm_phase<pg8::EpiSwiglu, pg8::TileOrder, GEMM_ALIGN, GEMM_SP2>(lds + RING_OFF, g, S, E, tid);
            SEAM(s0 + 9); }
        if (IN(s0 + 10)) { LOCALS();
            pg8::Gemm g{proj, (const bf16*)(ws + WS_WD), DFF, DFF, DFF}; pg8::TileOrder S; S.init(MTOK / 256, DM / 256, G, bid, DFF, DFF);
            pg8::EpiRes E{(const GAS float*)nullptr, DM, (GAS bf16*)xb, (GAS float*)(ws + WS_RSS)}; pg8::gemm_phase<pg8::EpiRes, pg8::TileOrder, GEMM_ALIGN, GEMM_SP2>(lds + RING_OFF, g, S, E, tid);
            SEAM(s0 + 10); }
    }
__global__ void __launch_bounds__(NTHR, 2) fwd_kernel(Params P) {
    extern __shared__ __attribute__((aligned(16))) unsigned char lds_raw[];
    LAS unsigned char* lds = (LAS unsigned char*)lds_raw; LAS unsigned char* const lds0 = lds;
    const int tid = threadIdx.x, lane = tid & 63, wave = __builtin_amdgcn_readfirstlane(tid >> 6), bid = blockIdx.x, G = gridDim.x;
    volatile LAS unsigned* MISC = (volatile LAS unsigned*)(lds + MISC_OFF);
    for (int u = tid; u < (LDS_BYTES - LDSCTL_OFF) / 4; u += NTHR) ((LAS unsigned*)(lds + LDSCTL_OFF))[u] = 0u;
    __syncthreads();
    unsigned char* ws = P.ws;
    XcdBarrier bar = xcd_barrier_post((unsigned*)(ws + WS_CTL) + CW_BAR + P.pad0 * XCD_BAR_WORDS, MISC + 8, tid);
    const int lo = P.step_lo, hi = P.step_hi;
    const int wave0 = wave, bid0 = bid, G0 = G; unsigned char* const ws0 = ws; float* const out0 = P.out;
    layer_body<0>(P, bar, lo, hi, wave0, bid0, G0, ws0, out0, lds0);
    layer_body<1>(P, bar, lo, hi, wave0, bid0, G0, ws0, out0, lds0);
    layer_body<2>(P, bar, lo, hi, wave0, bid0, G0, ws0, out0, lds0);
    layer_body<3>(P, bar, lo, hi, wave0, bid0, G0, ws0, out0, lds0);
    if (IN(NL * NPH)) { LOCALS(); const int gw = bid * NWAVES + wave, NGW = G * NWAVES;
        for (int m = gw; m < MTOK; m += NGW) final_norm_row(xb + (size_t)m * DM, xres + (size_t)m * DM, pin(P, 25), lane); }
#undef IN
#undef SEAM
}

#ifndef MK_SPLIT
#define MK_SPLIT 0
#endif
extern "C" void kernel_launch(void* const* d_in, const int* in_sizes, int n_in, void* d_out, int out_size, void* d_ws, size_t ws_size, hipStream_t stream) {
    static int grid = 0;
    if (grid == 0) {
        if (n_in != 26 || in_sizes[0] != MTOK * DM || out_size != MTOK * DM || ws_size < WS_END) { fprintf(stderr, "kernel_launch: unexpected shapes (n_in %d, in0 %d, out %d, ws %zu); nothing launched\n", n_in, n_in > 0 ? in_sizes[0] : -1, out_size, ws_size); grid = -1; return; }
        int dev = 0, cus = 0, per_cu = 0;
        if (hipGetDevice(&dev) != hipSuccess || hipDeviceGetAttribute(&cus, hipDeviceAttributeMultiprocessorCount, dev) != hipSuccess) { grid = -1; return; }
        if (hipFuncSetAttribute((const void*)fwd_kernel, hipFuncAttributeMaxDynamicSharedMemorySize, LDS_BYTES) != hipSuccess) { fprintf(stderr, "kernel_launch: hipFuncSetAttribute failed\n"); grid = -1; return; }
        if (hipOccupancyMaxActiveBlocksPerMultiprocessor(&per_cu, (const void*)fwd_kernel, NTHR, LDS_BYTES) != hipSuccess || per_cu < 1) { fprintf(stderr, "kernel_launch: occupancy query says %d\n", per_cu); }
        (void)hipGetLastError();
        grid = cus;
    }
    if (grid < 0) return;
    if (hipMemsetAsync((char*)d_ws + WS_CTL, 0, CTL_ZERO_BYTES, stream) != hipSuccess) return;
    Params p{};
    for (int i = 0; i < 26; ++i) p.in[i] = (const float*)d_in[i];
    p.out = (float*)d_out; p.ws = (unsigned char*)d_ws;
#if defined(PROBE_PH)
#ifndef PROBE_FLAGS
#define PROBE_FLAGS 0
#endif
    { int lo = 0; int li = 0;
      for (int l = 0; l < NL; ++l) { const int gk = l * NPH + PROBE_PH;
          p.pad0 = li++; p.step_lo = lo; p.step_hi = gk + 1; hipLaunchKernelGGL(fwd_kernel, dim3(grid), dim3(NTHR), LDS_BYTES, stream, p);
          p.pad0 = li++; p.step_lo = gk; p.step_hi = gk + 1; p.pad1 = PROBE_FLAGS; hipLaunchKernelGGL(fwd_kernel, dim3(grid), dim3(NTHR), LDS_BYTES, stream, p); p.pad1 = 0;
          lo = gk + 1; }
      p.pad0 = li++; p.step_lo = lo; p.step_hi = NSTEPS; hipLaunchKernelGGL(fwd_kernel, dim3(grid), dim3(NTHR), LDS_BYTES, stream, p); }
#elif MK_SPLIT
    for (int st = 0; st < NSTEPS; ++st) { p.pad0 = st; p.step_lo = st; p.step_hi = st + 1; hipLaunchKernelGGL(fwd_kernel, dim3(grid), dim3(NTHR), LDS_BYTES, stream, p); }
#else
    p.step_lo = 0; p.step_hi = NSTEPS; hipLaunchKernelGGL(fwd_kernel, dim3(grid), dim3(NTHR), LDS_BYTES, stream, p);
#endif
}
```

```cpp
#include <hip/hip_runtime.h>
#include <cstdio>
#include <cstdint>

namespace pg8 {
#define PG8_LAS __attribute__((address_space(3)))
#define PG8_GAS __attribute__((address_space(1)))
typedef unsigned short bf16_t;
typedef short bf16x8 __attribute__((ext_vector_type(8)));
typedef float f32x4 __attribute__((ext_vector_type(4)));
typedef unsigned u32x4 __attribute__((ext_vector_type(4)));
constexpr int BM = 256, BK = 64, HALF = 128, HTB = HALF * BK * 2  , STAGE_BYTES = 8 * HTB, NXCD = 8, WGM = 4;

__host__ __device__ __forceinline__ int lds_byte(int r, int c) { const int st = (r >> 4) * 2 + (c >> 5), rr = r & 15, cc = c & 31, ob = rr * 64 + cc * 2; return st * 1024 + (ob ^ (((ob >> 9) & 1) << 5)); }
__host__ __device__ __forceinline__ void stage_rc(int b, int& R, int& C) { const int st = b / 1024, sb = b % 1024, swz = sb ^ (((sb >> 9) & 1) << 5); R = (st >> 1) * 16 + swz / 64; C = (st & 1) * 32 + (swz % 64) / 2; }
__host__ __device__ __forceinline__ int perm32(int rho) { const int n = rho >> 4, i = rho & 15; return 8 * (i >> 2) + 4 * n + (i & 3); }

struct Unit { size_t aoff, boff; int pm, pn; };
struct Gemm { const bf16_t* A; const bf16_t* Bt; int lda, ldb, K; };

struct TileOrder {
    int nM, nN, nwg, G, c, bdiv, bmul; size_t atile, btile;
    __device__ void init(int nM_, int nN_, int G_, int c_, int lda, int ldb, int bdiv_ = 1 << 30, int bmul_ = 0) { nM = nM_; nN = nN_; nwg = nM * nN; G = G_; c = c_; bdiv = bdiv_; bmul = bmul_; atile = (size_t)BM * lda * 2; btile = (size_t)BM * ldb * 2; }
    __device__ bool next(int i, Unit& u) const {
        const long L = (long)i * G + c; if (L >= nwg) return false;
        int wgid = (int)L; { const int q = nwg / NXCD, r = nwg % NXCD, xcd = wgid % NXCD, off = wgid / NXCD; wgid = (xcd < r ? xcd * (q + 1) : r * (q + 1) + (xcd - r) * q) + off; }
        const int nig = WGM * nN, gid = wgid / nig, fm = gid * WGM, gsz = (nM - fm) < WGM ? (nM - fm) : WGM;
        u.pm = fm + ((wgid % nig) % gsz); u.pn = (wgid % nig) / gsz;
        u.aoff = (size_t)u.pm * atile; u.boff = (size_t)((u.pm / bdiv) * bmul + u.pn) * btile; return true;
    }
    __device__ __forceinline__ void a_ready(const Unit&) const {}
    __device__ __forceinline__ void done(const Unit&) const {}
};
template <int MODE> struct PairOrder {
    int G, c;
    __device__ bool next(int i, Unit& u) const {
        const long L = (long)i * G + c; if (L >= 256) return false;
        const int bh = (int)L >> 3, j = (int)L & 7, b = bh >> 2, h = bh & 3;
        if (MODE == 0) { u.aoff = ((size_t)(b * 256) * 4096 + h * 512) * 2; u.boff = ((size_t)(j * 256) * 2048 + h * 512) * 2; u.pm = b * 4 + h; u.pn = j; }
        else           { u.aoff = ((size_t)(j * 256) * 2048 + h * 512) * 2; u.boff = ((size_t)(b * 256) * 4096 + 2048 + h * 512) * 2; u.pm = b * 8 + j; u.pn = h; }
        return true;
    }
    __device__ __forceinline__ void a_ready(const Unit&) const {}
    __device__ __forceinline__ void done(const Unit&) const {}
};

struct FnetAOrder {
    int G, c;
    __device__ bool next(int i, Unit& u) const {
        const long L = (long)i * G + c; if (L >= 512) return false;
        const int combo = (int)L >> 5, rest = (int)L & 31, b = combo >> 1, gp = combo & 1, pml = rest >> 4, pn = rest & 15;
        u.aoff = (size_t)pml * 256 * 256 * 2; u.boff = ((size_t)(b * 4096 + pn * 256) * 3840 + 1792 + gp * 256) * 2; u.pm = b * 4 + gp * 2 + pml; u.pn = pn; return true;
    }
    __device__ __forceinline__ void a_ready(const Unit&) const {}
    __device__ __forceinline__ void done(const Unit&) const {}
};

__device__ __forceinline__ unsigned cvt_pk_bf16(float lo, float hi) { unsigned r; asm volatile("v_cvt_pk_bf16_f32 %0, %1, %2" : "=v"(r) : "v"(lo), "v"(hi)); return r; }

struct RstdTab { const PG8_LAS float* tab; const PG8_GAS float* RS; int pm0, pm1, pm2, pm3;
    __device__ __forceinline__ int slot(int pm) const { return !tab ? -2 : pm == pm0 ? 0 : pm == pm1 ? 1 : pm == pm2 ? 2 : pm == pm3 ? 3 : -1; }
    __device__ __forceinline__ void rows(const Unit& u, int wr, int fr, int fq, float (&rs)[2][4]) const {
        const int sl = slot(u.pm);
        if (sl == -2) {
#pragma unroll
            for (int ai = 0; ai < 2; ++ai)
#pragma unroll
                for (int m = 0; m < 4; ++m) rs[ai][m] = 1.0f;
        } else if (sl >= 0) {
#pragma unroll
            for (int ai = 0; ai < 2; ++ai)
#pragma unroll
                for (int m = 0; m < 4; ++m) rs[ai][m] = tab[sl * 256 + ai * HALF + wr * 64 + m * 16 + fr];
        } else {
#pragma unroll
            for (int ai = 0; ai < 2; ++ai)
#pragma unroll
                for (int m = 0; m < 4; ++m) { const PG8_GAS float* p = RS + (size_t)(u.pm * BM + ai * HALF + wr * 64 + m * 16 + fr) * 32 + fq * 8;
                    const f32x4 a = *(const PG8_GAS f32x4*)p, b = *(const PG8_GAS f32x4*)(p + 4);
                    float t = ((a[0] + a[1]) + (a[2] + a[3])) + ((b[0] + b[1]) + (b[2] + b[3])); t += __shfl_xor(t, 16); t += __shfl_xor(t, 32);
                    rs[ai][m] = rsqrtf(t * (1.0f / 2048.0f) + 1e-6f); }
        }
    }
};
struct EpiBf16 {
    static constexpr bool PERM = true, AFTER_DRAIN = false;
    PG8_GAS bf16_t* O; int ldc; RstdTab R;
    __device__ __forceinline__ void operator()(const f32x4 (&acc)[2][2][4][2], const Unit& u, int wr, int wc, int fr, int fq) const {
        const int row0 = u.pm * BM + wr * 64 + fr, col0 = u.pn * BM + wc * 32 + 8 * fq;
        float rs[2][4]; R.rows(u, wr, fr, fq, rs);
#pragma unroll
        for (int ai = 0; ai < 2; ++ai)
#pragma unroll
            for (int m = 0; m < 4; ++m) { PG8_GAS bf16_t* rowp = O + (size_t)(row0 + ai * HALF + m * 16) * ldc + col0;
#pragma unroll
                for (int bj = 0; bj < 2; ++bj) { const f32x4 v0 = acc[ai][bj][m][0] * rs[ai][m], v1 = acc[ai][bj][m][1] * rs[ai][m];
                    u32x4 w; w.x = cvt_pk_bf16(v0[0], v0[1]); w.y = cvt_pk_bf16(v0[2], v0[3]); w.z = cvt_pk_bf16(v1[0], v1[1]); w.w = cvt_pk_bf16(v1[2], v1[3]);
                    *(PG8_GAS u32x4*)(rowp + bj * HALF) = w; } }
    }
};
struct EpiBf16T {
    static constexpr bool PERM = true, AFTER_DRAIN = false;
    PG8_GAS bf16_t* O; int ldc; RstdTab R;
    __device__ __forceinline__ void operator()(const f32x4 (&acc)[2][2][4][2], const Unit& u, int wr, int wc, int fr, int fq) const {
        const int row0 = u.pm * BM + wr * 64 + fr, col0 = u.pn * BM + wc * 32 + 8 * fq;
        const int sl = R.slot(u.pn); f32x4 cs[2][2];
#pragma unroll
        for (int bj = 0; bj < 2; ++bj) { const int cl = bj * HALF + wc * 32 + 8 * fq;
            if (sl >= 0) { cs[bj][0] = *(const PG8_LAS f32x4*)(R.tab + sl * 256 + cl); cs[bj][1] = *(const PG8_LAS f32x4*)(R.tab + sl * 256 + cl + 4); }
            else {
#pragma unroll
                for (int e = 0; e < 8; ++e) { const PG8_GAS float* p = R.RS + (size_t)(u.pn * BM + cl + e) * 32; float t = 0.f;
#pragma unroll
                    for (int j = 0; j < 32; ++j) t += p[j];
                    cs[bj][e >> 2][e & 3] = rsqrtf(t * (1.0f / 2048.0f) + 1e-6f); } } }
#pragma unroll
        for (int ai = 0; ai < 2; ++ai)
#pragma unroll
            for (int m = 0; m < 4; ++m) { PG8_GAS bf16_t* rowp = O + (size_t)(row0 + ai * HALF + m * 16) * ldc + col0;
#pragma unroll
                for (int bj = 0; bj < 2; ++bj) { const f32x4 v0 = acc[ai][bj][m][0] * cs[bj][0], v1 = acc[ai][bj][m][1] * cs[bj][1];
                    u32x4 w; w.x = cvt_pk_bf16(v0[0], v0[1]); w.y = cvt_pk_bf16(v0[2], v0[3]); w.z = cvt_pk_bf16(v1[0], v1[1]); w.w = cvt_pk_bf16(v1[2], v1[3]);
                    *(PG8_GAS u32x4*)(rowp + bj * HALF) = w; } }
    }
};
struct EpiFnetA {
    static constexpr bool PERM = true, AFTER_DRAIN = false;
    PG8_GAS bf16_t* O;
    __device__ __forceinline__ void operator()(const f32x4 (&acc)[2][2][4][2], const Unit& u, int wr, int wc, int fr, int fq) const {
        const int col0 = u.pn * BM + wc * 32 + 8 * fq;
#pragma unroll
        for (int ai = 0; ai < 2; ++ai)
#pragma unroll
            for (int m = 0; m < 4; ++m) { PG8_GAS bf16_t* rowp = O + (size_t)(u.pm * 128 + wr * 64 + m * 16 + fr) * 8192 + ai * 4096 + col0;
#pragma unroll
                for (int bj = 0; bj < 2; ++bj) { const f32x4 v0 = acc[ai][bj][m][0], v1 = acc[ai][bj][m][1];
                    u32x4 w; w.x = cvt_pk_bf16(v0[0], v0[1]); w.y = cvt_pk_bf16(v0[2], v0[3]); w.z = cvt_pk_bf16(v1[0], v1[1]); w.w = cvt_pk_bf16(v1[2], v1[3]);
                    *(PG8_GAS u32x4*)(rowp + bj * HALF) = w; } }
    }
};
struct EpiF32 {
    static constexpr bool PERM = false, AFTER_DRAIN = false;
    PG8_GAS float* C; int ldc;
    __device__ __forceinline__ void operator()(const f32x4 (&acc)[2][2][4][2], const Unit& u, int wr, int wc, int fr, int fq) const {
        const int row0 = u.pm * BM + wr * 64 + fr, col0 = u.pn * BM + wc * 32 + 4 * fq;
#pragma unroll
        for (int ai = 0; ai < 2; ++ai)
#pragma unroll
            for (int m = 0; m < 4; ++m) { PG8_GAS float* rowp = C + (size_t)(row0 + ai * HALF + m * 16) * ldc + col0;
#pragma unroll
                for (int bj = 0; bj < 2; ++bj)
#pragma unroll
                    for (int n = 0; n < 2; ++n) *(PG8_GAS f32x4*)(rowp + bj * HALF + n * 16) = acc[ai][bj][m][n]; }
    }
};
struct EpiRes {
    static constexpr bool PERM = true, AFTER_DRAIN = false;
    const PG8_GAS float* Xs32; int ldc; PG8_GAS bf16_t* XB; PG8_GAS float* RS;
    __device__ __forceinline__ void operator()(const f32x4 (&acc)[2][2][4][2], const Unit& u, int wr, int wc, int fr, int fq) const {
        const int row0 = u.pm * BM + wr * 64 + fr, col0 = u.pn * BM + wc * 32 + 8 * fq;
#pragma unroll
        for (int ai = 0; ai < 2; ++ai) {
            f32x4 xv[4][2][2];
            if (Xs32) {
#pragma unroll
                for (int m = 0; m < 4; ++m) { const PG8_GAS float* rowp = Xs32 + (size_t)(row0 + ai * HALF + m * 16) * ldc + col0;
#pragma unroll
                    for (int bj = 0; bj < 2; ++bj)
#pragma unroll
                        for (int n = 0; n < 2; ++n) xv[m][bj][n] = __builtin_nontemporal_load((const PG8_GAS f32x4*)(rowp + bj * HALF + n * 4)); }
            } else {
                u32x4 xr[4][2];
#pragma unroll
                for (int m = 0; m < 4; ++m)
#pragma unroll
                    for (int bj = 0; bj < 2; ++bj) xr[m][bj] = *(const PG8_GAS u32x4*)(XB + (size_t)(row0 + ai * HALF + m * 16) * ldc + col0 + bj * HALF);
#pragma unroll
                for (int m = 0; m < 4; ++m)
#pragma unroll
                    for (int bj = 0; bj < 2; ++bj) { const u32x4 r = xr[m][bj];
                        xv[m][bj][0] = (f32x4){__builtin_bit_cast(float, r.x << 16), __builtin_bit_cast(float, r.x & 0xffff0000u), __builtin_bit_cast(float, r.y << 16), __builtin_bit_cast(float, r.y & 0xffff0000u)};
                        xv[m][bj][1] = (f32x4){__builtin_bit_cast(float, r.z << 16), __builtin_bit_cast(float, r.z & 0xffff0000u), __builtin_bit_cast(float, r.w << 16), __builtin_bit_cast(float, r.w & 0xffff0000u)}; }
            }
#pragma unroll
            for (int m = 0; m < 4; ++m) { const int row = row0 + ai * HALF + m * 16; float ss = 0.f;
#pragma unroll
                for (int bj = 0; bj < 2; ++bj) { const f32x4 y0 = xv[m][bj][0] + acc[ai][bj][m][0], y1 = xv[m][bj][1] + acc[ai][bj][m][1];
                    ss += ((y0[0] * y0[0] + y0[1] * y0[1]) + (y0[2] * y0[2] + y0[3] * y0[3])) + ((y1[0] * y1[0] + y1[1] * y1[1]) + (y1[2] * y1[2] + y1[3] * y1[3]));
                    u32x4 w; w.x = cvt_pk_bf16(y0[0], y0[1]); w.y = cvt_pk_bf16(y0[2], y0[3]); w.z = cvt_pk_bf16(y1[0], y1[1]); w.w = cvt_pk_bf16(y1[2], y1[3]);
                    *(PG8_GAS u32x4*)(XB + (size_t)row * ldc + col0 + bj * HALF) = w; }
                ss += __shfl_xor(ss, 16); ss += __shfl_xor(ss, 32); if (fq == 0) RS[(size_t)row * 32 + u.pn * 4 + wc] = ss; }
            asm volatile("" ::: "memory"); }
    }
};
struct EpiSoftmax {
    static constexpr bool PERM = true, AFTER_DRAIN = false;
    PG8_GAS bf16_t* O; int ldc; PG8_LAS float* T1; PG8_LAS float* T2; RstdTab R;
    typedef float f32x2 __attribute__((ext_vector_type(2)));
    static __device__ __forceinline__ f32x2 ex2(float x0, float x1, float c1, float m2) { const f32x2 t = (f32x2){x0, x1} * c1 - m2; f32x2 e; e.x = __builtin_amdgcn_exp2f(t.x); e.y = __builtin_amdgcn_exp2f(t.y); return e; }
    __device__ __forceinline__ void operator()(const f32x4 (&acc)[2][2][4][2], const Unit& u, int wr, int wc, int fr, int fq) const {
        const int row0 = u.pm * BM + wr * 64 + fr, col0 = u.pn * BM + wc * 32 + 8 * fq;
        float m2[2][4]; float rs[2][4]; R.rows(u, wr, fr, fq, rs);
#pragma unroll
        for (int ai = 0; ai < 2; ++ai)
#pragma unroll
            for (int m = 0; m < 4; ++m) { float a = -3.0e38f;
#pragma unroll
                for (int bj = 0; bj < 2; ++bj)
#pragma unroll
                    for (int n = 0; n < 2; ++n) { const f32x4 v = acc[ai][bj][m][n]; a = fmaxf(a, fmaxf(fmaxf(v[0], v[1]), fmaxf(v[2], v[3]))); }
                a = fmaxf(a, __shfl_xor(a, 16)); a = fmaxf(a, __shfl_xor(a, 32));
                if (fq == 0) T1[(ai * HALF + wr * 64 + m * 16 + fr) * 4 + wc] = a * rs[ai][m]; }
        asm volatile("s_waitcnt lgkmcnt(0)" ::: "memory"); __builtin_amdgcn_s_barrier(); asm volatile("" ::: "memory");
#pragma unroll
        for (int ai = 0; ai < 2; ++ai)
#pragma unroll
            for (int m = 0; m < 4; ++m) { const f32x4 t = *(const PG8_LAS f32x4*)(T1 + (ai * HALF + wr * 64 + m * 16 + fr) * 4); const float c1 = rs[ai][m] * 1.4426950408889634f;
                m2[ai][m] = fmaxf(fmaxf(t[0], t[1]), fmaxf(t[2], t[3])) * 1.4426950408889634f; f32x2 a2 = (f32x2){0.f, 0.f};
#pragma unroll
                for (int bj = 0; bj < 2; ++bj)
#pragma unroll
                    for (int n = 0; n < 2; ++n) { const f32x4 v = acc[ai][bj][m][n]; a2 += ex2(v[0], v[1], c1, m2[ai][m]) + ex2(v[2], v[3], c1, m2[ai][m]); }
                float a = a2.x + a2.y; a += __shfl_xor(a, 16); a += __shfl_xor(a, 32);
                if (fq == 0) T2[(ai * HALF + wr * 64 + m * 16 + fr) * 4 + wc] = a; }
        asm volatile("s_waitcnt lgkmcnt(0)" ::: "memory"); __builtin_amdgcn_s_barrier(); asm volatile("" ::: "memory");
#pragma unroll
        for (int ai = 0; ai < 2; ++ai)
#pragma unroll
            for (int m = 0; m < 4; ++m) { const f32x4 t = *(const PG8_LAS f32x4*)(T2 + (ai * HALF + wr * 64 + m * 16 + fr) * 4); const float inv = 1.0f / ((t[0] + t[1]) + (t[2] + t[3])), mm = m2[ai][m], c1 = rs[ai][m] * 1.4426950408889634f;
                PG8_GAS bf16_t* rowp = O + (size_t)(row0 + ai * HALF + m * 16) * ldc + col0;
#pragma unroll
                for (int bj = 0; bj < 2; ++bj) { const f32x4 v0 = acc[ai][bj][m][0], v1 = acc[ai][bj][m][1];
                    const f32x2 p0 = ex2(v0[0], v0[1], c1, mm) * inv, p1 = ex2(v0[2], v0[3], c1, mm) * inv, p2 = ex2(v1[0], v1[1], c1, mm) * inv, p3 = ex2(v1[2], v1[3], c1, mm) * inv;
                    u32x4 w; w.x = cvt_pk_bf16(p0.x, p0.y); w.y = cvt_pk_bf16(p1.x, p1.y); w.z = cvt_pk_bf16(p2.x, p2.y); w.w = cvt_pk_bf16(p3.x, p3.y);
                    *(PG8_GAS u32x4*)(rowp + bj * HALF) = w; } }
    }
};
__device__ __forceinline__ float silu_f(float g) { return g * __builtin_amdgcn_rcpf(1.0f + __expf(-g)); }
struct EpiSwiglu {
    static constexpr bool PERM = true, AFTER_DRAIN = false;
    PG8_GAS bf16_t* H; int ldc; RstdTab R;
    typedef float f32x2 __attribute__((ext_vector_type(2)));
    static __device__ __forceinline__ void quad(f32x4 G, f32x4 U, float a, float q, unsigned& w0, unsigned& w1) {
        const f32x2 G01 = (f32x2){G[0], G[1]}, G23 = (f32x2){G[2], G[3]}, U01 = (f32x2){U[0], U[1]}, U23 = (f32x2){U[2], U[3]};
        const f32x2 t01 = __builtin_elementwise_min(G01 * a, (f32x2){30.f, 30.f}), t23 = __builtin_elementwise_min(G23 * a, (f32x2){30.f, 30.f});
        f32x2 e01, e23; e01.x = __builtin_amdgcn_exp2f(t01.x); e01.y = __builtin_amdgcn_exp2f(t01.y); e23.x = __builtin_amdgcn_exp2f(t23.x); e23.y = __builtin_amdgcn_exp2f(t23.y);
        const f32x2 d01 = e01 + 1.0f, d23 = e23 + 1.0f, pp = d01 * d23;
        const float r = __builtin_amdgcn_rcpf(pp.x * pp.y);
        const f32x2 rp = (f32x2){pp.y, pp.x} * r;
        const f32x2 i01 = rp * d23, i23 = rp * d01;
        const f32x2 h01 = (G01 * U01) * (i01 * q), h23 = (G23 * U23) * (i23 * q);
        w0 = cvt_pk_bf16(h01.x, h01.y); w1 = cvt_pk_bf16(h23.x, h23.y);
    }
    __device__ __forceinline__ void operator()(const f32x4 (&acc)[2][2][4][2], const Unit& u, int wr, int wc, int fr, int fq) const {
        const int row0 = u.pm * BM + wr * 64 + fr, col0 = u.pn * HALF + wc * 32 + 8 * fq;
        float rs[2][4]; R.rows(u, wr, fr, fq, rs);
#pragma unroll
        for (int ai = 0; ai < 2; ++ai)
#pragma unroll
            for (int m = 0; m < 4; ++m) { PG8_GAS bf16_t* rowp = H + (size_t)(row0 + ai * HALF + m * 16) * ldc + col0;
                const float a = rs[ai][m] * -1.4426950408889634f, q = rs[ai][m] * rs[ai][m];
                const f32x4 g0 = acc[ai][0][m][0], g1 = acc[ai][0][m][1], u0 = acc[ai][1][m][0], u1 = acc[ai][1][m][1];
                u32x4 w; unsigned wa, wb, wc2, wd; quad(g0, u0, a, q, wa, wb); quad(g1, u1, a, q, wc2, wd); w.x = wa; w.y = wb; w.z = wc2; w.w = wd;
                *(PG8_GAS u32x4*)rowp = w; }
    }
};

template <class Epi, class Sched, bool ALIGN_EPI = false, bool SP2 = false>
__device__ __forceinline__ void gemm_phase(PG8_LAS unsigned char* lds, const Gemm g, const Sched& S, const Epi& E, int tid_in) {
    int tid = tid_in; asm volatile("" : "+v"(tid));
    const int wid = __builtin_amdgcn_readfirstlane(tid >> 6), lane = tid & 63, wr = wid >> 2, wc = wid & 3, fr = lane & 15, fq = lane >> 4;
    const int K = g.K, nt = K / BK;
    unsigned voffA[2], voffB[2];
#pragma unroll
    for (int i = 0; i < 2; ++i) { int R, C; stage_rc(tid * 16 + i * 8192, R, C); const int Rb = Epi::PERM ? ((R & ~31) + perm32(R & 31)) : R;
        voffA[i] = (unsigned)(R * g.lda + C) * 2u; voffB[i] = (unsigned)(Rb * g.ldb + C) * 2u; }
    const size_t kstep = (size_t)(BK * 2);
    const size_t hstepA = (size_t)HALF * g.lda * 2, hstepB = (size_t)HALF * g.ldb * 2;
    const unsigned ldsw = (unsigned)wid * 1024u;
    const int aoff = lds_byte(wr * 64 + fr, fq * 8), boff = lds_byte(wc * 32 + fr, fq * 8);
#define PG8_SA(b, h) (((b) * 2 + (h)) * HTB)
#define PG8_SB(b, h) ((4 + (b) * 2 + (h)) * HTB)
#define PG8_STAGE(bufoff, gbase, voff) do { _Pragma("unroll") for (int _i = 0; _i < 2; ++_i) \
        __builtin_amdgcn_global_load_lds((const unsigned*)((const char*)(gbase) + (voff)[_i]), (PG8_LAS unsigned*)(lds + (bufoff) + ldsw + _i * 8192), 16, 0, 0); } while (0)
#define PG8_LDA(dst, b, h) do { _Pragma("unroll") for (int m = 0; m < 4; ++m) _Pragma("unroll") for (int k = 0; k < 2; ++k) dst[m][k] = *(const PG8_LAS bf16x8*)(lds + PG8_SA(b, h) + aoff + m * 2048 + k * 1024); } while (0)
#define PG8_LDB(dst, b, h) do { _Pragma("unroll") for (int n = 0; n < 2; ++n) _Pragma("unroll") for (int k = 0; k < 2; ++k) dst[n][k] = *(const PG8_LAS bf16x8*)(lds + PG8_SB(b, h) + boff + n * 2048 + k * 1024); } while (0)
#define PG8_MMA(ai, bj, At, Bt) do { __builtin_amdgcn_s_setprio(1); _Pragma("unroll") for (int m = 0; m < 4; ++m) _Pragma("unroll") for (int n = 0; n < 2; ++n) _Pragma("unroll") for (int k = 0; k < 2; ++k) \
        acc[ai][bj][m][n] = __builtin_amdgcn_mfma_f32_16x16x32_bf16(Bt[n][k], At[m][k], acc[ai][bj][m][n], 0, 0, 0); __builtin_amdgcn_s_setprio(0); } while (0)
#define PG8_WAIT_V(n) asm volatile("s_waitcnt vmcnt(" #n ")" ::: "memory")
#define PG8_WAIT_L(n) asm volatile("s_waitcnt lgkmcnt(" #n ")" ::: "memory")
#define PG8_BAR __builtin_amdgcn_s_barrier()
#define PG8_SCHED __builtin_amdgcn_sched_barrier(0)
    Unit cur, nxt; int ui = 0;
    if (!S.next(0, cur)) return;
    f32x4 acc[2][2][4][2];
#pragma unroll
    for (int a = 0; a < 2; ++a)
#pragma unroll
        for (int b = 0; b < 2; ++b)
#pragma unroll
            for (int m = 0; m < 4; ++m)
#pragma unroll
                for (int n = 0; n < 2; ++n) acc[a][b][m][n] = (f32x4){0.f, 0.f, 0.f, 0.f};
    bf16x8 At[4][2], B0[2][2], B1[2][2];
    const char* cA = (const char*)g.A + cur.aoff; const char* cB = (const char*)g.Bt + cur.boff;
    S.a_ready(cur);
    if constexpr (SP2) {
        PG8_STAGE(PG8_SB(0, 0), cB, voffB); PG8_STAGE(PG8_SB(0, 1), cB + hstepB, voffB); PG8_STAGE(PG8_SA(0, 0), cA, voffA); PG8_STAGE(PG8_SA(0, 1), cA + hstepA, voffA);
        if (wr == 1) PG8_BAR;
        PG8_WAIT_V(2); PG8_BAR;
        PG8_STAGE(PG8_SB(1, 0), cB + kstep, voffB); PG8_STAGE(PG8_SA(1, 0), cA + kstep, voffA); PG8_STAGE(PG8_SB(1, 1), cB + hstepB + kstep, voffB);
        PG8_WAIT_V(6); PG8_BAR;
    } else {
        PG8_STAGE(PG8_SB(0, 0), cB, voffB); PG8_STAGE(PG8_SA(0, 0), cA, voffA); PG8_STAGE(PG8_SB(0, 1), cB + hstepB, voffB); PG8_STAGE(PG8_SA(0, 1), cA + hstepA, voffA);
        if (wr == 1) PG8_BAR;
        PG8_WAIT_V(4); PG8_BAR;
        PG8_STAGE(PG8_SB(1, 0), cB + kstep, voffB); PG8_STAGE(PG8_SA(1, 0), cA + kstep, voffA); PG8_STAGE(PG8_SB(1, 1), cB + hstepB + kstep, voffB);
        PG8_WAIT_V(6); PG8_BAR;
    }
    for (;;) {
        const bool has_next = S.next(ui + 1, nxt);
        const char* nA = has_next ? (const char*)g.A + nxt.aoff : cA; const char* nB = has_next ? (const char*)g.Bt + nxt.boff : cB;
        for (int t = 0; t < nt; t += 2) {
            const bool last = (t == nt - 2);
            const char* a1 = cA + (size_t)(t + 1) * kstep;
            const char* a2 = last ? nA : cA + (size_t)(t + 2) * kstep; const char* b2 = last ? nB : cB + (size_t)(t + 2) * kstep;
            const char* a3 = a2 + kstep; const char* b3 = b2 + kstep;
            if (last && has_next) S.a_ready(nxt);
            if constexpr (SP2) {
            PG8_LDB(B0, 0, 0); PG8_LDB(B1, 0, 1); PG8_SCHED; PG8_LDA(At, 0, 0); PG8_STAGE(PG8_SA(1, 1), a1 + hstepA, voffA);
            PG8_WAIT_V(8); PG8_WAIT_L(0); PG8_BAR; PG8_MMA(0, 0, At, B0); PG8_MMA(0, 1, At, B1); PG8_BAR; PG8_SCHED;
            PG8_LDA(At, 0, 1); PG8_STAGE(PG8_SB(0, 0), b2, voffB); PG8_STAGE(PG8_SB(0, 1), b2 + hstepB, voffB); PG8_STAGE(PG8_SA(0, 0), a2, voffA);
            PG8_WAIT_V(8); PG8_WAIT_L(0); PG8_BAR; PG8_MMA(1, 0, At, B0); PG8_MMA(1, 1, At, B1); PG8_BAR; PG8_SCHED;
            PG8_LDB(B0, 1, 0); PG8_LDB(B1, 1, 1); PG8_SCHED; PG8_LDA(At, 1, 0); PG8_STAGE(PG8_SA(0, 1), a2 + hstepA, voffA);
            PG8_WAIT_V(8); PG8_WAIT_L(0); PG8_BAR; PG8_MMA(0, 0, At, B0); PG8_MMA(0, 1, At, B1); PG8_BAR; PG8_SCHED;
            PG8_LDA(At, 1, 1); PG8_STAGE(PG8_SB(1, 0), b3, voffB); PG8_STAGE(PG8_SB(1, 1), b3 + hstepB, voffB); PG8_STAGE(PG8_SA(1, 0), a3, voffA);
            PG8_WAIT_V(8); PG8_WAIT_L(0); PG8_BAR; PG8_MMA(1, 0, At, B0); PG8_MMA(1, 1, At, B1); PG8_BAR; PG8_SCHED;
            } else {
            PG8_LDB(B0, 0, 0); PG8_SCHED; PG8_LDA(At, 0, 0); PG8_STAGE(PG8_SA(1, 1), a1 + hstepA, voffA);
            PG8_WAIT_L(8); PG8_BAR; PG8_WAIT_L(0); PG8_MMA(0, 0, At, B0); PG8_BAR; PG8_SCHED;
            PG8_LDB(B1, 0, 1); PG8_STAGE(PG8_SB(0, 0), b2, voffB);
            PG8_BAR; PG8_WAIT_L(0); PG8_MMA(0, 1, At, B1); PG8_BAR;
            PG8_LDA(At, 0, 1); PG8_STAGE(PG8_SA(0, 0), a2, voffA);
            PG8_BAR; PG8_WAIT_L(0); PG8_MMA(1, 0, At, B0); PG8_BAR; PG8_SCHED;
            PG8_STAGE(PG8_SB(0, 1), b2 + hstepB, voffB);
            PG8_WAIT_V(6); PG8_BAR; PG8_MMA(1, 1, At, B1); PG8_BAR;
            PG8_LDB(B0, 1, 0); PG8_SCHED; PG8_LDA(At, 1, 0); PG8_STAGE(PG8_SA(0, 1), a2 + hstepA, voffA);
            PG8_WAIT_L(8); PG8_BAR; PG8_WAIT_L(0); PG8_MMA(0, 0, At, B0); PG8_BAR; PG8_SCHED;
            PG8_LDB(B1, 1, 1); PG8_STAGE(PG8_SB(1, 0), b3, voffB);
            PG8_BAR; PG8_WAIT_L(0); PG8_MMA(0, 1, At, B1); PG8_BAR;
            PG8_LDA(At, 1, 1); PG8_STAGE(PG8_SA(1, 0), a3, voffA);
            PG8_BAR; PG8_WAIT_L(0); PG8_MMA(1, 0, At, B0); PG8_BAR; PG8_SCHED;
            PG8_STAGE(PG8_SB(1, 1), b3 + hstepB, voffB);
            PG8_WAIT_V(6); PG8_BAR; PG8_MMA(1, 1, At, B1); PG8_BAR;
            }
        }
        if constexpr (ALIGN_EPI) { if (wr == 0) PG8_BAR; }
        if constexpr (!Epi::AFTER_DRAIN) { E(acc, cur, wr, wc, fr, fq); S.done(cur); }
        if (!has_next) break;
#pragma unroll
        for (int a = 0; a < 2; ++a)
#pragma unroll
            for (int b = 0; b < 2; ++b)
#pragma unroll
                for (int m = 0; m < 4; ++m)
#pragma unroll
                    for (int n = 0; n < 2; ++n) acc[a][b][m][n] = (f32x4){0.f, 0.f, 0.f, 0.f};
        cur = nxt; cA = nA; cB = nB; ++ui;
        if constexpr (ALIGN_EPI) { if (wr == 1) PG8_BAR; }
    }
    PG8_WAIT_V(0);
    if constexpr (!ALIGN_EPI) { if (wr == 0) PG8_BAR; }
    PG8_BAR;
    if constexpr (Epi::AFTER_DRAIN) { E.fused(acc, cur, wr, wc, fr, fq, lds, wid, lane); S.done(cur); }
#undef PG8_SA
#undef PG8_SB
#undef PG8_STAGE
#undef PG8_LDA
#undef PG8_LDB
#undef PG8_MMA
#undef PG8_WAIT_V
#undef PG8_WAIT_L
#undef PG8_BAR
#undef PG8_SCHED
}
}

constexpr int NB = 8, SEQ = 4096, DM = 2048, NL = 4, MTOK = NB * SEQ, NMEM = 256;
constexpr int DIN = 5152, NPROJ = 3840, NWIN = 5376, DFF = 5632;
constexpr int PQ = 0, PK = 256, PV = 512, PG = 1024, PLR = 1536, PUF = 1792, PUS = 2304, WUH = 3840;
constexpr float EPS = 1e-6f;
constexpr int NWAVES = 8, NTHR = 512;

constexpr size_t MiB = 1u << 20;
constexpr size_t WS_CTL = 0, CTL_ZERO_BYTES = 1 * MiB;
constexpr size_t WS_WIN = 1 * MiB, WS_WOUT = 23 * MiB, WS_WQB = 31 * MiB, WS_WKV = 39 * MiB, WS_WXO = 55 * MiB, WS_WGU = 63 * MiB, WS_WD = 107 * MiB;
constexpr size_t WS_KVB = 129 * MiB, WS_MT = 145 * MiB, WS_VWO = 177 * MiB, WS_MEMN = 209 * MiB;
constexpr size_t WS_XB = 217 * MiB, WS_PROJ = 345 * MiB, WS_MIX = 697 * MiB, WS_OF = 825 * MiB, WS_FU = 889 * MiB, WS_FILT = 1017 * MiB, WS_UT = 1049 * MiB, WS_YT = 1145 * MiB;
constexpr size_t WS_FU2 = 889 * MiB, WS_FY = 953 * MiB, WS_C2 = 1177 * MiB, WS_S2 = 1186 * MiB, WS_FE = 1194 * MiB, WS_FO = 1211 * MiB, WS_Y2K = 1227 * MiB, WS_A1 = 1241 * MiB;
constexpr int FK1 = 2176;
constexpr size_t WS_GS = 1242 * MiB  , WS_GU = 1242 * MiB, WS_GD = 1370 * MiB;
constexpr size_t WS_RSS = 1371 * MiB;
constexpr size_t WS_END = 1375 * MiB;
constexpr int CW_BAR = 4096;

constexpr int RING_OFF = 0, RING_BYTES = 131072;
constexpr int LDSCTL_OFF = RING_BYTES, MISC_OFF = LDSCTL_OFF + 320;
constexpr int LDS_BYTES = 147456;

#define GAS __attribute__((address_space(1)))
#define LAS __attribute__((address_space(3)))
typedef unsigned short bf16;
typedef unsigned v4u __attribute__((ext_vector_type(4)));
typedef unsigned v2u __attribute__((ext_vector_type(2)));
typedef float f32x4 __attribute__((ext_vector_type(4)));
typedef GAS unsigned gu32;
#define LDS_WAIT() asm volatile("s_waitcnt lgkmcnt(0)" ::: "memory")
__device__ __forceinline__ unsigned f2bf(float f) { unsigned u = __builtin_bit_cast(unsigned, f); return (u + 0x7fffu + ((u >> 16) & 1u)) >> 16; }
__device__ __forceinline__ unsigned pk2(float lo, float hi) { return f2bf(lo) | (f2bf(hi) << 16); }
__device__ __forceinline__ float bf2f(bf16 h) { return __builtin_bit_cast(float, ((unsigned)h) << 16); }
__device__ __forceinline__ float bflo(unsigned w) { return __builtin_bit_cast(float, w << 16); }
__device__ __forceinline__ float bfhi(unsigned w) { return __builtin_bit_cast(float, w & 0xffff0000u); }

#define XB_TMO      128
#define XB_XCNT(j)  (256  + 64 * (j))
#define XB_XSUB(j)  (1280 + 64 * (j))
#define XB_XGEN(j)  (2304 + 64 * (j))
#define XB_TOP      3328
#define XB_TOPGEN   3392
#define XCD_BAR_WORDS 3456
#define XB_SPIN_CAP (1u << 18)

__device__ __forceinline__ unsigned xb_ld(unsigned* p)              { return __hip_atomic_load(p, __ATOMIC_RELAXED, __HIP_MEMORY_SCOPE_AGENT); }
__device__ __forceinline__ unsigned xb_add(unsigned* p, unsigned v) { return __hip_atomic_fetch_add(p, v, __ATOMIC_RELAXED, __HIP_MEMORY_SCOPE_AGENT); }
__device__ __forceinline__ unsigned xb_xcc_id() { return (unsigned)__builtin_amdgcn_s_getreg((3 << 11) | 20) & 0xFu; }
#define XB_SPIN(cond, bar) do { unsigned _sp = 0; while (cond) { __builtin_amdgcn_s_sleep(1); \
    if ((++_sp & 255u) == 0u) { if (xb_ld(&(bar)[XB_TMO])) break; if (_sp > XB_SPIN_CAP) { atomicAdd(&(bar)[XB_TMO], 1u); break; } } } } while (0)

struct XcdBarrier { unsigned* bar; unsigned x; volatile LAS unsigned* st; };

__device__ __forceinline__ XcdBarrier xcd_barrier_post(unsigned* bar, volatile LAS unsigned* st, int tid) {
    XcdBarrier b; b.bar = bar; b.x = xb_xcc_id(); b.st = st;
    if (tid == 0) (void)xb_add(&bar[XB_XCNT(b.x)], 1u);
    return b;
}
__device__ __forceinline__ void xcd_barrier_complete(unsigned* bar, unsigned x, unsigned& nloc, unsigned& nx) {
    const unsigned G = gridDim.x * gridDim.y * gridDim.z;
    unsigned sum, cnt, mine, sp = 0u;
    for (;;) {
        sum = 0u; cnt = 0u; mine = 0u;
#pragma unroll
        for (unsigned j = 0; j < 16; ++j) { const unsigned c = xb_ld(&bar[XB_XCNT(j)]); sum += c; cnt += (c > 0u) ? 1u : 0u; mine = (j == x) ? c : mine; }
        if (sum == G) break;
        __builtin_amdgcn_s_sleep(1);
        if ((++sp & 255u) == 0u) { if (xb_ld(&bar[XB_TMO])) break; if (sp > XB_SPIN_CAP) { atomicAdd(&bar[XB_TMO], 1u); break; } }
    }
    nloc = mine > 0u ? mine : 1u; nx = cnt > 0u ? cnt : 1u;
}
__device__ __forceinline__ void xcd_barrier(const XcdBarrier& b, int tid) {
    asm volatile("s_waitcnt vmcnt(0)" ::: "memory");
    __syncthreads();
    if (tid == 0) {
        unsigned* bar = b.bar;
        __builtin_amdgcn_s_waitcnt(0);
        unsigned nloc = b.st[0], nx = b.st[1];
        if (nloc == 0u) { xcd_barrier_complete(bar, b.x, nloc, nx); b.st[0] = nloc; b.st[1] = nx; }
        const unsigned old = xb_add(&bar[XB_XSUB(b.x)], 1u);
        const unsigned gen = old / nloc;
        if (old + 1u == (gen + 1u) * nloc) {
            __builtin_amdgcn_fence(__ATOMIC_RELEASE, "agent");
            asm volatile("s_waitcnt vmcnt(0)" ::: "memory");
            const unsigned og = xb_add(&bar[XB_TOP], 1u);
            const unsigned tg = og / nx;
            if (og + 1u == (tg + 1u) * nx) xb_add(&bar[XB_TOPGEN], 1u);
            else XB_SPIN(xb_ld(&bar[XB_TOPGEN]) == tg, bar);
            __builtin_amdgcn_fence(__ATOMIC_ACQUIRE, "agent");
            xb_add(&bar[XB_XGEN(b.x)], 1u);
            asm volatile("s_waitcnt vmcnt(0)" ::: "memory");
        } else {
            XB_SPIN(xb_ld(&bar[XB_XGEN(b.x)]) == gen, bar);
            __builtin_amdgcn_fence(__ATOMIC_ACQUIRE, "agent");
            asm volatile("s_waitcnt vmcnt(0)" ::: "memory");
        }
    }
    __syncthreads();
}

__device__ __forceinline__ float wave_sum(float v) {
#pragma unroll
    for (int o = 1; o < 64; o <<= 1) v += __shfl_xor(v, o);
    return v;
}
__device__ __forceinline__ float wave_max(float v) {
#pragma unroll
    for (int o = 1; o < 64; o <<= 1) v = fmaxf(v, __shfl_xor(v, o));
    return v;
}
__device__ __forceinline__ float block_sum(float v, LAS float* red, int wave, int lane) {
    v = wave_sum(v); if (lane == 0) red[wave] = v; __syncthreads();
    float s = 0.f;
#pragma unroll
    for (int i = 0; i < 8; ++i) s += red[i];
    __syncthreads(); return s;
}
__device__ __forceinline__ float log_sigmoid_f(float x) { return fminf(x, 0.f) - __logf(1.0f + __expf(-fabsf(x))); }

struct Params {
    const float* in[26]; float* out; unsigned char* ws;
    int step_lo, step_hi, pad0, pad1;
};
__device__ __forceinline__ int opaque_i(int x) { asm volatile("" : "+v"(x)); return __builtin_amdgcn_readfirstlane(x); }
template <class T> __device__ __forceinline__ T* opaque_p(T* p) { const unsigned long long v = (unsigned long long)p; const unsigned lo = (unsigned)opaque_i((int)(unsigned)v), hi = (unsigned)opaque_i((int)(unsigned)(v >> 32)); return (T*)(((unsigned long long)hi << 32) | lo); }
__device__ __forceinline__ const float* pin(const Params& P, int i) { return P.in[opaque_i(i)]; }

struct TrItem { const float* src; int ldsrc, nsrc0, k0, lddst, nd0; bf16* dst; const float* gain; float sc; };
__device__ __forceinline__ void tr_load(const TrItem& t, f32x4 (&v)[8], int lane) {
    const int lr = lane >> 3, lc = (lane & 7) * 4;
#pragma unroll
    for (int i = 0; i < 8; ++i) v[i] = *(const GAS f32x4*)(t.src + (size_t)(t.k0 + 8 * i + lr) * t.ldsrc + t.nsrc0 + lc);
}
__device__ __forceinline__ void tr_finish(const TrItem& t, const f32x4 (&v)[8], LAS float* scr, int lane) {
    const int lr = lane >> 3, lc = (lane & 7) * 4;
#pragma unroll
    for (int i = 0; i < 8; ++i) { const int kk = 8 * i + lr; const float gs = (t.gain ? t.gain[t.k0 + kk] : 1.f) * t.sc; LAS float* d = scr + kk * 33 + lc; d[0] = v[i].x * gs; d[1] = v[i].y * gs; d[2] = v[i].z * gs; d[3] = v[i].w * gs; }
    LDS_WAIT(); asm volatile("" ::: "memory");
    const int c = lane & 7;
#pragma unroll
    for (int j = 0; j < 4; ++j) { const int n = (lane >> 3) + 8 * j; const LAS float* s = scr + (8 * c) * 33 + n;
        v4u o; o.x = pk2(s[0 * 33], s[1 * 33]); o.y = pk2(s[2 * 33], s[3 * 33]); o.z = pk2(s[4 * 33], s[5 * 33]); o.w = pk2(s[6 * 33], s[7 * 33]);
        *(GAS v4u*)(t.dst + (size_t)(t.nd0 + n) * t.lddst + t.k0 + 8 * c) = o; }
    LDS_WAIT(); asm volatile("" ::: "memory");
}
__device__ __forceinline__ void norm_row(const float* xrow, bf16* orow, float* xcopy, int lane) {
    const GAS f32x4* xr = (const GAS f32x4*)xrow + lane;
    f32x4 v[8]; float s = 0.f;
#pragma unroll
    for (int j = 0; j < 8; ++j) { v[j] = xr[64 * j]; s += (v[j].x * v[j].x + v[j].y * v[j].y) + (v[j].z * v[j].z + v[j].w * v[j].w); }
    const float rstd = rsqrtf(wave_sum(s) * (1.f / DM) + EPS);
    GAS v2u* o8 = (GAS v2u*)orow + lane;
#pragma unroll
    for (int j = 0; j < 8; ++j) { v2u w; w.x = pk2(v[j].x * rstd, v[j].y * rstd); w.y = pk2(v[j].z * rstd, v[j].w * rstd); o8[64 * j] = w; }
    if (xcopy) { GAS f32x4* xc = (GAS f32x4*)xcopy + lane;
#pragma unroll
        for (int j = 0; j < 8; ++j) xc[64 * j] = v[j]; }
}
__device__ __forceinline__ void final_norm_row(const bf16* xrow, float* orow, const float* g, int lane) {
    const GAS v4u* xr = (const GAS v4u*)xrow + lane; float v[4][8]; float s = 0.f;
#pragma unroll
    for (int j = 0; j < 4; ++j) { const v4u r = xr[64 * j]; v[j][0] = bflo(r.x); v[j][1] = bfhi(r.x); v[j][2] = bflo(r.y); v[j][3] = bfhi(r.y); v[j][4] = bflo(r.z); v[j][5] = bfhi(r.z); v[j][6] = bflo(r.w); v[j][7] = bfhi(r.w);
#pragma unroll
        for (int e = 0; e < 8; ++e) s += v[j][e] * v[j][e]; }
    const float rstd = rsqrtf(wave_sum(s) * (1.f / DM) + EPS);
#pragma unroll
    for (int j = 0; j < 4; ++j) { const int c0 = (64 * j + lane) * 8; const f32x4 g0 = *(const GAS f32x4*)(g + c0), g1 = *(const GAS f32x4*)(g + c0 + 4);
        *(GAS f32x4*)(orow + c0) = (f32x4){v[j][0] * rstd * g0.x, v[j][1] * rstd * g0.y, v[j][2] * rstd * g0.z, v[j][3] * rstd * g0.w};
        *(GAS f32x4*)(orow + c0 + 4) = (f32x4){v[j][4] * rstd * g1.x, v[j][5] * rstd * g1.y, v[j][6] * rstd * g1.z, v[j][7] * rstd * g1.w}; }
}
__device__ __forceinline__ void norm_row_gain_f32(const float* xrow, float* orow, const float* g, int lane) {
    const GAS f32x4* xr = (const GAS f32x4*)xrow + lane; const GAS f32x4* gr = (const GAS f32x4*)g + lane;
    f32x4 v[8]; float s = 0.f;
#pragma unroll
    for (int j = 0; j < 8; ++j) { v[j] = xr[64 * j]; s += (v[j].x * v[j].x + v[j].y * v[j].y) + (v[j].z * v[j].z + v[j].w * v[j].w); }
    const float rstd = rsqrtf(wave_sum(s) * (1.f / DM) + EPS);
    GAS f32x4* o = (GAS f32x4*)orow + lane;
#pragma unroll
    for (int j = 0; j < 8; ++j) o[64 * j] = v[j] * rstd * gr[64 * j];
}
__device__ __forceinline__ void norm_row_gain_bf16(const float* xrow, bf16* orow, const float* g, int lane) {
    const GAS f32x4* xr = (const GAS f32x4*)xrow + lane; const GAS f32x4* gr = (const GAS f32x4*)g + lane;
    f32x4 v[8]; float s = 0.f;
#pragma unroll
    for (int j = 0; j < 8; ++j) { v[j] = xr[64 * j]; s += (v[j].x * v[j].x + v[j].y * v[j].y) + (v[j].z * v[j].z + v[j].w * v[j].w); }
    const float rstd = rsqrtf(wave_sum(s) * (1.f / DM) + EPS);
    GAS v2u* o8 = (GAS v2u*)orow + lane;
#pragma unroll
    for (int j = 0; j < 8; ++j) { const f32x4 y = v[j] * rstd * gr[64 * j]; v2u w; w.x = pk2(y.x, y.y); w.y = pk2(y.z, y.w); o8[64 * j] = w; }
}

__device__ __forceinline__ void phase_a(const Params& P, unsigned char* ws, float* xres, int l, LAS unsigned char* lds, int tid, int lane, int wave, int bid, int G) {
    bf16* WinT = (bf16*)(ws + WS_WIN); bf16* WoutT = (bf16*)(ws + WS_WOUT); bf16* WqB = (bf16*)(ws + WS_WQB); bf16* WkvT = (bf16*)(ws + WS_WKV);
    bf16* WxoT = (bf16*)(ws + WS_WXO); bf16* WguT = (bf16*)(ws + WS_WGU); bf16* WdT = (bf16*)(ws + WS_WD);
    const float* g0 = pin(P, 2) + (size_t)(l * 3 + 0) * DM; const float* g1 = g0 + DM; const float* g2 = g1 + DM;
    const float* w_in = pin(P, 3) + (size_t)l * DM * DIN;
    const float* w_out = pin(P, 18) + (size_t)l * DM * DM;
    const float* w_xq = pin(P, 20) + (size_t)l * DM * DM;
    const float* w_xkv = pin(P, 21) + (size_t)l * DM * 2 * DM;
    const float* w_xo = pin(P, 22) + (size_t)l * DM * DM;
    const float* w_gu = pin(P, 23) + (size_t)l * DM * 2 * DFF;
    const float* w_dn = pin(P, 24) + (size_t)l * DFF * DM;
    const int gw = bid * NWAVES + wave, NGW = G * NWAVES, gt = bid * NTHR + tid, NGT = G * NTHR;
    LAS float* scr = (LAS float*)(lds + wave * 16384);
    constexpr int I1 = 49 * 32, I2 = 112 * 32, I3 = 64 * 32, I4 = 128 * 32, I5 = 64 * 32, I6 = 352 * 32, I7 = 64 * 88, ITOT = I1 + I2 + I3 + I4 + I5 + I6 + I7;
    auto mk_item = [&](int it) -> TrItem {
        int r = it; TrItem t; t.gain = nullptr; t.sc = 1.f;
        if (r < I1) { const int kb = r / 49, nb = r % 49; t.src = w_in; t.ldsrc = DIN; t.nsrc0 = 32 * nb; t.k0 = 64 * kb; t.dst = WinT; t.lddst = DM; t.nd0 = 32 * nb; t.gain = g0; t.sc = nb < 8 ? 0.125f : 1.f; }
        else if ((r -= I1) < I2) { const int kb = r / 112, nb = r % 112; t.src = w_in; t.ldsrc = DIN; t.nsrc0 = 1568 + 32 * nb; t.k0 = 64 * kb; t.dst = WinT; t.lddst = DM; t.gain = g0; const int cc = 32 * nb;
            t.nd0 = cc < 512 ? PUF + cc : cc < 2048 ? WUH + (cc - 512) : PUS + (cc - 2048); }
        else if ((r -= I2) < I3) { const int kb = r / 64, nb = r % 64; t.src = w_out; t.ldsrc = DM; t.nsrc0 = 32 * nb; t.k0 = 64 * kb; t.dst = WoutT; t.lddst = DM; t.nd0 = 32 * nb; }
        else if ((r -= I3) < I4) { const int kb = r / 128, nb = r % 128; t.src = w_xkv; t.ldsrc = 2 * DM; t.nsrc0 = 32 * nb; t.k0 = 64 * kb; t.dst = WkvT; t.lddst = DM; t.nd0 = 32 * nb; }
        else if ((r -= I4) < I5) { const int kb = r / 64, nb = r % 64; t.src = w_xo; t.ldsrc = DM; t.nsrc0 = 32 * nb; t.k0 = 64 * kb; t.dst = WxoT; t.lddst = DM; t.nd0 = 32 * nb; }
        else if ((r -= I5) < I6) { const int kb = r / 352, nb = r % 352, c0 = 32 * nb; t.src = w_gu; t.ldsrc = 2 * DFF; t.nsrc0 = c0; t.k0 = 64 * kb; t.dst = WguT; t.lddst = DM; t.gain = g2;
            t.nd0 = c0 < DFF ? (c0 / 128) * 256 + (c0 % 128) : ((c0 - DFF) / 128) * 256 + 128 + ((c0 - DFF) % 128); }
        else { r -= I6; const int kb = r / 64, nb = r % 64; t.src = w_dn; t.ldsrc = DM; t.nsrc0 = 32 * nb; t.k0 = 64 * kb; t.dst = WdT; t.lddst = DFF; t.nd0 = 32 * nb; }
        return t; };
    { f32x4 va[8], vb[8]; int it = gw;
      if (it < ITOT) { TrItem ta = mk_item(it); tr_load(ta, va, lane);
          for (;;) { const int itb = it + NGW; const bool hb = itb < ITOT; TrItem tb = ta; if (hb) { tb = mk_item(itb); tr_load(tb, vb, lane); }
              tr_finish(ta, va, scr, lane); if (!hb) break;
              const int ita = itb + NGW; const bool ha = ita < ITOT; if (ha) { ta = mk_item(ita); tr_load(ta, va, lane); }
              tr_finish(tb, vb, scr, lane); if (!ha) break; it = ita; } } }
    for (int i = gt; i < DM * DM / 8; i += NGT) { const int k = i >> 8; const float s = g1[k] * 0.044194173824159216f;
        const f32x4 a = *(const GAS f32x4*)(w_xq + (size_t)i * 8), b = *(const GAS f32x4*)(w_xq + (size_t)i * 8 + 4);
        v4u o; o.x = pk2(a.x * s, a.y * s); o.y = pk2(a.z * s, a.w * s); o.z = pk2(b.x * s, b.y * s); o.w = pk2(b.z * s, b.w * s);
        *(GAS v4u*)(WqB + (size_t)i * 8) = o; }
    __syncthreads();
    { float* filtT = (float*)(ws + WS_FILT);
      const float* w1 = pin(P, 8) + (size_t)l * 33 * 64; const float* b1 = pin(P, 9) + l * 64; const float* w2 = pin(P, 10) + (size_t)l * 64 * 64; const float* b2 = pin(P, 11) + l * 64;
      const float* w3 = pin(P, 12) + (size_t)l * 64 * 2048; const float* fr = pin(P, 13) + l * 64; const float* dec = pin(P, 14) + (size_t)l * 2048;
      LAS float* ft = (LAS float*)lds; LAS float* h1 = ft + 16 * 34; LAS float* h2 = h1 + 16 * 64;
      LAS float* w1s = h2 + 16 * 64; LAS float* w2s = w1s + 33 * 64;
      for (int i = tid; i < 33 * 64; i += NTHR) w1s[i] = w1[i];
      for (int i = tid; i < 64 * 64; i += NTHR) w2s[i] = w2[i];
      __syncthreads();
      for (int pg = bid; pg < SEQ / 16; pg += G) {
          if (tid < 256) { const int p = tid >> 4, i = tid & 15; const float t = (float)(pg * 16 + p) * (1.0f / SEQ);
              const float f = 1e-4f + (float)i * ((15.0f - 1e-4f) / 15.0f); const float rev = t * f; ft[p * 34 + 1 + i] = __builtin_amdgcn_cosf(rev); ft[p * 34 + 17 + i] = -__builtin_amdgcn_sinf(rev);
              if (i == 0) ft[p * 34] = t; }
          __syncthreads();
#pragma unroll
          for (int e = 0; e < 2; ++e) { const int o = tid + 512 * e, p = o >> 6, j = o & 63; float a = b1[j];
#pragma unroll 11
              for (int i = 0; i < 33; ++i) a += ft[p * 34 + i] * w1s[i * 64 + j];
              h1[p * 64 + j] = __builtin_amdgcn_sinf(fr[j] * a * 0.15915494309189535f); }
          __syncthreads();
#pragma unroll
          for (int e = 0; e < 2; ++e) { const int o = tid + 512 * e, p = o >> 6, j = o & 63; float a = b2[j];
#pragma unroll 16
              for (int i = 0; i < 64; ++i) a += h1[p * 64 + i] * w2s[i * 64 + j];
              h2[j * 16 + p] = __builtin_amdgcn_sinf(fr[j] * a * 0.15915494309189535f); }
          __syncthreads();
#pragma unroll 1
          for (int q = 0; q < 4; ++q) { const int n = tid + 512 * q; float a[16];
#pragma unroll
              for (int p = 0; p < 16; ++p) a[p] = 0.f;
#pragma unroll 1
              for (int j0 = 0; j0 < 64; j0 += 16) { float wv[16];
#pragma unroll
                  for (int jj = 0; jj < 16; ++jj) wv[jj] = w3[(j0 + jj) * 2048 + n];
#pragma unroll
                  for (int jj = 0; jj < 16; ++jj) { const LAS f32x4* hp = (const LAS f32x4*)(h2 + (j0 + jj) * 16); const f32x4 ha = hp[0], hb = hp[1], hc = hp[2], hd = hp[3]; const float w = wv[jj];
                      a[0] += ha.x * w; a[1] += ha.y * w; a[2] += ha.z * w; a[3] += ha.w * w; a[4] += hb.x * w; a[5] += hb.y * w; a[6] += hb.z * w; a[7] += hb.w * w;
                      a[8] += hc.x * w; a[9] += hc.y * w; a[10] += hc.z * w; a[11] += hc.w * w; a[12] += hd.x * w; a[13] += hd.y * w; a[14] += hd.z * w; a[15] += hd.w * w; } }
              const float dc = fabsf(dec[n]);
#pragma unroll
              for (int p4 = 0; p4 < 4; ++p4) { f32x4 o;
                  o.x = a[4 * p4 + 0] * __expf(-(float)(pg * 16 + 4 * p4 + 0) * (1.0f / SEQ) * dc); o.y = a[4 * p4 + 1] * __expf(-(float)(pg * 16 + 4 * p4 + 1) * (1.0f / SEQ) * dc);
                  o.z = a[4 * p4 + 2] * __expf(-(float)(pg * 16 + 4 * p4 + 2) * (1.0f / SEQ) * dc); o.w = a[4 * p4 + 3] * __expf(-(float)(pg * 16 + 4 * p4 + 3) * (1.0f / SEQ) * dc);
                  *(GAS f32x4*)(filtT + (size_t)n * SEQ + pg * 16 + 4 * p4) = o; } }
          __syncthreads();
      } }
    if (l == 0) { bf16* xb = (bf16*)(ws + WS_XB); float* rss = (float*)(ws + WS_RSS); const float* xin = pin(P, 0);
      for (int m = gw; m < MTOK; m += NGW) { const GAS f32x4* xr = (const GAS f32x4*)(xin + (size_t)m * DM) + lane; f32x4 v[8]; float ss = 0.f;
#pragma unroll
          for (int j = 0; j < 8; ++j) { v[j] = xr[64 * j]; ss += (v[j].x * v[j].x + v[j].y * v[j].y) + (v[j].z * v[j].z + v[j].w * v[j].w); }
          ss = wave_sum(ss); GAS v2u* o8 = (GAS v2u*)(xb + (size_t)m * DM) + lane;
#pragma unroll
          for (int j = 0; j < 8; ++j) { v2u w; w.x = pk2(v[j].x, v[j].y); w.y = pk2(v[j].z, v[j].w); o8[64 * j] = w; }
          if (lane < 32) rss[(size_t)m * 32 + lane] = lane == 0 ? ss : 0.f; } }
    if (l == 0) {
        typedef float f32x2 __attribute__((ext_vector_type(2)));
        __syncthreads();
        LAS f32x2* tw = (LAS f32x2*)lds;
        for (int i = tid; i < 4096; i += NTHR) { const float rv = (float)i * (1.0f / 4096.0f); tw[i] = (f32x2){__builtin_amdgcn_cosf(rv) * 0.001381067932f, __builtin_amdgcn_sinf(rv) * 0.001381067932f}; }
        __syncthreads();
        bf16* C2 = (bf16*)(ws + WS_C2); bf16* S2 = (bf16*)(ws + WS_S2);
        for (int i = gt; i < 2048 * (FK1 / 8); i += NGT) { const int srow = i / (FK1 / 8), t0 = (i % (FK1 / 8)) * 8; float cv[8];
#pragma unroll
            for (int e = 0; e < 8; ++e) cv[e] = (t0 + e) <= 2048 ? tw[(srow * (t0 + e)) & 4095].x : 0.f;
            v4u oc; oc.x = pk2(cv[0], cv[1]); oc.y = pk2(cv[2], cv[3]); oc.z = pk2(cv[4], cv[5]); oc.w = pk2(cv[6], cv[7]);
            *(GAS v4u*)(C2 + (size_t)srow * FK1 + t0) = oc; }
        for (int i = gt; i < 2048 * 256; i += NGT) { const int srow = i >> 8, t0 = (i & 255) * 8; float sv[8];
#pragma unroll
            for (int e = 0; e < 8; ++e) sv[e] = tw[(srow * (t0 + e)) & 4095].y;
            v4u os; os.x = pk2(sv[0], sv[1]); os.y = pk2(sv[2], sv[3]); os.z = pk2(sv[4], sv[5]); os.w = pk2(sv[6], sv[7]);
            *(GAS v4u*)(S2 + (size_t)srow * 2048 + t0) = os; }
        bf16* A1 = (bf16*)(ws + WS_A1);
        for (int i = gt; i < 512 * 256; i += NGT) { const int r = i >> 8, k = i & 255, gl = r >> 8, ri = (r >> 7) & 1, cp = r & 127, kg = k >> 7, cc = k & 127;
            float v = 0.f; if (kg == gl) { const float rv = (float)((cc * cp) & 127) * (1.0f / 128.0f); v = ri == 0 ? __builtin_amdgcn_cosf(rv) : -__builtin_amdgcn_sinf(rv); }
            A1[i] = (bf16)f2bf(v); }
        __syncthreads();
    }
    if (l == 0) { bf16* memn = (bf16*)(ws + WS_MEMN);
      for (int m = gw; m < NB * NMEM; m += NGW) norm_row_gain_bf16(pin(P, 1) + (size_t)m * DM, memn + (size_t)m * DM, pin(P, 19), lane); }
}


typedef short gbf16x8 __attribute__((ext_vector_type(8)));
constexpr int GP = 72;
__device__ __forceinline__ f32x4 mma16(const LAS bf16* A, const LAS bf16* Bt, int K, int lane, f32x4 acc) {
    const int r = lane & 15, q = lane >> 4;
#pragma unroll
    for (int k0 = 0; k0 < 64; k0 += 32) { if (k0 < K) {
        const gbf16x8 a = *(const LAS gbf16x8*)(A + r * GP + k0 + 8 * q), b = *(const LAS gbf16x8*)(Bt + r * GP + k0 + 8 * q);
        acc = __builtin_amdgcn_mfma_f32_16x16x32_bf16(a, b, acc, 0, 0, 0); } }
    return acc;
}
constexpr int RP = 72;
__device__ __forceinline__ v4u gla_ld64(const bf16* proj, int tok0, int col0, int tid) { return *(const GAS v4u*)(proj + (size_t)(tok0 + (tid >> 3)) * NPROJ + col0 + (tid & 7) * 8); }
__device__ __forceinline__ v4u gla_ld128(const bf16* proj, int tok0, int col0, int id) { return *(const GAS v4u*)(proj + (size_t)(tok0 + (id >> 4)) * NPROJ + col0 + (id & 15) * 8); }
__device__ __forceinline__ void gla_st64(LAS bf16* raw, v4u v, int tid) { *(LAS v4u*)(raw + (tid >> 3) * RP + (tid & 7) * 8) = v; }
__device__ __forceinline__ void gla_st_vT(LAS bf16* vT, v4u v, int id) {
    const int i = id >> 4, c0 = (id & 15) * 8; const unsigned w[4] = {v.x, v.y, v.z, v.w};
#pragma unroll
    for (int e = 0; e < 8; ++e) vT[(c0 + e) * GP + i] = (bf16)((e & 1) ? (w[e >> 1] >> 16) : (w[e >> 1] & 0xffffu));
}
constexpr int LRP = 40;
__device__ __forceinline__ void gla_cumsum_lds(const LAS bf16* lrraw, const LAS float* gwl, const float* gkb_, int h, int dir, LAS float* bL, LAS float* tot, int tid) {
    const GAS float* gkb = (const GAS float*)gkb_;
    const int k = tid & 63, seg = tid >> 6;
    const float bias = gkb[dir * 256 + h * 64 + k];
    float w[16];
#pragma unroll
    for (int r = 0; r < 16; ++r) w[r] = gwl[(dir * 16 + r) * 64 + k];
    float c[8];
#pragma unroll
    for (int e = 0; e < 8; ++e) { const LAS v4u* lp = (const LAS v4u*)(lrraw + (8 * seg + e) * LRP + dir * 16); const v4u a = lp[0], b = lp[1];
        float pre = bias;
        pre += bflo(a.x) * w[0] + bfhi(a.x) * w[1] + bflo(a.y) * w[2] + bfhi(a.y) * w[3] + bflo(a.z) * w[4] + bfhi(a.z) * w[5] + bflo(a.w) * w[6] + bfhi(a.w) * w[7];
        pre += bflo(b.x) * w[8] + bfhi(b.x) * w[9] + bflo(b.y) * w[10] + bfhi(b.y) * w[11] + bflo(b.z) * w[12] + bfhi(b.z) * w[13] + bflo(b.w) * w[14] + bfhi(b.w) * w[15];
        c[e] = log_sigmoid_f(pre) * (1.f / 16.f); }
    if (dir == 0) {
#pragma unroll
        for (int e = 1; e < 8; ++e) c[e] += c[e - 1];
        tot[seg * 64 + k] = c[7];
    } else {
#pragma unroll
        for (int e = 6; e >= 0; --e) c[e] += c[e + 1];
        tot[seg * 64 + k] = c[0];
    }
    __syncthreads();
    float off = 0.f;
#pragma unroll
    for (int s2 = 0; s2 < 8; ++s2) { const float tv = tot[s2 * 64 + k]; if (dir == 0 ? (s2 < seg) : (s2 > seg)) off += tv; }
#pragma unroll
    for (int e = 0; e < 8; ++e) bL[(8 * seg + e) * 64 + k] = c[e] + off;
    __syncthreads();
}
__device__ __forceinline__ v4u gla_ld_lr(const bf16* proj, int tok0, int tid) { return *(const GAS v4u*)(proj + (size_t)(tok0 + ((tid & 255) >> 2)) * NPROJ + PLR + (tid & 3) * 8); }
__device__ __forceinline__ void gla_st_lr(LAS bf16* lrraw, v4u v, int tid) { if (tid < 256) *(LAS v4u*)(lrraw + (tid >> 2) * LRP + (tid & 3) * 8) = v; }
__device__ __forceinline__ void gla_stage_gkw(const float* gkw_, int h, LAS float* gwl, int tid) {
    const GAS float* gkw = (const GAS float*)gkw_;
#pragma unroll
    for (int e = 0; e < 4; ++e) { const int i = tid + 512 * e, dr = i >> 6, k = i & 63; gwl[i] = gkw[dr * 256 + h * 64 + k]; }
}
__device__ __forceinline__ void gla_g1(const bf16* proj, const float* gkw, const float* gkb, bf16* GU_, float* GD_, LAS unsigned char* lds, int tid, int lane, int wave, int bid, int G) {
    GAS bf16* GU = (GAS bf16*)GU_; GAS float* GD = (GAS float*)GD_;
    LAS bf16* vT = (LAS bf16*)lds; LAS bf16* kdT = (LAS bf16*)(lds + 18432); LAS float* bL = (LAS float*)(lds + 27648); LAS float* tot = (LAS float*)(lds + 44032);
    LAS bf16* kraw = (LAS bf16*)(lds + 46080); LAS bf16* lrraw = (LAS bf16*)(lds + 55296); LAS float* gwl = (LAS float*)(lds + 60416);
    int unit = bid; if (unit >= 2048) return;
    int hcur = -1; v4u rk, rlr, rv0, rv1;
    { const int bh = unit >> 6, n = unit & 63, h = bh & 3, tok0 = (bh >> 2) * SEQ + n * 64;
      rk = gla_ld64(proj, tok0, PK + h * 64, tid); rlr = gla_ld_lr(proj, tok0, tid);
      rv0 = gla_ld128(proj, tok0, PV + h * 128, tid); rv1 = gla_ld128(proj, tok0, PV + h * 128, tid + 512); }
    for (;;) { const int bh = unit >> 6, h = bh & 3;
        gla_st64(kraw, rk, tid); gla_st_lr(lrraw, rlr, tid); gla_st_vT(vT, rv0, tid); gla_st_vT(vT, rv1, tid + 512);
        if (h != hcur) { gla_stage_gkw(gkw, h, gwl, tid); hcur = h; }
        __syncthreads();
        const int nunit = unit + G; const bool more = nunit < 2048;
        if (more) { const int bh2 = nunit >> 6, n2 = nunit & 63, h2 = bh2 & 3, tok2 = (bh2 >> 2) * SEQ + n2 * 64;
            rk = gla_ld64(proj, tok2, PK + h2 * 64, tid); rlr = gla_ld_lr(proj, tok2, tid);
            rv0 = gla_ld128(proj, tok2, PV + h2 * 128, tid); rv1 = gla_ld128(proj, tok2, PV + h2 * 128, tid + 512); }
        for (int dir = 0; dir < 2; ++dir) {
            gla_cumsum_lds(lrraw, gwl, gkb, h, dir, bL, tot, tid);
            { const int k = tid & 63, seg = tid >> 6; const float bl = bL[(dir ? 0 : 63) * 64 + k]; unsigned w[4];
#pragma unroll
              for (int e = 0; e < 4; ++e) { const int i0 = 8 * seg + 2 * e;
                  const float k0 = bf2f(kraw[i0 * RP + k]) * __expf(bl - bL[i0 * 64 + k]);
                  const float k1 = bf2f(kraw[(i0 + 1) * RP + k]) * __expf(bl - bL[(i0 + 1) * 64 + k]);
                  w[e] = pk2(k0, k1); }
              *(LAS v4u*)(kdT + k * GP + 8 * seg) = (v4u){w[0], w[1], w[2], w[3]};
              if (seg == 0) GD[(size_t)(unit * 2 + dir) * 64 + k] = __expf(bl); }
            __syncthreads();
            { GAS bf16* U = GU + (size_t)(unit * 2 + dir) * 8192; const int r = lane & 15, q = lane >> 4;
#pragma unroll
              for (int kt = 0; kt < 4; ++kt) { f32x4 acc = (f32x4){0.f, 0.f, 0.f, 0.f};
                  acc = mma16(vT + 16 * wave * GP, kdT + 16 * kt * GP, 64, lane, acc);
#pragma unroll
                  for (int j = 0; j < 4; ++j) U[(16 * wave + 4 * q + j) * 64 + 16 * kt + r] = (bf16)f2bf(acc[j]); } }
            __syncthreads();
        }
        if (!more) break; unit = nunit;
    }
}
__device__ __forceinline__ void gla_g3(const bf16* proj, const float* gkw, const float* gkb, const float* gnorm_, const bf16* GS_, bf16* mix_, LAS unsigned char* lds, int tid, int lane, int wave, int bid, int G) {
    const GAS float* gnorm = (const GAS float*)gnorm_; const GAS bf16* GS = (const GAS bf16*)GS_; GAS bf16* mix = (GAS bf16*)mix_; const GAS bf16* gproj = (const GAS bf16*)proj;
    LAS bf16* vT = (LAS bf16*)lds; LAS bf16* ST = (LAS bf16*)(lds + 18432); LAS bf16* qd = (LAS bf16*)(lds + 36864); LAS bf16* kd = (LAS bf16*)(lds + 46080);
    LAS bf16* qb = (LAS bf16*)(lds + 55296); LAS bf16* Pm = (LAS bf16*)(lds + 64512); LAS float* bL = (LAS float*)(lds + 73728); LAS float* tot = (LAS float*)(lds + 90112); LAS float* rs = (LAS float*)(lds + 92160);
    LAS bf16* qraw = (LAS bf16*)(lds + 92672); LAS bf16* kraw = (LAS bf16*)(lds + 101888); LAS bf16* lrraw = (LAS bf16*)(lds + 111104); LAS float* gwl = (LAS float*)(lds + 116224);
    const int r = lane & 15, q = lane >> 4, wr = wave >> 1, wc = wave & 1;
    int unit = bid; if (unit >= 2048) return;
    int hcur = -1; v4u rq, rk, rlr, rv0, rv1, rs0a, rs0b, rs1a, rs1b; unsigned short rg[16];
#define G3_LOAD(UNIT) do { const int bh_ = (UNIT) >> 6, n_ = (UNIT) & 63, h_ = bh_ & 3, tok_ = (bh_ >> 2) * SEQ + n_ * 64; \
        rq = gla_ld64(proj, tok_, PQ + h_ * 64, tid); rk = gla_ld64(proj, tok_, PK + h_ * 64, tid); rlr = gla_ld_lr(proj, tok_, tid); \
        rv0 = gla_ld128(proj, tok_, PV + h_ * 128, tid); rv1 = gla_ld128(proj, tok_, PV + h_ * 128, tid + 512); \
        { const GAS bf16* S0_ = GS + (size_t)((UNIT) * 2) * 8192; rs0a = *(const GAS v4u*)(S0_ + tid * 8); rs0b = *(const GAS v4u*)(S0_ + 4096 + tid * 8); rs1a = *(const GAS v4u*)(S0_ + 8192 + tid * 8); rs1b = *(const GAS v4u*)(S0_ + 12288 + tid * 8); } \
        _Pragma("unroll") for (int j_ = 0; j_ < 4; ++j_) _Pragma("unroll") for (int ct_ = 0; ct_ < 4; ++ct_) rg[j_ * 4 + ct_] = gproj[(size_t)(tok_ + 16 * wr + 4 * q + j_) * NPROJ + PG + h_ * 128 + 64 * wc + 16 * ct_ + r]; } while (0)
    G3_LOAD(unit);
    for (;;) { const int bh = unit >> 6, n = unit & 63, bb = bh >> 2, h = bh & 3, tok0 = bb * SEQ + n * 64;
        gla_st64(qraw, rq, tid); gla_st64(kraw, rk, tid); gla_st_lr(lrraw, rlr, tid); gla_st_vT(vT, rv0, tid); gla_st_vT(vT, rv1, tid + 512);
        if (h != hcur) { gla_stage_gkw(gkw, h, gwl, tid); hcur = h; }
        const v4u s0a = rs0a, s0b = rs0b, s1a = rs1a, s1b = rs1b; unsigned short gcur[16];
#pragma unroll
        for (int e = 0; e < 16; ++e) gcur[e] = rg[e];
        __syncthreads();
        const int nunit = unit + G; const bool more = nunit < 2048;
        if (more) G3_LOAD(nunit);
        f32x4 acc[4];
#pragma unroll
        for (int ct = 0; ct < 4; ++ct) acc[ct] = (f32x4){0.f, 0.f, 0.f, 0.f};
        for (int dir = 0; dir < 2; ++dir) {
            gla_cumsum_lds(lrraw, gwl, gkb, h, dir, bL, tot, tid);
            { const int i = tid >> 3, kg = (tid & 7) * 8;
              const v4u qv = *(const LAS v4u*)(qraw + i * RP + kg), kv = *(const LAS v4u*)(kraw + i * RP + kg);
              const f32x4 b0 = *(const LAS f32x4*)(bL + i * 64 + kg), b1 = *(const LAS f32x4*)(bL + i * 64 + kg + 4), r0 = *(const LAS f32x4*)(bL + 32 * 64 + kg), r1 = *(const LAS f32x4*)(bL + 32 * 64 + kg + 4);
              const unsigned qw[4] = {qv.x, qv.y, qv.z, qv.w}, kw[4] = {kv.x, kv.y, kv.z, kv.w}; unsigned oqd[4], okd[4], oqb[4];
#pragma unroll
              for (int e2 = 0; e2 < 4; ++e2) { const float bva = e2 < 2 ? b0[2 * e2] : b1[2 * e2 - 4], bvb = e2 < 2 ? b0[2 * e2 + 1] : b1[2 * e2 - 3], bra = e2 < 2 ? r0[2 * e2] : r1[2 * e2 - 4], brb = e2 < 2 ? r0[2 * e2 + 1] : r1[2 * e2 - 3];
                  const float qa = bflo(qw[e2]), qbv = bfhi(qw[e2]), ka = bflo(kw[e2]), kb = bfhi(kw[e2]);
                  oqd[e2] = pk2(qa * __expf(bva - bra), qbv * __expf(bvb - brb)); okd[e2] = pk2(ka * __expf(bra - bva), kb * __expf(brb - bvb)); oqb[e2] = pk2(qa * __expf(bva), qbv * __expf(bvb)); }
              *(LAS v4u*)(qd + i * GP + kg) = (v4u){oqd[0], oqd[1], oqd[2], oqd[3]}; *(LAS v4u*)(kd + i * GP + kg) = (v4u){okd[0], okd[1], okd[2], okd[3]}; *(LAS v4u*)(qb + i * GP + kg) = (v4u){oqb[0], oqb[1], oqb[2], oqb[3]};
              *(LAS v4u*)(ST + (tid >> 3) * GP + (tid & 7) * 8) = dir ? s1a : s0a; *(LAS v4u*)(ST + (64 + (tid >> 3)) * GP + (tid & 7) * 8) = dir ? s1b : s0b; }
            __syncthreads();
#pragma unroll
            for (int e = 0; e < 2; ++e) { const int jt = wc * 2 + e; f32x4 s = (f32x4){0.f, 0.f, 0.f, 0.f};
                s = mma16(qd + 16 * wr * GP, kd + 16 * jt * GP, 64, lane, s);
#pragma unroll
                for (int j = 0; j < 4; ++j) { const int i = 16 * wr + 4 * q + j, jj = 16 * jt + r; const bool keep = dir == 0 ? (jj <= i) : (jj > i);
                    Pm[i * GP + jj] = (bf16)f2bf(keep ? s[j] : 0.f); } }
            __syncthreads();
#pragma unroll
            for (int ct = 0; ct < 4; ++ct) { const int v0 = 64 * wc + 16 * ct;
                acc[ct] = mma16(Pm + 16 * wr * GP, vT + v0 * GP, 64, lane, acc[ct]);
                acc[ct] = mma16(qb + 16 * wr * GP, ST + v0 * GP, 64, lane, acc[ct]); }
            __syncthreads();
        }
        float ss[4];
#pragma unroll
        for (int j = 0; j < 4; ++j) { float a = 0.f;
#pragma unroll
            for (int ct = 0; ct < 4; ++ct) a += acc[ct][j] * acc[ct][j];
            a += __shfl_xor(a, 1); a += __shfl_xor(a, 2); a += __shfl_xor(a, 4); a += __shfl_xor(a, 8); ss[j] = a; }
        if (r == 0) {
#pragma unroll
            for (int j = 0; j < 4; ++j) rs[(16 * wr + 4 * q + j) * 2 + wc] = ss[j]; }
        __syncthreads();
#pragma unroll
        for (int j = 0; j < 4; ++j) { const int i = 16 * wr + 4 * q + j; const float rstd = rsqrtf((rs[i * 2] + rs[i * 2 + 1]) * (1.f / 128.f) + EPS);
#pragma unroll
            for (int ct = 0; ct < 4; ++ct) { const int v = 64 * wc + 16 * ct + r; const float gate = bf2f(gcur[j * 4 + ct]);
                mix[(size_t)(tok0 + i) * DM + h * 128 + v] = (bf16)f2bf(acc[ct][j] * rstd * gnorm[v] * pg8::silu_f(gate)); } }
        __syncthreads();
        if (!more) break; unit = nunit;
    }
#undef G3_LOAD
}

__device__ __forceinline__ void gla_g2(const bf16* GU_, const float* GD_, bf16* GS_, int tid, int bid, int G) {
    typedef float f32x2 __attribute__((ext_vector_type(2)));
    const GAS unsigned* GU = (const GAS unsigned*)GU_; const GAS float* GD = (const GAS float*)GD_; GAS unsigned* GS = (GAS unsigned*)GS_;
    for (int it = bid * NTHR + tid; it < 32 * 2 * 4096; it += G * NTHR) { const int e2 = it & 4095, dir = (it >> 12) & 1, bh = it >> 13, k = (2 * e2) & 63;
        float S0 = 0.f, S1 = 0.f;
#pragma unroll 1
        for (int nb = 0; nb < 64; nb += 16) { unsigned u[16]; f32x2 d[16];
#pragma unroll
            for (int j = 0; j < 16; ++j) { const int nv = nb + j, n = dir ? 63 - nv : nv; const size_t ud = (size_t)((bh * 64 + n) * 2 + dir);
                u[j] = GU[ud * 4096 + e2]; d[j] = *(const GAS f32x2*)(GD + ud * 64 + k); }
            asm volatile("" ::: "memory");
#pragma unroll
            for (int j = 0; j < 16; ++j) { const int nv = nb + j, n = dir ? 63 - nv : nv; const size_t ud = (size_t)((bh * 64 + n) * 2 + dir);
                GS[ud * 4096 + e2] = pk2(S0, S1); S0 = S0 * d[j].x + bflo(u[j]); S1 = S1 * d[j].y + bfhi(u[j]); } }
    }
}
__device__ __forceinline__ float sconv3(const bf16* proj, int b, int t, int col, const float* w, int wld, int wc) {
    const bf16* p = proj + (size_t)(b * SEQ + t) * NPROJ + col;
    float a = w[wld + wc] * bf2f(p[0]);
    if (t > 0) a += w[wc] * bf2f(p[-NPROJ]);
    if (t < SEQ - 1) a += w[2 * wld + wc] * bf2f(p[NPROJ]);
    return a;
}


typedef float f32x16 __attribute__((ext_vector_type(16)));
typedef short hbf16x8 __attribute__((ext_vector_type(8)));
constexpr int HY_PITCH = 4360, HY_ZOFF = 96;
constexpr int HY_ZBYTES = 8 * HY_PITCH * 2;
constexpr int HY_HRN = 8200;
constexpr int HY_LDS_BYTES = HY_ZBYTES + 2 * HY_HRN * 2;

__device__ __forceinline__ hbf16x8 hy_afrag(LAS const unsigned char* hrb, int m0) {
    const int p = m0 + 4096, odd = p & 1;
    const LAS unsigned* src = (const LAS unsigned*)(hrb + odd * (HY_HRN * 2) + (p + odd) * 2);
    v4u w; w.x = src[0]; w.y = src[1]; w.z = src[2]; w.w = src[3];
    return __builtin_bit_cast(hbf16x8, w);
}
__device__ __forceinline__ void hy_fill_hr(const float* filtT_, int order, int c, LAS unsigned char* hrb, int tid) {
    const GAS float* filtT = (const GAS float*)filtT_;
    const GAS float* hf = filtT + (size_t)(order * 1024 + c) * SEQ; const GAS float* hb = filtT + (size_t)(order * 1024 + 512 + c) * SEQ;
    LAS bf16* c0 = (LAS bf16*)hrb; LAS bf16* c1 = c0 + HY_HRN;
    asm volatile("" : "+v"(tid));
    float v[16];
#pragma unroll
    for (int k = 0; k < 16; ++k) { const int m = tid + 512 * k - 4096, am = m < 0 ? -m : m; v[k] = (m <= 0 ? hf : hb)[am > 4095 ? 4095 : am]; }
#pragma unroll
    for (int k = 0; k < 16; ++k) { const int q = tid + 512 * k; const float v0 = q == 0 ? 0.f : v[k]; c0[q] = (bf16)f2bf(v0); c1[q + 1] = (bf16)f2bf(v0); }
    if (tid < 8) { c0[8192 + tid] = 0; if (tid < 7) c1[8193 + tid] = 0; }
    if (tid == 0) c1[0] = 0;
}
__device__ __forceinline__ void hy_conv(LAS const unsigned char* zbb, LAS const unsigned char* hrb, int w, int lane, f32x4 (&acc)[8][2]) {
    const int n = lane & 15, b = n >> 1, il = n & 1, kq = lane >> 4, i = n;
#pragma unroll
    for (int p = 0; p < 8; ++p)
#pragma unroll
        for (int hh = 0; hh < 2; ++hh) acc[p][hh] = (f32x4){0.f, 0.f, 0.f, 0.f};
    const LAS unsigned char* zl = zbb + (b * HY_PITCH + HY_ZOFF + 32 * il + 8 * kq) * 2 - 64;
    const int mb = -32 * (16 * w + 1) - i + 8 * kq;
    hbf16x8 A[16][2];
#pragma unroll
    for (int d = 0; d <= 14; ++d) { A[(1 + d) & 15][0] = hy_afrag(hrb, mb - 32 * d); A[(1 + d) & 15][1] = hy_afrag(hrb, mb - 32 * d - 16); }
    hbf16x8 b0 = *(const LAS hbf16x8*)zl;
#pragma unroll 1
    for (int c = 0; c < 9; ++c) {
#pragma unroll
        for (int u = 0; u < 16; ++u) { const int s = 16 * c + u;
            if (s <= 128) {
                hbf16x8 nb0 = b0;
                if (s < 128) {
                    A[(16 - u) & 15][0] = hy_afrag(hrb, mb + 32 * (s + 1)); A[(16 - u) & 15][1] = hy_afrag(hrb, mb + 32 * (s + 1) - 16);
                    nb0 = *(const LAS hbf16x8*)(zl + (s + 1) * 64); }
#pragma unroll
                for (int hh = 0; hh < 2; ++hh)
#pragma unroll
                    for (int p = 0; p < 8; ++p) acc[p][hh] = __builtin_amdgcn_mfma_f32_16x16x32_bf16(A[(17 - u + 2 * p) & 15][hh], b0, acc[p][hh], 0, 0, 0);
                b0 = nb0; } }
    }
}
__device__ __forceinline__ v2u hy_conv4_fin(v2u v, bf16 l, bf16 r, int t0, float w0, float w1, float w2) {
    const float xl = t0 > 0 ? bf2f(l) : 0.f, xr = t0 < SEQ - 4 ? bf2f(r) : 0.f;
    const float x0 = bflo(v.x), x1 = bfhi(v.x), x2 = bflo(v.y), x3 = bfhi(v.y);
    v2u o; o.x = pk2(w0 * xl + w1 * x0 + w2 * x1, w0 * x0 + w1 * x1 + w2 * x2); o.y = pk2(w0 * x1 + w1 * x2 + w2 * x3, w0 * x2 + w1 * x3 + w2 * xr); return o;
}
__device__ __forceinline__ void hy_toeplitz_phase(const bf16* uT, const float* cw_, const float* filtT, const float* skip_, bf16* yT, LAS unsigned char* lds, int tid, int lane, int wave, int bid, int G) {
    const GAS float* skip = (const GAS float*)skip_; const GAS float* cw = (const GAS float*)cw_; const GAS bf16* ur = (const GAS bf16*)uT;
    LAS unsigned char* zbb = lds; LAS unsigned char* hrb = lds + HY_ZBYTES;
    for (int i = tid; i < HY_ZBYTES / 4; i += NTHR) ((LAS unsigned*)zbb)[i] = 0u;
    __syncthreads();
    const int w = wave;
    for (int c = bid; c < 512; c += G) {
        { const float w0 = cw[c], w1 = cw[1536 + c], w2 = cw[3072 + c];
#pragma unroll 8
          for (int bb = 0; bb < 8; ++bb) { const int q = tid; const GAS bf16* src = ur + (size_t)c * MTOK + bb * SEQ + q * 8;
              const v4u v = *(const GAS v4u*)src; const float xlr = bf2f(src[q > 0 ? -1 : 0]), xrr = bf2f(src[q < 511 ? 8 : 7]); const float xl = q > 0 ? xlr : 0.f, xr = q < 511 ? xrr : 0.f;
              const float x[10] = {xl, bflo(v.x), bfhi(v.x), bflo(v.y), bfhi(v.y), bflo(v.z), bfhi(v.z), bflo(v.w), bfhi(v.w), xr};
              v4u o; o.x = pk2(w0 * x[0] + w1 * x[1] + w2 * x[2], w0 * x[1] + w1 * x[2] + w2 * x[3]); o.y = pk2(w0 * x[2] + w1 * x[3] + w2 * x[4], w0 * x[3] + w1 * x[4] + w2 * x[5]);
              o.z = pk2(w0 * x[4] + w1 * x[5] + w2 * x[6], w0 * x[5] + w1 * x[6] + w2 * x[7]); o.w = pk2(w0 * x[6] + w1 * x[7] + w2 * x[8], w0 * x[7] + w1 * x[8] + w2 * x[9]);
              *(LAS v4u*)(zbb + (bb * HY_PITCH + HY_ZOFF + q * 8) * 2) = o; } }
        hy_fill_hr(filtT, 0, c, hrb, tid);
        __syncthreads();
        f32x4 acc[8][2];
        hy_conv(zbb, hrb, w, lane, acc);
        { unsigned zp[8][2][2];
        int ln = lane; asm volatile("" : "+v"(ln)); const int n = ln & 15, b = n >> 1, il = n & 1, kq = ln >> 4;
        { const float sk = skip[c]; const float a0 = cw[512 + c], a1 = cw[1536 + 512 + c], a2 = cw[3072 + 512 + c];
          const int tb = 32 * (16 * w + il) + 4 * kq; const GAS bf16* xb0 = ur + (size_t)(512 + c) * MTOK + b * SEQ + tb;
#pragma unroll
          for (int gh = 0; gh < 2; ++gh) { v2u rv[8]; bf16 rl[8], rr[8];
#pragma unroll
            for (int k = 0; k < 8; ++k) { const int off = 64 * (4 * gh + (k >> 1)) + 16 * (k & 1); rv[k] = *(const GAS v2u*)(xb0 + off); rl[k] = xb0[off - 1]; rr[k] = xb0[off + 4]; }
            asm volatile("" ::: "memory");
#pragma unroll
            for (int k = 0; k < 8; ++k) { const int g = 4 * gh + (k >> 1), rq = k & 1, t0 = tb + 64 * g + 16 * rq;
                const v2u xv = hy_conv4_fin(rv[k], rl[k], rr[k], t0, a0, a1, a2);
                const v2u vv = *(const LAS v2u*)(zbb + (b * HY_PITCH + HY_ZOFF + t0) * 2);
                const float z0 = bflo(xv.x) * (acc[g][rq][0] + bflo(vv.x) * sk), z1 = bfhi(xv.x) * (acc[g][rq][1] + bfhi(vv.x) * sk);
                const float z2 = bflo(xv.y) * (acc[g][rq][2] + bflo(vv.y) * sk), z3 = bfhi(xv.y) * (acc[g][rq][3] + bfhi(vv.y) * sk);
                zp[g][rq][0] = pk2(z0, z1); zp[g][rq][1] = pk2(z2, z3); } } }
        __syncthreads();
#pragma unroll
        for (int g = 0; g < 8; ++g)
#pragma unroll
            for (int rq = 0; rq < 2; ++rq) { const int t0 = 32 * (16 * w + 2 * g + il) + 16 * rq + 4 * kq;
                *(LAS v2u*)(zbb + (b * HY_PITCH + HY_ZOFF + t0) * 2) = (v2u){zp[g][rq][0], zp[g][rq][1]}; } }
        hy_fill_hr(filtT, 1, c, hrb, tid);
        __syncthreads();
        hy_conv(zbb, hrb, w, lane, acc);
        { int ln = lane; asm volatile("" : "+v"(ln)); const int n = ln & 15, b = n >> 1, il = n & 1, kq = ln >> 4; const float sk = skip[512 + c]; const float a0 = cw[1024 + c], a1 = cw[1536 + 1024 + c], a2 = cw[3072 + 1024 + c];
          const int tb = 32 * (16 * w + il) + 4 * kq; const GAS bf16* xb0 = ur + (size_t)(1024 + c) * MTOK + b * SEQ + tb;
#pragma unroll
          for (int gh = 0; gh < 2; ++gh) { v2u rv[8]; bf16 rl[8], rr[8];
#pragma unroll
            for (int k = 0; k < 8; ++k) { const int off = 64 * (4 * gh + (k >> 1)) + 16 * (k & 1); rv[k] = *(const GAS v2u*)(xb0 + off); rl[k] = xb0[off - 1]; rr[k] = xb0[off + 4]; }
            asm volatile("" ::: "memory");
#pragma unroll
            for (int k = 0; k < 8; ++k) { const int g = 4 * gh + (k >> 1), rq = k & 1, t0 = tb + 64 * g + 16 * rq;
                const v2u xv = hy_conv4_fin(rv[k], rl[k], rr[k], t0, a0, a1, a2);
                const v2u zv = *(const LAS v2u*)(zbb + (b * HY_PITCH + HY_ZOFF + t0) * 2);
                const float z0 = bflo(zv.x), z1 = bfhi(zv.x), z2 = bflo(zv.y), z3 = bfhi(zv.y);
                const float o0 = bflo(xv.x) * (acc[g][rq][0] + z0 * sk), o1 = bfhi(xv.x) * (acc[g][rq][1] + z1 * sk);
                const float o2 = bflo(xv.y) * (acc[g][rq][2] + z2 * sk), o3 = bfhi(xv.y) * (acc[g][rq][3] + z3 * sk);
                *(GAS v2u*)(yT + (size_t)c * MTOK + b * SEQ + t0) = (v2u){pk2(o0, o1), pk2(o2, o3)}; } } }
        __syncthreads();
    }
}
__device__ __forceinline__ void hy_transpose_out(const bf16* yT, const float* gC, bf16* mix, LAS unsigned char* lds, int tid, int lane, int wave, int bid, int G) {
    constexpr int TP = 66;
    LAS bf16* T = (LAS bf16*)lds;
    for (int tile = bid; tile < MTOK / 64; tile += G) { const int tok0 = tile * 64;
#pragma unroll
        for (int pass = 0; pass < 8; ++pass) { const int c = (tid >> 3) + 64 * pass, sg = tid & 7;
            const v4u v = *(const GAS v4u*)(yT + (size_t)c * MTOK + tok0 + 8 * sg);
            LAS unsigned* d = (LAS unsigned*)(T + c * TP + 8 * sg); d[0] = v.x; d[1] = v.y; d[2] = v.z; d[3] = v.w; }
        __syncthreads();
#pragma unroll 1
        for (int k = 0; k < 8; ++k) { const int s = wave * 8 + k; float y[8]; float ss = 0.f;
#pragma unroll
            for (int e = 0; e < 8; ++e) { y[e] = bf2f(T[(lane * 8 + e) * TP + s]); ss += y[e] * y[e]; }
            const float rstd = rsqrtf(wave_sum(ss) * (1.f / 512.f) + EPS);
            const f32x4 g0 = *(const GAS f32x4*)(gC + lane * 8), g1 = *(const GAS f32x4*)(gC + lane * 8 + 4);
            v4u o; o.x = pk2(y[0] * rstd * g0.x, y[1] * rstd * g0.y); o.y = pk2(y[2] * rstd * g0.z, y[3] * rstd * g0.w);
            o.z = pk2(y[4] * rstd * g1.x, y[5] * rstd * g1.y); o.w = pk2(y[6] * rstd * g1.z, y[7] * rstd * g1.w);
            *(GAS v4u*)(mix + (size_t)(tok0 + s) * DM + 1024 + lane * 8) = o; }
        __syncthreads();
    }
}

__device__ __forceinline__ void phase_c_misc(const Params& P, unsigned char* ws, float* xres, int l, LAS unsigned char* lds, int tid, int lane, int wave, int bid, int G) {
    const bf16* proj = (const bf16*)(ws + WS_PROJ); bf16* mix = (bf16*)(ws + WS_MIX);
    { const bf16* FU2 = (const bf16*)(ws + WS_FU2); bf16* FE = (bf16*)(ws + WS_FE); bf16* FO = (bf16*)(ws + WS_FO); float* Y2K = (float*)(ws + WS_Y2K);
      const int gw = bid * NWAVES + wave, NGW = G * NWAVES;
      for (int col = gw; col < 4096; col += NGW) { const bf16* ur = FU2 + (size_t)col * 8192; const bf16* ui = ur + 4096; float alt = 0.f;
#pragma unroll
          for (int j = 0; j < 4; ++j) { const int t0 = 8 * (lane + 64 * j);
              const v4u a = *(const GAS v4u*)(ur + t0), c = *(const GAS v4u*)(ui + t0);
              const v4u ma = *(const GAS v4u*)(ur + 4096 - t0 - 8), mc = *(const GAS v4u*)(ui + 4096 - t0 - 8);
              const float m0rr = bf2f(ur[t0 ? 4096 - t0 : 0]), m0ir = bf2f(ui[t0 ? 4096 - t0 : 0]); const float m0r = t0 ? m0rr : 0.f, m0i = t0 ? m0ir : 0.f;
              float er[8], oi[8];
              const unsigned aw[4] = {a.x, a.y, a.z, a.w}, cw[4] = {c.x, c.y, c.z, c.w}, maw[4] = {ma.x, ma.y, ma.z, ma.w}, mcw[4] = {mc.x, mc.y, mc.z, mc.w};
#pragma unroll
              for (int e = 0; e < 8; ++e) { const float xr = (e & 1) ? bfhi(aw[e >> 1]) : bflo(aw[e >> 1]), xi = (e & 1) ? bfhi(cw[e >> 1]) : bflo(cw[e >> 1]);
                  float mr, mi; if (e == 0) { mr = m0r; mi = m0i; } else { const int q = 8 - e; mr = (q & 1) ? bfhi(maw[q >> 1]) : bflo(maw[q >> 1]); mi = (q & 1) ? bfhi(mcw[q >> 1]) : bflo(mcw[q >> 1]); }
                  er[e] = xr + mr; oi[e] = (t0 + e) ? xi - mi : 0.f; alt += (e & 1) ? -er[e] : er[e]; }
              v4u oe, oo; oe.x = pk2(er[0], er[1]); oe.y = pk2(er[2], er[3]); oe.z = pk2(er[4], er[5]); oe.w = pk2(er[6], er[7]);
              oo.x = pk2(oi[0], oi[1]); oo.y = pk2(oi[2], oi[3]); oo.z = pk2(oi[4], oi[5]); oo.w = pk2(oi[6], oi[7]);
              *(GAS v4u*)(FE + (size_t)col * FK1 + t0) = oe; *(GAS v4u*)(FO + (size_t)col * 2048 + t0) = oo; }
          const float e2k = bf2f(ur[2048]);
          if (lane < 16) { v4u z = (v4u){0u, 0u, 0u, 0u}; if (lane == 0) z.x = f2bf(e2k); *(GAS v4u*)(FE + (size_t)col * FK1 + 2048 + 8 * lane) = z; }
          alt = wave_sum(alt) + e2k;
          if (lane == 0) Y2K[col] = alt * 0.001381067932f; } }
    { const float* cw = pin(P, 16) + (size_t)l * 3 * 512; const float* gD = pin(P, 17) + (size_t)(l * 3 + 2) * 512;
      const int gw = bid * NWAVES + wave, NGW = G * NWAVES, c0 = lane * 8;
      float w0[8], w1[8], w2[8], gd[8];
#pragma unroll
      for (int e = 0; e < 8; ++e) { w0[e] = cw[c0 + e]; w1[e] = cw[512 + c0 + e]; w2[e] = cw[1024 + c0 + e]; gd[e] = gD[c0 + e]; }
      for (int tk0 = gw; tk0 < MTOK; tk0 += 2 * NGW) {
          v4u vb[2], vc[2], vh[2], vcm[2], vhm[2], vcp[2], vhp[2];
#pragma unroll
          for (int h = 0; h < 2; ++h) { const int tk = tk0 + h * NGW, token = tk < MTOK ? tk : MTOK - 1, t = token & (SEQ - 1);
              const bf16* p = proj + (size_t)token * NPROJ + PUS + c0; const int om = t > 0 ? -NPROJ : 0, op = t < SEQ - 1 ? NPROJ : 0;
              vb[h] = *(const GAS v4u*)p; vc[h] = *(const GAS v4u*)(p + 512); vh[h] = *(const GAS v4u*)(p + 1024);
              vcm[h] = *(const GAS v4u*)(p + 512 + om); vhm[h] = *(const GAS v4u*)(p + 1024 + om); vcp[h] = *(const GAS v4u*)(p + 512 + op); vhp[h] = *(const GAS v4u*)(p + 1024 + op); }
#pragma unroll
          for (int h = 0; h < 2; ++h) { const int token = tk0 + h * NGW, t = token & (SEQ - 1); const float km = t > 0 ? 1.f : 0.f, kp = t < SEQ - 1 ? 1.f : 0.f;
              float y[8]; float ss = 0.f;
#pragma unroll
              for (int e2 = 0; e2 < 4; ++e2) {
                  const float a0 = km * w0[2 * e2] * bflo(vcm[h][e2]) * bflo(vhm[h][e2]) + w1[2 * e2] * bflo(vc[h][e2]) * bflo(vh[h][e2]) + kp * w2[2 * e2] * bflo(vcp[h][e2]) * bflo(vhp[h][e2]);
                  const float a1 = km * w0[2 * e2 + 1] * bfhi(vcm[h][e2]) * bfhi(vhm[h][e2]) + w1[2 * e2 + 1] * bfhi(vc[h][e2]) * bfhi(vh[h][e2]) + kp * w2[2 * e2 + 1] * bfhi(vcp[h][e2]) * bfhi(vhp[h][e2]);
                  y[2 * e2] = bflo(vb[h][e2]) * a0; y[2 * e2 + 1] = bfhi(vb[h][e2]) * a1; ss += y[2 * e2] * y[2 * e2] + y[2 * e2 + 1] * y[2 * e2 + 1]; }
              const float rstd = rsqrtf(wave_sum(ss) * (1.f / 512.f) + EPS);
              v4u o; o.x = pk2(y[0] * rstd * gd[0], y[1] * rstd * gd[1]); o.y = pk2(y[2] * rstd * gd[2], y[3] * rstd * gd[3]); o.z = pk2(y[4] * rstd * gd[4], y[5] * rstd * gd[5]); o.w = pk2(y[6] * rstd * gd[6], y[7] * rstd * gd[7]);
              if (token < MTOK) *(GAS v4u*)(mix + (size_t)token * DM + 1536 + c0) = o; } } }
    __syncthreads();
    gla_g1(proj, pin(P, 4) + (size_t)l * 2 * 16 * 256, pin(P, 5) + (size_t)l * 512, (bf16*)(ws + WS_GU), (float*)(ws + WS_GD), lds, tid, lane, wave, bid, G);
}

__device__ __forceinline__ void phase_d(const Params& P, unsigned char* ws, float* xres, int l, LAS unsigned char* lds, int tid, int lane, int wave, int bid, int G) {
    if (!(P.pad1 & 2)) gla_g3((const bf16*)(ws + WS_PROJ), pin(P, 4) + (size_t)l * 2 * 16 * 256, pin(P, 5) + (size_t)l * 512, pin(P, 6) + (size_t)l * 128, (const bf16*)(ws + WS_GS), (bf16*)(ws + WS_MIX), lds, tid, lane, wave, bid, G);
}
__device__ __forceinline__ void phase_e(const Params& P, unsigned char* ws, float* xres, int l, LAS unsigned char* lds, int tid, int lane, int wave, int bid, int G) {
    hy_transpose_out((const bf16*)(ws + WS_YT), pin(P, 17) + (size_t)(l * 3 + 1) * 512, (bf16*)(ws + WS_MIX), lds, tid, lane, wave, bid, G);
    { const bf16* FY = (const bf16*)(ws + WS_FY); const float* gB = pin(P, 17) + (size_t)(l * 3 + 0) * 512; bf16* mix = (bf16*)(ws + WS_MIX);
      const int gw = bid * NWAVES + wave, NGW = G * NWAVES;
      const f32x4 g0 = *(const GAS f32x4*)(gB + lane * 8), g1 = *(const GAS f32x4*)(gB + lane * 8 + 4);
      const float* Y2K = (const float*)(ws + WS_Y2K);
      for (int it0 = gw; it0 < MTOK; it0 += 2 * NGW) {
          v4u ya[2], yb[2];
#pragma unroll
          for (int h = 0; h < 2; ++h) { const int i2 = it0 + h * NGW, it = i2 < MTOK ? i2 : MTOK - 1, b = it >> 12, sp = it & (SEQ - 1);
              const int sf = sp < 2048 ? sp : 4096 - sp, sfc = sf > 2047 ? 2047 : sf;
              const bf16* src = FY + (size_t)sfc * 4096 + b * 512 + lane * 8; const bf16* srb = src + (size_t)2048 * 4096;
              ya[h] = *(const GAS v4u*)src; yb[h] = *(const GAS v4u*)srb; }
#pragma unroll
          for (int h = 0; h < 2; ++h) { const int it = it0 + h * NGW, b = it >> 12, sp = it & (SEQ - 1); const float sg = sp < 2048 ? 1.f : -1.f;
              f32x4 a = (f32x4){bflo(ya[h].x), bfhi(ya[h].x), bflo(ya[h].y), bfhi(ya[h].y)} + (f32x4){bflo(yb[h].x), bfhi(yb[h].x), bflo(yb[h].y), bfhi(yb[h].y)} * sg;
              f32x4 c = (f32x4){bflo(ya[h].z), bfhi(ya[h].z), bflo(ya[h].w), bfhi(ya[h].w)} + (f32x4){bflo(yb[h].z), bfhi(yb[h].z), bflo(yb[h].w), bfhi(yb[h].w)} * sg;
              if (sp == 2048) { a = *(const GAS f32x4*)(Y2K + (b & 7) * 512 + lane * 8); c = *(const GAS f32x4*)(Y2K + (b & 7) * 512 + lane * 8 + 4); }
              const float ss = (a.x * a.x + a.y * a.y) + (a.z * a.z + a.w * a.w) + (c.x * c.x + c.y * c.y) + (c.z * c.z + c.w * c.w);
              const float rstd = rsqrtf(wave_sum(ss) * (1.f / 512.f) + EPS);
              v4u o; o.x = pk2(a.x * rstd * g0.x, a.y * rstd * g0.y); o.y = pk2(a.z * rstd * g0.z, a.w * rstd * g0.w); o.z = pk2(c.x * rstd * g1.x, c.y * rstd * g1.y); o.w = pk2(c.z * rstd * g1.z, c.w * rstd * g1.w);
              if (it < MTOK) *(GAS v4u*)(mix + (size_t)it * DM + 512 + lane * 8) = o; } } }
}
__device__ __forceinline__ void phase_softmax(const float* sc, bf16* Pm, int lane, int wave, int bid, int G) {
    const int gw = bid * NWAVES + wave, NGW = G * NWAVES;
    for (int it = gw; it < MTOK * 4; it += NGW) {
        const f32x4 v = *((const GAS f32x4*)(sc + (size_t)it * 256) + lane);
        const float m = wave_max(fmaxf(fmaxf(v.x, v.y), fmaxf(v.z, v.w)));
        const float e0 = __expf(v.x - m), e1 = __expf(v.y - m), e2 = __expf(v.z - m), e3 = __expf(v.w - m);
        const float inv = 1.0f / wave_sum((e0 + e1) + (e2 + e3));
        v2u w; w.x = pk2(e0 * inv, e1 * inv); w.y = pk2(e2 * inv, e3 * inv);
        *((GAS v2u*)(Pm + (size_t)it * 256) + lane) = w;
    }
}

#ifndef EPIRES_XB
#define EPIRES_XB (GAS bf16*)xb
#endif
#ifndef GEMM_ALIGN
#define GEMM_ALIGN false
#endif
#ifndef GEMM_SP2
#define GEMM_SP2 true
#endif
constexpr int NPH = 11, NSTEPS = NL * NPH + 1;
template <class Sched, bool COLS = false> __device__ __forceinline__ pg8::RstdTab build_rstd(const Sched& S, const float* RS, LAS float* tab, int tid) {
    pg8::RstdTab T; T.tab = tab; T.RS = (const GAS float*)RS; T.pm0 = T.pm1 = T.pm2 = T.pm3 = -1; int n = 0; pg8::Unit u;
    for (int i = 0; S.next(i, u); ++i) { const int pm = COLS ? u.pn : u.pm;
        if (pm != T.pm0 && pm != T.pm1 && pm != T.pm2 && pm != T.pm3) { if (n == 0) T.pm0 = pm; else if (n == 1) T.pm1 = pm; else if (n == 2) T.pm2 = pm; else if (n == 3) T.pm3 = pm; ++n; } }
    const int row = tid >> 1, half = tid & 1;
#pragma unroll
    for (int sl = 0; sl < 4; ++sl) { const int pm = sl == 0 ? T.pm0 : sl == 1 ? T.pm1 : sl == 2 ? T.pm2 : T.pm3;
        if (pm >= 0) { const GAS float* p = (const GAS float*)RS + (size_t)(pm * 256 + row) * 32 + half * 16;
            const f32x4 a = *(const GAS f32x4*)p, b = *(const GAS f32x4*)(p + 4), c = *(const GAS f32x4*)(p + 8), d = *(const GAS f32x4*)(p + 12);
            float t = (((a.x + a.y) + (a.z + a.w)) + ((b.x + b.y) + (b.z + b.w))) + (((c.x + c.y) + (c.z + c.w)) + ((d.x + d.y) + (d.z + d.w)));
            t += __shfl_xor(t, 1);
            if (half == 0) tab[sl * 256 + row] = rsqrtf(t * (1.0f / DM) + EPS); } }
    __syncthreads();
    return T;
}
#define IN(st) (lo <= (st) && (st) < hi)
#define SEAM(stp_) do { if ((stp_) + 1 < hi) { XcdBarrier b2_; b2_.bar = opaque_p(bar.bar); b2_.x = (unsigned)opaque_i((int)bar.x); b2_.st = bar.st; xcd_barrier(b2_, tid); } } while (0)
#define OPAQ() int tid = wave0 * 64 + (int)__builtin_amdgcn_mbcnt_hi(~0u, __builtin_amdgcn_mbcnt_lo(~0u, 0u)); asm volatile("" : "+v"(tid)); const int bid = opaque_i(bid0), G = opaque_i(G0); unsigned char* ws = opaque_p(ws0); float* xres = opaque_p(out0); const unsigned ldsa = (unsigned)opaque_i((int)(unsigned)(size_t)lds0)
#define LOCALS() OPAQ(); LAS unsigned char* lds = (LAS unsigned char*)(size_t)ldsa; const int lane = tid & 63, wave = __builtin_amdgcn_readfirstlane(tid >> 6); \
        bf16* xb = (bf16*)(ws + WS_XB); bf16* proj = (bf16*)(ws + WS_PROJ); bf16* mix = (bf16*)(ws + WS_MIX); (void)lds; (void)lane; (void)wave; (void)xb; (void)proj; (void)mix
template <int L> __device__ __forceinline__ void layer_body(const Params& P, const XcdBarrier& bar, int lo, int hi, int wave0, int bid0, int G0, unsigned char* ws0, float* out0, LAS unsigned char* lds0) {
    constexpr int l = L; const int s0 = l * NPH;
        if (s0 + NPH <= lo || s0 >= hi) return;
        if (IN(s0 + 0)) { LOCALS(); phase_a(P, ws, xres, l, lds, tid, lane, wave, bid, G); SEAM(s0 + 0); }
        if (IN(s0 + 1)) { LOCALS();
            { pg8::Gemm g{xb, (const bf16*)(ws + WS_WIN), DM, DM, DM}; pg8::TileOrder S; S.init(MTOK / 256, NPROJ / 256, G, bid, DM, DM);
            pg8::EpiBf16 E{(GAS bf16*)proj, NPROJ, build_rstd(S, (const float*)(ws + WS_RSS), (LAS float*)(lds + LDSCTL_OFF + 1024 + 8192), tid)}; pg8::gemm_phase<pg8::EpiBf16, pg8::TileOrder, GEMM_ALIGN, GEMM_SP2>(lds + RING_OFF, g, S, E, tid);
            }
            { pg8::Gemm g{(const bf16*)(ws + WS_MEMN), (const bf16*)(ws + WS_WKV), DM, DM, DM}; pg8::TileOrder S; S.init(NB * NMEM / 256, 2 * DM / 256, G, (bid + G / 2) % G, DM, DM);
            pg8::EpiBf16 E{(GAS bf16*)(ws + WS_KVB), 2 * DM, pg8::RstdTab{nullptr, nullptr, -1, -1, -1, -1}}; pg8::gemm_phase<pg8::EpiBf16, pg8::TileOrder, GEMM_ALIGN, GEMM_SP2>(lds + RING_OFF, g, S, E, tid); }
            { pg8::Gemm g{(const bf16*)(ws + WS_WIN) + (size_t)WUH * DM, xb, DM, DM, DM}; pg8::TileOrder S; S.init(1536 / 256, MTOK / 256, G, bid, DM, DM);
              pg8::EpiBf16T E{(GAS bf16*)(ws + WS_UT), MTOK, build_rstd<pg8::TileOrder, true>(S, (const float*)(ws + WS_RSS), (LAS float*)(lds + LDSCTL_OFF + 1024 + 8192), tid)};
              pg8::gemm_phase<pg8::EpiBf16T, pg8::TileOrder, GEMM_ALIGN, GEMM_SP2>(lds + RING_OFF, g, S, E, tid); }
            SEAM(s0 + 1); }
        if (IN(s0 + 2)) { LOCALS();
            { pg8::Gemm g{(const bf16*)(ws + WS_KVB), (const bf16*)(ws + WS_WQB), 2 * DM, DM, 512}; pg8::PairOrder<0> S{G, bid};
            pg8::EpiBf16 E{(GAS bf16*)(ws + WS_MT), DM, pg8::RstdTab{nullptr, nullptr, -1, -1, -1, -1}}; pg8::gemm_phase<pg8::EpiBf16, pg8::PairOrder<0>, GEMM_ALIGN, GEMM_SP2>(lds + RING_OFF, g, S, E, tid); }
            { pg8::Gemm g{(const bf16*)(ws + WS_WXO), (const bf16*)(ws + WS_KVB), DM, 2 * DM, 512}; pg8::PairOrder<1> S{G, bid};
            pg8::EpiBf16 E{(GAS bf16*)(ws + WS_VWO), 1024, pg8::RstdTab{nullptr, nullptr, -1, -1, -1, -1}}; pg8::gemm_phase<pg8::EpiBf16, pg8::PairOrder<1>, GEMM_ALIGN, GEMM_SP2>(lds + RING_OFF, g, S, E, tid); }
            { pg8::Gemm g{(const bf16*)(ws + WS_A1), proj, 256, NPROJ, 256}; pg8::FnetAOrder S{G, bid};
            pg8::EpiFnetA E{(GAS bf16*)(ws + WS_FU2)}; pg8::gemm_phase<pg8::EpiFnetA, pg8::FnetAOrder, GEMM_ALIGN, GEMM_SP2>(lds + RING_OFF, g, S, E, tid); }
            SEAM(s0 + 2); }
        if (IN(s0 + 3)) { LOCALS(); phase_c_misc(P, ws, xres, l, lds, tid, lane, wave, bid, G); SEAM(s0 + 3); }
        if (IN(s0 + 4)) { LOCALS();
            { pg8::Gemm g{(const bf16*)(ws + WS_C2), (const bf16*)(ws + WS_FE), FK1, FK1, FK1}; pg8::TileOrder S; S.init(8, 16, G, bid, FK1, FK1);
              pg8::EpiBf16 E{(GAS bf16*)(ws + WS_FY), 4096, pg8::RstdTab{nullptr, nullptr, -1, -1, -1, -1}}; pg8::gemm_phase<pg8::EpiBf16, pg8::TileOrder, GEMM_ALIGN, GEMM_SP2>(lds + RING_OFF, g, S, E, tid); }
            { pg8::Gemm g{(const bf16*)(ws + WS_S2), (const bf16*)(ws + WS_FO), 2048, 2048, 2048}; pg8::TileOrder S; S.init(8, 16, G, (bid + G / 2) % G, 2048, 2048);
              pg8::EpiBf16 E{(GAS bf16*)(ws + WS_FY) + (size_t)2048 * 4096, 4096, pg8::RstdTab{nullptr, nullptr, -1, -1, -1, -1}}; pg8::gemm_phase<pg8::EpiBf16, pg8::TileOrder, GEMM_ALIGN, GEMM_SP2>(lds + RING_OFF, g, S, E, tid); }
            gla_g2((const bf16*)(ws + WS_GU), (const float*)(ws + WS_GD), (bf16*)(ws + WS_GS), tid, bid, G);
            __syncthreads();
            hy_toeplitz_phase((const bf16*)(ws + WS_UT), pin(P, 7) + (size_t)l * 3 * 1536, (const float*)(ws + WS_FILT), pin(P, 15) + (size_t)l * 1024, (bf16*)(ws + WS_YT), lds, tid, lane, wave, bid, G);
            SEAM(s0 + 4); }
        if (IN(s0 + 5)) { LOCALS(); phase_d(P, ws, xres, l, lds, tid, lane, wave, bid, G); __syncthreads(); phase_e(P, ws, xres, l, lds, tid, lane, wave, bid, G); SEAM(s0 + 5); }
        if (IN(s0 + 6)) { LOCALS();
            pg8::Gemm g{mix, (const bf16*)(ws + WS_WOUT), DM, DM, DM}; pg8::TileOrder S; S.init(MTOK / 256, DM / 256, G, bid, DM, DM);
            pg8::EpiRes E{l == 0 ? (const GAS float*)pin(P, 0) : (const GAS float*)nullptr, DM, (GAS bf16*)xb, (GAS float*)(ws + WS_RSS)}; pg8::gemm_phase<pg8::EpiRes, pg8::TileOrder, GEMM_ALIGN, GEMM_SP2>(lds + RING_OFF, g, S, E, tid);
            SEAM(s0 + 6); }
        if (IN(s0 + 7)) { LOCALS();
            pg8::Gemm g{xb, (const bf16*)(ws + WS_MT), DM, DM, DM}; pg8::TileOrder S; S.init(MTOK / 256, 4, G, bid, DM, DM, 16, 4);
            pg8::EpiSoftmax E{(GAS bf16*)mix, 1024, (LAS float*)(lds + LDSCTL_OFF + 1024), (LAS float*)(lds + LDSCTL_OFF + 1024 + 4096), build_rstd(S, (const float*)(ws + WS_RSS), (LAS float*)(lds + LDSCTL_OFF + 1024 + 8192), tid)}; pg8::gemm_phase<pg8::EpiSoftmax, pg8::TileOrder, true, GEMM_SP2>(lds + RING_OFF, g, S, E, tid);
            SEAM(s0 + 7); }
        if (IN(s0 + 8)) { LOCALS();
            pg8::Gemm g{mix, (const bf16*)(ws + WS_VWO), 1024, 1024, 1024}; pg8::TileOrder S; S.init(MTOK / 256, DM / 256, G, bid, 1024, 1024, 16, 8);
            pg8::EpiRes E{(const GAS float*)nullptr, DM, (GAS bf16*)xb, (GAS float*)(ws + WS_RSS)}; pg8::gemm_phase<pg8::EpiRes, pg8::TileOrder, GEMM_ALIGN, GEMM_SP2>(lds + RING_OFF, g, S, E, tid);
            SEAM(s0 + 8); }
        if (IN(s0 + 9)) { LOCALS();
            pg8::Gemm g{xb, (const bf16*)(ws + WS_WGU), DM, DM, DM}; pg8::TileOrder S; S.init(MTOK / 256, 2 * DFF / 256, G, bid, DM, DM);
            pg8::EpiSwiglu E{(GAS bf16*)proj, DFF, build_rstd(S, (const float*)(ws + WS_RSS), (LAS float*)(lds + LDSCTL_OFF + 1024 + 8192), tid)}; pg8::gemm_phase<pg8::EpiSwiglu, pg8::TileOrder, GEMM_ALIGN, GEMM_SP2>(lds + RING_OFF, g, S, E, tid);
            SEAM(s0 + 9); }
        if (IN(s0 + 10)) { LOCALS();
            pg8::Gemm g{proj, (const bf16*)(ws + WS_WD), DFF, DFF, DFF}; pg8::TileOrder S; S.init(MTOK / 256, DM / 256, G, bid, DFF, DFF);
            pg8::EpiRes E{(const GAS float*)nullptr, DM, (GAS bf16*)xb, (GAS float*)(ws + WS_RSS)}; pg8::gemm_phase<pg8::EpiRes, pg8::TileOrder, GEMM_ALIGN, GEMM_SP2>(lds + RING_OFF, g, S, E, tid);
            SEAM(s0 + 10); }
    }
__global__ void __launch_bounds__(NTHR, 2) fwd_kernel(Params P) {
    extern __shared__ __attribute__((aligned(16))) unsigned char lds_raw[];
    LAS unsigned char* lds = (LAS unsigned char*)lds_raw; LAS unsigned char* const lds0 = lds;
    const int tid = threadIdx.x, lane = tid & 63, wave = __builtin_amdgcn_readfirstlane(tid >> 6), bid = blockIdx.x, G = gridDim.x;
    volatile LAS unsigned* MISC = (volatile LAS unsigned*)(lds + MISC_OFF);
    for (int u = tid; u < (LDS_BYTES - LDSCTL_OFF) / 4; u += NTHR) ((LAS unsigned*)(lds + LDSCTL_OFF))[u] = 0u;
    __syncthreads();
    unsigned char* ws = P.ws;
    XcdBarrier bar = xcd_barrier_post((unsigned*)(ws + WS_CTL) + CW_BAR + P.pad0 * XCD_BAR_WORDS, MISC + 8, tid);
    const int lo = P.step_lo, hi = P.step_hi;
    const int wave0 = wave, bid0 = bid, G0 = G; unsigned char* const ws0 = ws; float* const out0 = P.out;
    layer_body<0>(P, bar, lo, hi, wave0, bid0, G0, ws0, out0, lds0);
    layer_body<1>(P, bar, lo, hi, wave0, bid0, G0, ws0, out0, lds0);
    layer_body<2>(P, bar, lo, hi, wave0, bid0, G0, ws0, out0, lds0);
    layer_body<3>(P, bar, lo, hi, wave0, bid0, G0, ws0, out0, lds0);
    if (IN(NL * NPH)) { LOCALS(); const int gw = bid * NWAVES + wave, NGW = G * NWAVES;
        for (int m = gw; m < MTOK; m += NGW) final_norm_row(xb + (size_t)m * DM, xres + (size_t)m * DM, pin(P, 25), lane); }
#undef IN
#undef SEAM
}

#ifndef MK_SPLIT
#define MK_SPLIT 0
#endif
extern "C" void kernel_launch(void* const* d_in, const int* in_sizes, int n_in, void* d_out, int out_size, void* d_ws, size_t ws_size, hipStream_t stream) {
    static int grid = 0;
    if (grid == 0) {
        if (n_in != 26 || in_sizes[0] != MTOK * DM || out_size != MTOK * DM || ws_size < WS_END) { fprintf(stderr, "kernel_launch: unexpected shapes (n_in %d, in0 %d, out %d, ws %zu); nothing launched\n", n_in, n_in > 0 ? in_sizes[0] : -1, out_size, ws_size); grid = -1; return; }
        int dev = 0, cus = 0, per_cu = 0;
        if (hipGetDevice(&dev) != hipSuccess || hipDeviceGetAttribute(&cus, hipDeviceAttributeMultiprocessorCount, dev) != hipSuccess) { grid = -1; return; }
        if (hipFuncSetAttribute((const void*)fwd_kernel, hipFuncAttributeMaxDynamicSharedMemorySize, LDS_BYTES) != hipSuccess) { fprintf(stderr, "kernel_launch: hipFuncSetAttribute failed\n"); grid = -1; return; }
        if (hipOccupancyMaxActiveBlocksPerMultiprocessor(&per_cu, (const void*)fwd_kernel, NTHR, LDS_BYTES) != hipSuccess || per_cu < 1) { fprintf(stderr, "kernel_launch: occupancy query says %d\n", per_cu); }
        (void)hipGetLastError();
        grid = cus;
    }
    if (grid < 0) return;
    if (hipMemsetAsync((char*)d_ws + WS_CTL, 0, CTL_ZERO_BYTES, stream) != hipSuccess) return;
    Params p{};
    for (int i = 0; i < 26; ++i) p.in[i] = (const float*)d_in[i];
    p.out = (float*)d_out; p.ws = (unsigned char*)d_ws;
#if defined(PROBE_PH)
#ifndef PROBE_FLAGS
#define PROBE_FLAGS 0
#endif
    { int lo = 0; int li = 0;
      for (int l = 0; l < NL; ++l) { const int gk = l * NPH + PROBE_PH;
          p.pad0 = li++; p.step_lo = lo; p.step_hi = gk + 1; hipLaunchKernelGGL(fwd_kernel, dim3(grid), dim3(NTHR), LDS_BYTES, stream, p);
          p.pad0 = li++; p.step_lo = gk; p.step_hi = gk + 1; p.pad1 = PROBE_FLAGS; hipLaunchKernelGGL(fwd_kernel, dim3(grid), dim3(NTHR), LDS_BYTES, stream, p); p.pad1 = 0;
          lo = gk + 1; }
      p.pad0 = li++; p.step_lo = lo; p.step_hi = NSTEPS; hipLaunchKernelGGL(fwd_kernel, dim3(grid), dim3(NTHR), LDS_BYTES, stream, p); }
#elif MK_SPLIT
    for (int st = 0; st < NSTEPS; ++st) { p.pad0 = st; p.step_lo = st; p.step_hi = st + 1; hipLaunchKernelGGL(fwd_kernel, dim3(grid), dim3(NTHR), LDS_BYTES, stream, p); }
#else
    p.step_lo = 0; p.step_hi = NSTEPS; hipLaunchKernelGGL(fwd_kernel, dim3(grid), dim3(NTHR), LDS_BYTES, stream, p);
#endif
}
```

```cpp
#include <hip/hip_runtime.h>
#include <cstdio>
#include <cstdint>

namespace pg8 {
#define PG8_LAS __attribute__((address_space(3)))
#define PG8_GAS __attribute__((address_space(1)))
typedef unsigned short bf16_t;
typedef short bf16x8 __attribute__((ext_vector_type(8)));
typedef float f32x4 __attribute__((ext_vector_type(4)));
typedef unsigned u32x4 __attribute__((ext_vector_type(4)));
constexpr int BM = 256, BK = 64, HALF = 128, HTB = HALF * BK * 2  , STAGE_BYTES = 8 * HTB, NXCD = 8, WGM = 4;

__host__ __device__ __forceinline__ int lds_byte(int r, int c) { const int st = (r >> 4) * 2 + (c >> 5), rr = r & 15, cc = c & 31, ob = rr * 64 + cc * 2; return st * 1024 + (ob ^ (((ob >> 9) & 1) << 5)); }
__host__ __device__ __forceinline__ void stage_rc(int b, int& R, int& C) { const int st = b / 1024, sb = b % 1024, swz = sb ^ (((sb >> 9) & 1) << 5); R = (st >> 1) * 16 + swz / 64; C = (st & 1) * 32 + (swz % 64) / 2; }
__host__ __device__ __forceinline__ int perm32(int rho) { const int n = rho >> 4, i = rho & 15; return 8 * (i >> 2) + 4 * n + (i & 3); }

struct Unit { size_t aoff, boff; int pm, pn; };
struct Gemm { const bf16_t* A; const bf16_t* Bt; int lda, ldb, K; };

struct TileOrder {
    int nM, nN, nwg, G, c, bdiv, bmul; size_t atile, btile;
    __device__ void init(int nM_, int nN_, int G_, int c_, int lda, int ldb, int bdiv_ = 1 << 30, int bmul_ = 0) { nM = nM_; nN = nN_; nwg = nM * nN; G = G_; c = c_; bdiv = bdiv_; bmul = bmul_; atile = (size_t)BM * lda * 2; btile = (size_t)BM * ldb * 2; }
    __device__ bool next(int i, Unit& u) const {
        const long L = (long)i * G + c; if (L >= nwg) return false;
        int wgid = (int)L; { const int q = nwg / NXCD, r = nwg % NXCD, xcd = wgid % NXCD, off = wgid / NXCD; wgid = (xcd < r ? xcd * (q + 1) : r * (q + 1) + (xcd - r) * q) + off; }
        const int nig = WGM * nN, gid = wgid / nig, fm = gid * WGM, gsz = (nM - fm) < WGM ? (nM - fm) : WGM;
        u.pm = fm + ((wgid % nig) % gsz); u.pn = (wgid % nig) / gsz;
        u.aoff = (size_t)u.pm * atile; u.boff = (size_t)((u.pm / bdiv) * bmul + u.pn) * btile; return true;
    }
    __device__ __forceinline__ void a_ready(const Unit&) const {}
    __device__ __forceinline__ void done(const Unit&) const {}
};
template <int MODE> struct PairOrder {
    int G, c;
    __device__ bool next(int i, Unit& u) const {
        const long L = (long)i * G + c; if (L >= 256) return false;
        const int bh = (int)L >> 3, j = (int)L & 7, b = bh >> 2, h = bh & 3;
        if (MODE == 0) { u.aoff = ((size_t)(b * 256) * 4096 + h * 512) * 2; u.boff = ((size_t)(j * 256) * 2048 + h * 512) * 2; u.pm = b * 4 + h; u.pn = j; }
        else           { u.aoff = ((size_t)(j * 256) * 2048 + h * 512) * 2; u.boff = ((size_t)(b * 256) * 4096 + 2048 + h * 512) * 2; u.pm = b * 8 + j; u.pn = h; }
        return true;
    }
    __device__ __forceinline__ void a_ready(const Unit&) const {}
    __device__ __forceinline__ void done(const Unit&) const {}
};

struct FnetAOrder {
    int G, c;
    __device__ bool next(int i, Unit& u) const {
        const long L = (long)i * G + c; if (L >= 512) return false;
        const int combo = (int)L >> 5, rest = (int)L & 31, b = combo >> 1, gp = combo & 1, pml = rest >> 4, pn = rest & 15;
        u.aoff = (size_t)pml * 256 * 256 * 2; u.boff = ((size_t)(b * 4096 + pn * 256) * 3840 + 1792 + gp * 256) * 2; u.pm = b * 4 + gp * 2 + pml; u.pn = pn; return true;
    }
    __device__ __forceinline__ void a_ready(const Unit&) const {}
    __device__ __forceinline__ void done(const Unit&) const {}
};

__device__ __forceinline__ unsigned cvt_pk_bf16(float lo, float hi) { unsigned r; asm volatile("v_cvt_pk_bf16_f32 %0, %1, %2" : "=v"(r) : "v"(lo), "v"(hi)); return r; }

struct RstdTab { const PG8_LAS float* tab; const PG8_GAS float* RS; int pm0, pm1, pm2, pm3;
    __device__ __forceinline__ int slot(int pm) const { return !tab ? -2 : pm == pm0 ? 0 : pm == pm1 ? 1 : pm == pm2 ? 2 : pm == pm3 ? 3 : -1; }
    __device__ __forceinline__ void rows(const Unit& u, int wr, int fr, int fq, float (&rs)[2][4]) const {
        const int sl = slot(u.pm);
        if (sl == -2) {
#pragma unroll
            for (int ai = 0; ai < 2; ++ai)
#pragma unroll
                for (int m = 0; m < 4; ++m) rs[ai][m] = 1.0f;
        } else if (sl >= 0) {
#pragma unroll
            for (int ai = 0; ai < 2; ++ai)
#pragma unroll
                for (int m = 0; m < 4; ++m) rs[ai][m] = tab[sl * 256 + ai * HALF + wr * 64 + m * 16 + fr];
        } else {
#pragma unroll
            for (int ai = 0; ai < 2; ++ai)
#pragma unroll
                for (int m = 0; m < 4; ++m) { const PG8_GAS float* p = RS + (size_t)(u.pm * BM + ai * HALF + wr * 64 + m * 16 + fr) * 32 + fq * 8;
                    const f32x4 a = *(const PG8_GAS f32x4*)p, b = *(const PG8_GAS f32x4*)(p + 4);
                    float t = ((a[0] + a[1]) + (a[2] + a[3])) + ((b[0] + b[1]) + (b[2] + b[3])); t += __shfl_xor(t, 16); t += __shfl_xor(t, 32);
                    rs[ai][m] = rsqrtf(t * (1.0f / 2048.0f) + 1e-6f); }
        }
    }
};
struct EpiBf16 {
    static constexpr bool PERM = true, AFTER_DRAIN = false;
    PG8_GAS bf16_t* O; int ldc; RstdTab R;
    __device__ __forceinline__ void operator()(const f32x4 (&acc)[2][2][4][2], const Unit& u, int wr, int wc, int fr, int fq) const {
        const int row0 = u.pm * BM + wr * 64 + fr, col0 = u.pn * BM + wc * 32 + 8 * fq;
        float rs[2][4]; R.rows(u, wr, fr, fq, rs);
#pragma unroll
        for (int ai = 0; ai < 2; ++ai)
#pragma unroll
            for (int m = 0; m < 4; ++m) { PG8_GAS bf16_t* rowp = O + (size_t)(row0 + ai * HALF + m * 16) * ldc + col0;
#pragma unroll
                for (int bj = 0; bj < 2; ++bj) { const f32x4 v0 = acc[ai][bj][m][0] * rs[ai][m], v1 = acc[ai][bj][m][1] * rs[ai][m];
                    u32x4 w; w.x = cvt_pk_bf16(v0[0], v0[1]); w.y = cvt_pk_bf16(v0[2], v0[3]); w.z = cvt_pk_bf16(v1[0], v1[1]); w.w = cvt_pk_bf16(v1[2], v1[3]);
                    *(PG8_GAS u32x4*)(rowp + bj * HALF) = w; } }
    }
};
struct EpiBf16T {
    static constexpr bool PERM = true, AFTER_DRAIN = false;
    PG8_GAS bf16_t* O; int ldc; RstdTab R;
    __device__ __forceinline__ void operator()(const f32x4 (&acc)[2][2][4][2], const Unit& u, int wr, int wc, int fr, int fq) const {
        const int row0 = u.pm * BM + wr * 64 + fr, col0 = u.pn * BM + wc * 32 + 8 * fq;
        const int sl = R.slot(u.pn); f32x4 cs[2][2];
#pragma unroll
        for (int bj = 0; bj < 2; ++bj) { const int cl = bj * HALF + wc * 32 + 8 * fq;
            if (sl >= 0) { cs[bj][0] = *(const PG8_LAS f32x4*)(R.tab + sl * 256 + cl); cs[bj][1] = *(const PG8_LAS f32x4*)(R.tab + sl * 256 + cl + 4); }
            else {
#pragma unroll
                for (int e = 0; e < 8; ++e) { const PG8_GAS float* p = R.RS + (size_t)(u.pn * BM + cl + e) * 32; float t = 0.f;
#pragma unroll
                    for (int j = 0; j < 32; ++j) t += p[j];
                    cs[bj][e >> 2][e & 3] = rsqrtf(t * (1.0f / 2048.0f) + 1e-6f); } } }
#pragma unroll
        for (int ai = 0; ai < 2; ++ai)
#pragma unroll
            for (int m = 0; m < 4; ++m) { PG8_GAS bf16_t* rowp = O + (size_t)(row0 + ai * HALF + m * 16) * ldc + col0;
#pragma unroll
                for (int bj = 0; bj < 2; ++bj) { const f32x4 v0 = acc[ai][bj][m][0] * cs[bj][0], v1 = acc[ai][bj][m][1] * cs[bj][1];
                    u32x4 w; w.x = cvt_pk_bf16(v0[0], v0[1]); w.y = cvt_pk_bf16(v0[2], v0[3]); w.z = cvt_pk_bf16(v1[0], v1[1]); w.w = cvt_pk_bf16(v1[2], v1[3]);
                    *(PG8_GAS u32x4*)(rowp + bj * HALF) = w; } }
    }
};
struct EpiFnetA {
    static constexpr bool PERM = true, AFTER_DRAIN = false;
    PG8_GAS bf16_t* O;
    __device__ __forceinline__ void operator()(const f32x4 (&acc)[2][2][4][2], const Unit& u, int wr, int wc, int fr, int fq) const {
        const int col0 = u.pn * BM + wc * 32 + 8 * fq;
#pragma unroll
        for (int ai = 0; ai < 2; ++ai)
#pragma unroll
            for (int m = 0; m < 4; ++m) { PG8_GAS bf16_t* rowp = O + (size_t)(u.pm * 128 + wr * 64 + m * 16 + fr) * 8192 + ai * 4096 + col0;
#pragma unroll
                for (int bj = 0; bj < 2; ++bj) { const f32x4 v0 = acc[ai][bj][m][0], v1 = acc[ai][bj][m][1];
                    u32x4 w; w.x = cvt_pk_bf16(v0[0], v0[1]); w.y = cvt_pk_bf16(v0[2], v0[3]); w.z = cvt_pk_bf16(v1[0], v1[1]); w.w = cvt_pk_bf16(v1[2], v1[3]);
                    *(PG8_GAS u32x4*)(rowp + bj * HALF) = w; } }
    }
};
struct EpiF32 {
    static constexpr bool PERM = false, AFTER_DRAIN = false;
    PG8_GAS float* C; int ldc;
    __device__ __forceinline__ void operator()(const f32x4 (&acc)[2][2][4][2], const Unit& u, int wr, int wc, int fr, int fq) const {
        const int row0 = u.pm * BM + wr * 64 + fr, col0 = u.pn * BM + wc * 32 + 4 * fq;
#pragma unroll
        for (int ai = 0; ai < 2; ++ai)
#pragma unroll
            for (int m = 0; m < 4; ++m) { PG8_GAS float* rowp = C + (size_t)(row0 + ai * HALF + m * 16) * ldc + col0;
#pragma unroll
                for (int bj = 0; bj < 2; ++bj)
#pragma unroll
                    for (int n = 0; n < 2; ++n) *(PG8_GAS f32x4*)(rowp + bj * HALF + n * 16) = acc[ai][bj][m][n]; }
    }
};
struct EpiRes {
    static constexpr bool PERM = true, AFTER_DRAIN = false;
    const PG8_GAS float* Xs32; int ldc; PG8_GAS bf16_t* XB; PG8_GAS float* RS;
    __device__ __forceinline__ void operator()(const f32x4 (&acc)[2][2][4][2], const Unit& u, int wr, int wc, int fr, int fq) const {
        const int row0 = u.pm * BM + wr * 64 + fr, col0 = u.pn * BM + wc * 32 + 8 * fq;
#pragma unroll
        for (int ai = 0; ai < 2; ++ai) {
            f32x4 xv[4][2][2];
            if (Xs32) {
#pragma unroll
                for (int m = 0; m < 4; ++m) { const PG8_GAS float* rowp = Xs32 + (size_t)(row0 + ai * HALF + m * 16) * ldc + col0;
#pragma unroll
                    for (int bj = 0; bj < 2; ++bj)
#pragma unroll
                        for (int n = 0; n < 2; ++n) xv[m][bj][n] = __builtin_nontemporal_load((const PG8_GAS f32x4*)(rowp + bj * HALF + n * 4)); }
            } else {
                u32x4 xr[4][2];
#pragma unroll
                for (int m = 0; m < 4; ++m)
#pragma unroll
                    for (int bj = 0; bj < 2; ++bj) xr[m][bj] = *(const PG8_GAS u32x4*)(XB + (size_t)(row0 + ai * HALF + m * 16) * ldc + col0 + bj * HALF);
#pragma unroll
                for (int m = 0; m < 4; ++m)
#pragma unroll
                    for (int bj = 0; bj < 2; ++bj) { const u32x4 r = xr[m][bj];
                        xv[m][bj][0] = (f32x4){__builtin_bit_cast(float, r.x << 16), __builtin_bit_cast(float, r.x & 0xffff0000u), __builtin_bit_cast(float, r.y << 16), __builtin_bit_cast(float, r.y & 0xffff0000u)};
                        xv[m][bj][1] = (f32x4){__builtin_bit_cast(float, r.z << 16), __builtin_bit_cast(float, r.z & 0xffff0000u), __builtin_bit_cast(float, r.w << 16), __builtin_bit_cast(float, r.w & 0xffff0000u)}; }
            }
#pragma unroll
            for (int m = 0; m < 4; ++m) { const int row = row0 + ai * HALF + m * 16; float ss = 0.f;
#pragma unroll
                for (int bj = 0; bj < 2; ++bj) { const f32x4 y0 = xv[m][bj][0] + acc[ai][bj][m][0], y1 = xv[m][bj][1] + acc[ai][bj][m][1];
                    ss += ((y0[0] * y0[0] + y0[1] * y0[1]) + (y0[2] * y0[2] + y0[3] * y0[3])) + ((y1[0] * y1[0] + y1[1] * y1[1]) + (y1[2] * y1[2] + y1[3] * y1[3]));
                    u32x4 w; w.x = cvt_pk_bf16(y0[0], y0[1]); w.y = cvt_pk_bf16(y0[2], y0[3]); w.z = cvt_pk_bf16(y1[0], y1[1]); w.w = cvt_pk_bf16(y1[2], y1[3]);
                    *(PG8_GAS u32x4*)(XB + (size_t)row * ldc + col0 + bj * HALF) = w; }
                ss += __shfl_xor(ss, 16); ss += __shfl_xor(ss, 32); if (fq == 0) RS[(size_t)row * 32 + u.pn * 4 + wc] = ss; }
            asm volatile("" ::: "memory"); }
    }
};
struct EpiSoftmax {
    static constexpr bool PERM = true, AFTER_DRAIN = false;
    PG8_GAS bf16_t* O; int ldc; PG8_LAS float* T1; PG8_LAS float* T2; RstdTab R;
    typedef float f32x2 __attribute__((ext_vector_type(2)));
    static __device__ __forceinline__ f32x2 ex2(float x0, float x1, float c1, float m2) { const f32x2 t = (f32x2){x0, x1} * c1 - m2; f32x2 e; e.x = __builtin_amdgcn_exp2f(t.x); e.y = __builtin_amdgcn_exp2f(t.y); return e; }
    __device__ __forceinline__ void operator()(const f32x4 (&acc)[2][2][4][2], const Unit& u, int wr, int wc, int fr, int fq) const {
        const int row0 = u.pm * BM + wr * 64 + fr, col0 = u.pn * BM + wc * 32 + 8 * fq;
        float m2[2][4]; float rs[2][4]; R.rows(u, wr, fr, fq, rs);
#pragma unroll
        for (int ai = 0; ai < 2; ++ai)
#pragma unroll
            for (int m = 0; m < 4; ++m) { float a = -3.0e38f;
#pragma unroll
                for (int bj = 0; bj < 2; ++bj)
#pragma unroll
                    for (int n = 0; n < 2; ++n) { const f32x4 v = acc[ai][bj][m][n]; a = fmaxf(a, fmaxf(fmaxf(v[0], v[1]), fmaxf(v[2], v[3]))); }
                a = fmaxf(a, __shfl_xor(a, 16)); a = fmaxf(a, __shfl_xor(a, 32));
                if (fq == 0) T1[(ai * HALF + wr * 64 + m * 16 + fr) * 4 + wc] = a * rs[ai][m]; }
        asm volatile("s_waitcnt lgkmcnt(0)" ::: "memory"); __builtin_amdgcn_s_barrier(); asm volatile("" ::: "memory");
#pragma unroll
        for (int ai = 0; ai < 2; ++ai)
#pragma unroll
            for (int m = 0; m < 4; ++m) { const f32x4 t = *(const PG8_LAS f32x4*)(T1 + (ai * HALF + wr * 64 + m * 16 + fr) * 4); const float c1 = rs[ai][m] * 1.4426950408889634f;
                m2[ai][m] = fmaxf(fmaxf(t[0], t[1]), fmaxf(t[2], t[3])) * 1.4426950408889634f; f32x2 a2 = (f32x2){0.f, 0.f};
#pragma unroll
                for (int bj = 0; bj < 2; ++bj)
#pragma unroll
                    for (int n = 0; n < 2; ++n) { const f32x4 v = acc[ai][bj][m][n]; a2 += ex2(v[0], v[1], c1, m2[ai][m]) + ex2(v[2], v[3], c1, m2[ai][m]); }
                float a = a2.x + a2.y; a += __shfl_xor(a, 16); a += __shfl_xor(a, 32);
                if (fq == 0) T2[(ai * HALF + wr * 64 + m * 16 + fr) * 4 + wc] = a; }
        asm volatile("s_waitcnt lgkmcnt(0)" ::: "memory"); __builtin_amdgcn_s_barrier(); asm volatile("" ::: "memory");
#pragma unroll
        for (int ai = 0; ai < 2; ++ai)
#pragma unroll
            for (int m = 0; m < 4; ++m) { const f32x4 t = *(const PG8_LAS f32x4*)(T2 + (ai * HALF + wr * 64 + m * 16 + fr) * 4); const float inv = 1.0f / ((t[0] + t[1]) + (t[2] + t[3])), mm = m2[ai][m], c1 = rs[ai][m] * 1.4426950408889634f;
                PG8_GAS bf16_t* rowp = O + (size_t)(row0 + ai * HALF + m * 16) * ldc + col0;
#pragma unroll
                for (int bj = 0; bj < 2; ++bj) { const f32x4 v0 = acc[ai][bj][m][0], v1 = acc[ai][bj][m][1];
                    const f32x2 p0 = ex2(v0[0], v0[1], c1, mm) * inv, p1 = ex2(v0[2], v0[3], c1, mm) * inv, p2 = ex2(v1[0], v1[1], c1, mm) * inv, p3 = ex2(v1[2], v1[3], c1, mm) * inv;
                    u32x4 w; w.x = cvt_pk_bf16(p0.x, p0.y); w.y = cvt_pk_bf16(p1.x, p1.y); w.z = cvt_pk_bf16(p2.x, p2.y); w.w = cvt_pk_bf16(p3.x, p3.y);
                    *(PG8_GAS u32x4*)(rowp + bj * HALF) = w; } }
    }
};
__device__ __forceinline__ float silu_f(float g) { return g * __builtin_amdgcn_rcpf(1.0f + __expf(-g)); }
struct EpiSwiglu {
    static constexpr bool PERM = true, AFTER_DRAIN = false;
    PG8_GAS bf16_t* H; int ldc; RstdTab R;
    typedef float f32x2 __attribute__((ext_vector_type(2)));
    static __device__ __forceinline__ void quad(f32x4 G, f32x4 U, float a, float q, unsigned& w0, unsigned& w1) {
        const f32x2 G01 = (f32x2){G[0], G[1]}, G23 = (f32x2){G[2], G[3]}, U01 = (f32x2){U[0], U[1]}, U23 = (f32x2){U[2], U[3]};
        const f32x2 t01 = __builtin_elementwise_min(G01 * a, (f32x2){30.f, 30.f}), t23 = __builtin_elementwise_min(G23 * a, (f32x2){30.f, 30.f});
        f32x2 e01, e23; e01.x = __builtin_amdgcn_exp2f(t01.x); e01.y = __builtin_amdgcn_exp2f(t01.y); e23.x = __builtin_amdgcn_exp2f(t23.x); e23.y = __builtin_amdgcn_exp2f(t23.y);
        const f32x2 d01 = e01 + 1.0f, d23 = e23 + 1.0f, pp = d01 * d23;
        const float r = __builtin_amdgcn_rcpf(pp.x * pp.y);
        const f32x2 rp = (f32x2){pp.y, pp.x} * r;
        const f32x2 i01 = rp * d23, i23 = rp * d01;
        const f32x2 h01 = (G01 * U01) * (i01 * q), h23 = (G23 * U23) * (i23 * q);
        w0 = cvt_pk_bf16(h01.x, h01.y); w1 = cvt_pk_bf16(h23.x, h23.y);
    }
    __device__ __forceinline__ void operator()(const f32x4 (&acc)[2][2][4][2], const Unit& u, int wr, int wc, int fr, int fq) const {
        const int row0 = u.pm * BM + wr * 64 + fr, col0 = u.pn * HALF + wc * 32 + 8 * fq;
        float rs[2][4]; R.rows(u, wr, fr, fq, rs);
#pragma unroll
        for (int ai = 0; ai < 2; ++ai)
#pragma unroll
            for (int m = 0; m < 4; ++m) { PG8_GAS bf16_t* rowp = H + (size_t)(row0 + ai * HALF + m * 16) * ldc + col0;
                const float a = rs[ai][m] * -1.4426950408889634f, q = rs[ai][m] * rs[ai][m];
                const f32x4 g0 = acc[ai][0][m][0], g1 = acc[ai][0][m][1], u0 = acc[ai][1][m][0], u1 = acc[ai][1][m][1];
                u32x4 w; unsigned wa, wb, wc2, wd; quad(g0, u0, a, q, wa, wb); quad(g1, u1, a, q, wc2, wd); w.x = wa; w.y = wb; w.z = wc2; w.w = wd;
                *(PG8_GAS u32x4*)rowp = w; }
    }
};

template <class Epi, class Sched, bool ALIGN_EPI = false, bool SP2 = false>
__device__ __forceinline__ void gemm_phase(PG8_LAS unsigned char* lds, const Gemm g, const Sched& S, const Epi& E, int tid_in) {
    int tid = tid_in; asm volatile("" : "+v"(tid));
    const int wid = __builtin_amdgcn_readfirstlane(tid >> 6), lane = tid & 63, wr = wid >> 2, wc = wid & 3, fr = lane & 15, fq = lane >> 4;
    const int K = g.K, nt = K / BK;
    unsigned voffA[2], voffB[2];
#pragma unroll
    for (int i = 0; i < 2; ++i) { int R, C; stage_rc(tid * 16 + i * 8192, R, C); const int Rb = Epi::PERM ? ((R & ~31) + perm32(R & 31)) : R;
        voffA[i] = (unsigned)(R * g.lda + C) * 2u; voffB[i] = (unsigned)(Rb * g.ldb + C) * 2u; }
    const size_t kstep = (size_t)(BK * 2);
    const size_t hstepA = (size_t)HALF * g.lda * 2, hstepB = (size_t)HALF * g.ldb * 2;
    const unsigned ldsw = (unsigned)wid * 1024u;
    const int aoff = lds_byte(wr * 64 + fr, fq * 8), boff = lds_byte(wc * 32 + fr, fq * 8);
#define PG8_SA(b, h) (((b) * 2 + (h)) * HTB)
#define PG8_SB(b, h) ((4 + (b) * 2 + (h)) * HTB)
#define PG8_STAGE(bufoff, gbase, voff) do { _Pragma("unroll") for (int _i = 0; _i < 2; ++_i) \
        __builtin_amdgcn_global_load_lds((const unsigned*)((const char*)(gbase) + (voff)[_i]), (PG8_LAS unsigned*)(lds + (bufoff) + ldsw + _i * 8192), 16, 0, 0); } while (0)
#define PG8_LDA(dst, b, h) do { _Pragma("unroll") for (int m = 0; m < 4; ++m) _Pragma("unroll") for (int k = 0; k < 2; ++k) dst[m][k] = *(const PG8_LAS bf16x8*)(lds + PG8_SA(b, h) + aoff + m * 2048 + k * 1024); } while (0)
#define PG8_LDB(dst, b, h) do { _Pragma("unroll") for (int n = 0; n < 2; ++n) _Pragma("unroll") for (int k = 0; k < 2; ++k) dst[n][k] = *(const PG8_LAS bf16x8*)(lds + PG8_SB(b, h) + boff + n * 2048 + k * 1024); } while (0)
#define PG8_MMA(ai, bj, At, Bt) do { __builtin_amdgcn_s_setprio(1); _Pragma("unroll") for (int m = 0; m < 4; ++m) _Pragma("unroll") for (int n = 0; n < 2; ++n) _Pragma("unroll") for (int k = 0; k < 2; ++k) \
        acc[ai][bj][m][n] = __builtin_amdgcn_mfma_f32_16x16x32_bf16(Bt[n][k], At[m][k], acc[ai][bj][m][n], 0, 0, 0); __builtin_amdgcn_s_setprio(0); } while (0)
#define PG8_WAIT_V(n) asm volatile("s_waitcnt vmcnt(" #n ")" ::: "memory")
#define PG8_WAIT_L(n) asm volatile("s_waitcnt lgkmcnt(" #n ")" ::: "memory")
#define PG8_BAR __builtin_amdgcn_s_barrier()
#define PG8_SCHED __builtin_amdgcn_sched_barrier(0)
    Unit cur, nxt; int ui = 0;
    if (!S.next(0, cur)) return;
    f32x4 acc[2][2][4][2];
#pragma unroll
    for (int a = 0; a < 2; ++a)
#pragma unroll
        for (int b = 0; b < 2; ++b)
#pragma unroll
            for (int m = 0; m < 4; ++m)
#pragma unroll
                for (int n = 0; n < 2; ++n) acc[a][b][m][n] = (f32x4){0.f, 0.f, 0.f, 0.f};
    bf16x8 At[4][2], B0[2][2], B1[2][2];
    const char* cA = (const char*)g.A + cur.aoff; const char* cB = (const char*)g.Bt + cur.boff;
    S.a_ready(cur);
    if constexpr (SP2) {
        PG8_STAGE(PG8_SB(0, 0), cB, voffB); PG8_STAGE(PG8_SB(0, 1), cB + hstepB, voffB); PG8_STAGE(PG8_SA(0, 0), cA, voffA); PG8_STAGE(PG8_SA(0, 1), cA + hstepA, voffA);
        if (wr == 1) PG8_BAR;
        PG8_WAIT_V(2); PG8_BAR;
        PG8_STAGE(PG8_SB(1, 0), cB + kstep, voffB); PG8_STAGE(PG8_SA(1, 0), cA + kstep, voffA); PG8_STAGE(PG8_SB(1, 1), cB + hstepB + kstep, voffB);
        PG8_WAIT_V(6); PG8_BAR;
    } else {
        PG8_STAGE(PG8_SB(0, 0), cB, voffB); PG8_STAGE(PG8_SA(0, 0), cA, voffA); PG8_STAGE(PG8_SB(0, 1), cB + hstepB, voffB); PG8_STAGE(PG8_SA(0, 1), cA + hstepA, voffA);
        if (wr == 1) PG8_BAR;
        PG8_WAIT_V(4); PG8_BAR;
        PG8_STAGE(PG8_SB(1, 0), cB + kstep, voffB); PG8_STAGE(PG8_SA(1, 0), cA + kstep, voffA); PG8_STAGE(PG8_SB(1, 1), cB + hstepB + kstep, voffB);
        PG8_WAIT_V(6); PG8_BAR;
    }
    for (;;) {
        const bool has_next = S.next(ui + 1, nxt);
        const char* nA = has_next ? (const char*)g.A + nxt.aoff : cA; const char* nB = has_next ? (const char*)g.Bt + nxt.boff : cB;
        for (int t = 0; t < nt; t += 2) {
            const bool last = (t == nt - 2);
            const char* a1 = cA + (size_t)(t + 1) * kstep;
            const char* a2 = last ? nA : cA + (size_t)(t + 2) * kstep; const char* b2 = last ? nB : cB + (size_t)(t + 2) * kstep;
            const char* a3 = a2 + kstep; const char* b3 = b2 + kstep;
            if (last && has_next) S.a_ready(nxt);
            if constexpr (SP2) {
            PG8_LDB(B0, 0, 0); PG8_LDB(B1, 0, 1); PG8_SCHED; PG8_LDA(At, 0, 0); PG8_STAGE(PG8_SA(1, 1), a1 + hstepA, voffA);
            PG8_WAIT_V(8); PG8_WAIT_L(0); PG8_BAR; PG8_MMA(0, 0, At, B0); PG8_MMA(0, 1, At, B1); PG8_BAR; PG8_SCHED;
            PG8_LDA(At, 0, 1); PG8_STAGE(PG8_SB(0, 0), b2, voffB); PG8_STAGE(PG8_SB(0, 1), b2 + hstepB, voffB); PG8_STAGE(PG8_SA(0, 0), a2, voffA);
            PG8_WAIT_V(8); PG8_WAIT_L(0); PG8_BAR; PG8_MMA(1, 0, At, B0); PG8_MMA(1, 1, At, B1); PG8_BAR; PG8_SCHED;
            PG8_LDB(B0, 1, 0); PG8_LDB(B1, 1, 1); PG8_SCHED; PG8_LDA(At, 1, 0); PG8_STAGE(PG8_SA(0, 1), a2 + hstepA, voffA);
            PG8_WAIT_V(8); PG8_WAIT_L(0); PG8_BAR; PG8_MMA(0, 0, At, B0); PG8_MMA(0, 1, At, B1); PG8_BAR; PG8_SCHED;
            PG8_LDA(At, 1, 1); PG8_STAGE(PG8_SB(1, 0), b3, voffB); PG8_STAGE(PG8_SB(1, 1), b3 + hstepB, voffB); PG8_STAGE(PG8_SA(1, 0), a3, voffA);
            PG8_WAIT_V(8); PG8_WAIT_L(0); PG8_BAR; PG8_MMA(1, 0, At, B0); PG8_MMA(1, 1, At, B1); PG8_BAR; PG8_SCHED;
            } else {
            PG8_LDB(B0, 0, 0); PG8_SCHED; PG8_LDA(At, 0, 0); PG8_STAGE(PG8_SA(1, 1), a1 + hstepA, voffA);
            PG8_WAIT_L(8); PG8_BAR; PG8_WAIT_L(0); PG8_MMA(0, 0, At, B0); PG8_BAR; PG8_SCHED;
            PG8_LDB(B1, 0, 1); PG8_STAGE(PG8_SB(0, 0), b2, voffB);
            PG8_BAR; PG8_WAIT_L(0); PG8_MMA(0, 1, At, B1); PG8_BAR;
            PG8_LDA(At, 0, 1); PG8_STAGE(PG8_SA(0, 0), a2, voffA);
            PG8_BAR; PG8_WAIT_L(0); PG8_MMA(1, 0, At, B0); PG8_BAR; PG8_SCHED;
            PG8_STAGE(PG8_SB(0, 1), b2 + hstepB, voffB);
            PG8_WAIT_V(6); PG8_BAR; PG8_MMA(1, 1, At, B1); PG8_BAR;
            PG8_LDB(B0, 1, 0); PG8_SCHED; PG8_LDA(At, 1, 0); PG8_STAGE(PG8_SA(0, 1), a2 + hstepA, voffA);
            PG8_WAIT_L(8); PG8_BAR; PG8_WAIT_L(0); PG8_MMA(0, 0, At, B0); PG8_BAR; PG8_SCHED;
            PG8_LDB(B1, 1, 1); PG8_STAGE(PG8_SB(1, 0), b3, voffB);
            PG8_BAR; PG8_WAIT_L(0); PG8_MMA(0, 1, At, B1); PG8_BAR;
            PG8_LDA(At, 1, 1); PG8_STAGE(PG8_SA(1, 0), a3, voffA);
            PG8_BAR; PG8_WAIT_L(0); PG8_MMA(1, 0, At, B0); PG8_BAR; PG8_SCHED;
            PG8_STAGE(PG8_SB(1, 1), b3 + hstepB, voffB);
            PG8_WAIT_V(6); PG8_BAR; PG8_MMA(1, 1, At, B1); PG8_BAR;
            }
        }
        if constexpr (ALIGN_EPI) { if (wr == 0) PG8_BAR; }
        if constexpr (!Epi::AFTER_DRAIN) { E(acc, cur, wr, wc, fr, fq); S.done(cur); }
        if (!has_next) break;
#pragma unroll
        for (int a = 0; a < 2; ++a)
#pragma unroll
            for (int b = 0; b < 2; ++b)
#pragma unroll
                for (int m = 0; m < 4; ++m)
#pragma unroll
                    for (int n = 0; n < 2; ++n) acc[a][b][m][n] = (f32x4){0.f, 0.f, 0.f, 0.f};
        cur = nxt; cA = nA; cB = nB; ++ui;
        if constexpr (ALIGN_EPI) { if (wr == 1) PG8_BAR; }
    }
    PG8_WAIT_V(0);
    if constexpr (!ALIGN_EPI) { if (wr == 0) PG8_BAR; }
    PG8_BAR;
    if constexpr (Epi::AFTER_DRAIN) { E.fused(acc, cur, wr, wc, fr, fq, lds, wid, lane); S.done(cur); }
#undef PG8_SA
#undef PG8_SB
#undef PG8_STAGE
#undef PG8_LDA
#undef PG8_LDB
#undef PG8_MMA
#undef PG8_WAIT_V
#undef PG8_WAIT_L
#undef PG8_BAR
#undef PG8_SCHED
}
}

constexpr int NB = 8, SEQ = 4096, DM = 2048, NL = 4, MTOK = NB * SEQ, NMEM = 256;
constexpr int DIN = 5152, NPROJ = 3840, NWIN = 5376, DFF = 5632;
constexpr int PQ = 0, PK = 256, PV = 512, PG = 1024, PLR = 1536, PUF = 1792, PUS = 2304, WUH = 3840;
constexpr float EPS = 1e-6f;
constexpr int NWAVES = 8, NTHR = 512;

constexpr size_t MiB = 1u << 20;
constexpr size_t WS_CTL = 0, CTL_ZERO_BYTES = 1 * MiB;
constexpr size_t WS_WIN = 1 * MiB, WS_WOUT = 23 * MiB, WS_WQB = 31 * MiB, WS_WKV = 39 * MiB, WS_WXO = 55 * MiB, WS_WGU = 63 * MiB, WS_WD = 107 * MiB;
constexpr size_t WS_KVB = 129 * MiB, WS_MT = 145 * MiB, WS_VWO = 177 * MiB, WS_MEMN = 209 * MiB;
constexpr size_t WS_XB = 217 * MiB, WS_PROJ = 345 * MiB, WS_MIX = 697 * MiB, WS_OF = 825 * MiB, WS_FU = 889 * MiB, WS_FILT = 1017 * MiB, WS_UT = 1049 * MiB, WS_YT = 1145 * MiB;
constexpr size_t WS_FU2 = 889 * MiB, WS_FY = 953 * MiB, WS_C2 = 1177 * MiB, WS_S2 = 1186 * MiB, WS_FE = 1194 * MiB, WS_FO = 1211 * MiB, WS_Y2K = 1227 * MiB, WS_A1 = 1241 * MiB;
constexpr int FK1 = 2176;
constexpr size_t WS_GS = 1242 * MiB  , WS_GU = 1242 * MiB, WS_GD = 1370 * MiB;
constexpr size_t WS_RSS = 1371 * MiB;
constexpr size_t WS_END = 1375 * MiB;
constexpr int CW_BAR = 4096;

constexpr int RING_OFF = 0, RING_BYTES = 131072;
constexpr int LDSCTL_OFF = RING_BYTES, MISC_OFF = LDSCTL_OFF + 320;
constexpr int LDS_BYTES = 147456;

#define GAS __attribute__((address_space(1)))
#define LAS __attribute__((address_space(3)))
typedef unsigned short bf16;
typedef unsigned v4u __attribute__((ext_vector_type(4)));
typedef unsigned v2u __attribute__((ext_vector_type(2)));
typedef float f32x4 __attribute__((ext_vector_type(4)));
typedef GAS unsigned gu32;
#define LDS_WAIT() asm volatile("s_waitcnt lgkmcnt(0)" ::: "memory")
__device__ __forceinline__ unsigned f2bf(float f) { unsigned u = __builtin_bit_cast(unsigned, f); return (u + 0x7fffu + ((u >> 16) & 1u)) >> 16; }
__device__ __forceinline__ unsigned pk2(float lo, float hi) { return f2bf(lo) | (f2bf(hi) << 16); }
__device__ __forceinline__ float bf2f(bf16 h) { return __builtin_bit_cast(float, ((unsigned)h) << 16); }
__device__ __forceinline__ float bflo(unsigned w) { return __builtin_bit_cast(float, w << 16); }
__device__ __forceinline__ float bfhi(unsigned w) { return __builtin_bit_cast(float, w & 0xffff0000u); }

#define XB_TMO      128
#define XB_XCNT(j)  (256  + 64 * (j))
#define XB_XSUB(j)  (1280 + 64 * (j))
#define XB_XGEN(j)  (2304 + 64 * (j))
#define XB_TOP      3328
#define XB_TOPGEN   3392
#define XCD_BAR_WORDS 3456
#define XB_SPIN_CAP (1u << 18)

__device__ __forceinline__ unsigned xb_ld(unsigned* p)              { return __hip_atomic_load(p, __ATOMIC_RELAXED, __HIP_MEMORY_SCOPE_AGENT); }
__device__ __forceinline__ unsigned xb_add(unsigned* p, unsigned v) { return __hip_atomic_fetch_add(p, v, __ATOMIC_RELAXED, __HIP_MEMORY_SCOPE_AGENT); }
__device__ __forceinline__ unsigned xb_xcc_id() { return (unsigned)__builtin_amdgcn_s_getreg((3 << 11) | 20) & 0xFu; }
#define XB_SPIN(cond, bar) do { unsigned _sp = 0; while (cond) { __builtin_amdgcn_s_sleep(1); \
    if ((++_sp & 255u) == 0u) { if (xb_ld(&(bar)[XB_TMO])) break; if (_sp > XB_SPIN_CAP) { atomicAdd(&(bar)[XB_TMO], 1u); break; } } } } while (0)

struct XcdBarrier { unsigned* bar; unsigned x; volatile LAS unsigned* st; };

__device__ __forceinline__ XcdBarrier xcd_barrier_post(unsigned* bar, volatile LAS unsigned* st, int tid) {
    XcdBarrier b; b.bar = bar; b.x = xb_xcc_id(); b.st = st;
    if (tid == 0) (void)xb_add(&bar[XB_XCNT(b.x)], 1u);
    return b;
}
__device__ __forceinline__ void xcd_barrier_complete(unsigned* bar, unsigned x, unsigned& nloc, unsigned& nx) {
    const unsigned G = gridDim.x * gridDim.y * gridDim.z;
    unsigned sum, cnt, mine, sp = 0u;
    for (;;) {
        sum = 0u; cnt = 0u; mine = 0u;
#pragma unroll
        for (unsigned j = 0; j < 16; ++j) { const unsigned c = xb_ld(&bar[XB_XCNT(j)]); sum += c; cnt += (c > 0u) ? 1u : 0u; mine = (j == x) ? c : mine; }
        if (sum == G) break;
        __builtin_amdgcn_s_sleep(1);
        if ((++sp & 255u) == 0u) { if (xb_ld(&bar[XB_TMO])) break; if (sp > XB_SPIN_CAP) { atomicAdd(&bar[XB_TMO], 1u); break; } }
    }
    nloc = mine > 0u ? mine : 1u; nx = cnt > 0u ? cnt : 1u;
}
__device__ __forceinline__ void xcd_barrier(const XcdBarrier& b, int tid) {
    asm volatile("s_waitcnt vmcnt(0)" ::: "memory");
    __syncthreads();
    if (tid == 0) {
        unsigned* bar = b.bar;
        __builtin_amdgcn_s_waitcnt(0);
        unsigned nloc = b.st[0], nx = b.st[1];
        if (nloc == 0u) { xcd_barrier_complete(bar, b.x, nloc, nx); b.st[0] = nloc; b.st[1] = nx; }
        const unsigned old = xb_add(&bar[XB_XSUB(b.x)], 1u);
        const unsigned gen = old / nloc;
        if (old + 1u == (gen + 1u) * nloc) {
            __builtin_amdgcn_fence(__ATOMIC_RELEASE, "agent");
            asm volatile("s_waitcnt vmcnt(0)" ::: "memory");
            const unsigned og = xb_add(&bar[XB_TOP], 1u);
            const unsigned tg = og / nx;
            if (og + 1u == (tg + 1u) * nx) xb_add(&bar[XB_TOPGEN], 1u);
            else XB_SPIN(xb_ld(&bar[XB_TOPGEN]) == tg, bar);
            __builtin_amdgcn_fence(__ATOMIC_ACQUIRE, "agent");
            xb_add(&bar[XB_XGEN(b.x)], 1u);
            asm volatile("s_waitcnt vmcnt(0)" ::: "memory");
        } else {
            XB_SPIN(xb_ld(&bar[XB_XGEN(b.x)]) == gen, bar);
            __builtin_amdgcn_fence(__ATOMIC_ACQUIRE, "agent");
            asm volatile("s_waitcnt vmcnt(0)" ::: "memory");
        }
    }
    __syncthreads();
}

__device__ __forceinline__ float wave_sum(float v) {
#pragma unroll
    for (int o = 1; o < 64; o <<= 1) v += __shfl_xor(v, o);
    return v;
}
__device__ __forceinline__ float wave_max(float v) {
#pragma unroll
    for (int o = 1; o < 64; o <<= 1) v = fmaxf(v, __shfl_xor(v, o));
    return v;
}
__device__ __forceinline__ float block_sum(float v, LAS float* red, int wave, int lane) {
    v = wave_sum(v); if (lane == 0) red[wave] = v; __syncthreads();
    float s = 0.f;
#pragma unroll
    for (int i = 0; i < 8; ++i) s += red[i];
    __syncthreads(); return s;
}
__device__ __forceinline__ float log_sigmoid_f(float x) { return fminf(x, 0.f) - __logf(1.0f + __expf(-fabsf(x))); }

struct Params {
    const float* in[26]; float* out; unsigned char* ws;
    int step_lo, step_hi, pad0, pad1;
};
__device__ __forceinline__ int opaque_i(int x) { asm volatile("" : "+v"(x)); return __builtin_amdgcn_readfirstlane(x); }
template <class T> __device__ __forceinline__ T* opaque_p(T* p) { const unsigned long long v = (unsigned long long)p; const unsigned lo = (unsigned)opaque_i((int)(unsigned)v), hi = (unsigned)opaque_i((int)(unsigned)(v >> 32)); return (T*)(((unsigned long long)hi << 32) | lo); }
__device__ __forceinline__ const float* pin(const Params& P, int i) { return P.in[opaque_i(i)]; }

struct TrItem { const float* src; int ldsrc, nsrc0, k0, lddst, nd0; bf16* dst; const float* gain; float sc; };
__device__ __forceinline__ void tr_load(const TrItem& t, f32x4 (&v)[8], int lane) {
    const int lr = lane >> 3, lc = (lane & 7) * 4;
#pragma unroll
    for (int i = 0; i < 8; ++i) v[i] = *(const GAS f32x4*)(t.src + (size_t)(t.k0 + 8 * i + lr) * t.ldsrc + t.nsrc0 + lc);
}
__device__ __forceinline__ void tr_finish(const TrItem& t, const f32x4 (&v)[8], LAS float* scr, int lane) {
    const int lr = lane >> 3, lc = (lane & 7) * 4;
#pragma unroll
    for (int i = 0; i < 8; ++i) { const int kk = 8 * i + lr; const float gs = (t.gain ? t.gain[t.k0 + kk] : 1.f) * t.sc; LAS float* d = scr + kk * 33 + lc; d[0] = v[i].x * gs; d[1] = v[i].y * gs; d[2] = v[i].z * gs; d[3] = v[i].w * gs; }
    LDS_WAIT(); asm volatile("" ::: "memory");
    const int c = lane & 7;
#pragma unroll
    for (int j = 0; j < 4; ++j) { const int n = (lane >> 3) + 8 * j; const LAS float* s = scr + (8 * c) * 33 + n;
        v4u o; o.x = pk2(s[0 * 33], s[1 * 33]); o.y = pk2(s[2 * 33], s[3 * 33]); o.z = pk2(s[4 * 33], s[5 * 33]); o.w = pk2(s[6 * 33], s[7 * 33]);
        *(GAS v4u*)(t.dst + (size_t)(t.nd0 + n) * t.lddst + t.k0 + 8 * c) = o; }
    LDS_WAIT(); asm volatile("" ::: "memory");
}
__device__ __forceinline__ void norm_row(const float* xrow, bf16* orow, float* xcopy, int lane) {
    const GAS f32x4* xr = (const GAS f32x4*)xrow + lane;
    f32x4 v[8]; float s = 0.f;
#pragma unroll
    for (int j = 0; j < 8; ++j) { v[j] = xr[64 * j]; s += (v[j].x * v[j].x + v[j].y * v[j].y) + (v[j].z * v[j].z + v[j].w * v[j].w); }
    const float rstd = rsqrtf(wave_sum(s) * (1.f / DM) + EPS);
    GAS v2u* o8 = (GAS v2u*)orow + lane;
#pragma unroll
    for (int j = 0; j < 8; ++j) { v2u w; w.x = pk2(v[j].x * rstd, v[j].y * rstd); w.y = pk2(v[j].z * rstd, v[j].w * rstd); o8[64 * j] = w; }
    if (xcopy) { GAS f32x4* xc = (GAS f32x4*)xcopy + lane;
#pragma unroll
        for (int j = 0; j < 8; ++j) xc[64 * j] = v[j]; }
}
__device__ __forceinline__ void final_norm_row(const bf16* xrow, float* orow, const float* g, int lane) {
    const GAS v4u* xr = (const GAS v4u*)xrow + lane; float v[4][8]; float s = 0.f;
#pragma unroll
    for (int j = 0; j < 4; ++j) { const v4u r = xr[64 * j]; v[j][0] = bflo(r.x); v[j][1] = bfhi(r.x); v[j][2] = bflo(r.y); v[j][3] = bfhi(r.y); v[j][4] = bflo(r.z); v[j][5] = bfhi(r.z); v[j][6] = bflo(r.w); v[j][7] = bfhi(r.w);
#pragma unroll
        for (int e = 0; e < 8; ++e) s += v[j][e] * v[j][e]; }
    const float rstd = rsqrtf(wave_sum(s) * (1.f / DM) + EPS);
#pragma unroll
    for (int j = 0; j < 4; ++j) { const int c0 = (64 * j + lane) * 8; const f32x4 g0 = *(const GAS f32x4*)(g + c0), g1 = *(const GAS f32x4*)(g + c0 + 4);
        *(GAS f32x4*)(orow + c0) = (f32x4){v[j][0] * rstd * g0.x, v[j][1] * rstd * g0.y, v[j][2] * rstd * g0.z, v[j][3] * rstd * g0.w};
        *(GAS f32x4*)(orow + c0 + 4) = (f32x4){v[j][4] * rstd * g1.x, v[j][5] * rstd * g1.y, v[j][6] * rstd * g1.z, v[j][7] * rstd * g1.w}; }
}
__device__ __forceinline__ void norm_row_gain_f32(const float* xrow, float* orow, const float* g, int lane) {
    const GAS f32x4* xr = (const GAS f32x4*)xrow + lane; const GAS f32x4* gr = (const GAS f32x4*)g + lane;
    f32x4 v[8]; float s = 0.f;
#pragma unroll
    for (int j = 0; j < 8; ++j) { v[j] = xr[64 * j]; s += (v[j].x * v[j].x + v[j].y * v[j].y) + (v[j].z * v[j].z + v[j].w * v[j].w); }
    const float rstd = rsqrtf(wave_sum(s) * (1.f / DM) + EPS);
    GAS f32x4* o = (GAS f32x4*)orow + lane;
#pragma unroll
    for (int j = 0; j < 8; ++j) o[64 * j] = v[j] * rstd * gr[64 * j];
}
__device__ __forceinline__ void norm_row_gain_bf16(const float* xrow, bf16* orow, const float* g, int lane) {
    const GAS f32x4* xr = (const GAS f32x4*)xrow + lane; const GAS f32x4* gr = (const GAS f32x4*)g + lane;
    f32x4 v[8]; float s = 0.f;
#pragma unroll
    for (int j = 0; j < 8; ++j) { v[j] = xr[64 * j]; s += (v[j].x * v[j].x + v[j].y * v[j].y) + (v[j].z * v[j].z + v[j].w * v[j].w); }
    const float rstd = rsqrtf(wave_sum(s) * (1.f / DM) + EPS);
    GAS v2u* o8 = (GAS v2u*)orow + lane;
#pragma unroll
    for (int j = 0; j < 8; ++j) { const f32x4 y = v[j] * rstd * gr[64 * j]; v2u w; w.x = pk2(y.x, y.y); w.y = pk2(y.z, y.w); o8[64 * j] = w; }
}

__device__ __forceinline__ void phase_a(const Params& P, unsigned char* ws, float* xres, int l, LAS unsigned char* lds, int tid, int lane, int wave, int bid, int G) {
    bf16* WinT = (bf16*)(ws + WS_WIN); bf16* WoutT = (bf16*)(ws + WS_WOUT); bf16* WqB = (bf16*)(ws + WS_WQB); bf16* WkvT = (bf16*)(ws + WS_WKV);
    bf16* WxoT = (bf16*)(ws + WS_WXO); bf16* WguT = (bf16*)(ws + WS_WGU); bf16* WdT = (bf16*)(ws + WS_WD);
    const float* g0 = pin(P, 2) + (size_t)(l * 3 + 0) * DM; const float* g1 = g0 + DM; const float* g2 = g1 + DM;
    const float* w_in = pin(P, 3) + (size_t)l * DM * DIN;
    const float* w_out = pin(P, 18) + (size_t)l * DM * DM;
    const float* w_xq = pin(P, 20) + (size_t)l * DM * DM;
    const float* w_xkv = pin(P, 21) + (size_t)l * DM * 2 * DM;
    const float* w_xo = pin(P, 22) + (size_t)l * DM * DM;
    const float* w_gu = pin(P, 23) + (size_t)l * DM * 2 * DFF;
    const float* w_dn = pin(P, 24) + (size_t)l * DFF * DM;
    const int gw = bid * NWAVES + wave, NGW = G * NWAVES, gt = bid * NTHR + tid, NGT = G * NTHR;
    LAS float* scr = (LAS float*)(lds + wave * 16384);
    constexpr int I1 = 49 * 32, I2 = 112 * 32, I3 = 64 * 32, I4 = 128 * 32, I5 = 64 * 32, I6 = 352 * 32, I7 = 64 * 88, ITOT = I1 + I2 + I3 + I4 + I5 + I6 + I7;
    auto mk_item = [&](int it) -> TrItem {
        int r = it; TrItem t; t.gain = nullptr; t.sc = 1.f;
        if (r < I1) { const int kb = r / 49, nb = r % 49; t.src = w_in; t.ldsrc = DIN; t.nsrc0 = 32 * nb; t.k0 = 64 * kb; t.dst = WinT; t.lddst = DM; t.nd0 = 32 * nb; t.gain = g0; t.sc = nb < 8 ? 0.125f : 1.f; }
        else if ((r -= I1) < I2) { const int kb = r / 112, nb = r % 112; t.src = w_in; t.ldsrc = DIN; t.nsrc0 = 1568 + 32 * nb; t.k0 = 64 * kb; t.dst = WinT; t.lddst = DM; t.gain = g0; const int cc = 32 * nb;
            t.nd0 = cc < 512 ? PUF + cc : cc < 2048 ? WUH + (cc - 512) : PUS + (cc - 2048); }
        else if ((r -= I2) < I3) { const int kb = r / 64, nb = r % 64; t.src = w_out; t.ldsrc = DM; t.nsrc0 = 32 * nb; t.k0 = 64 * kb; t.dst = WoutT; t.lddst = DM; t.nd0 = 32 * nb; }
        else if ((r -= I3) < I4) { const int kb = r / 128, nb = r % 128; t.src = w_xkv; t.ldsrc = 2 * DM; t.nsrc0 = 32 * nb; t.k0 = 64 * kb; t.dst = WkvT; t.lddst = DM; t.nd0 = 32 * nb; }
        else if ((r -= I4) < I5) { const int kb = r / 64, nb = r % 64; t.src = w_xo; t.ldsrc = DM; t.nsrc0 = 32 * nb; t.k0 = 64 * kb; t.dst = WxoT; t.lddst = DM; t.nd0 = 32 * nb; }
        else if ((r -= I5) < I6) { const int kb = r / 352, nb = r % 352, c0 = 32 * nb; t.src = w_gu; t.ldsrc = 2 * DFF; t.nsrc0 = c0; t.k0 = 64 * kb; t.dst = WguT; t.lddst = DM; t.gain = g2;
            t.nd0 = c0 < DFF ? (c0 / 128) * 256 + (c0 % 128) : ((c0 - DFF) / 128) * 256 + 128 + ((c0 - DFF) % 128); }
        else { r -= I6; const int kb = r / 64, nb = r % 64; t.src = w_dn; t.ldsrc = DM; t.nsrc0 = 32 * nb; t.k0 = 64 * kb; t.dst = WdT; t.lddst = DFF; t.nd0 = 32 * nb; }
        return t; };
    { f32x4 va[8], vb[8]; int it = gw;
      if (it < ITOT) { TrItem ta = mk_item(it); tr_load(ta, va, lane);
          for (;;) { const int itb = it + NGW; const bool hb = itb < ITOT; TrItem tb = ta; if (hb) { tb = mk_item(itb); tr_load(tb, vb, lane); }
              tr_finish(ta, va, scr, lane); if (!hb) break;
              const int ita = itb + NGW; const bool ha = ita < ITOT; if (ha) { ta = mk_item(ita); tr_load(ta, va, lane); }
              tr_finish(tb, vb, scr, lane); if (!ha) break; it = ita; } } }
    for (int i = gt; i < DM * DM / 8; i += NGT) { const int k = i >> 8; const float s = g1[k] * 0.044194173824159216f;
        const f32x4 a = *(const GAS f32x4*)(w_xq + (size_t)i * 8), b = *(const GAS f32x4*)(w_xq + (size_t)i * 8 + 4);
        v4u o; o.x = pk2(a.x * s, a.y * s); o.y = pk2(a.z * s, a.w * s); o.z = pk2(b.x * s, b.y * s); o.w = pk2(b.z * s, b.w * s);
        *(GAS v4u*)(WqB + (size_t)i * 8) = o; }
    __syncthreads();
    { bf16* filtT = (bf16*)(ws + WS_FILT);
      const float* w1 = pin(P, 8) + (size_t)l * 33 * 64; const float* b1 = pin(P, 9) + l * 64; const float* w2 = pin(P, 10) + (size_t)l * 64 * 64; const float* b2 = pin(P, 11) + l * 64;
      const float* w3 = pin(P, 12) + (size_t)l * 64 * 2048; const float* fr = pin(P, 13) + l * 64; const float* dec = pin(P, 14) + (size_t)l * 2048;
      LAS float* ft = (LAS float*)lds; LAS float* h1 = ft + 16 * 34; LAS float* h2 = h1 + 16 * 64;
      LAS float* w1s = h2 + 16 * 64; LAS float* w2s = w1s + 33 * 64;
      for (int i = tid; i < 33 * 64; i += NTHR) w1s[i] = w1[i];
      for (int i = tid; i < 64 * 64; i += NTHR) w2s[i] = w2[i];
      __syncthreads();
      for (int pg = bid; pg < SEQ / 16; pg += G) {
          if (tid < 256) { const int p = tid >> 4, i = tid & 15; const float t = (float)(pg * 16 + p) * (1.0f / SEQ);
              const float f = 1e-4f + (float)i * ((15.0f - 1e-4f) / 15.0f); const float rev = t * f; ft[p * 34 + 1 + i] = __builtin_amdgcn_cosf(rev); ft[p * 34 + 17 + i] = -__builtin_amdgcn_sinf(rev);
              if (i == 0) ft[p * 34] = t; }
          __syncthreads();
#pragma unroll
          for (int e = 0; e < 2; ++e) { const int o = tid + 512 * e, p = o >> 6, j = o & 63; float a = b1[j];
#pragma unroll 11
              for (int i = 0; i < 33; ++i) a += ft[p * 34 + i] * w1s[i * 64 + j];
              h1[p * 64 + j] = __builtin_amdgcn_sinf(fr[j] * a * 0.15915494309189535f); }
          __syncthreads();
#pragma unroll
          for (int e = 0; e < 2; ++e) { const int o = tid + 512 * e, p = o >> 6, j = o & 63; float a = b2[j];
#pragma unroll 16
              for (int i = 0; i < 64; ++i) a += h1[p * 64 + i] * w2s[i * 64 + j];
              h2[j * 16 + p] = __builtin_amdgcn_sinf(fr[j] * a * 0.15915494309189535f); }
          __syncthreads();
#pragma unroll 1
          for (int q = 0; q < 4; ++q) { const int n = tid + 512 * q; float a[16];
#pragma unroll
              for (int p = 0; p < 16; ++p) a[p] = 0.f;
#pragma unroll 1
              for (int j0 = 0; j0 < 64; j0 += 16) { float wv[16];
#pragma unroll
                  for (int jj = 0; jj < 16; ++jj) wv[jj] = w3[(j0 + jj) * 2048 + n];
#pragma unroll
                  for (int jj = 0; jj < 16; ++jj) { const LAS f32x4* hp = (const LAS f32x4*)(h2 + (j0 + jj) * 16); const f32x4 ha = hp[0], hb = hp[1], hc = hp[2], hd = hp[3]; const float w = wv[jj];
                      a[0] += ha.x * w; a[1] += ha.y * w; a[2] += ha.z * w; a[3] += ha.w * w; a[4] += hb.x * w; a[5] += hb.y * w; a[6] += hb.z * w; a[7] += hb.w * w;
                      a[8] += hc.x * w; a[9] += hc.y * w; a[10] += hc.z * w; a[11] += hc.w * w; a[12] += hd.x * w; a[13] += hd.y * w; a[14] += hd.z * w; a[15] += hd.w * w; } }
              const float dc = fabsf(dec[n]);
#pragma unroll
              for (int p4 = 0; p4 < 4; ++p4) { f32x4 o;
                  o.x = a[4 * p4 + 0] * __expf(-(float)(pg * 16 + 4 * p4 + 0) * (1.0f / SEQ) * dc); o.y = a[4 * p4 + 1] * __expf(-(float)(pg * 16 + 4 * p4 + 1) * (1.0f / SEQ) * dc);
                  o.z = a[4 * p4 + 2] * __expf(-(float)(pg * 16 + 4 * p4 + 2) * (1.0f / SEQ) * dc); o.w = a[4 * p4 + 3] * __expf(-(float)(pg * 16 + 4 * p4 + 3) * (1.0f / SEQ) * dc);
                  *(GAS v2u*)(filtT + (size_t)n * SEQ + pg * 16 + 4 * p4) = (v2u){pk2(o.x, o.y), pk2(o.z, o.w)}; } }
          __syncthreads();
      } }
    if (l == 0) { bf16* xb = (bf16*)(ws + WS_XB); float* rss = (float*)(ws + WS_RSS); const float* xin = pin(P, 0);
      for (int m = gw; m < MTOK; m += NGW) { const GAS f32x4* xr = (const GAS f32x4*)(xin + (size_t)m * DM) + lane; f32x4 v[8]; float ss = 0.f;
#pragma unroll
          for (int j = 0; j < 8; ++j) { v[j] = xr[64 * j]; ss += (v[j].x * v[j].x + v[j].y * v[j].y) + (v[j].z * v[j].z + v[j].w * v[j].w); }
          ss = wave_sum(ss); GAS v2u* o8 = (GAS v2u*)(xb + (size_t)m * DM) + lane;
#pragma unroll
          for (int j = 0; j < 8; ++j) { v2u w; w.x = pk2(v[j].x, v[j].y); w.y = pk2(v[j].z, v[j].w); o8[64 * j] = w; }
          if (lane < 32) rss[(size_t)m * 32 + lane] = lane == 0 ? ss : 0.f; } }
    if (l == 0) {
        typedef float f32x2 __attribute__((ext_vector_type(2)));
        __syncthreads();
        LAS f32x2* tw = (LAS f32x2*)lds;
        for (int i = tid; i < 4096; i += NTHR) { const float rv = (float)i * (1.0f / 4096.0f); tw[i] = (f32x2){__builtin_amdgcn_cosf(rv) * 0.001381067932f, __builtin_amdgcn_sinf(rv) * 0.001381067932f}; }
        __syncthreads();
        bf16* C2 = (bf16*)(ws + WS_C2); bf16* S2 = (bf16*)(ws + WS_S2);
        for (int i = gt; i < 2048 * (FK1 / 8); i += NGT) { const int srow = i / (FK1 / 8), t0 = (i % (FK1 / 8)) * 8; float cv[8];
#pragma unroll
            for (int e = 0; e < 8; ++e) cv[e] = (t0 + e) <= 2048 ? tw[(srow * (t0 + e)) & 4095].x : 0.f;
            v4u oc; oc.x = pk2(cv[0], cv[1]); oc.y = pk2(cv[2], cv[3]); oc.z = pk2(cv[4], cv[5]); oc.w = pk2(cv[6], cv[7]);
            *(GAS v4u*)(C2 + (size_t)srow * FK1 + t0) = oc; }
        for (int i = gt; i < 2048 * 256; i += NGT) { const int srow = i >> 8, t0 = (i & 255) * 8; float sv[8];
#pragma unroll
            for (int e = 0; e < 8; ++e) sv[e] = tw[(srow * (t0 + e)) & 4095].y;
            v4u os; os.x = pk2(sv[0], sv[1]); os.y = pk2(sv[2], sv[3]); os.z = pk2(sv[4], sv[5]); os.w = pk2(sv[6], sv[7]);
            *(GAS v4u*)(S2 + (size_t)srow * 2048 + t0) = os; }
        bf16* A1 = (bf16*)(ws + WS_A1);
        for (int i = gt; i < 512 * 256; i += NGT) { const int r = i >> 8, k = i & 255, gl = r >> 8, ri = (r >> 7) & 1, cp = r & 127, kg = k >> 7, cc = k & 127;
            float v = 0.f; if (kg == gl) { const float rv = (float)((cc * cp) & 127) * (1.0f / 128.0f); v = ri == 0 ? __builtin_amdgcn_cosf(rv) : -__builtin_amdgcn_sinf(rv); }
            A1[i] = (bf16)f2bf(v); }
        __syncthreads();
    }
    if (l == 0) { bf16* memn = (bf16*)(ws + WS_MEMN);
      for (int m = gw; m < NB * NMEM; m += NGW) norm_row_gain_bf16(pin(P, 1) + (size_t)m * DM, memn + (size_t)m * DM, pin(P, 19), lane); }
}


typedef short gbf16x8 __attribute__((ext_vector_type(8)));
constexpr int GP = 72;
__device__ __forceinline__ f32x4 mma16(const LAS bf16* A, const LAS bf16* Bt, int K, int lane, f32x4 acc) {
    const int r = lane & 15, q = lane >> 4;
#pragma unroll
    for (int k0 = 0; k0 < 64; k0 += 32) { if (k0 < K) {
        const gbf16x8 a = *(const LAS gbf16x8*)(A + r * GP + k0 + 8 * q), b = *(const LAS gbf16x8*)(Bt + r * GP + k0 + 8 * q);
        acc = __builtin_amdgcn_mfma_f32_16x16x32_bf16(a, b, acc, 0, 0, 0); } }
    return acc;
}
constexpr int RP = 72;
__device__ __forceinline__ v4u gla_ld64(const bf16* proj, int tok0, int col0, int tid) { return *(const GAS v4u*)(proj + (size_t)(tok0 + (tid >> 3)) * NPROJ + col0 + (tid & 7) * 8); }
__device__ __forceinline__ v4u gla_ld128(const bf16* proj, int tok0, int col0, int id) { return *(const GAS v4u*)(proj + (size_t)(tok0 + (id >> 4)) * NPROJ + col0 + (id & 15) * 8); }
__device__ __forceinline__ void gla_st64(LAS bf16* raw, v4u v, int tid) { *(LAS v4u*)(raw + (tid >> 3) * RP + (tid & 7) * 8) = v; }
__device__ __forceinline__ void gla_st_vT(LAS bf16* vT, v4u v, int id) {
    const int i = id >> 4, c0 = (id & 15) * 8; const unsigned w[4] = {v.x, v.y, v.z, v.w};
#pragma unroll
    for (int e = 0; e < 8; ++e) vT[(c0 + e) * GP + i] = (bf16)((e & 1) ? (w[e >> 1] >> 16) : (w[e >> 1] & 0xffffu));
}
constexpr int LRP = 40;
__device__ __forceinline__ void gla_cumsum_lds(const LAS bf16* lrraw, const LAS float* gwl, const float* gkb_, int h, int dir, LAS float* bL, LAS float* tot, int tid) {
    const GAS float* gkb = (const GAS float*)gkb_;
    const int k = tid & 63, seg = tid >> 6;
    const float bias = gkb[dir * 256 + h * 64 + k];
    float w[16];
#pragma unroll
    for (int r = 0; r < 16; ++r) w[r] = gwl[(dir * 16 + r) * 64 + k];
    float c[8];
#pragma unroll
    for (int e = 0; e < 8; ++e) { const LAS v4u* lp = (const LAS v4u*)(lrraw + (8 * seg + e) * LRP + dir * 16); const v4u a = lp[0], b = lp[1];
        float pre = bias;
        pre += bflo(a.x) * w[0] + bfhi(a.x) * w[1] + bflo(a.y) * w[2] + bfhi(a.y) * w[3] + bflo(a.z) * w[4] + bfhi(a.z) * w[5] + bflo(a.w) * w[6] + bfhi(a.w) * w[7];
        pre += bflo(b.x) * w[8] + bfhi(b.x) * w[9] + bflo(b.y) * w[10] + bfhi(b.y) * w[11] + bflo(b.z) * w[12] + bfhi(b.z) * w[13] + bflo(b.w) * w[14] + bfhi(b.w) * w[15];
        c[e] = log_sigmoid_f(pre) * (1.f / 16.f); }
    if (dir == 0) {
#pragma unroll
        for (int e = 1; e < 8; ++e) c[e] += c[e - 1];
        tot[seg * 64 + k] = c[7];
    } else {
#pragma unroll
        for (int e = 6; e >= 0; --e) c[e] += c[e + 1];
        tot[seg * 64 + k] = c[0];
    }
    __syncthreads();
    float off = 0.f;
#pragma unroll
    for (int s2 = 0; s2 < 8; ++s2) { const float tv = tot[s2 * 64 + k]; if (dir == 0 ? (s2 < seg) : (s2 > seg)) off += tv; }
#pragma unroll
    for (int e = 0; e < 8; ++e) bL[(8 * seg + e) * 64 + k] = c[e] + off;
    __syncthreads();
}
__device__ __forceinline__ v4u gla_ld_lr(const bf16* proj, int tok0, int tid) { return *(const GAS v4u*)(proj + (size_t)(tok0 + ((tid & 255) >> 2)) * NPROJ + PLR + (tid & 3) * 8); }
__device__ __forceinline__ void gla_st_lr(LAS bf16* lrraw, v4u v, int tid) { if (tid < 256) *(LAS v4u*)(lrraw + (tid >> 2) * LRP + (tid & 3) * 8) = v; }
__device__ __forceinline__ void gla_stage_gkw(const float* gkw_, int h, LAS float* gwl, int tid) {
    const GAS float* gkw = (const GAS float*)gkw_;
#pragma unroll
    for (int e = 0; e < 4; ++e) { const int i = tid + 512 * e, dr = i >> 6, k = i & 63; gwl[i] = gkw[dr * 256 + h * 64 + k]; }
}
__device__ __forceinline__ void gla_g1(const bf16* proj, const float* gkw, const float* gkb, bf16* GU_, float* GD_, LAS unsigned char* lds, int tid, int lane, int wave, int bid, int G) {
    GAS bf16* GU = (GAS bf16*)GU_; GAS float* GD = (GAS float*)GD_;
    LAS bf16* vT = (LAS bf16*)lds; LAS bf16* kdT = (LAS bf16*)(lds + 18432); LAS float* bL = (LAS float*)(lds + 27648); LAS float* tot = (LAS float*)(lds + 44032);
    LAS bf16* kraw = (LAS bf16*)(lds + 46080); LAS bf16* lrraw = (LAS bf16*)(lds + 55296); LAS float* gwl = (LAS float*)(lds + 60416);
    int unit = bid; if (unit >= 2048) return;
    int hcur = -1; v4u rk, rlr, rv0, rv1;
    { const int bh = unit >> 6, n = unit & 63, h = bh & 3, tok0 = (bh >> 2) * SEQ + n * 64;
      rk = gla_ld64(proj, tok0, PK + h * 64, tid); rlr = gla_ld_lr(proj, tok0, tid);
      rv0 = gla_ld128(proj, tok0, PV + h * 128, tid); rv1 = gla_ld128(proj, tok0, PV + h * 128, tid + 512); }
    for (;;) { const int bh = unit >> 6, h = bh & 3;
        gla_st64(kraw, rk, tid); gla_st_lr(lrraw, rlr, tid); gla_st_vT(vT, rv0, tid); gla_st_vT(vT, rv1, tid + 512);
        if (h != hcur) { gla_stage_gkw(gkw, h, gwl, tid); hcur = h; }
        __syncthreads();
        const int nunit = unit + G; const bool more = nunit < 2048;
        if (more) { const int bh2 = nunit >> 6, n2 = nunit & 63, h2 = bh2 & 3, tok2 = (bh2 >> 2) * SEQ + n2 * 64;
            rk = gla_ld64(proj, tok2, PK + h2 * 64, tid); rlr = gla_ld_lr(proj, tok2, tid);
            rv0 = gla_ld128(proj, tok2, PV + h2 * 128, tid); rv1 = gla_ld128(proj, tok2, PV + h2 * 128, tid + 512); }
        for (int dir = 0; dir < 2; ++dir) {
            gla_cumsum_lds(lrraw, gwl, gkb, h, dir, bL, tot, tid);
            { const int k = tid & 63, seg = tid >> 6; const float bl = bL[(dir ? 0 : 63) * 64 + k]; unsigned w[4];
#pragma unroll
              for (int e = 0; e < 4; ++e) { const int i0 = 8 * seg + 2 * e;
                  const float k0 = bf2f(kraw[i0 * RP + k]) * __expf(bl - bL[i0 * 64 + k]);
                  const float k1 = bf2f(kraw[(i0 + 1) * RP + k]) * __expf(bl - bL[(i0 + 1) * 64 + k]);
                  w[e] = pk2(k0, k1); }
              *(LAS v4u*)(kdT + k * GP + 8 * seg) = (v4u){w[0], w[1], w[2], w[3]};
              if (seg == 0) GD[(size_t)(unit * 2 + dir) * 64 + k] = __expf(bl); }
            __syncthreads();
            { GAS bf16* U = GU + (size_t)(unit * 2 + dir) * 8192; const int r = lane & 15, q = lane >> 4;
#pragma unroll
              for (int kt = 0; kt < 4; ++kt) { f32x4 acc = (f32x4){0.f, 0.f, 0.f, 0.f};
                  acc = mma16(vT + 16 * wave * GP, kdT + 16 * kt * GP, 64, lane, acc);
#pragma unroll
                  for (int j = 0; j < 4; ++j) U[(16 * wave + 4 * q + j) * 64 + 16 * kt + r] = (bf16)f2bf(acc[j]); } }
            __syncthreads();
        }
        if (!more) break; unit = nunit;
    }
}
__device__ __forceinline__ void gla_g3(const bf16* proj, const float* gkw, const float* gkb, const float* gnorm_, const bf16* GS_, bf16* mix_, LAS unsigned char* lds, int tid, int lane, int wave, int bid, int G) {
    const GAS float* gnorm = (const GAS float*)gnorm_; const GAS bf16* GS = (const GAS bf16*)GS_; GAS bf16* mix = (GAS bf16*)mix_; const GAS bf16* gproj = (const GAS bf16*)proj;
    LAS bf16* vT = (LAS bf16*)lds; LAS bf16* ST = (LAS bf16*)(lds + 18432); LAS bf16* qd = (LAS bf16*)(lds + 36864); LAS bf16* kd = (LAS bf16*)(lds + 46080);
    LAS bf16* qb = (LAS bf16*)(lds + 55296); LAS bf16* Pm = (LAS bf16*)(lds + 64512); LAS float* bL = (LAS float*)(lds + 73728); LAS float* tot = (LAS float*)(lds + 90112); LAS float* rs = (LAS float*)(lds + 92160);
    LAS bf16* qraw = (LAS bf16*)(lds + 92672); LAS bf16* kraw = (LAS bf16*)(lds + 101888); LAS bf16* lrraw = (LAS bf16*)(lds + 111104); LAS float* gwl = (LAS float*)(lds + 116224);
    const int r = lane & 15, q = lane >> 4, wr = wave >> 1, wc = wave & 1;
    int unit = bid; if (unit >= 2048) return;
    int hcur = -1; v4u rq, rk, rlr, rv0, rv1, rs0a, rs0b, rs1a, rs1b; unsigned short rg[16];
#define G3_LOAD(UNIT) do { const int bh_ = (UNIT) >> 6, n_ = (UNIT) & 63, h_ = bh_ & 3, tok_ = (bh_ >> 2) * SEQ + n_ * 64; \
        rq = gla_ld64(proj, tok_, PQ + h_ * 64, tid); rk = gla_ld64(proj, tok_, PK + h_ * 64, tid); rlr = gla_ld_lr(proj, tok_, tid); \
        rv0 = gla_ld128(proj, tok_, PV + h_ * 128, tid); rv1 = gla_ld128(proj, tok_, PV + h_ * 128, tid + 512); \
        { const GAS bf16* S0_ = GS + (size_t)((UNIT) * 2) * 8192; rs0a = *(const GAS v4u*)(S0_ + tid * 8); rs0b = *(const GAS v4u*)(S0_ + 4096 + tid * 8); rs1a = *(const GAS v4u*)(S0_ + 8192 + tid * 8); rs1b = *(const GAS v4u*)(S0_ + 12288 + tid * 8); } \
        _Pragma("unroll") for (int j_ = 0; j_ < 4; ++j_) _Pragma("unroll") for (int ct_ = 0; ct_ < 4; ++ct_) rg[j_ * 4 + ct_] = gproj[(size_t)(tok_ + 16 * wr + 4 * q + j_) * NPROJ + PG + h_ * 128 + 64 * wc + 16 * ct_ + r]; } while (0)
    G3_LOAD(unit);
    for (;;) { const int bh = unit >> 6, n = unit & 63, bb = bh >> 2, h = bh & 3, tok0 = bb * SEQ + n * 64;
        gla_st64(qraw, rq, tid); gla_st64(kraw, rk, tid); gla_st_lr(lrraw, rlr, tid); gla_st_vT(vT, rv0, tid); gla_st_vT(vT, rv1, tid + 512);
        if (h != hcur) { gla_stage_gkw(gkw, h, gwl, tid); hcur = h; }
        const v4u s0a = rs0a, s0b = rs0b, s1a = rs1a, s1b = rs1b; unsigned short gcur[16];
#pragma unroll
        for (int e = 0; e < 16; ++e) gcur[e] = rg[e];
        __syncthreads();
        const int nunit = unit + G; const bool more = nunit < 2048;
        if (more) G3_LOAD(nunit);
        f32x4 acc[4];
#pragma unroll
        for (int ct = 0; ct < 4; ++ct) acc[ct] = (f32x4){0.f, 0.f, 0.f, 0.f};
        for (int dir = 0; dir < 2; ++dir) {
            gla_cumsum_lds(lrraw, gwl, gkb, h, dir, bL, tot, tid);
            { const int i = tid >> 3, kg = (tid & 7) * 8;
              const v4u qv = *(const LAS v4u*)(qraw + i * RP + kg), kv = *(const LAS v4u*)(kraw + i * RP + kg);
              const f32x4 b0 = *(const LAS f32x4*)(bL + i * 64 + kg), b1 = *(const LAS f32x4*)(bL + i * 64 + kg + 4), r0 = *(const LAS f32x4*)(bL + 32 * 64 + kg), r1 = *(const LAS f32x4*)(bL + 32 * 64 + kg + 4);
              const unsigned qw[4] = {qv.x, qv.y, qv.z, qv.w}, kw[4] = {kv.x, kv.y, kv.z, kv.w}; unsigned oqd[4], okd[4], oqb[4];
#pragma unroll
              for (int e2 = 0; e2 < 4; ++e2) { const float bva = e2 < 2 ? b0[2 * e2] : b1[2 * e2 - 4], bvb = e2 < 2 ? b0[2 * e2 + 1] : b1[2 * e2 - 3], bra = e2 < 2 ? r0[2 * e2] : r1[2 * e2 - 4], brb = e2 < 2 ? r0[2 * e2 + 1] : r1[2 * e2 - 3];
                  const float qa = bflo(qw[e2]), qbv = bfhi(qw[e2]), ka = bflo(kw[e2]), kb = bfhi(kw[e2]);
                  oqd[e2] = pk2(qa * __expf(bva - bra), qbv * __expf(bvb - brb)); okd[e2] = pk2(ka * __expf(bra - bva), kb * __expf(brb - bvb)); oqb[e2] = pk2(qa * __expf(bva), qbv * __expf(bvb)); }
              *(LAS v4u*)(qd + i * GP + kg) = (v4u){oqd[0], oqd[1], oqd[2], oqd[3]}; *(LAS v4u*)(kd + i * GP + kg) = (v4u){okd[0], okd[1], okd[2], okd[3]}; *(LAS v4u*)(qb + i * GP + kg) = (v4u){oqb[0], oqb[1], oqb[2], oqb[3]};
              *(LAS v4u*)(ST + (tid >> 3) * GP + (tid & 7) * 8) = dir ? s1a : s0a; *(LAS v4u*)(ST + (64 + (tid >> 3)) * GP + (tid & 7) * 8) = dir ? s1b : s0b; }
            __syncthreads();
#pragma unroll
            for (int e = 0; e < 2; ++e) { const int jt = wc * 2 + e; f32x4 s = (f32x4){0.f, 0.f, 0.f, 0.f};
                s = mma16(qd + 16 * wr * GP, kd + 16 * jt * GP, 64, lane, s);
#pragma unroll
                for (int j = 0; j < 4; ++j) { const int i = 16 * wr + 4 * q + j, jj = 16 * jt + r; const bool keep = dir == 0 ? (jj <= i) : (jj > i);
                    Pm[i * GP + jj] = (bf16)f2bf(keep ? s[j] : 0.f); } }
            __syncthreads();
#pragma unroll
            for (int ct = 0; ct < 4; ++ct) { const int v0 = 64 * wc + 16 * ct;
                acc[ct] = mma16(Pm + 16 * wr * GP, vT + v0 * GP, 64, lane, acc[ct]);
                acc[ct] = mma16(qb + 16 * wr * GP, ST + v0 * GP, 64, lane, acc[ct]); }
            __syncthreads();
        }
        float ss[4];
#pragma unroll
        for (int j = 0; j < 4; ++j) { float a = 0.f;
#pragma unroll
            for (int ct = 0; ct < 4; ++ct) a += acc[ct][j] * acc[ct][j];
            a += __shfl_xor(a, 1); a += __shfl_xor(a, 2); a += __shfl_xor(a, 4); a += __shfl_xor(a, 8); ss[j] = a; }
        if (r == 0) {
#pragma unroll
            for (int j = 0; j < 4; ++j) rs[(16 * wr + 4 * q + j) * 2 + wc] = ss[j]; }
        __syncthreads();
#pragma unroll
        for (int j = 0; j < 4; ++j) { const int i = 16 * wr + 4 * q + j; const float rstd = rsqrtf((rs[i * 2] + rs[i * 2 + 1]) * (1.f / 128.f) + EPS);
#pragma unroll
            for (int ct = 0; ct < 4; ++ct) { const int v = 64 * wc + 16 * ct + r; const float gate = bf2f(gcur[j * 4 + ct]);
                mix[(size_t)(tok0 + i) * DM + h * 128 + v] = (bf16)f2bf(acc[ct][j] * rstd * gnorm[v] * pg8::silu_f(gate)); } }
        __syncthreads();
        if (!more) break; unit = nunit;
    }
#undef G3_LOAD
}

__device__ __forceinline__ void gla_g2(const bf16* GU_, const float* GD_, bf16* GS_, int tid, int bid, int G) {
    typedef float f32x2 __attribute__((ext_vector_type(2)));
    const GAS unsigned* GU = (const GAS unsigned*)GU_; const GAS float* GD = (const GAS float*)GD_; GAS unsigned* GS = (GAS unsigned*)GS_;
    for (int it = bid * NTHR + tid; it < 32 * 2 * 4096; it += G * NTHR) { const int e2 = it & 4095, dir = (it >> 12) & 1, bh = it >> 13, k = (2 * e2) & 63;
        float S0 = 0.f, S1 = 0.f;
#pragma unroll 1
        for (int nb = 0; nb < 64; nb += 16) { unsigned u[16]; f32x2 d[16];
#pragma unroll
            for (int j = 0; j < 16; ++j) { const int nv = nb + j, n = dir ? 63 - nv : nv; const size_t ud = (size_t)((bh * 64 + n) * 2 + dir);
                u[j] = GU[ud * 4096 + e2]; d[j] = *(const GAS f32x2*)(GD + ud * 64 + k); }
            asm volatile("" ::: "memory");
#pragma unroll
            for (int j = 0; j < 16; ++j) { const int nv = nb + j, n = dir ? 63 - nv : nv; const size_t ud = (size_t)((bh * 64 + n) * 2 + dir);
                GS[ud * 4096 + e2] = pk2(S0, S1); S0 = S0 * d[j].x + bflo(u[j]); S1 = S1 * d[j].y + bfhi(u[j]); } }
    }
}
__device__ __forceinline__ float sconv3(const bf16* proj, int b, int t, int col, const float* w, int wld, int wc) {
    const bf16* p = proj + (size_t)(b * SEQ + t) * NPROJ + col;
    float a = w[wld + wc] * bf2f(p[0]);
    if (t > 0) a += w[wc] * bf2f(p[-NPROJ]);
    if (t < SEQ - 1) a += w[2 * wld + wc] * bf2f(p[NPROJ]);
    return a;
}


typedef float f32x16 __attribute__((ext_vector_type(16)));
typedef short hbf16x8 __attribute__((ext_vector_type(8)));
constexpr int HY_PITCH = 4360, HY_ZOFF = 96;
constexpr int HY_ZBYTES = 8 * HY_PITCH * 2;
constexpr int HY_HRN = 8200;
constexpr int HY_LDS_BYTES = HY_ZBYTES + 2 * HY_HRN * 2;

__device__ __forceinline__ hbf16x8 hy_afrag(LAS const unsigned char* hrb, int m0) {
    const int p = m0 + 4096, odd = p & 1;
    const LAS unsigned* src = (const LAS unsigned*)(hrb + odd * (HY_HRN * 2) + (p + odd) * 2);
    v4u w; w.x = src[0]; w.y = src[1]; w.z = src[2]; w.w = src[3];
    return __builtin_bit_cast(hbf16x8, w);
}
__device__ __forceinline__ void hy_fill_hr(const float* filtT_, int order, int c, LAS unsigned char* hrb, int tid) {
    const GAS bf16* filtT = (const GAS bf16*)filtT_;
    const GAS bf16* hf = filtT + (size_t)(order * 1024 + c) * SEQ; const GAS bf16* hb = filtT + (size_t)(order * 1024 + 512 + c) * SEQ;
    LAS bf16* c0 = (LAS bf16*)hrb; LAS bf16* c1 = c0 + HY_HRN;
    asm volatile("" : "+v"(tid));
    bf16 v[16];
#pragma unroll
    for (int k = 0; k < 16; ++k) { const int m = tid + 512 * k - 4096, am = m < 0 ? -m : m; v[k] = (m <= 0 ? hf : hb)[am > 4095 ? 4095 : am]; }
#pragma unroll
    for (int k = 0; k < 16; ++k) { const int q = tid + 512 * k; const bf16 v0 = q == 0 ? (bf16)0 : v[k]; c0[q] = v0; c1[q + 1] = v0; }
    if (tid < 8) { c0[8192 + tid] = 0; if (tid < 7) c1[8193 + tid] = 0; }
    if (tid == 0) c1[0] = 0;
}
__device__ __forceinline__ void hy_conv(LAS const unsigned char* zbb, LAS const unsigned char* hrb, int w, int lane, f32x4 (&acc)[8][2]) {
    const int n = lane & 15, b = n >> 1, il = n & 1, kq = lane >> 4, i = n;
#pragma unroll
    for (int p = 0; p < 8; ++p)
#pragma unroll
        for (int hh = 0; hh < 2; ++hh) acc[p][hh] = (f32x4){0.f, 0.f, 0.f, 0.f};
    const LAS unsigned char* zl = zbb + (b * HY_PITCH + HY_ZOFF + 32 * il + 8 * kq) * 2 - 64;
    const int mb = -32 * (16 * w + 1) - i + 8 * kq;
    hbf16x8 A[16][2];
#pragma unroll
    for (int d = 0; d <= 14; ++d) { A[(1 + d) & 15][0] = hy_afrag(hrb, mb - 32 * d); A[(1 + d) & 15][1] = hy_afrag(hrb, mb - 32 * d - 16); }
    hbf16x8 b0 = *(const LAS hbf16x8*)zl;
#pragma unroll 1
    for (int c = 0; c < 9; ++c) {
#pragma unroll
        for (int u = 0; u < 16; ++u) { const int s = 16 * c + u;
            if (s <= 128) {
                hbf16x8 nb0 = b0;
                if (s < 128) {
                    A[(16 - u) & 15][0] = hy_afrag(hrb, mb + 32 * (s + 1)); A[(16 - u) & 15][1] = hy_afrag(hrb, mb + 32 * (s + 1) - 16);
                    nb0 = *(const LAS hbf16x8*)(zl + (s + 1) * 64); }
#pragma unroll
                for (int hh = 0; hh < 2; ++hh)
#pragma unroll
                    for (int p = 0; p < 8; ++p) acc[p][hh] = __builtin_amdgcn_mfma_f32_16x16x32_bf16(A[(17 - u + 2 * p) & 15][hh], b0, acc[p][hh], 0, 0, 0);
                b0 = nb0; } }
    }
}
__device__ __forceinline__ v2u hy_conv4_fin(v2u v, bf16 l, bf16 r, int t0, float w0, float w1, float w2) {
    const float xl = t0 > 0 ? bf2f(l) : 0.f, xr = t0 < SEQ - 4 ? bf2f(r) : 0.f;
    const float x0 = bflo(v.x), x1 = bfhi(v.x), x2 = bflo(v.y), x3 = bfhi(v.y);
    v2u o; o.x = pk2(w0 * xl + w1 * x0 + w2 * x1, w0 * x0 + w1 * x1 + w2 * x2); o.y = pk2(w0 * x1 + w1 * x2 + w2 * x3, w0 * x2 + w1 * x3 + w2 * xr); return o;
}
__device__ __forceinline__ void hy_toeplitz_phase(const bf16* uT, const float* cw_, const float* filtT, const float* skip_, bf16* yT, LAS unsigned char* lds, int tid, int lane, int wave, int bid, int G) {
    const GAS float* skip = (const GAS float*)skip_; const GAS float* cw = (const GAS float*)cw_; const GAS bf16* ur = (const GAS bf16*)uT;
    LAS unsigned char* zbb = lds; LAS unsigned char* hrb = lds + HY_ZBYTES;
    for (int i = tid; i < HY_ZBYTES / 4; i += NTHR) ((LAS unsigned*)zbb)[i] = 0u;
    __syncthreads();
    const int w = wave;
    for (int c = bid; c < 512; c += G) {
        { const float w0 = cw[c], w1 = cw[1536 + c], w2 = cw[3072 + c];
#pragma unroll 8
          for (int bb = 0; bb < 8; ++bb) { const int q = tid; const GAS bf16* src = ur + (size_t)c * MTOK + bb * SEQ + q * 8;
              const v4u v = *(const GAS v4u*)src; const float xlr = bf2f(src[q > 0 ? -1 : 0]), xrr = bf2f(src[q < 511 ? 8 : 7]); const float xl = q > 0 ? xlr : 0.f, xr = q < 511 ? xrr : 0.f;
              const float x[10] = {xl, bflo(v.x), bfhi(v.x), bflo(v.y), bfhi(v.y), bflo(v.z), bfhi(v.z), bflo(v.w), bfhi(v.w), xr};
              v4u o; o.x = pk2(w0 * x[0] + w1 * x[1] + w2 * x[2], w0 * x[1] + w1 * x[2] + w2 * x[3]); o.y = pk2(w0 * x[2] + w1 * x[3] + w2 * x[4], w0 * x[3] + w1 * x[4] + w2 * x[5]);
              o.z = pk2(w0 * x[4] + w1 * x[5] + w2 * x[6], w0 * x[5] + w1 * x[6] + w2 * x[7]); o.w = pk2(w0 * x[6] + w1 * x[7] + w2 * x[8], w0 * x[7] + w1 * x[8] + w2 * x[9]);
              *(LAS v4u*)(zbb + (bb * HY_PITCH + HY_ZOFF + q * 8) * 2) = o; } }
        hy_fill_hr(filtT, 0, c, hrb, tid);
        __syncthreads();
        f32x4 acc[8][2];
        hy_conv(zbb, hrb, w, lane, acc);
        { unsigned zp[8][2][2];
        int ln = lane; asm volatile("" : "+v"(ln)); const int n = ln & 15, b = n >> 1, il = n & 1, kq = ln >> 4;
        { const float sk = skip[c]; const float a0 = cw[512 + c], a1 = cw[1536 + 512 + c], a2 = cw[3072 + 512 + c];
          const int tb = 32 * (16 * w + il) + 4 * kq; const GAS bf16* xb0 = ur + (size_t)(512 + c) * MTOK + b * SEQ + tb;
#pragma unroll
          for (int gh = 0; gh < 2; ++gh) { v2u rv[8]; bf16 rl[8], rr[8];
#pragma unroll
            for (int k = 0; k < 8; ++k) { const int off = 64 * (4 * gh + (k >> 1)) + 16 * (k & 1); rv[k] = *(const GAS v2u*)(xb0 + off); rl[k] = xb0[off - 1]; rr[k] = xb0[off + 4]; }
            asm volatile("" ::: "memory");
#pragma unroll
            for (int k = 0; k < 8; ++k) { const int g = 4 * gh + (k >> 1), rq = k & 1, t0 = tb + 64 * g + 16 * rq;
                const v2u xv = hy_conv4_fin(rv[k], rl[k], rr[k], t0, a0, a1, a2);
                const v2u vv = *(const LAS v2u*)(zbb + (b * HY_PITCH + HY_ZOFF + t0) * 2);
                const float z0 = bflo(xv.x) * (acc[g][rq][0] + bflo(vv.x) * sk), z1 = bfhi(xv.x) * (acc[g][rq][1] + bfhi(vv.x) * sk);
                const float z2 = bflo(xv.y) * (acc[g][rq][2] + bflo(vv.y) * sk), z3 = bfhi(xv.y) * (acc[g][rq][3] + bfhi(vv.y) * sk);
                zp[g][rq][0] = pk2(z0, z1); zp[g][rq][1] = pk2(z2, z3); } } }
        __syncthreads();
#pragma unroll
        for (int g = 0; g < 8; ++g)
#pragma unroll
            for (int rq = 0; rq < 2; ++rq) { const int t0 = 32 * (16 * w + 2 * g + il) + 16 * rq + 4 * kq;
                *(LAS v2u*)(zbb + (b * HY_PITCH + HY_ZOFF + t0) * 2) = (v2u){zp[g][rq][0], zp[g][rq][1]}; } }
        hy_fill_hr(filtT, 1, c, hrb, tid);
        __syncthreads();
        hy_conv(zbb, hrb, w, lane, acc);
        { int ln = lane; asm volatile("" : "+v"(ln)); const int n = ln & 15, b = n >> 1, il = n & 1, kq = ln >> 4; const float sk = skip[512 + c]; const float a0 = cw[1024 + c], a1 = cw[1536 + 1024 + c], a2 = cw[3072 + 1024 + c];
          const int tb = 32 * (16 * w + il) + 4 * kq; const GAS bf16* xb0 = ur + (size_t)(1024 + c) * MTOK + b * SEQ + tb;
#pragma unroll
          for (int gh = 0; gh < 2; ++gh) { v2u rv[8]; bf16 rl[8], rr[8];
#pragma unroll
            for (int k = 0; k < 8; ++k) { const int off = 64 * (4 * gh + (k >> 1)) + 16 * (k & 1); rv[k] = *(const GAS v2u*)(xb0 + off); rl[k] = xb0[off - 1]; rr[k] = xb0[off + 4]; }
            asm volatile("" ::: "memory");
#pragma unroll
            for (int k = 0; k < 8; ++k) { const int g = 4 * gh + (k >> 1), rq = k & 1, t0 = tb + 64 * g + 16 * rq;
                const v2u xv = hy_conv4_fin(rv[k], rl[k], rr[k], t0, a0, a1, a2);
                const v2u zv = *(const LAS v2u*)(zbb + (b * HY_PITCH + HY_ZOFF + t0) * 2);
                const float z0 = bflo(zv.x), z1 = bfhi(zv.x), z2 = bflo(zv.y), z3 = bfhi(zv.y);
                const float o0 = bflo(xv.x) * (acc[g][rq][0] + z0 * sk), o1 = bfhi(xv.x) * (acc[g][rq][1] + z1 * sk);
                const float o2 = bflo(xv.y) * (acc[g][rq][2] + z2 * sk), o3 = bfhi(xv.y) * (acc[g][rq][3] + z3 * sk);
                *(GAS v2u*)(yT + (size_t)c * MTOK + b * SEQ + t0) = (v2u){pk2(o0, o1), pk2(o2, o3)}; } } }
        __syncthreads();
    }
}
__device__ __forceinline__ void hy_transpose_out(const bf16* yT, const float* gC, bf16* mix, LAS unsigned char* lds, int tid, int lane, int wave, int bid, int G) {
    constexpr int TP = 66;
    LAS bf16* T = (LAS bf16*)lds;
    for (int tile = bid; tile < MTOK / 64; tile += G) { const int tok0 = tile * 64;
#pragma unroll
        for (int pass = 0; pass < 8; ++pass) { const int c = (tid >> 3) + 64 * pass, sg = tid & 7;
            const v4u v = *(const GAS v4u*)(yT + (size_t)c * MTOK + tok0 + 8 * sg);
            LAS unsigned* d = (LAS unsigned*)(T + c * TP + 8 * sg); d[0] = v.x; d[1] = v.y; d[2] = v.z; d[3] = v.w; }
        __syncthreads();
#pragma unroll 1
        for (int k = 0; k < 8; ++k) { const int s = wave * 8 + k; float y[8]; float ss = 0.f;
#pragma unroll
            for (int e = 0; e < 8; ++e) { y[e] = bf2f(T[(lane * 8 + e) * TP + s]); ss += y[e] * y[e]; }
            const float rstd = rsqrtf(wave_sum(ss) * (1.f / 512.f) + EPS);
            const f32x4 g0 = *(const GAS f32x4*)(gC + lane * 8), g1 = *(const GAS f32x4*)(gC + lane * 8 + 4);
            v4u o; o.x = pk2(y[0] * rstd * g0.x, y[1] * rstd * g0.y); o.y = pk2(y[2] * rstd * g0.z, y[3] * rstd * g0.w);
            o.z = pk2(y[4] * rstd * g1.x, y[5] * rstd * g1.y); o.w = pk2(y[6] * rstd * g1.z, y[7] * rstd * g1.w);
            *(GAS v4u*)(mix + (size_t)(tok0 + s) * DM + 1024 + lane * 8) = o; }
        __syncthreads();
    }
}

__device__ __forceinline__ void phase_c_misc(const Params& P, unsigned char* ws, float* xres, int l, LAS unsigned char* lds, int tid, int lane, int wave, int bid, int G) {
    const bf16* proj = (const bf16*)(ws + WS_PROJ); bf16* mix = (bf16*)(ws + WS_MIX);
    { const bf16* FU2 = (const bf16*)(ws + WS_FU2); bf16* FE = (bf16*)(ws + WS_FE); bf16* FO = (bf16*)(ws + WS_FO); float* Y2K = (float*)(ws + WS_Y2K);
      const int gw = bid * NWAVES + wave, NGW = G * NWAVES;
      for (int col = gw; col < 4096; col += NGW) { const bf16* ur = FU2 + (size_t)col * 8192; const bf16* ui = ur + 4096; float alt = 0.f;
#pragma unroll
          for (int j = 0; j < 4; ++j) { const int t0 = 8 * (lane + 64 * j);
              const v4u a = *(const GAS v4u*)(ur + t0), c = *(const GAS v4u*)(ui + t0);
              const v4u ma = *(const GAS v4u*)(ur + 4096 - t0 - 8), mc = *(const GAS v4u*)(ui + 4096 - t0 - 8);
              const float m0rr = bf2f(ur[t0 ? 4096 - t0 : 0]), m0ir = bf2f(ui[t0 ? 4096 - t0 : 0]); const float m0r = t0 ? m0rr : 0.f, m0i = t0 ? m0ir : 0.f;
              float er[8], oi[8];
              const unsigned aw[4] = {a.x, a.y, a.z, a.w}, cw[4] = {c.x, c.y, c.z, c.w}, maw[4] = {ma.x, ma.y, ma.z, ma.w}, mcw[4] = {mc.x, mc.y, mc.z, mc.w};
#pragma unroll
              for (int e = 0; e < 8; ++e) { const float xr = (e & 1) ? bfhi(aw[e >> 1]) : bflo(aw[e >> 1]), xi = (e & 1) ? bfhi(cw[e >> 1]) : bflo(cw[e >> 1]);
                  float mr, mi; if (e == 0) { mr = m0r; mi = m0i; } else { const int q = 8 - e; mr = (q & 1) ? bfhi(maw[q >> 1]) : bflo(maw[q >> 1]); mi = (q & 1) ? bfhi(mcw[q >> 1]) : bflo(mcw[q >> 1]); }
                  er[e] = xr + mr; oi[e] = (t0 + e) ? xi - mi : 0.f; alt += (e & 1) ? -er[e] : er[e]; }
              v4u oe, oo; oe.x = pk2(er[0], er[1]); oe.y = pk2(er[2], er[3]); oe.z = pk2(er[4], er[5]); oe.w = pk2(er[6], er[7]);
              oo.x = pk2(oi[0], oi[1]); oo.y = pk2(oi[2], oi[3]); oo.z = pk2(oi[4], oi[5]); oo.w = pk2(oi[6], oi[7]);
              *(GAS v4u*)(FE + (size_t)col * FK1 + t0) = oe; *(GAS v4u*)(FO + (size_t)col * 2048 + t0) = oo; }
          const float e2k = bf2f(ur[2048]);
          if (lane < 16) { v4u z = (v4u){0u, 0u, 0u, 0u}; if (lane == 0) z.x = f2bf(e2k); *(GAS v4u*)(FE + (size_t)col * FK1 + 2048 + 8 * lane) = z; }
          alt = wave_sum(alt) + e2k;
          if (lane == 0) Y2K[col] = alt * 0.001381067932f; } }
    { const float* cw = pin(P, 16) + (size_t)l * 3 * 512; const float* gD = pin(P, 17) + (size_t)(l * 3 + 2) * 512;
      const int gw = bid * NWAVES + wave, NGW = G * NWAVES, c0 = lane * 8;
      float w0[8], w1[8], w2[8], gd[8];
#pragma unroll
      for (int e = 0; e < 8; ++e) { w0[e] = cw[c0 + e]; w1[e] = cw[512 + c0 + e]; w2[e] = cw[1024 + c0 + e]; gd[e] = gD[c0 + e]; }
      for (int tk0 = gw; tk0 < MTOK; tk0 += 2 * NGW) {
          v4u vb[2], vc[2], vh[2], vcm[2], vhm[2], vcp[2], vhp[2];
#pragma unroll
          for (int h = 0; h < 2; ++h) { const int tk = tk0 + h * NGW, token = tk < MTOK ? tk : MTOK - 1, t = token & (SEQ - 1);
              const bf16* p = proj + (size_t)token * NPROJ + PUS + c0; const int om = t > 0 ? -NPROJ : 0, op = t < SEQ - 1 ? NPROJ : 0;
              vb[h] = *(const GAS v4u*)p; vc[h] = *(const GAS v4u*)(p + 512); vh[h] = *(const GAS v4u*)(p + 1024);
              vcm[h] = *(const GAS v4u*)(p + 512 + om); vhm[h] = *(const GAS v4u*)(p + 1024 + om); vcp[h] = *(const GAS v4u*)(p + 512 + op); vhp[h] = *(const GAS v4u*)(p + 1024 + op); }
#pragma unroll
          for (int h = 0; h < 2; ++h) { const int token = tk0 + h * NGW, t = token & (SEQ - 1); const float km = t > 0 ? 1.f : 0.f, kp = t < SEQ - 1 ? 1.f : 0.f;
              float y[8]; float ss = 0.f;
#pragma unroll
              for (int e2 = 0; e2 < 4; ++e2) {
                  const float a0 = km * w0[2 * e2] * bflo(vcm[h][e2]) * bflo(vhm[h][e2]) + w1[2 * e2] * bflo(vc[h][e2]) * bflo(vh[h][e2]) + kp * w2[2 * e2] * bflo(vcp[h][e2]) * bflo(vhp[h][e2]);
                  const float a1 = km * w0[2 * e2 + 1] * bfhi(vcm[h][e2]) * bfhi(vhm[h][e2]) + w1[2 * e2 + 1] * bfhi(vc[h][e2]) * bfhi(vh[h][e2]) + kp * w2[2 * e2 + 1] * bfhi(vcp[h][e2]) * bfhi(vhp[h][e2]);
                  y[2 * e2] = bflo(vb[h][e2]) * a0; y[2 * e2 + 1] = bfhi(vb[h][e2]) * a1; ss += y[2 * e2] * y[2 * e2] + y[2 * e2 + 1] * y[2 * e2 + 1]; }
              const float rstd = rsqrtf(wave_sum(ss) * (1.f / 512.f) + EPS);
              v4u o; o.x = pk2(y[0] * rstd * gd[0], y[1] * rstd * gd[1]); o.y = pk2(y[2] * rstd * gd[2], y[3] * rstd * gd[3]); o.z = pk2(y[4] * rstd * gd[4], y[5] * rstd * gd[5]); o.w = pk2(y[6] * rstd * gd[6], y[7] * rstd * gd[7]);
              if (token < MTOK) *(GAS v4u*)(mix + (size_t)token * DM + 1536 + c0) = o; } } }
    __syncthreads();
    gla_g1(proj, pin(P, 4) + (size_t)l * 2 * 16 * 256, pin(P, 5) + (size_t)l * 512, (bf16*)(ws + WS_GU), (float*)(ws + WS_GD), lds, tid, lane, wave, bid, G);
}

__device__ __forceinline__ void phase_d(const Params& P, unsigned char* ws, float* xres, int l, LAS unsigned char* lds, int tid, int lane, int wave, int bid, int G) {
    if (!(P.pad1 & 2)) gla_g3((const bf16*)(ws + WS_PROJ), pin(P, 4) + (size_t)l * 2 * 16 * 256, pin(P, 5) + (size_t)l * 512, pin(P, 6) + (size_t)l * 128, (const bf16*)(ws + WS_GS), (bf16*)(ws + WS_MIX), lds, tid, lane, wave, bid, G);
}
__device__ __forceinline__ void phase_e(const Params& P, unsigned char* ws, float* xres, int l, LAS unsigned char* lds, int tid, int lane, int wave, int bid, int G) {
    hy_transpose_out((const bf16*)(ws + WS_YT), pin(P, 17) + (size_t)(l * 3 + 1) * 512, (bf16*)(ws + WS_MIX), lds, tid, lane, wave, bid, G);
    { const bf16* FY = (const bf16*)(ws + WS_FY); const float* gB = pin(P, 17) + (size_t)(l * 3 + 0) * 512; bf16* mix = (bf16*)(ws + WS_MIX);
      const int gw = bid * NWAVES + wave, NGW = G * NWAVES;
      const f32x4 g0 = *(const GAS f32x4*)(gB + lane * 8), g1 = *(const GAS f32x4*)(gB + lane * 8 + 4);
      const float* Y2K = (const float*)(ws + WS_Y2K);
      for (int it0 = gw; it0 < MTOK; it0 += 2 * NGW) {
          v4u ya[2], yb[2];
#pragma unroll
          for (int h = 0; h < 2; ++h) { const int i2 = it0 + h * NGW, it = i2 < MTOK ? i2 : MTOK - 1, b = it >> 12, sp = it & (SEQ - 1);
              const int sf = sp < 2048 ? sp : 4096 - sp, sfc = sf > 2047 ? 2047 : sf;
              const bf16* src = FY + (size_t)sfc * 4096 + b * 512 + lane * 8; const bf16* srb = src + (size_t)2048 * 4096;
              ya[h] = *(const GAS v4u*)src; yb[h] = *(const GAS v4u*)srb; }
#pragma unroll
          for (int h = 0; h < 2; ++h) { const int it = it0 + h * NGW, b = it >> 12, sp = it & (SEQ - 1); const float sg = sp < 2048 ? 1.f : -1.f;
              f32x4 a = (f32x4){bflo(ya[h].x), bfhi(ya[h].x), bflo(ya[h].y), bfhi(ya[h].y)} + (f32x4){bflo(yb[h].x), bfhi(yb[h].x), bflo(yb[h].y), bfhi(yb[h].y)} * sg;
              f32x4 c = (f32x4){bflo(ya[h].z), bfhi(ya[h].z), bflo(ya[h].w), bfhi(ya[h].w)} + (f32x4){bflo(yb[h].z), bfhi(yb[h].z), bflo(yb[h].w), bfhi(yb[h].w)} * sg;
              if (sp == 2048) { a = *(const GAS f32x4*)(Y2K + (b & 7) * 512 + lane * 8); c = *(const GAS f32x4*)(Y2K + (b & 7) * 512 + lane * 8 + 4); }
              const float ss = (a.x * a.x + a.y * a.y) + (a.z * a.z + a.w * a.w) + (c.x * c.x + c.y * c.y) + (c.z * c.z + c.w * c.w);
              const float rstd = rsqrtf(wave_sum(ss) * (1.f / 512.f) + EPS);
              v4u o; o.x = pk2(a.x * rstd * g0.x, a.y * rstd * g0.y); o.y = pk2(a.z * rstd * g0.z, a.w * rstd * g0.w); o.z = pk2(c.x * rstd * g1.x, c.y * rstd * g1.y); o.w = pk2(c.z * rstd * g1.z, c.w * rstd * g1.w);
              if (it < MTOK) *(GAS v4u*)(mix + (size_t)it * DM + 512 + lane * 8) = o; } } }
}
__device__ __forceinline__ void phase_softmax(const float* sc, bf16* Pm, int lane, int wave, int bid, int G) {
    const int gw = bid * NWAVES + wave, NGW = G * NWAVES;
    for (int it = gw; it < MTOK * 4; it += NGW) {
        const f32x4 v = *((const GAS f32x4*)(sc + (size_t)it * 256) + lane);
        const float m = wave_max(fmaxf(fmaxf(v.x, v.y), fmaxf(v.z, v.w)));
        const float e0 = __expf(v.x - m), e1 = __expf(v.y - m), e2 = __expf(v.z - m), e3 = __expf(v.w - m);
        const float inv = 1.0f / wave_sum((e0 + e1) + (e2 + e3));
        v2u w; w.x = pk2(e0 * inv, e1 * inv); w.y = pk2(e2 * inv, e3 * inv);
        *((GAS v2u*)(Pm + (size_t)it * 256) + lane) = w;
    }
}

#ifndef EPIRES_XB
#define EPIRES_XB (GAS bf16*)xb
#endif
#ifndef GEMM_ALIGN
#define GEMM_ALIGN false
#endif
#ifndef GEMM_SP2
#define GEMM_SP2 true
#endif
constexpr int NPH = 11, NSTEPS = NL * NPH + 1;
template <class Sched, bool COLS = false> __device__ __forceinline__ pg8::RstdTab build_rstd(const Sched& S, const float* RS, LAS float* tab, int tid) {
    pg8::RstdTab T; T.tab = tab; T.RS = (const GAS float*)RS; T.pm0 = T.pm1 = T.pm2 = T.pm3 = -1; int n = 0; pg8::Unit u;
    for (int i = 0; S.next(i, u); ++i) { const int pm = COLS ? u.pn : u.pm;
        if (pm != T.pm0 && pm != T.pm1 && pm != T.pm2 && pm != T.pm3) { if (n == 0) T.pm0 = pm; else if (n == 1) T.pm1 = pm; else if (n == 2) T.pm2 = pm; else if (n == 3) T.pm3 = pm; ++n; } }
    const int row = tid >> 1, half = tid & 1;
#pragma unroll
    for (int sl = 0; sl < 4; ++sl) { const int pm = sl == 0 ? T.pm0 : sl == 1 ? T.pm1 : sl == 2 ? T.pm2 : T.pm3;
        if (pm >= 0) { const GAS float* p = (const GAS float*)RS + (size_t)(pm * 256 + row) * 32 + half * 16;
            const f32x4 a = *(const GAS f32x4*)p, b = *(const GAS f32x4*)(p + 4), c = *(const GAS f32x4*)(p + 8), d = *(const GAS f32x4*)(p + 12);
            float t = (((a.x + a.y) + (a.z + a.w)) + ((b.x + b.y) + (b.z + b.w))) + (((c.x + c.y) + (c.z + c.w)) + ((d.x + d.y) + (d.z + d.w)));
            t += __shfl_xor(t, 1);
            if (half == 0) tab[sl * 256 + row] = rsqrtf(t * (1.0f / DM) + EPS); } }
    __syncthreads();
    return T;
}
#define IN(st) (lo <= (st) && (st) < hi)
#define SEAM(stp_) do { if ((stp_) + 1 < hi) { XcdBarrier b2_; b2_.bar = opaque_p(bar.bar); b2_.x = (unsigned)opaque_i((int)bar.x); b2_.st = bar.st; xcd_barrier(b2_, tid); } } while (0)
#define OPAQ() int tid = wave0 * 64 + (int)__builtin_amdgcn_mbcnt_hi(~0u, __builtin_amdgcn_mbcnt_lo(~0u, 0u)); asm volatile("" : "+v"(tid)); const int bid = opaque_i(bid0), G = opaque_i(G0); unsigned char* ws = opaque_p(ws0); float* xres = opaque_p(out0); const unsigned ldsa = (unsigned)opaque_i((int)(unsigned)(size_t)lds0)
#define LOCALS() OPAQ(); LAS unsigned char* lds = (LAS unsigned char*)(size_t)ldsa; const int lane = tid & 63, wave = __builtin_amdgcn_readfirstlane(tid >> 6); \
        bf16* xb = (bf16*)(ws + WS_XB); bf16* proj = (bf16*)(ws + WS_PROJ); bf16* mix = (bf16*)(ws + WS_MIX); (void)lds; (void)lane; (void)wave; (void)xb; (void)proj; (void)mix
template <int L> __device__ __forceinline__ void layer_body(const Params& P, const XcdBarrier& bar, int lo, int hi, int wave0, int bid0, int G0, unsigned char* ws0, float* out0, LAS unsigned char* lds0) {
    constexpr int l = L; const int s0 = l * NPH;
        if (s0 + NPH <= lo || s0 >= hi) return;
        if (IN(s0 + 0)) { LOCALS(); phase_a(P, ws, xres, l, lds, tid, lane, wave, bid, G); SEAM(s0 + 0); }
        if (IN(s0 + 1)) { LOCALS();
            { pg8::Gemm g{xb, (const bf16*)(ws + WS_WIN), DM, DM, DM}; pg8::TileOrder S; S.init(MTOK / 256, NPROJ / 256, G, bid, DM, DM);
            pg8::EpiBf16 E{(GAS bf16*)proj, NPROJ, build_rstd(S, (const float*)(ws + WS_RSS), (LAS float*)(lds + LDSCTL_OFF + 1024 + 8192), tid)}; pg8::gemm_phase<pg8::EpiBf16, pg8::TileOrder, GEMM_ALIGN, GEMM_SP2>(lds + RING_OFF, g, S, E, tid);
            }
            { pg8::Gemm g{(const bf16*)(ws + WS_MEMN), (const bf16*)(ws + WS_WKV), DM, DM, DM}; pg8::TileOrder S; S.init(NB * NMEM / 256, 2 * DM / 256, G, (bid + G / 2) % G, DM, DM);
            pg8::EpiBf16 E{(GAS bf16*)(ws + WS_KVB), 2 * DM, pg8::RstdTab{nullptr, nullptr, -1, -1, -1, -1}}; pg8::gemm_phase<pg8::EpiBf16, pg8::TileOrder, GEMM_ALIGN, GEMM_SP2>(lds + RING_OFF, g, S, E, tid); }
            { pg8::Gemm g{(const bf16*)(ws + WS_WIN) + (size_t)WUH * DM, xb, DM, DM, DM}; pg8::TileOrder S; S.init(1536 / 256, MTOK / 256, G, bid, DM, DM);
              pg8::EpiBf16T E{(GAS bf16*)(ws + WS_UT), MTOK, build_rstd<pg8::TileOrder, true>(S, (const float*)(ws + WS_RSS), (LAS float*)(lds + LDSCTL_OFF + 1024 + 8192), tid)};
              pg8::gemm_phase<pg8::EpiBf16T, pg8::TileOrder, GEMM_ALIGN, GEMM_SP2>(lds + RING_OFF, g, S, E, tid); }
            SEAM(s0 + 1); }
        if (IN(s0 + 2)) { LOCALS();
            { pg8::Gemm g{(const bf16*)(ws + WS_KVB), (const bf16*)(ws + WS_WQB), 2 * DM, DM, 512}; pg8::PairOrder<0> S{G, bid};
            pg8::EpiBf16 E{(GAS bf16*)(ws + WS_MT), DM, pg8::RstdTab{nullptr, nullptr, -1, -1, -1, -1}}; pg8::gemm_phase<pg8::EpiBf16, pg8::PairOrder<0>, GEMM_ALIGN, GEMM_SP2>(lds + RING_OFF, g, S, E, tid); }
            { pg8::Gemm g{(const bf16*)(ws + WS_WXO), (const bf16*)(ws + WS_KVB), DM, 2 * DM, 512}; pg8::PairOrder<1> S{G, bid};
            pg8::EpiBf16 E{(GAS bf16*)(ws + WS_VWO), 1024, pg8::RstdTab{nullptr, nullptr, -1, -1, -1, -1}}; pg8::gemm_phase<pg8::EpiBf16, pg8::PairOrder<1>, GEMM_ALIGN, GEMM_SP2>(lds + RING_OFF, g, S, E, tid); }
            { pg8::Gemm g{(const bf16*)(ws + WS_A1), proj, 256, NPROJ, 256}; pg8::FnetAOrder S{G, bid};
            pg8::EpiFnetA E{(GAS bf16*)(ws + WS_FU2)}; pg8::gemm_phase<pg8::EpiFnetA, pg8::FnetAOrder, GEMM_ALIGN, GEMM_SP2>(lds + RING_OFF, g, S, E, tid); }
            SEAM(s0 + 2); }
        if (IN(s0 + 3)) { LOCALS(); phase_c_misc(P, ws, xres, l, lds, tid, lane, wave, bid, G); SEAM(s0 + 3); }
        if (IN(s0 + 4)) { LOCALS();
            { pg8::Gemm g{(const bf16*)(ws + WS_C2), (const bf16*)(ws + WS_FE), FK1, FK1, FK1}; pg8::TileOrder S; S.init(8, 16, G, bid, FK1, FK1);
              pg8::EpiBf16 E{(GAS bf16*)(ws + WS_FY), 4096, pg8::RstdTab{nullptr, nullptr, -1, -1, -1, -1}}; pg8::gemm_phase<pg8::EpiBf16, pg8::TileOrder, GEMM_ALIGN, GEMM_SP2>(lds + RING_OFF, g, S, E, tid); }
            { pg8::Gemm g{(const bf16*)(ws + WS_S2), (const bf16*)(ws + WS_FO), 2048, 2048, 2048}; pg8::TileOrder S; S.init(8, 16, G, (bid + G / 2) % G, 2048, 2048);
              pg8::EpiBf16 E{(GAS bf16*)(ws + WS_FY) + (size_t)2048 * 4096, 4096, pg8::RstdTab{nullptr, nullptr, -1, -1, -1, -1}}; pg8::gemm_phase<pg8::EpiBf16, pg8::TileOrder, GEMM_ALIGN, GEMM_SP2>(lds + RING_OFF, g, S, E, tid); }
            gla_g2((const bf16*)(ws + WS_GU), (const float*)(ws + WS_GD), (bf16*)(ws + WS_GS), tid, bid, G);
            __syncthreads();
            hy_toeplitz_phase((const bf16*)(ws + WS_UT), pin(P, 7) + (size_t)l * 3 * 1536, (const float*)(ws + WS_FILT), pin(P, 15) + (size_t)l * 1024, (bf16*)(ws + WS_YT), lds, tid, lane, wave, bid, G);
            SEAM(s0 + 4); }
        if (IN(s0 + 5)) { LOCALS(); phase_d(P, ws, xres, l, lds, tid, lane, wave, bid, G); __syncthreads(); phase_e(P, ws, xres, l, lds, tid, lane, wave, bid, G); SEAM(s0 + 5); }
        if (IN(s0 + 6)) { LOCALS();
            pg8::Gemm g{mix, (const bf16*)(ws + WS_WOUT), DM, DM, DM}; pg8::TileOrder S; S.init(MTOK / 256, DM / 256, G, bid, DM, DM);
            pg8::EpiRes E{l == 0 ? (const GAS float*)pin(P, 0) : (const GAS float*)nullptr, DM, (GAS bf16*)xb, (GAS float*)(ws + WS_RSS)}; pg8::gemm_phase<pg8::EpiRes, pg8::TileOrder, GEMM_ALIGN, GEMM_SP2>(lds + RING_OFF, g, S, E, tid);
            SEAM(s0 + 6); }
        if (IN(s0 + 7)) { LOCALS();
            pg8::Gemm g{xb, (const bf16*)(ws + WS_MT), DM, DM, DM}; pg8::TileOrder S; S.init(MTOK / 256, 4, G, bid, DM, DM, 16, 4);
            pg8::EpiSoftmax E{(GAS bf16*)mix, 1024, (LAS float*)(lds + LDSCTL_OFF + 1024), (LAS float*)(lds + LDSCTL_OFF + 1024 + 4096), build_rstd(S, (const float*)(ws + WS_RSS), (LAS float*)(lds + LDSCTL_OFF + 1024 + 8192), tid)}; pg8::gemm_phase<pg8::EpiSoftmax, pg8::TileOrder, true, GEMM_SP2>(lds + RING_OFF, g, S, E, tid);
            SEAM(s0 + 7); }
        if (IN(s0 + 8)) { LOCALS();
            pg8::Gemm g{mix, (const bf16*)(ws + WS_VWO), 1024, 1024, 1024}; pg8::TileOrder S; S.init(MTOK / 256, DM / 256, G, bid, 1024, 1024, 16, 8);
            pg8::EpiRes E{(const GAS float*)nullptr, DM, (GAS bf16*)xb, (GAS float*)(ws + WS_RSS)}; pg8::gemm_phase<pg8::EpiRes, pg8::TileOrder, GEMM_ALIGN, GEMM_SP2>(lds + RING_OFF, g, S, E, tid);
            SEAM(s0 + 8); }
        if (IN(s0 + 9)) { LOCALS();
            pg8::Gemm g{xb, (const bf16*)(ws + WS_WGU), DM, DM, DM}; pg8::TileOrder S; S.init(MTOK / 256, 2 * DFF / 256, G, bid, DM, DM);
            pg8::EpiSwiglu E{(GAS bf16*)proj, DFF, build_rstd(S, (const float*)(ws + WS_RSS), (LAS float*)(lds + LDSCTL_OFF + 1024 + 8192), tid)}; pg8::gemm_phase<pg8::EpiSwiglu, pg8::TileOrder, GEMM_ALIGN, GEMM_SP2>(lds + RING_OFF, g, S, E, tid);
            SEAM(s0 + 9); }
        if (IN(s0 + 10)) { LOCALS();
            pg8::Gemm g{proj, (const bf16*)(ws + WS_WD), DFF, DFF, DFF}; pg8::TileOrder S; S.init(MTOK / 256, DM / 256, G, bid, DFF, DFF);
            pg8::EpiRes E{(const GAS float*)nullptr, DM, (GAS bf16*)xb, (GAS float*)(ws + WS_RSS)}; pg8::gemm_phase<pg8::EpiRes, pg8::TileOrder, GEMM_ALIGN, GEMM_SP2>(lds + RING_OFF, g, S, E, tid);
            SEAM(s0 + 10); }
    }
__global__ void __launch_bounds__(NTHR, 2) fwd_kernel(Params P) {
    extern __shared__ __attribute__((aligned(16))) unsigned char lds_raw[];
    LAS unsigned char* lds = (LAS unsigned char*)lds_raw; LAS unsigned char* const lds0 = lds;
    const int tid = threadIdx.x, lane = tid & 63, wave = __builtin_amdgcn_readfirstlane(tid >> 6), bid = blockIdx.x, G = gridDim.x;
    volatile LAS unsigned* MISC = (volatile LAS unsigned*)(lds + MISC_OFF);
    for (int u = tid; u < (LDS_BYTES - LDSCTL_OFF) / 4; u += NTHR) ((LAS unsigned*)(lds + LDSCTL_OFF))[u] = 0u;
    __syncthreads();
    unsigned char* ws = P.ws;
    XcdBarrier bar = xcd_barrier_post((unsigned*)(ws + WS_CTL) + CW_BAR + P.pad0 * XCD_BAR_WORDS, MISC + 8, tid);
    const int lo = P.step_lo, hi = P.step_hi;
    const int wave0 = wave, bid0 = bid, G0 = G; unsigned char* const ws0 = ws; float* const out0 = P.out;
    layer_body<0>(P, bar, lo, hi, wave0, bid0, G0, ws0, out0, lds0);
    layer_body<1>(P, bar, lo, hi, wave0, bid0, G0, ws0, out0, lds0);
    layer_body<2>(P, bar, lo, hi, wave0, bid0, G0, ws0, out0, lds0);
    layer_body<3>(P, bar, lo, hi, wave0, bid0, G0, ws0, out0, lds0);
    if (IN(NL * NPH)) { LOCALS(); const int gw = bid * NWAVES + wave, NGW = G * NWAVES;
        for (int m = gw; m < MTOK; m += NGW) final_norm_row(xb + (size_t)m * DM, xres + (size_t)m * DM, pin(P, 25), lane); }
#undef IN
#undef SEAM
}

#ifndef MK_SPLIT
#define MK_SPLIT 0
#endif
extern "C" void kernel_launch(void* const* d_in, const int* in_sizes, int n_in, void* d_out, int out_size, void* d_ws, size_t ws_size, hipStream_t stream) {
    static int grid = 0;
    if (grid == 0) {
        if (n_in != 26 || in_sizes[0] != MTOK * DM || out_size != MTOK * DM || ws_size < WS_END) { fprintf(stderr, "kernel_launch: unexpected shapes (n_in %d, in0 %d, out %d, ws %zu); nothing launched\n", n_in, n_in > 0 ? in_sizes[0] : -1, out_size, ws_size); grid = -1; return; }
        int dev = 0, cus = 0, per_cu = 0;
        if (hipGetDevice(&dev) != hipSuccess || hipDeviceGetAttribute(&cus, hipDeviceAttributeMultiprocessorCount, dev) != hipSuccess) { grid = -1; return; }
        if (hipFuncSetAttribute((const void*)fwd_kernel, hipFuncAttributeMaxDynamicSharedMemorySize, LDS_BYTES) != hipSuccess) { fprintf(stderr, "kernel_launch: hipFuncSetAttribute failed\n"); grid = -1; return; }
        if (hipOccupancyMaxActiveBlocksPerMultiprocessor(&per_cu, (const void*)fwd_kernel, NTHR, LDS_BYTES) != hipSuccess || per_cu < 1) { fprintf(stderr, "kernel_launch: occupancy query says %d\n", per_cu); }
        (void)hipGetLastError();
        grid = cus;
    }
    if (grid < 0) return;
    if (hipMemsetAsync((char*)d_ws + WS_CTL, 0, CTL_ZERO_BYTES, stream) != hipSuccess) return;
    Params p{};
    for (int i = 0; i < 26; ++i) p.in[i] = (const float*)d_in[i];
    p.out = (float*)d_out; p.ws = (unsigned char*)d_ws;
#if defined(PROBE_PH)
#ifndef PROBE_FLAGS
#define PROBE_FLAGS 0
#endif
    { int lo = 0; int li = 0;
      for (int l = 0; l < NL; ++l) { const int gk = l * NPH + PROBE_PH;
          p.pad0 = li++; p.step_lo = lo; p.step_hi = gk + 1; hipLaunchKernelGGL(fwd_kernel, dim3(grid), dim3(NTHR), LDS_BYTES, stream, p);
          p.pad0 = li++; p.step_lo = gk; p.step_hi = gk + 1; p.pad1 = PROBE_FLAGS; hipLaunchKernelGGL(fwd_kernel, dim3(grid), dim3(NTHR), LDS_BYTES, stream, p); p.pad1 = 0;
          lo = gk + 1; }
      p.pad0 = li++; p.step_lo = lo; p.step_hi = NSTEPS; hipLaunchKernelGGL(fwd_kernel, dim3(grid), dim3(NTHR), LDS_BYTES, stream, p); }
#elif MK_SPLIT
    for (int st = 0; st < NSTEPS; ++st) { p.pad0 = st; p.step_lo = st; p.step_hi = st + 1; hipLaunchKernelGGL(fwd_kernel, dim3(grid), dim3(NTHR), LDS_BYTES, stream, p); }
#else
    p.step_lo = 0; p.step_hi = NSTEPS; hipLaunchKernelGGL(fwd_kernel, dim3(grid), dim3(NTHR), LDS_BYTES, stream, p);
#endif
}
```

```cpp
#include <hip/hip_runtime.h>
#include <cstdio>
#include <cstdint>

namespace pg8 {
#define PG8_LAS __attribute__((address_space(3)))
#define PG8_GAS __attribute__((address_space(1)))
typedef unsigned short bf16_t;
typedef short bf16x8 __attribute__((ext_vector_type(8)));
typedef float f32x4 __attribute__((ext_vector_type(4)));
typedef unsigned u32x4 __attribute__((ext_vector_type(4)));
constexpr int BM = 256, BK = 64, HALF = 128, HTB = HALF * BK * 2  , STAGE_BYTES = 8 * HTB, NXCD = 8, WGM = 4;

__host__ __device__ __forceinline__ int lds_byte(int r, int c) { const int st = (r >> 4) * 2 + (c >> 5), rr = r & 15, cc = c & 31, ob = rr * 64 + cc * 2; return st * 1024 + (ob ^ (((ob >> 9) & 1) << 5)); }
__host__ __device__ __forceinline__ void stage_rc(int b, int& R, int& C) { const int st = b / 1024, sb = b % 1024, swz = sb ^ (((sb >> 9) & 1) << 5); R = (st >> 1) * 16 + swz / 64; C = (st & 1) * 32 + (swz % 64) / 2; }
__host__ __device__ __forceinline__ int perm32(int rho) { const int n = rho >> 4, i = rho & 15; return 8 * (i >> 2) + 4 * n + (i & 3); }

struct Unit { size_t aoff, boff; int pm, pn; };
struct Gemm { const bf16_t* A; const bf16_t* Bt; int lda, ldb, K; };

struct TileOrder {
    int nM, nN, nwg, G, c, bdiv, bmul; size_t atile, btile;
    __device__ void init(int nM_, int nN_, int G_, int c_, int lda, int ldb, int bdiv_ = 1 << 30, int bmul_ = 0) { nM = nM_; nN = nN_; nwg = nM * nN; G = G_; c = c_; bdiv = bdiv_; bmul = bmul_; atile = (size_t)BM * lda * 2; btile = (size_t)BM * ldb * 2; }
    __device__ bool next(int i, Unit& u) const {
        const long L = (long)i * G + c; if (L >= nwg) return false;
        int wgid = (int)L; { const int q = nwg / NXCD, r = nwg % NXCD, xcd = wgid % NXCD, off = wgid / NXCD; wgid = (xcd < r ? xcd * (q + 1) : r * (q + 1) + (xcd - r) * q) + off; }
        const int nig = WGM * nN, gid = wgid / nig, fm = gid * WGM, gsz = (nM - fm) < WGM ? (nM - fm) : WGM;
        u.pm = fm + ((wgid % nig) % gsz); u.pn = (wgid % nig) / gsz;
        u.aoff = (size_t)u.pm * atile; u.boff = (size_t)((u.pm / bdiv) * bmul + u.pn) * btile; return true;
    }
    __device__ __forceinline__ void a_ready(const Unit&) const {}
    __device__ __forceinline__ void done(const Unit&) const {}
};
template <int MODE> struct PairOrder {
    int G, c;
    __device__ bool next(int i, Unit& u) const {
        const long L = (long)i * G + c; if (L >= 256) return false;
        const int bh = (int)L >> 3, j = (int)L & 7, b = bh >> 2, h = bh & 3;
        if (MODE == 0) { u.aoff = ((size_t)(b * 256) * 4096 + h * 512) * 2; u.boff = ((size_t)(j * 256) * 2048 + h * 512) * 2; u.pm = b * 4 + h; u.pn = j; }
        else           { u.aoff = ((size_t)(j * 256) * 2048 + h * 512) * 2; u.boff = ((size_t)(b * 256) * 4096 + 2048 + h * 512) * 2; u.pm = b * 8 + j; u.pn = h; }
        return true;
    }
    __device__ __forceinline__ void a_ready(const Unit&) const {}
    __device__ __forceinline__ void done(const Unit&) const {}
};

struct FnetAOrder {
    int G, c;
    __device__ bool next(int i, Unit& u) const {
        const long L = (long)i * G + c; if (L >= 512) return false;
        const int combo = (int)L >> 5, rest = (int)L & 31, b = combo >> 1, gp = combo & 1, pml = rest >> 4, pn = rest & 15;
        u.aoff = (size_t)pml * 256 * 256 * 2; u.boff = ((size_t)(b * 4096 + pn * 256) * 3840 + 1792 + gp * 256) * 2; u.pm = b * 4 + gp * 2 + pml; u.pn = pn; return true;
    }
    __device__ __forceinline__ void a_ready(const Unit&) const {}
    __device__ __forceinline__ void done(const Unit&) const {}
};

__device__ __forceinline__ unsigned cvt_pk_bf16(float lo, float hi) { unsigned r; asm volatile("v_cvt_pk_bf16_f32 %0, %1, %2" : "=v"(r) : "v"(lo), "v"(hi)); return r; }

struct RstdTab { const PG8_LAS float* tab; const PG8_GAS float* RS; int pm0, pm1, pm2, pm3;
    __device__ __forceinline__ int slot(int pm) const { return !tab ? -2 : pm == pm0 ? 0 : pm == pm1 ? 1 : pm == pm2 ? 2 : pm == pm3 ? 3 : -1; }
    __device__ __forceinline__ void rows(const Unit& u, int wr, int fr, int fq, float (&rs)[2][4]) const {
        const int sl = slot(u.pm);
        if (sl == -2) {
#pragma unroll
            for (int ai = 0; ai < 2; ++ai)
#pragma unroll
                for (int m = 0; m < 4; ++m) rs[ai][m] = 1.0f;
        } else if (sl >= 0) {
#pragma unroll
            for (int ai = 0; ai < 2; ++ai)
#pragma unroll
                for (int m = 0; m < 4; ++m) rs[ai][m] = tab[sl * 256 + ai * HALF + wr * 64 + m * 16 + fr];
        } else {
#pragma unroll
            for (int ai = 0; ai < 2; ++ai)
#pragma unroll
                for (int m = 0; m < 4; ++m) { const PG8_GAS float* p = RS + (size_t)(u.pm * BM + ai * HALF + wr * 64 + m * 16 + fr) * 32 + fq * 8;
                    const f32x4 a = *(const PG8_GAS f32x4*)p, b = *(const PG8_GAS f32x4*)(p + 4);
                    float t = ((a[0] + a[1]) + (a[2] + a[3])) + ((b[0] + b[1]) + (b[2] + b[3])); t += __shfl_xor(t, 16); t += __shfl_xor(t, 32);
                    rs[ai][m] = rsqrtf(t * (1.0f / 2048.0f) + 1e-6f); }
        }
    }
};
struct EpiBf16 {
    static constexpr bool PERM = true, AFTER_DRAIN = false;
    PG8_GAS bf16_t* O; int ldc; RstdTab R;
    __device__ __forceinline__ void operator()(const f32x4 (&acc)[2][2][4][2], const Unit& u, int wr, int wc, int fr, int fq) const {
        const int row0 = u.pm * BM + wr * 64 + fr, col0 = u.pn * BM + wc * 32 + 8 * fq;
        float rs[2][4]; R.rows(u, wr, fr, fq, rs);
#pragma unroll
        for (int ai = 0; ai < 2; ++ai)
#pragma unroll
            for (int m = 0; m < 4; ++m) { PG8_GAS bf16_t* rowp = O + (size_t)(row0 + ai * HALF + m * 16) * ldc + col0;
#pragma unroll
                for (int bj = 0; bj < 2; ++bj) { const f32x4 v0 = acc[ai][bj][m][0] * rs[ai][m], v1 = acc[ai][bj][m][1] * rs[ai][m];
                    u32x4 w; w.x = cvt_pk_bf16(v0[0], v0[1]); w.y = cvt_pk_bf16(v0[2], v0[3]); w.z = cvt_pk_bf16(v1[0], v1[1]); w.w = cvt_pk_bf16(v1[2], v1[3]);
                    *(PG8_GAS u32x4*)(rowp + bj * HALF) = w; } }
    }
};
struct EpiBf16T {
    static constexpr bool PERM = true, AFTER_DRAIN = false;
    PG8_GAS bf16_t* O; int ldc; RstdTab R;
    __device__ __forceinline__ void operator()(const f32x4 (&acc)[2][2][4][2], const Unit& u, int wr, int wc, int fr, int fq) const {
        const int row0 = u.pm * BM + wr * 64 + fr, col0 = u.pn * BM + wc * 32 + 8 * fq;
        const int sl = R.slot(u.pn); f32x4 cs[2][2];
#pragma unroll
        for (int bj = 0; bj < 2; ++bj) { const int cl = bj * HALF + wc * 32 + 8 * fq;
            if (sl >= 0) { cs[bj][0] = *(const PG8_LAS f32x4*)(R.tab + sl * 256 + cl); cs[bj][1] = *(const PG8_LAS f32x4*)(R.tab + sl * 256 + cl + 4); }
            else {
#pragma unroll
                for (int e = 0; e < 8; ++e) { const PG8_GAS float* p = R.RS + (size_t)(u.pn * BM + cl + e) * 32; float t = 0.f;
#pragma unroll
                    for (int j = 0; j < 32; ++j) t += p[j];
                    cs[bj][e >> 2][e & 3] = rsqrtf(t * (1.0f / 2048.0f) + 1e-6f); } } }
#pragma unroll
        for (int ai = 0; ai < 2; ++ai)
#pragma unroll
            for (int m = 0; m < 4; ++m) { PG8_GAS bf16_t* rowp = O + (size_t)(row0 + ai * HALF + m * 16) * ldc + col0;
#pragma unroll
                for (int bj = 0; bj < 2; ++bj) { const f32x4 v0 = acc[ai][bj][m][0] * cs[bj][0], v1 = acc[ai][bj][m][1] * cs[bj][1];
                    u32x4 w; w.x = cvt_pk_bf16(v0[0], v0[1]); w.y = cvt_pk_bf16(v0[2], v0[3]); w.z = cvt_pk_bf16(v1[0], v1[1]); w.w = cvt_pk_bf16(v1[2], v1[3]);
                    *(PG8_GAS u32x4*)(rowp + bj * HALF) = w; } }
    }
};
struct EpiFnetA {
    static constexpr bool PERM = true, AFTER_DRAIN = false;
    PG8_GAS bf16_t* O;
    __device__ __forceinline__ void operator()(const f32x4 (&acc)[2][2][4][2], const Unit& u, int wr, int wc, int fr, int fq) const {
        const int col0 = u.pn * BM + wc * 32 + 8 * fq;
#pragma unroll
        for (int ai = 0; ai < 2; ++ai)
#pragma unroll
            for (int m = 0; m < 4; ++m) { PG8_GAS bf16_t* rowp = O + (size_t)(u.pm * 128 + wr * 64 + m * 16 + fr) * 8192 + ai * 4096 + col0;
#pragma unroll
                for (int bj = 0; bj < 2; ++bj) { const f32x4 v0 = acc[ai][bj][m][0], v1 = acc[ai][bj][m][1];
                    u32x4 w; w.x = cvt_pk_bf16(v0[0], v0[1]); w.y = cvt_pk_bf16(v0[2], v0[3]); w.z = cvt_pk_bf16(v1[0], v1[1]); w.w = cvt_pk_bf16(v1[2], v1[3]);
                    *(PG8_GAS u32x4*)(rowp + bj * HALF) = w; } }
    }
};
struct EpiF32 {
    static constexpr bool PERM = false, AFTER_DRAIN = false;
    PG8_GAS float* C; int ldc;
    __device__ __forceinline__ void operator()(const f32x4 (&acc)[2][2][4][2], const Unit& u, int wr, int wc, int fr, int fq) const {
        const int row0 = u.pm * BM + wr * 64 + fr, col0 = u.pn * BM + wc * 32 + 4 * fq;
#pragma unroll
        for (int ai = 0; ai < 2; ++ai)
#pragma unroll
            for (int m = 0; m < 4; ++m) { PG8_GAS float* rowp = C + (size_t)(row0 + ai * HALF + m * 16) * ldc + col0;
#pragma unroll
                for (int bj = 0; bj < 2; ++bj)
#pragma unroll
                    for (int n = 0; n < 2; ++n) *(PG8_GAS f32x4*)(rowp + bj * HALF + n * 16) = acc[ai][bj][m][n]; }
    }
};
struct EpiRes {
    static constexpr bool PERM = true, AFTER_DRAIN = false;
    const PG8_GAS float* Xs32; int ldc; PG8_GAS bf16_t* XB; PG8_GAS float* RS;
    __device__ __forceinline__ void operator()(const f32x4 (&acc)[2][2][4][2], const Unit& u, int wr, int wc, int fr, int fq) const {
        const int row0 = u.pm * BM + wr * 64 + fr, col0 = u.pn * BM + wc * 32 + 8 * fq;
#pragma unroll
        for (int ai = 0; ai < 2; ++ai) {
            f32x4 xv[4][2][2];
            if (Xs32) {
#pragma unroll
                for (int m = 0; m < 4; ++m) { const PG8_GAS float* rowp = Xs32 + (size_t)(row0 + ai * HALF + m * 16) * ldc + col0;
#pragma unroll
                    for (int bj = 0; bj < 2; ++bj)
#pragma unroll
                        for (int n = 0; n < 2; ++n) xv[m][bj][n] = __builtin_nontemporal_load((const PG8_GAS f32x4*)(rowp + bj * HALF + n * 4)); }
            } else {
                u32x4 xr[4][2];
#pragma unroll
                for (int m = 0; m < 4; ++m)
#pragma unroll
                    for (int bj = 0; bj < 2; ++bj) xr[m][bj] = *(const PG8_GAS u32x4*)(XB + (size_t)(row0 + ai * HALF + m * 16) * ldc + col0 + bj * HALF);
#pragma unroll
                for (int m = 0; m < 4; ++m)
#pragma unroll
                    for (int bj = 0; bj < 2; ++bj) { const u32x4 r = xr[m][bj];
                        xv[m][bj][0] = (f32x4){__builtin_bit_cast(float, r.x << 16), __builtin_bit_cast(float, r.x & 0xffff0000u), __builtin_bit_cast(float, r.y << 16), __builtin_bit_cast(float, r.y & 0xffff0000u)};
                        xv[m][bj][1] = (f32x4){__builtin_bit_cast(float, r.z << 16), __builtin_bit_cast(float, r.z & 0xffff0000u), __builtin_bit_cast(float, r.w << 16), __builtin_bit_cast(float, r.w & 0xffff0000u)}; }
            }
#pragma unroll
            for (int m = 0; m < 4; ++m) { const int row = row0 + ai * HALF + m * 16; float ss = 0.f;
#pragma unroll
                for (int bj = 0; bj < 2; ++bj) { const f32x4 y0 = xv[m][bj][0] + acc[ai][bj][m][0], y1 = xv[m][bj][1] + acc[ai][bj][m][1];
                    ss += ((y0[0] * y0[0] + y0[1] * y0[1]) + (y0[2] * y0[2] + y0[3] * y0[3])) + ((y1[0] * y1[0] + y1[1] * y1[1]) + (y1[2] * y1[2] + y1[3] * y1[3]));
                    u32x4 w; w.x = cvt_pk_bf16(y0[0], y0[1]); w.y = cvt_pk_bf16(y0[2], y0[3]); w.z = cvt_pk_bf16(y1[0], y1[1]); w.w = cvt_pk_bf16(y1[2], y1[3]);
                    *(PG8_GAS u32x4*)(XB + (size_t)row * ldc + col0 + bj * HALF) = w; }
                ss += __shfl_xor(ss, 16); ss += __shfl_xor(ss, 32); if (fq == 0) RS[(size_t)row * 32 + u.pn * 4 + wc] = ss; }
            asm volatile("" ::: "memory"); }
    }
};
struct EpiSoftmax {
    static constexpr bool PERM = true, AFTER_DRAIN = false;
    PG8_GAS bf16_t* O; int ldc; PG8_LAS float* T1; PG8_LAS float* T2; RstdTab R;
    typedef float f32x2 __attribute__((ext_vector_type(2)));
    static __device__ __forceinline__ f32x2 ex2(float x0, float x1, float c1, float m2) { const f32x2 t = (f32x2){x0, x1} * c1 - m2; f32x2 e; e.x = __builtin_amdgcn_exp2f(t.x); e.y = __builtin_amdgcn_exp2f(t.y); return e; }
    __device__ __forceinline__ void operator()(const f32x4 (&acc)[2][2][4][2], const Unit& u, int wr, int wc, int fr, int fq) const {
        const int row0 = u.pm * BM + wr * 64 + fr, col0 = u.pn * BM + wc * 32 + 8 * fq;
        float m2[2][4]; float rs[2][4]; R.rows(u, wr, fr, fq, rs);
#pragma unroll
        for (int ai = 0; ai < 2; ++ai)
#pragma unroll
            for (int m = 0; m < 4; ++m) { float a = -3.0e38f;
#pragma unroll
                for (int bj = 0; bj < 2; ++bj)
#pragma unroll
                    for (int n = 0; n < 2; ++n) { const f32x4 v = acc[ai][bj][m][n]; a = fmaxf(a, fmaxf(fmaxf(v[0], v[1]), fmaxf(v[2], v[3]))); }
                a = fmaxf(a, __shfl_xor(a, 16)); a = fmaxf(a, __shfl_xor(a, 32));
                if (fq == 0) T1[(ai * HALF + wr * 64 + m * 16 + fr) * 4 + wc] = a * rs[ai][m]; }
        asm volatile("s_waitcnt lgkmcnt(0)" ::: "memory"); __builtin_amdgcn_s_barrier(); asm volatile("" ::: "memory");
#pragma unroll
        for (int ai = 0; ai < 2; ++ai)
#pragma unroll
            for (int m = 0; m < 4; ++m) { const f32x4 t = *(const PG8_LAS f32x4*)(T1 + (ai * HALF + wr * 64 + m * 16 + fr) * 4); const float c1 = rs[ai][m] * 1.4426950408889634f;
                m2[ai][m] = fmaxf(fmaxf(t[0], t[1]), fmaxf(t[2], t[3])) * 1.4426950408889634f; f32x2 a2 = (f32x2){0.f, 0.f};
#pragma unroll
                for (int bj = 0; bj < 2; ++bj)
#pragma unroll
                    for (int n = 0; n < 2; ++n) { const f32x4 v = acc[ai][bj][m][n]; a2 += ex2(v[0], v[1], c1, m2[ai][m]) + ex2(v[2], v[3], c1, m2[ai][m]); }
                float a = a2.x + a2.y; a += __shfl_xor(a, 16); a += __shfl_xor(a, 32);
                if (fq == 0) T2[(ai * HALF + wr * 64 + m * 16 + fr) * 4 + wc] = a; }
        asm volatile("s_waitcnt lgkmcnt(0)" ::: "memory"); __builtin_amdgcn_s_barrier(); asm volatile("" ::: "memory");
#pragma unroll
        for (int ai = 0; ai < 2; ++ai)
#pragma unroll
            for (int m = 0; m < 4; ++m) { const f32x4 t = *(const PG8_LAS f32x4*)(T2 + (ai * HALF + wr * 64 + m * 16 + fr) * 4); const float inv = 1.0f / ((t[0] + t[1]) + (t[2] + t[3])), mm = m2[ai][m], c1 = rs[ai][m] * 1.4426950408889634f;
                PG8_GAS bf16_t* rowp = O + (size_t)(row0 + ai * HALF + m * 16) * ldc + col0;
#pragma unroll
                for (int bj = 0; bj < 2; ++bj) { const f32x4 v0 = acc[ai][bj][m][0], v1 = acc[ai][bj][m][1];
                    const f32x2 p0 = ex2(v0[0], v0[1], c1, mm) * inv, p1 = ex2(v0[2], v0[3], c1, mm) * inv, p2 = ex2(v1[0], v1[1], c1, mm) * inv, p3 = ex2(v1[2], v1[3], c1, mm) * inv;
                    u32x4 w; w.x = cvt_pk_bf16(p0.x, p0.y); w.y = cvt_pk_bf16(p1.x, p1.y); w.z = cvt_pk_bf16(p2.x, p2.y); w.w = cvt_pk_bf16(p3.x, p3.y);
                    *(PG8_GAS u32x4*)(rowp + bj * HALF) = w; } }
    }
};
__device__ __forceinline__ float silu_f(float g) { return g * __builtin_amdgcn_rcpf(1.0f + __expf(-g)); }
struct EpiSwiglu {
    static constexpr bool PERM = true, AFTER_DRAIN = false;
    PG8_GAS bf16_t* H; int ldc; RstdTab R;
    typedef float f32x2 __attribute__((ext_vector_type(2)));
    static __device__ __forceinline__ void quad(f32x4 G, f32x4 U, float a, float q, unsigned& w0, unsigned& w1) {
        const f32x2 G01 = (f32x2){G[0], G[1]}, G23 = (f32x2){G[2], G[3]}, U01 = (f32x2){U[0], U[1]}, U23 = (f32x2){U[2], U[3]};
        const f32x2 t01 = __builtin_elementwise_min(G01 * a, (f32x2){30.f, 30.f}), t23 = __builtin_elementwise_min(G23 * a, (f32x2){30.f, 30.f});
        f32x2 e01, e23; e01.x = __builtin_amdgcn_exp2f(t01.x); e01.y = __builtin_amdgcn_exp2f(t01.y); e23.x = __builtin_amdgcn_exp2f(t23.x); e23.y = __builtin_amdgcn_exp2f(t23.y);
        const f32x2 d01 = e01 + 1.0f, d23 = e23 + 1.0f, pp = d01 * d23;
        const float r = __builtin_amdgcn_rcpf(pp.x * pp.y);
        const f32x2 rp = (f32x2){pp.y, pp.x} * r;
        const f32x2 i01 = rp * d23, i23 = rp * d01;
        const f32x2 h01 = (G01 * U01) * (i01 * q), h23 = (G23 * U23) * (i23 * q);
        w0 = cvt_pk_bf16(h01.x, h01.y); w1 = cvt_pk_bf16(h23.x, h23.y);
    }
    __device__ __forceinline__ void operator()(const f32x4 (&acc)[2][2][4][2], const Unit& u, int wr, int wc, int fr, int fq) const {
        const int row0 = u.pm * BM + wr * 64 + fr, col0 = u.pn * HALF + wc * 32 + 8 * fq;
        float rs[2][4]; R.rows(u, wr, fr, fq, rs);
#pragma unroll
        for (int ai = 0; ai < 2; ++ai)
#pragma unroll
            for (int m = 0; m < 4; ++m) { PG8_GAS bf16_t* rowp = H + (size_t)(row0 + ai * HALF + m * 16) * ldc + col0;
                const float a = rs[ai][m] * -1.4426950408889634f, q = rs[ai][m] * rs[ai][m];
                const f32x4 g0 = acc[ai][0][m][0], g1 = acc[ai][0][m][1], u0 = acc[ai][1][m][0], u1 = acc[ai][1][m][1];
                u32x4 w; unsigned wa, wb, wc2, wd; quad(g0, u0, a, q, wa, wb); quad(g1, u1, a, q, wc2, wd); w.x = wa; w.y = wb; w.z = wc2; w.w = wd;
                *(PG8_GAS u32x4*)rowp = w; }
    }
};

template <class Epi, class Sched, bool ALIGN_EPI = false, bool SP2 = false>
__device__ __forceinline__ void gemm_phase(PG8_LAS unsigned char* lds, const Gemm g, const Sched& S, const Epi& E, int tid_in) {
    int tid = tid_in; asm volatile("" : "+v"(tid));
    const int wid = __builtin_amdgcn_readfirstlane(tid >> 6), lane = tid & 63, wr = wid >> 2, wc = wid & 3, fr = lane & 15, fq = lane >> 4;
    const int K = g.K, nt = K / BK;
    unsigned voffA[2], voffB[2];
#pragma unroll
    for (int i = 0; i < 2; ++i) { int R, C; stage_rc(tid * 16 + i * 8192, R, C); const int Rb = Epi::PERM ? ((R & ~31) + perm32(R & 31)) : R;
        voffA[i] = (unsigned)(R * g.lda + C) * 2u; voffB[i] = (unsigned)(Rb * g.ldb + C) * 2u; }
    const size_t kstep = (size_t)(BK * 2);
    const size_t hstepA = (size_t)HALF * g.lda * 2, hstepB = (size_t)HALF * g.ldb * 2;
    const unsigned ldsw = (unsigned)wid * 1024u;
    const int aoff = lds_byte(wr * 64 + fr, fq * 8), boff = lds_byte(wc * 32 + fr, fq * 8);
#define PG8_SA(b, h) (((b) * 2 + (h)) * HTB)
#define PG8_SB(b, h) ((4 + (b) * 2 + (h)) * HTB)
#define PG8_STAGE(bufoff, gbase, voff) do { _Pragma("unroll") for (int _i = 0; _i < 2; ++_i) \
        __builtin_amdgcn_global_load_lds((const unsigned*)((const char*)(gbase) + (voff)[_i]), (PG8_LAS unsigned*)(lds + (bufoff) + ldsw + _i * 8192), 16, 0, 0); } while (0)
#define PG8_LDA(dst, b, h) do { _Pragma("unroll") for (int m = 0; m < 4; ++m) _Pragma("unroll") for (int k = 0; k < 2; ++k) dst[m][k] = *(const PG8_LAS bf16x8*)(lds + PG8_SA(b, h) + aoff + m * 2048 + k * 1024); } while (0)
#define PG8_LDB(dst, b, h) do { _Pragma("unroll") for (int n = 0; n < 2; ++n) _Pragma("unroll") for (int k = 0; k < 2; ++k) dst[n][k] = *(const PG8_LAS bf16x8*)(lds + PG8_SB(b, h) + boff + n * 2048 + k * 1024); } while (0)
#define PG8_MMA(ai, bj, At, Bt) do { __builtin_amdgcn_s_setprio(1); _Pragma("unroll") for (int m = 0; m < 4; ++m) _Pragma("unroll") for (int n = 0; n < 2; ++n) _Pragma("unroll") for (int k = 0; k < 2; ++k) \
        acc[ai][bj][m][n] = __builtin_amdgcn_mfma_f32_16x16x32_bf16(Bt[n][k], At[m][k], acc[ai][bj][m][n], 0, 0, 0); __builtin_amdgcn_s_setprio(0); } while (0)
#define PG8_WAIT_V(n) asm volatile("s_waitcnt vmcnt(" #n ")" ::: "memory")
#define PG8_WAIT_L(n) asm volatile("s_waitcnt lgkmcnt(" #n ")" ::: "memory")
#define PG8_BAR __builtin_amdgcn_s_barrier()
#define PG8_SCHED __builtin_amdgcn_sched_barrier(0)
    Unit cur, nxt; int ui = 0;
    if (!S.next(0, cur)) return;
    f32x4 acc[2][2][4][2];
#pragma unroll
    for (int a = 0; a < 2; ++a)
#pragma unroll
        for (int b = 0; b < 2; ++b)
#pragma unroll
            for (int m = 0; m < 4; ++m)
#pragma unroll
                for (int n = 0; n < 2; ++n) acc[a][b][m][n] = (f32x4){0.f, 0.f, 0.f, 0.f};
    bf16x8 At[4][2], B0[2][2], B1[2][2];
    const char* cA = (const char*)g.A + cur.aoff; const char* cB = (const char*)g.Bt + cur.boff;
    S.a_ready(cur);
    if constexpr (SP2) {
        PG8_STAGE(PG8_SB(0, 0), cB, voffB); PG8_STAGE(PG8_SB(0, 1), cB + hstepB, voffB); PG8_STAGE(PG8_SA(0, 0), cA, voffA); PG8_STAGE(PG8_SA(0, 1), cA + hstepA, voffA);
        if (wr == 1) PG8_BAR;
        PG8_WAIT_V(2); PG8_BAR;
        PG8_STAGE(PG8_SB(1, 0), cB + kstep, voffB); PG8_STAGE(PG8_SA(1, 0), cA + kstep, voffA); PG8_STAGE(PG8_SB(1, 1), cB + hstepB + kstep, voffB);
        PG8_WAIT_V(6); PG8_BAR;
    } else {
        PG8_STAGE(PG8_SB(0, 0), cB, voffB); PG8_STAGE(PG8_SA(0, 0), cA, voffA); PG8_STAGE(PG8_SB(0, 1), cB + hstepB, voffB); PG8_STAGE(PG8_SA(0, 1), cA + hstepA, voffA);
        if (wr == 1) PG8_BAR;
        PG8_WAIT_V(4); PG8_BAR;
        PG8_STAGE(PG8_SB(1, 0), cB + kstep, voffB); PG8_STAGE(PG8_SA(1, 0), cA + kstep, voffA); PG8_STAGE(PG8_SB(1, 1), cB + hstepB + kstep, voffB);
        PG8_WAIT_V(6); PG8_BAR;
    }
    for (;;) {
        const bool has_next = S.next(ui + 1, nxt);
        const char* nA = has_next ? (const char*)g.A + nxt.aoff : cA; const char* nB = has_next ? (const char*)g.Bt + nxt.boff : cB;
        for (int t = 0; t < nt; t += 2) {
            const bool last = (t == nt - 2);
            const char* a1 = cA + (size_t)(t + 1) * kstep;
            const char* a2 = last ? nA : cA + (size_t)(t + 2) * kstep; const char* b2 = last ? nB : cB + (size_t)(t + 2) * kstep;
            const char* a3 = a2 + kstep; const char* b3 = b2 + kstep;
            if (last && has_next) S.a_ready(nxt);
            if constexpr (SP2) {
            PG8_LDB(B0, 0, 0); PG8_LDB(B1, 0, 1); PG8_SCHED; PG8_LDA(At, 0, 0); PG8_STAGE(PG8_SA(1, 1), a1 + hstepA, voffA);
            PG8_WAIT_V(8); PG8_WAIT_L(0); PG8_BAR; PG8_MMA(0, 0, At, B0); PG8_MMA(0, 1, At, B1); PG8_BAR; PG8_SCHED;
            PG8_LDA(At, 0, 1); PG8_STAGE(PG8_SB(0, 0), b2, voffB); PG8_STAGE(PG8_SB(0, 1), b2 + hstepB, voffB); PG8_STAGE(PG8_SA(0, 0), a2, voffA);
            PG8_WAIT_V(8); PG8_WAIT_L(0); PG8_BAR; PG8_MMA(1, 0, At, B0); PG8_MMA(1, 1, At, B1); PG8_BAR; PG8_SCHED;
            PG8_LDB(B0, 1, 0); PG8_LDB(B1, 1, 1); PG8_SCHED; PG8_LDA(At, 1, 0); PG8_STAGE(PG8_SA(0, 1), a2 + hstepA, voffA);
            PG8_WAIT_V(8); PG8_WAIT_L(0); PG8_BAR; PG8_MMA(0, 0, At, B0); PG8_MMA(0, 1, At, B1); PG8_BAR; PG8_SCHED;
            PG8_LDA(At, 1, 1); PG8_STAGE(PG8_SB(1, 0), b3, voffB); PG8_STAGE(PG8_SB(1, 1), b3 + hstepB, voffB); PG8_STAGE(PG8_SA(1, 0), a3, voffA);
            PG8_WAIT_V(8); PG8_WAIT_L(0); PG8_BAR; PG8_MMA(1, 0, At, B0); PG8_MMA(1, 1, At, B1); PG8_BAR; PG8_SCHED;
            } else {
            PG8_LDB(B0, 0, 0); PG8_SCHED; PG8_LDA(At, 0, 0); PG8_STAGE(PG8_SA(1, 1), a1 + hstepA, voffA);
            PG8_WAIT_L(8); PG8_BAR; PG8_WAIT_L(0); PG8_MMA(0, 0, At, B0); PG8_BAR; PG8_SCHED;
            PG8_LDB(B1, 0, 1); PG8_STAGE(PG8_SB(0, 0), b2, voffB);
            PG8_BAR; PG8_WAIT_L(0); PG8_MMA(0, 1, At, B1); PG8_BAR;
            PG8_LDA(At, 0, 1); PG8_STAGE(PG8_SA(0, 0), a2, voffA);
            PG8_BAR; PG8_WAIT_L(0); PG8_MMA(1, 0, At, B0); PG8_BAR; PG8_SCHED;
            PG8_STAGE(PG8_SB(0, 1), b2 + hstepB, voffB);
            PG8_WAIT_V(6); PG8_BAR; PG8_MMA(1, 1, At, B1); PG8_BAR;
            PG8_LDB(B0, 1, 0); PG8_SCHED; PG8_LDA(At, 1, 0); PG8_STAGE(PG8_SA(0, 1), a2 + hstepA, voffA);
            PG8_WAIT_L(8); PG8_BAR; PG8_WAIT_L(0); PG8_MMA(0, 0, At, B0); PG8_BAR; PG8_SCHED;
            PG8_LDB(B1, 1, 1); PG8_STAGE(PG8_SB(1, 0), b3, voffB);
            PG8_BAR; PG8_WAIT_L(0); PG8_MMA(0, 1, At, B1); PG8_BAR;
            PG8_LDA(At, 1, 1); PG8_STAGE(PG8_SA(1, 0), a3, voffA);
            PG8_BAR; PG8_WAIT_L(0); PG8_MMA(1, 0, At, B0); PG8_BAR; PG8_SCHED;
            PG8_STAGE(PG8_SB(1, 1), b3 + hstepB, voffB);
            PG8_WAIT_V(6); PG8_BAR; PG8_MMA(1, 1, At, B1); PG8_BAR;
            }
        }
        if constexpr (ALIGN_EPI) { if (wr == 0) PG8_BAR; }
        if constexpr (!Epi::AFTER_DRAIN) { E(acc, cur, wr, wc, fr, fq); S.done(cur); }
        if (!has_next) break;
#pragma unroll
        for (int a = 0; a < 2; ++a)
#pragma unroll
            for (int b = 0; b < 2; ++b)
#pragma unroll
                for (int m = 0; m < 4; ++m)
#pragma unroll
                    for (int n = 0; n < 2; ++n) acc[a][b][m][n] = (f32x4){0.f, 0.f, 0.f, 0.f};
        cur = nxt; cA = nA; cB = nB; ++ui;
        if constexpr (ALIGN_EPI) { if (wr == 1) PG8_BAR; }
    }
    PG8_WAIT_V(0);
    if constexpr (!ALIGN_EPI) { if (wr == 0) PG8_BAR; }
    PG8_BAR;
    if constexpr (Epi::AFTER_DRAIN) { E.fused(acc, cur, wr, wc, fr, fq, lds, wid, lane); S.done(cur); }
#undef PG8_SA
#undef PG8_SB
#undef PG8_STAGE
#undef PG8_LDA
#undef PG8_LDB
#undef PG8_MMA
#undef PG8_WAIT_V
#undef PG8_WAIT_L
#undef PG8_BAR
#undef PG8_SCHED
}
}

constexpr int NB = 8, SEQ = 4096, DM = 2048, NL = 4, MTOK = NB * SEQ, NMEM = 256;
constexpr int DIN = 5152, NPROJ = 3840, NWIN = 5376, DFF = 5632;
constexpr int PQ = 0, PK = 256, PV = 512, PG = 1024, PLR = 1536, PUF = 1792, PUS = 2304, WUH = 3840;
constexpr float EPS = 1e-6f;
constexpr int NWAVES = 8, NTHR = 512;

constexpr size_t MiB = 1u << 20;
constexpr size_t WS_CTL = 0, CTL_ZERO_BYTES = 1 * MiB;
constexpr size_t WS_WIN = 1 * MiB, WS_WOUT = 23 * MiB, WS_WQB = 31 * MiB, WS_WKV = 39 * MiB, WS_WXO = 55 * MiB, WS_WGU = 63 * MiB, WS_WD = 107 * MiB;
constexpr size_t WS_KVB = 129 * MiB, WS_MT = 145 * MiB, WS_VWO = 177 * MiB, WS_MEMN = 209 * MiB;
constexpr size_t WS_XB = 217 * MiB, WS_PROJ = 345 * MiB, WS_MIX = 697 * MiB, WS_OF = 825 * MiB, WS_FU = 889 * MiB, WS_FILT = 1017 * MiB, WS_UT = 1049 * MiB, WS_YT = 1145 * MiB;
constexpr size_t WS_FU2 = 889 * MiB, WS_FY = 953 * MiB, WS_C2 = 1177 * MiB, WS_S2 = 1186 * MiB, WS_FE = 1194 * MiB, WS_FO = 1211 * MiB, WS_Y2K = 1227 * MiB, WS_A1 = 1241 * MiB;
constexpr int FK1 = 2176;
constexpr size_t WS_GS = 1242 * MiB  , WS_GU = 1242 * MiB, WS_GD = 1370 * MiB;
constexpr size_t WS_RSS = 1371 * MiB;
constexpr size_t WS_END = 1375 * MiB;
constexpr int CW_BAR = 4096;

constexpr int RING_OFF = 0, RING_BYTES = 131072;
constexpr int LDSCTL_OFF = RING_BYTES, MISC_OFF = LDSCTL_OFF + 320;
constexpr int LDS_BYTES = 147456;

#define GAS __attribute__((address_space(1)))
#define LAS __attribute__((address_space(3)))
typedef unsigned short bf16;
typedef unsigned v4u __attribute__((ext_vector_type(4)));
typedef unsigned v2u __attribute__((ext_vector_type(2)));
typedef float f32x4 __attribute__((ext_vector_type(4)));
typedef GAS unsigned gu32;
#define LDS_WAIT() asm volatile("s_waitcnt lgkmcnt(0)" ::: "memory")
__device__ __forceinline__ unsigned f2bf(float f) { unsigned u = __builtin_bit_cast(unsigned, f); return (u + 0x7fffu + ((u >> 16) & 1u)) >> 16; }
__device__ __forceinline__ unsigned pk2(float lo, float hi) { return f2bf(lo) | (f2bf(hi) << 16); }
__device__ __forceinline__ float bf2f(bf16 h) { return __builtin_bit_cast(float, ((unsigned)h) << 16); }
__device__ __forceinline__ float bflo(unsigned w) { return __builtin_bit_cast(float, w << 16); }
__device__ __forceinline__ float bfhi(unsigned w) { return __builtin_bit_cast(float, w & 0xffff0000u); }

#define XB_TMO      128
#define XB_XCNT(j)  (256  + 64 * (j))
#define XB_XSUB(j)  (1280 + 64 * (j))
#define XB_XGEN(j)  (2304 + 64 * (j))
#define XB_TOP      3328
#define XB_TOPGEN   3392
#define XCD_BAR_WORDS 3456
#define XB_SPIN_CAP (1u << 18)

__device__ __forceinline__ unsigned xb_ld(unsigned* p)              { return __hip_atomic_load(p, __ATOMIC_RELAXED, __HIP_MEMORY_SCOPE_AGENT); }
__device__ __forceinline__ unsigned xb_add(unsigned* p, unsigned v) { return __hip_atomic_fetch_add(p, v, __ATOMIC_RELAXED, __HIP_MEMORY_SCOPE_AGENT); }
__device__ __forceinline__ unsigned xb_xcc_id() { return (unsigned)__builtin_amdgcn_s_getreg((3 << 11) | 20) & 0xFu; }
#define XB_SPIN(cond, bar) do { unsigned _sp = 0; while (cond) { __builtin_amdgcn_s_sleep(1); \
    if ((++_sp & 255u) == 0u) { if (xb_ld(&(bar)[XB_TMO])) break; if (_sp > XB_SPIN_CAP) { atomicAdd(&(bar)[XB_TMO], 1u); break; } } } } while (0)

struct XcdBarrier { unsigned* bar; unsigned x; volatile LAS unsigned* st; };

__device__ __forceinline__ XcdBarrier xcd_barrier_post(unsigned* bar, volatile LAS unsigned* st, int tid) {
    XcdBarrier b; b.bar = bar; b.x = xb_xcc_id(); b.st = st;
    if (tid == 0) (void)xb_add(&bar[XB_XCNT(b.x)], 1u);
    return b;
}
__device__ __forceinline__ void xcd_barrier_complete(unsigned* bar, unsigned x, unsigned& nloc, unsigned& nx) {
    const unsigned G = gridDim.x * gridDim.y * gridDim.z;
    unsigned sum, cnt, mine, sp = 0u;
    for (;;) {
        sum = 0u; cnt = 0u; mine = 0u;
#pragma unroll
        for (unsigned j = 0; j < 16; ++j) { const unsigned c = xb_ld(&bar[XB_XCNT(j)]); sum += c; cnt += (c > 0u) ? 1u : 0u; mine = (j == x) ? c : mine; }
        if (sum == G) break;
        __builtin_amdgcn_s_sleep(1);
        if ((++sp & 255u) == 0u) { if (xb_ld(&bar[XB_TMO])) break; if (sp > XB_SPIN_CAP) { atomicAdd(&bar[XB_TMO], 1u); break; } }
    }
    nloc = mine > 0u ? mine : 1u; nx = cnt > 0u ? cnt : 1u;
}
__device__ __forceinline__ void xcd_barrier(const XcdBarrier& b, int tid) {
    asm volatile("s_waitcnt vmcnt(0)" ::: "memory");
    __syncthreads();
    if (tid == 0) {
        unsigned* bar = b.bar;
        __builtin_amdgcn_s_waitcnt(0);
        unsigned nloc = b.st[0], nx = b.st[1];
        if (nloc == 0u) { xcd_barrier_complete(bar, b.x, nloc, nx); b.st[0] = nloc; b.st[1] = nx; }
        const unsigned old = xb_add(&bar[XB_XSUB(b.x)], 1u);
        const unsigned gen = old / nloc;
        if (old + 1u == (gen + 1u) * nloc) {
            __builtin_amdgcn_fence(__ATOMIC_RELEASE, "agent");
            asm volatile("s_waitcnt vmcnt(0)" ::: "memory");
            const unsigned og = xb_add(&bar[XB_TOP], 1u);
            const unsigned tg = og / nx;
            if (og + 1u == (tg + 1u) * nx) xb_add(&bar[XB_TOPGEN], 1u);
            else XB_SPIN(xb_ld(&bar[XB_TOPGEN]) == tg, bar);
            __builtin_amdgcn_fence(__ATOMIC_ACQUIRE, "agent");
            xb_add(&bar[XB_XGEN(b.x)], 1u);
            asm volatile("s_waitcnt vmcnt(0)" ::: "memory");
        } else {
            XB_SPIN(xb_ld(&bar[XB_XGEN(b.x)]) == gen, bar);
            __builtin_amdgcn_fence(__ATOMIC_ACQUIRE, "agent");
            asm volatile("s_waitcnt vmcnt(0)" ::: "memory");
        }
    }
    __syncthreads();
}

__device__ __forceinline__ float wave_sum(float v) {
#pragma unroll
    for (int o = 1; o < 64; o <<= 1) v += __shfl_xor(v, o);
    return v;
}
__device__ __forceinline__ float wave_max(float v) {
#pragma unroll
    for (int o = 1; o < 64; o <<= 1) v = fmaxf(v, __shfl_xor(v, o));
    return v;
}
__device__ __forceinline__ float block_sum(float v, LAS float* red, int wave, int lane) {
    v = wave_sum(v); if (lane == 0) red[wave] = v; __syncthreads();
    float s = 0.f;
#pragma unroll
    for (int i = 0; i < 8; ++i) s += red[i];
    __syncthreads(); return s;
}
__device__ __forceinline__ float log_sigmoid_f(float x) { return fminf(x, 0.f) - __logf(1.0f + __expf(-fabsf(x))); }

struct Params {
    const float* in[26]; float* out; unsigned char* ws;
    int step_lo, step_hi, pad0, pad1;
};
__device__ __forceinline__ int opaque_i(int x) { asm volatile("" : "+v"(x)); return __builtin_amdgcn_readfirstlane(x); }
template <class T> __device__ __forceinline__ T* opaque_p(T* p) { const unsigned long long v = (unsigned long long)p; const unsigned lo = (unsigned)opaque_i((int)(unsigned)v), hi = (unsigned)opaque_i((int)(unsigned)(v >> 32)); return (T*)(((unsigned long long)hi << 32) | lo); }
__device__ __forceinline__ const float* pin(const Params& P, int i) { return P.in[opaque_i(i)]; }

struct TrItem { const float* src; int ldsrc, nsrc0, k0, lddst, nd0; bf16* dst; const float* gain; float sc; };
__device__ __forceinline__ void tr_load(const TrItem& t, f32x4 (&v)[8], int lane) {
    const int lr = lane >> 3, lc = (lane & 7) * 4;
#pragma unroll
    for (int i = 0; i < 8; ++i) v[i] = *(const GAS f32x4*)(t.src + (size_t)(t.k0 + 8 * i + lr) * t.ldsrc + t.nsrc0 + lc);
}
__device__ __forceinline__ void tr_finish(const TrItem& t, const f32x4 (&v)[8], LAS float* scr, int lane) {
    const int lr = lane >> 3, lc = (lane & 7) * 4;
#pragma unroll
    for (int i = 0; i < 8; ++i) { const int kk = 8 * i + lr; const float gs = (t.gain ? t.gain[t.k0 + kk] : 1.f) * t.sc; LAS float* d = scr + kk * 33 + lc; d[0] = v[i].x * gs; d[1] = v[i].y * gs; d[2] = v[i].z * gs; d[3] = v[i].w * gs; }
    LDS_WAIT(); asm volatile("" ::: "memory");
    const int c = lane & 7;
#pragma unroll
    for (int j = 0; j < 4; ++j) { const int n = (lane >> 3) + 8 * j; const LAS float* s = scr + (8 * c) * 33 + n;
        v4u o; o.x = pk2(s[0 * 33], s[1 * 33]); o.y = pk2(s[2 * 33], s[3 * 33]); o.z = pk2(s[4 * 33], s[5 * 33]); o.w = pk2(s[6 * 33], s[7 * 33]);
        *(GAS v4u*)(t.dst + (size_t)(t.nd0 + n) * t.lddst + t.k0 + 8 * c) = o; }
    LDS_WAIT(); asm volatile("" ::: "memory");
}
__device__ __forceinline__ void norm_row(const float* xrow, bf16* orow, float* xcopy, int lane) {
    const GAS f32x4* xr = (const GAS f32x4*)xrow + lane;
    f32x4 v[8]; float s = 0.f;
#pragma unroll
    for (int j = 0; j < 8; ++j) { v[j] = xr[64 * j]; s += (v[j].x * v[j].x + v[j].y * v[j].y) + (v[j].z * v[j].z + v[j].w * v[j].w); }
    const float rstd = rsqrtf(wave_sum(s) * (1.f / DM) + EPS);
    GAS v2u* o8 = (GAS v2u*)orow + lane;
#pragma unroll
    for (int j = 0; j < 8; ++j) { v2u w; w.x = pk2(v[j].x * rstd, v[j].y * rstd); w.y = pk2(v[j].z * rstd, v[j].w * rstd); o8[64 * j] = w; }
    if (xcopy) { GAS f32x4* xc = (GAS f32x4*)xcopy + lane;
#pragma unroll
        for (int j = 0; j < 8; ++j) xc[64 * j] = v[j]; }
}
__device__ __forceinline__ void final_norm_row(const bf16* xrow, float* orow, const float* g, int lane) {
    const GAS v4u* xr = (const GAS v4u*)xrow + lane; float v[4][8]; float s = 0.f;
#pragma unroll
    for (int j = 0; j < 4; ++j) { const v4u r = xr[64 * j]; v[j][0] = bflo(r.x); v[j][1] = bfhi(r.x); v[j][2] = bflo(r.y); v[j][3] = bfhi(r.y); v[j][4] = bflo(r.z); v[j][5] = bfhi(r.z); v[j][6] = bflo(r.w); v[j][7] = bfhi(r.w);
#pragma unroll
        for (int e = 0; e < 8; ++e) s += v[j][e] * v[j][e]; }
    const float rstd = rsqrtf(wave_sum(s) * (1.f / DM) + EPS);
#pragma unroll
    for (int j = 0; j < 4; ++j) { const int c0 = (64 * j + lane) * 8; const f32x4 g0 = *(const GAS f32x4*)(g + c0), g1 = *(const GAS f32x4*)(g + c0 + 4);
        *(GAS f32x4*)(orow + c0) = (f32x4){v[j][0] * rstd * g0.x, v[j][1] * rstd * g0.y, v[j][2] * rstd * g0.z, v[j][3] * rstd * g0.w};
        *(GAS f32x4*)(orow + c0 + 4) = (f32x4){v[j][4] * rstd * g1.x, v[j][5] * rstd * g1.y, v[j][6] * rstd * g1.z, v[j][7] * rstd * g1.w}; }
}
__device__ __forceinline__ void norm_row_gain_f32(const float* xrow, float* orow, const float* g, int lane) {
    const GAS f32x4* xr = (const GAS f32x4*)xrow + lane; const GAS f32x4* gr = (const GAS f32x4*)g + lane;
    f32x4 v[8]; float s = 0.f;
#pragma unroll
    for (int j = 0; j < 8; ++j) { v[j] = xr[64 * j]; s += (v[j].x * v[j].x + v[j].y * v[j].y) + (v[j].z * v[j].z + v[j].w * v[j].w); }
    const float rstd = rsqrtf(wave_sum(s) * (1.f / DM) + EPS);
    GAS f32x4* o = (GAS f32x4*)orow + lane;
#pragma unroll
    for (int j = 0; j < 8; ++j) o[64 * j] = v[j] * rstd * gr[64 * j];
}
__device__ __forceinline__ void norm_row_gain_bf16(const float* xrow, bf16* orow, const float* g, int lane) {
    const GAS f32x4* xr = (const GAS f32x4*)xrow + lane; const GAS f32x4* gr = (const GAS f32x4*)g + lane;
    f32x4 v[8]; float s = 0.f;
#pragma unroll
    for (int j = 0; j < 8; ++j) { v[j] = xr[64 * j]; s += (v[j].x * v[j].x + v[j].y * v[j].y) + (v[j].z * v[j].z + v[j].w * v[j].w); }
    const float rstd = rsqrtf(wave_sum(s) * (1.f / DM) + EPS);
    GAS v2u* o8 = (GAS v2u*)orow + lane;
#pragma unroll
    for (int j = 0; j < 8; ++j) { const f32x4 y = v[j] * rstd * gr[64 * j]; v2u w; w.x = pk2(y.x, y.y); w.y = pk2(y.z, y.w); o8[64 * j] = w; }
}

__device__ __forceinline__ void phase_a(const Params& P, unsigned char* ws, float* xres, int l, LAS unsigned char* lds, int tid, int lane, int wave, int bid, int G) {
    bf16* WinT = (bf16*)(ws + WS_WIN); bf16* WoutT = (bf16*)(ws + WS_WOUT); bf16* WqB = (bf16*)(ws + WS_WQB); bf16* WkvT = (bf16*)(ws + WS_WKV);
    bf16* WxoT = (bf16*)(ws + WS_WXO); bf16* WguT = (bf16*)(ws + WS_WGU); bf16* WdT = (bf16*)(ws + WS_WD);
    const float* g0 = pin(P, 2) + (size_t)(l * 3 + 0) * DM; const float* g1 = g0 + DM; const float* g2 = g1 + DM;
    const float* w_in = pin(P, 3) + (size_t)l * DM * DIN;
    const float* w_out = pin(P, 18) + (size_t)l * DM * DM;
    const float* w_xq = pin(P, 20) + (size_t)l * DM * DM;
    const float* w_xkv = pin(P, 21) + (size_t)l * DM * 2 * DM;
    const float* w_xo = pin(P, 22) + (size_t)l * DM * DM;
    const float* w_gu = pin(P, 23) + (size_t)l * DM * 2 * DFF;
    const float* w_dn = pin(P, 24) + (size_t)l * DFF * DM;
    const int gw = bid * NWAVES + wave, NGW = G * NWAVES, gt = bid * NTHR + tid, NGT = G * NTHR;
    LAS float* scr = (LAS float*)(lds + wave * 16384);
    constexpr int I1 = 49 * 32, I2 = 112 * 32, I3 = 64 * 32, I4 = 128 * 32, I5 = 64 * 32, I6 = 352 * 32, I7 = 64 * 88, ITOT = I1 + I2 + I3 + I4 + I5 + I6 + I7;
    auto mk_item = [&](int it) -> TrItem {
        int r = it; TrItem t; t.gain = nullptr; t.sc = 1.f;
        if (r < I1) { const int kb = r / 49, nb = r % 49; t.src = w_in; t.ldsrc = DIN; t.nsrc0 = 32 * nb; t.k0 = 64 * kb; t.dst = WinT; t.lddst = DM; t.nd0 = 32 * nb; t.gain = g0; t.sc = nb < 8 ? 0.125f : 1.f; }
        else if ((r -= I1) < I2) { const int kb = r / 112, nb = r % 112; t.src = w_in; t.ldsrc = DIN; t.nsrc0 = 1568 + 32 * nb; t.k0 = 64 * kb; t.dst = WinT; t.lddst = DM; t.gain = g0; const int cc = 32 * nb;
            t.nd0 = cc < 512 ? PUF + cc : cc < 2048 ? WUH + (cc - 512) : PUS + (cc - 2048); }
        else if ((r -= I2) < I3) { const int kb = r / 64, nb = r % 64; t.src = w_out; t.ldsrc = DM; t.nsrc0 = 32 * nb; t.k0 = 64 * kb; t.dst = WoutT; t.lddst = DM; t.nd0 = 32 * nb; }
        else if ((r -= I3) < I4) { const int kb = r / 128, nb = r % 128; t.src = w_xkv; t.ldsrc = 2 * DM; t.nsrc0 = 32 * nb; t.k0 = 64 * kb; t.dst = WkvT; t.lddst = DM; t.nd0 = 32 * nb; }
        else if ((r -= I4) < I5) { const int kb = r / 64, nb = r % 64; t.src = w_xo; t.ldsrc = DM; t.nsrc0 = 32 * nb; t.k0 = 64 * kb; t.dst = WxoT; t.lddst = DM; t.nd0 = 32 * nb; }
        else if ((r -= I5) < I6) { const int kb = r / 352, nb = r % 352, c0 = 32 * nb; t.src = w_gu; t.ldsrc = 2 * DFF; t.nsrc0 = c0; t.k0 = 64 * kb; t.dst = WguT; t.lddst = DM; t.gain = g2;
            t.nd0 = c0 < DFF ? (c0 / 128) * 256 + (c0 % 128) : ((c0 - DFF) / 128) * 256 + 128 + ((c0 - DFF) % 128); }
        else { r -= I6; const int kb = r / 64, nb = r % 64; t.src = w_dn; t.ldsrc = DM; t.nsrc0 = 32 * nb; t.k0 = 64 * kb; t.dst = WdT; t.lddst = DFF; t.nd0 = 32 * nb; }
        return t; };
    { f32x4 va[8], vb[8]; int it = gw;
      if (it < ITOT) { TrItem ta = mk_item(it); tr_load(ta, va, lane);
          for (;;) { const int itb = it + NGW; const bool hb = itb < ITOT; TrItem tb = ta; if (hb) { tb = mk_item(itb); tr_load(tb, vb, lane); }
              tr_finish(ta, va, scr, lane); if (!hb) break;
              const int ita = itb + NGW; const bool ha = ita < ITOT; if (ha) { ta = mk_item(ita); tr_load(ta, va, lane); }
              tr_finish(tb, vb, scr, lane); if (!ha) break; it = ita; } } }
    for (int i = gt; i < DM * DM / 8; i += NGT) { const int k = i >> 8; const float s = g1[k] * 0.044194173824159216f;
        const f32x4 a = *(const GAS f32x4*)(w_xq + (size_t)i * 8), b = *(const GAS f32x4*)(w_xq + (size_t)i * 8 + 4);
        v4u o; o.x = pk2(a.x * s, a.y * s); o.y = pk2(a.z * s, a.w * s); o.z = pk2(b.x * s, b.y * s); o.w = pk2(b.z * s, b.w * s);
        *(GAS v4u*)(WqB + (size_t)i * 8) = o; }
    __syncthreads();
    { bf16* filtT = (bf16*)(ws + WS_FILT);
      const float* w1 = pin(P, 8) + (size_t)l * 33 * 64; const float* b1 = pin(P, 9) + l * 64; const float* w2 = pin(P, 10) + (size_t)l * 64 * 64; const float* b2 = pin(P, 11) + l * 64;
      const float* w3 = pin(P, 12) + (size_t)l * 64 * 2048; const float* fr = pin(P, 13) + l * 64; const float* dec = pin(P, 14) + (size_t)l * 2048;
      LAS float* ft = (LAS float*)lds; LAS float* h1 = ft + 16 * 34; LAS float* h2 = h1 + 16 * 64;
      LAS float* w1s = h2 + 16 * 64; LAS float* w2s = w1s + 33 * 64;
      for (int i = tid; i < 33 * 64; i += NTHR) w1s[i] = w1[i];
      for (int i = tid; i < 64 * 64; i += NTHR) w2s[i] = w2[i];
      __syncthreads();
      for (int pg = bid; pg < SEQ / 16; pg += G) {
          if (tid < 256) { const int p = tid >> 4, i = tid & 15; const float t = (float)(pg * 16 + p) * (1.0f / SEQ);
              const float f = 1e-4f + (float)i * ((15.0f - 1e-4f) / 15.0f); const float rev = t * f; ft[p * 34 + 1 + i] = __builtin_amdgcn_cosf(rev); ft[p * 34 + 17 + i] = -__builtin_amdgcn_sinf(rev);
              if (i == 0) ft[p * 34] = t; }
          __syncthreads();
#pragma unroll
          for (int e = 0; e < 2; ++e) { const int o = tid + 512 * e, p = o >> 6, j = o & 63; float a = b1[j];
#pragma unroll 11
              for (int i = 0; i < 33; ++i) a += ft[p * 34 + i] * w1s[i * 64 + j];
              h1[p * 64 + j] = __builtin_amdgcn_sinf(fr[j] * a * 0.15915494309189535f); }
          __syncthreads();
#pragma unroll
          for (int e = 0; e < 2; ++e) { const int o = tid + 512 * e, p = o >> 6, j = o & 63; float a = b2[j];
#pragma unroll 16
              for (int i = 0; i < 64; ++i) a += h1[p * 64 + i] * w2s[i * 64 + j];
              h2[j * 16 + p] = __builtin_amdgcn_sinf(fr[j] * a * 0.15915494309189535f); }
          __syncthreads();
#pragma unroll 1
          for (int q = 0; q < 4; ++q) { const int n = tid + 512 * q; float a[16];
#pragma unroll
              for (int p = 0; p < 16; ++p) a[p] = 0.f;
#pragma unroll 1
              for (int j0 = 0; j0 < 64; j0 += 16) { float wv[16];
#pragma unroll
                  for (int jj = 0; jj < 16; ++jj) wv[jj] = w3[(j0 + jj) * 2048 + n];
#pragma unroll
                  for (int jj = 0; jj < 16; ++jj) { const LAS f32x4* hp = (const LAS f32x4*)(h2 + (j0 + jj) * 16); const f32x4 ha = hp[0], hb = hp[1], hc = hp[2], hd = hp[3]; const float w = wv[jj];
                      a[0] += ha.x * w; a[1] += ha.y * w; a[2] += ha.z * w; a[3] += ha.w * w; a[4] += hb.x * w; a[5] += hb.y * w; a[6] += hb.z * w; a[7] += hb.w * w;
                      a[8] += hc.x * w; a[9] += hc.y * w; a[10] += hc.z * w; a[11] += hc.w * w; a[12] += hd.x * w; a[13] += hd.y * w; a[14] += hd.z * w; a[15] += hd.w * w; } }
              const float dc = fabsf(dec[n]);
#pragma unroll
              for (int p4 = 0; p4 < 4; ++p4) { f32x4 o;
                  o.x = a[4 * p4 + 0] * __expf(-(float)(pg * 16 + 4 * p4 + 0) * (1.0f / SEQ) * dc); o.y = a[4 * p4 + 1] * __expf(-(float)(pg * 16 + 4 * p4 + 1) * (1.0f / SEQ) * dc);
                  o.z = a[4 * p4 + 2] * __expf(-(float)(pg * 16 + 4 * p4 + 2) * (1.0f / SEQ) * dc); o.w = a[4 * p4 + 3] * __expf(-(float)(pg * 16 + 4 * p4 + 3) * (1.0f / SEQ) * dc);
                  *(GAS v2u*)(filtT + (size_t)n * SEQ + pg * 16 + 4 * p4) = (v2u){pk2(o.x, o.y), pk2(o.z, o.w)}; } }
          __syncthreads();
      } }
    if (l == 0) { bf16* xb = (bf16*)(ws + WS_XB); float* rss = (float*)(ws + WS_RSS); const float* xin = pin(P, 0);
      for (int m = gw; m < MTOK; m += NGW) { const GAS f32x4* xr = (const GAS f32x4*)(xin + (size_t)m * DM) + lane; f32x4 v[8]; float ss = 0.f;
#pragma unroll
          for (int j = 0; j < 8; ++j) { v[j] = xr[64 * j]; ss += (v[j].x * v[j].x + v[j].y * v[j].y) + (v[j].z * v[j].z + v[j].w * v[j].w); }
          ss = wave_sum(ss); GAS v2u* o8 = (GAS v2u*)(xb + (size_t)m * DM) + lane;
#pragma unroll
          for (int j = 0; j < 8; ++j) { v2u w; w.x = pk2(v[j].x, v[j].y); w.y = pk2(v[j].z, v[j].w); o8[64 * j] = w; }
          if (lane < 32) rss[(size_t)m * 32 + lane] = lane == 0 ? ss : 0.f; } }
    if (l == 0) {
        typedef float f32x2 __attribute__((ext_vector_type(2)));
        __syncthreads();
        LAS f32x2* tw = (LAS f32x2*)lds;
        for (int i = tid; i < 4096; i += NTHR) { const float rv = (float)i * (1.0f / 4096.0f); tw[i] = (f32x2){__builtin_amdgcn_cosf(rv) * 0.001381067932f, __builtin_amdgcn_sinf(rv) * 0.001381067932f}; }
        __syncthreads();
        bf16* C2 = (bf16*)(ws + WS_C2); bf16* S2 = (bf16*)(ws + WS_S2);
        for (int i = gt; i < 2048 * (FK1 / 8); i += NGT) { const int srow = i / (FK1 / 8), t0 = (i % (FK1 / 8)) * 8; float cv[8];
#pragma unroll
            for (int e = 0; e < 8; ++e) cv[e] = (t0 + e) <= 2048 ? tw[(srow * (t0 + e)) & 4095].x : 0.f;
            v4u oc; oc.x = pk2(cv[0], cv[1]); oc.y = pk2(cv[2], cv[3]); oc.z = pk2(cv[4], cv[5]); oc.w = pk2(cv[6], cv[7]);
            *(GAS v4u*)(C2 + (size_t)srow * FK1 + t0) = oc; }
        for (int i = gt; i < 2048 * 256; i += NGT) { const int srow = i >> 8, t0 = (i & 255) * 8; float sv[8];
#pragma unroll
            for (int e = 0; e < 8; ++e) sv[e] = tw[(srow * (t0 + e)) & 4095].y;
            v4u os; os.x = pk2(sv[0], sv[1]); os.y = pk2(sv[2], sv[3]); os.z = pk2(sv[4], sv[5]); os.w = pk2(sv[6], sv[7]);
            *(GAS v4u*)(S2 + (size_t)srow * 2048 + t0) = os; }
        bf16* A1 = (bf16*)(ws + WS_A1);
        for (int i = gt; i < 512 * 256; i += NGT) { const int r = i >> 8, k = i & 255, gl = r >> 8, ri = (r >> 7) & 1, cp = r & 127, kg = k >> 7, cc = k & 127;
            float v = 0.f; if (kg == gl) { const float rv = (float)((cc * cp) & 127) * (1.0f / 128.0f); v = ri == 0 ? __builtin_amdgcn_cosf(rv) : -__builtin_amdgcn_sinf(rv); }
            A1[i] = (bf16)f2bf(v); }
        __syncthreads();
    }
    if (l == 0) { bf16* memn = (bf16*)(ws + WS_MEMN);
      for (int m = gw; m < NB * NMEM; m += NGW) norm_row_gain_bf16(pin(P, 1) + (size_t)m * DM, memn + (size_t)m * DM, pin(P, 19), lane); }
}


typedef short gbf16x8 __attribute__((ext_vector_type(8)));
constexpr int GP = 72;
__device__ __forceinline__ f32x4 mma16(const LAS bf16* A, const LAS bf16* Bt, int K, int lane, f32x4 acc) {
    const int r = lane & 15, q = lane >> 4;
#pragma unroll
    for (int k0 = 0; k0 < 64; k0 += 32) { if (k0 < K) {
        const gbf16x8 a = *(const LAS gbf16x8*)(A + r * GP + k0 + 8 * q), b = *(const LAS gbf16x8*)(Bt + r * GP + k0 + 8 * q);
        acc = __builtin_amdgcn_mfma_f32_16x16x32_bf16(a, b, acc, 0, 0, 0); } }
    return acc;
}
constexpr int RP = 72;
__device__ __forceinline__ v4u gla_ld64(const bf16* proj, int tok0, int col0, int tid) { return *(const GAS v4u*)(proj + (size_t)(tok0 + (tid >> 3)) * NPROJ + col0 + (tid & 7) * 8); }
__device__ __forceinline__ v4u gla_ld128(const bf16* proj, int tok0, int col0, int id) { return *(const GAS v4u*)(proj + (size_t)(tok0 + (id >> 4)) * NPROJ + col0 + (id & 15) * 8); }
__device__ __forceinline__ void gla_st64(LAS bf16* raw, v4u v, int tid) { *(LAS v4u*)(raw + (tid >> 3) * RP + (tid & 7) * 8) = v; }
__device__ __forceinline__ void gla_st_vT(LAS bf16* vT, v4u v, int id) {
    const int i = id >> 4, c0 = (id & 15) * 8; const unsigned w[4] = {v.x, v.y, v.z, v.w};
#pragma unroll
    for (int e = 0; e < 8; ++e) vT[(c0 + e) * GP + i] = (bf16)((e & 1) ? (w[e >> 1] >> 16) : (w[e >> 1] & 0xffffu));
}
constexpr int LRP = 40;
__device__ __forceinline__ void gla_cumsum_lds(const LAS bf16* lrraw, const LAS float* gwl, const float* gkb_, int h, int dir, LAS float* bL, LAS float* tot, int tid) {
    const GAS float* gkb = (const GAS float*)gkb_;
    const int k = tid & 63, seg = tid >> 6;
    const float bias = gkb[dir * 256 + h * 64 + k];
    float w[16];
#pragma unroll
    for (int r = 0; r < 16; ++r) w[r] = gwl[(dir * 16 + r) * 64 + k];
    float c[8];
#pragma unroll
    for (int e = 0; e < 8; ++e) { const LAS v4u* lp = (const LAS v4u*)(lrraw + (8 * seg + e) * LRP + dir * 16); const v4u a = lp[0], b = lp[1];
        float pre = bias;
        pre += bflo(a.x) * w[0] + bfhi(a.x) * w[1] + bflo(a.y) * w[2] + bfhi(a.y) * w[3] + bflo(a.z) * w[4] + bfhi(a.z) * w[5] + bflo(a.w) * w[6] + bfhi(a.w) * w[7];
        pre += bflo(b.x) * w[8] + bfhi(b.x) * w[9] + bflo(b.y) * w[10] + bfhi(b.y) * w[11] + bflo(b.z) * w[12] + bfhi(b.z) * w[13] + bflo(b.w) * w[14] + bfhi(b.w) * w[15];
        c[e] = log_sigmoid_f(pre) * (1.f / 16.f); }
    if (dir == 0) {
#pragma unroll
        for (int e = 1; e < 8; ++e) c[e] += c[e - 1];
        tot[seg * 64 + k] = c[7];
    } else {
#pragma unroll
        for (int e = 6; e >= 0; --e) c[e] += c[e + 1];
        tot[seg * 64 + k] = c[0];
    }
    __syncthreads();
    float off = 0.f;
#pragma unroll
    for (int s2 = 0; s2 < 8; ++s2) { const float tv = tot[s2 * 64 + k]; if (dir == 0 ? (s2 < seg) : (s2 > seg)) off += tv; }
#pragma unroll
    for (int e = 0; e < 8; ++e) bL[(8 * seg + e) * 64 + k] = c[e] + off;
    __syncthreads();
}
__device__ __forceinline__ v4u gla_ld_lr(const bf16* proj, int tok0, int tid) { return *(const GAS v4u*)(proj + (size_t)(tok0 + ((tid & 255) >> 2)) * NPROJ + PLR + (tid & 3) * 8); }
__device__ __forceinline__ void gla_st_lr(LAS bf16* lrraw, v4u v, int tid) { if (tid < 256) *(LAS v4u*)(lrraw + (tid >> 2) * LRP + (tid & 3) * 8) = v; }
__device__ __forceinline__ void gla_stage_gkw(const float* gkw_, int h, LAS float* gwl, int tid) {
    const GAS float* gkw = (const GAS float*)gkw_;
#pragma unroll
    for (int e = 0; e < 4; ++e) { const int i = tid + 512 * e, dr = i >> 6, k = i & 63; gwl[i] = gkw[dr * 256 + h * 64 + k]; }
}
__device__ __forceinline__ void gla_g1(const bf16* proj, const float* gkw, const float* gkb, bf16* GU_, float* GD_, LAS unsigned char* lds, int tid, int lane, int wave, int bid, int G) {
    GAS bf16* GU = (GAS bf16*)GU_; GAS float* GD = (GAS float*)GD_;
    LAS bf16* vT = (LAS bf16*)lds; LAS bf16* kdT = (LAS bf16*)(lds + 18432); LAS float* bL = (LAS float*)(lds + 27648); LAS float* tot = (LAS float*)(lds + 44032);
    LAS bf16* kraw = (LAS bf16*)(lds + 46080); LAS bf16* lrraw = (LAS bf16*)(lds + 55296); LAS float* gwl = (LAS float*)(lds + 60416);
    int unit = bid; if (unit >= 2048) return;
    int hcur = -1; v4u rk, rlr, rv0, rv1;
    { const int bh = unit >> 6, n = unit & 63, h = bh & 3, tok0 = (bh >> 2) * SEQ + n * 64;
      rk = gla_ld64(proj, tok0, PK + h * 64, tid); rlr = gla_ld_lr(proj, tok0, tid);
      rv0 = gla_ld128(proj, tok0, PV + h * 128, tid); rv1 = gla_ld128(proj, tok0, PV + h * 128, tid + 512); }
    for (;;) { const int bh = unit >> 6, h = bh & 3;
        gla_st64(kraw, rk, tid); gla_st_lr(lrraw, rlr, tid); gla_st_vT(vT, rv0, tid); gla_st_vT(vT, rv1, tid + 512);
        if (h != hcur) { gla_stage_gkw(gkw, h, gwl, tid); hcur = h; }
        __syncthreads();
        const int nunit = unit + G; const bool more = nunit < 2048;
        if (more) { const int bh2 = nunit >> 6, n2 = nunit & 63, h2 = bh2 & 3, tok2 = (bh2 >> 2) * SEQ + n2 * 64;
            rk = gla_ld64(proj, tok2, PK + h2 * 64, tid); rlr = gla_ld_lr(proj, tok2, tid);
            rv0 = gla_ld128(proj, tok2, PV + h2 * 128, tid); rv1 = gla_ld128(proj, tok2, PV + h2 * 128, tid + 512); }
        for (int dir = 0; dir < 2; ++dir) {
            gla_cumsum_lds(lrraw, gwl, gkb, h, dir, bL, tot, tid);
            { const int k = tid & 63, seg = tid >> 6; const float bl = bL[(dir ? 0 : 63) * 64 + k]; unsigned w[4];
#pragma unroll
              for (int e = 0; e < 4; ++e) { const int i0 = 8 * seg + 2 * e;
                  const float k0 = bf2f(kraw[i0 * RP + k]) * __expf(bl - bL[i0 * 64 + k]);
                  const float k1 = bf2f(kraw[(i0 + 1) * RP + k]) * __expf(bl - bL[(i0 + 1) * 64 + k]);
                  w[e] = pk2(k0, k1); }
              *(LAS v4u*)(kdT + k * GP + 8 * seg) = (v4u){w[0], w[1], w[2], w[3]};
              if (seg == 0) GD[(size_t)(unit * 2 + dir) * 64 + k] = __expf(bl); }
            __syncthreads();
            { GAS bf16* U = GU + (size_t)(unit * 2 + dir) * 8192; const int r = lane & 15, q = lane >> 4;
#pragma unroll
              for (int kt = 0; kt < 4; ++kt) { f32x4 acc = (f32x4){0.f, 0.f, 0.f, 0.f};
                  acc = mma16(vT + 16 * wave * GP, kdT + 16 * kt * GP, 64, lane, acc);
#pragma unroll
                  for (int j = 0; j < 4; ++j) U[(16 * wave + 4 * q + j) * 64 + 16 * kt + r] = (bf16)f2bf(acc[j]); } }
            __syncthreads();
        }
        if (!more) break; unit = nunit;
    }
}
__device__ __forceinline__ void gla_g3(const bf16* proj, const float* gkw, const float* gkb, const float* gnorm_, const bf16* GS_, bf16* mix_, LAS unsigned char* lds, int tid, int lane, int wave, int bid, int G) {
    const GAS float* gnorm = (const GAS float*)gnorm_; const GAS bf16* GS = (const GAS bf16*)GS_; GAS bf16* mix = (GAS bf16*)mix_; const GAS bf16* gproj = (const GAS bf16*)proj;
    LAS bf16* vT = (LAS bf16*)lds; LAS bf16* ST = (LAS bf16*)(lds + 18432); LAS bf16* qd = (LAS bf16*)(lds + 36864); LAS bf16* kd = (LAS bf16*)(lds + 46080);
    LAS bf16* qb = (LAS bf16*)(lds + 55296); LAS bf16* Pm = (LAS bf16*)(lds + 64512); LAS float* bL = (LAS float*)(lds + 73728); LAS float* tot = (LAS float*)(lds + 90112); LAS float* rs = (LAS float*)(lds + 92160);
    LAS bf16* qraw = (LAS bf16*)(lds + 92672); LAS bf16* kraw = (LAS bf16*)(lds + 101888); LAS bf16* lrraw = (LAS bf16*)(lds + 111104); LAS float* gwl = (LAS float*)(lds + 116224);
    const int r = lane & 15, q = lane >> 4, wr = wave >> 1, wc = wave & 1;
    int unit = bid; if (unit >= 2048) return;
    int hcur = -1; v4u rq, rk, rlr, rv0, rv1, rs0a, rs0b, rs1a, rs1b; unsigned short rg[16];
#define G3_LOAD(UNIT) do { const int bh_ = (UNIT) >> 6, n_ = (UNIT) & 63, h_ = bh_ & 3, tok_ = (bh_ >> 2) * SEQ + n_ * 64; \
        rq = gla_ld64(proj, tok_, PQ + h_ * 64, tid); rk = gla_ld64(proj, tok_, PK + h_ * 64, tid); rlr = gla_ld_lr(proj, tok_, tid); \
        rv0 = gla_ld128(proj, tok_, PV + h_ * 128, tid); rv1 = gla_ld128(proj, tok_, PV + h_ * 128, tid + 512); \
        { const GAS bf16* S0_ = GS + (size_t)((UNIT) * 2) * 8192; rs0a = *(const GAS v4u*)(S0_ + tid * 8); rs0b = *(const GAS v4u*)(S0_ + 4096 + tid * 8); rs1a = *(const GAS v4u*)(S0_ + 8192 + tid * 8); rs1b = *(const GAS v4u*)(S0_ + 12288 + tid * 8); } \
        _Pragma("unroll") for (int j_ = 0; j_ < 4; ++j_) _Pragma("unroll") for (int ct_ = 0; ct_ < 4; ++ct_) rg[j_ * 4 + ct_] = gproj[(size_t)(tok_ + 16 * wr + 4 * q + j_) * NPROJ + PG + h_ * 128 + 64 * wc + 16 * ct_ + r]; } while (0)
    G3_LOAD(unit);
    for (;;) { const int bh = unit >> 6, n = unit & 63, bb = bh >> 2, h = bh & 3, tok0 = bb * SEQ + n * 64;
        gla_st64(qraw, rq, tid); gla_st64(kraw, rk, tid); gla_st_lr(lrraw, rlr, tid); gla_st_vT(vT, rv0, tid); gla_st_vT(vT, rv1, tid + 512);
        if (h != hcur) { gla_stage_gkw(gkw, h, gwl, tid); hcur = h; }
        const v4u s0a = rs0a, s0b = rs0b, s1a = rs1a, s1b = rs1b; unsigned short gcur[16];
#pragma unroll
        for (int e = 0; e < 16; ++e) gcur[e] = rg[e];
        __syncthreads();
        const int nunit = unit + G; const bool more = nunit < 2048;
        if (more) G3_LOAD(nunit);
        f32x4 acc[4];
#pragma unroll
        for (int ct = 0; ct < 4; ++ct) acc[ct] = (f32x4){0.f, 0.f, 0.f, 0.f};
        for (int dir = 0; dir < 2; ++dir) {
            gla_cumsum_lds(lrraw, gwl, gkb, h, dir, bL, tot, tid);
            { const int i = tid >> 3, kg = (tid & 7) * 8;
              const v4u qv = *(const LAS v4u*)(qraw + i * RP + kg), kv = *(const LAS v4u*)(kraw + i * RP + kg);
              const f32x4 b0 = *(const LAS f32x4*)(bL + i * 64 + kg), b1 = *(const LAS f32x4*)(bL + i * 64 + kg + 4), r0 = *(const LAS f32x4*)(bL + 32 * 64 + kg), r1 = *(const LAS f32x4*)(bL + 32 * 64 + kg + 4);
              const unsigned qw[4] = {qv.x, qv.y, qv.z, qv.w}, kw[4] = {kv.x, kv.y, kv.z, kv.w}; unsigned oqd[4], okd[4], oqb[4];
#pragma unroll
              for (int e2 = 0; e2 < 4; ++e2) { const float bva = e2 < 2 ? b0[2 * e2] : b1[2 * e2 - 4], bvb = e2 < 2 ? b0[2 * e2 + 1] : b1[2 * e2 - 3], bra = e2 < 2 ? r0[2 * e2] : r1[2 * e2 - 4], brb = e2 < 2 ? r0[2 * e2 + 1] : r1[2 * e2 - 3];
                  const float qa = bflo(qw[e2]), qbv = bfhi(qw[e2]), ka = bflo(kw[e2]), kb = bfhi(kw[e2]);
                  oqd[e2] = pk2(qa * __expf(bva - bra), qbv * __expf(bvb - brb)); okd[e2] = pk2(ka * __expf(bra - bva), kb * __expf(brb - bvb)); oqb[e2] = pk2(qa * __expf(bva), qbv * __expf(bvb)); }
              *(LAS v4u*)(qd + i * GP + kg) = (v4u){oqd[0], oqd[1], oqd[2], oqd[3]}; *(LAS v4u*)(kd + i * GP + kg) = (v4u){okd[0], okd[1], okd[2], okd[3]}; *(LAS v4u*)(qb + i * GP + kg) = (v4u){oqb[0], oqb[1], oqb[2], oqb[3]};
              *(LAS v4u*)(ST + (tid >> 3) * GP + (tid & 7) * 8) = dir ? s1a : s0a; *(LAS v4u*)(ST + (64 + (tid >> 3)) * GP + (tid & 7) * 8) = dir ? s1b : s0b; }
            __syncthreads();
#pragma unroll
            for (int e = 0; e < 2; ++e) { const int jt = wc * 2 + e; f32x4 s = (f32x4){0.f, 0.f, 0.f, 0.f};
                s = mma16(qd + 16 * wr * GP, kd + 16 * jt * GP, 64, lane, s);
#pragma unroll
                for (int j = 0; j < 4; ++j) { const int i = 16 * wr + 4 * q + j, jj = 16 * jt + r; const bool keep = dir == 0 ? (jj <= i) : (jj > i);
                    Pm[i * GP + jj] = (bf16)f2bf(keep ? s[j] : 0.f); } }
            __syncthreads();
#pragma unroll
            for (int ct = 0; ct < 4; ++ct) { const int v0 = 64 * wc + 16 * ct;
                acc[ct] = mma16(Pm + 16 * wr * GP, vT + v0 * GP, 64, lane, acc[ct]);
                acc[ct] = mma16(qb + 16 * wr * GP, ST + v0 * GP, 64, lane, acc[ct]); }
            __syncthreads();
        }
        float ss[4];
#pragma unroll
        for (int j = 0; j < 4; ++j) { float a = 0.f;
#pragma unroll
            for (int ct = 0; ct < 4; ++ct) a += acc[ct][j] * acc[ct][j];
            a += __shfl_xor(a, 1); a += __shfl_xor(a, 2); a += __shfl_xor(a, 4); a += __shfl_xor(a, 8); ss[j] = a; }
        if (r == 0) {
#pragma unroll
            for (int j = 0; j < 4; ++j) rs[(16 * wr + 4 * q + j) * 2 + wc] = ss[j]; }
        __syncthreads();
#pragma unroll
        for (int j = 0; j < 4; ++j) { const int i = 16 * wr + 4 * q + j; const float rstd = rsqrtf((rs[i * 2] + rs[i * 2 + 1]) * (1.f / 128.f) + EPS);
#pragma unroll
            for (int ct = 0; ct < 4; ++ct) { const int v = 64 * wc + 16 * ct + r; const float gate = bf2f(gcur[j * 4 + ct]);
                mix[(size_t)(tok0 + i) * DM + h * 128 + v] = (bf16)f2bf(acc[ct][j] * rstd * gnorm[v] * pg8::silu_f(gate)); } }
        __syncthreads();
        if (!more) break; unit = nunit;
    }
#undef G3_LOAD
}

__device__ __forceinline__ void gla_g2(const bf16* GU_, const float* GD_, bf16* GS_, int tid, int bid, int G) {
    typedef float f32x2 __attribute__((ext_vector_type(2)));
    const GAS unsigned* GU = (const GAS unsigned*)GU_; const GAS float* GD = (const GAS float*)GD_; GAS unsigned* GS = (GAS unsigned*)GS_;
    for (int it = bid * NTHR + tid; it < 32 * 2 * 4096; it += G * NTHR) { const int e2 = it & 4095, dir = (it >> 12) & 1, bh = it >> 13, k = (2 * e2) & 63;
        float S0 = 0.f, S1 = 0.f;
#pragma unroll 1
        for (int nb = 0; nb < 64; nb += 16) { unsigned u[16]; f32x2 d[16];
#pragma unroll
            for (int j = 0; j < 16; ++j) { const int nv = nb + j, n = dir ? 63 - nv : nv; const size_t ud = (size_t)((bh * 64 + n) * 2 + dir);
                u[j] = GU[ud * 4096 + e2]; d[j] = *(const GAS f32x2*)(GD + ud * 64 + k); }
            asm volatile("" ::: "memory");
#pragma unroll
            for (int j = 0; j < 16; ++j) { const int nv = nb + j, n = dir ? 63 - nv : nv; const size_t ud = (size_t)((bh * 64 + n) * 2 + dir);
                GS[ud * 4096 + e2] = pk2(S0, S1); S0 = S0 * d[j].x + bflo(u[j]); S1 = S1 * d[j].y + bfhi(u[j]); } }
    }
}
__device__ __forceinline__ float sconv3(const bf16* proj, int b, int t, int col, const float* w, int wld, int wc) {
    const bf16* p = proj + (size_t)(b * SEQ + t) * NPROJ + col;
    float a = w[wld + wc] * bf2f(p[0]);
    if (t > 0) a += w[wc] * bf2f(p[-NPROJ]);
    if (t < SEQ - 1) a += w[2 * wld + wc] * bf2f(p[NPROJ]);
    return a;
}


typedef float f32x16 __attribute__((ext_vector_type(16)));
typedef short hbf16x8 __attribute__((ext_vector_type(8)));
constexpr int HY_PITCH = 4360, HY_ZOFF = 96;
constexpr int HY_ZBYTES = 8 * HY_PITCH * 2;
constexpr int HY_HRN = 8200;
constexpr int HY_LDS_BYTES = HY_ZBYTES + 2 * HY_HRN * 2;

__device__ __forceinline__ hbf16x8 hy_afrag(LAS const unsigned char* hrb, int m0) {
    const int p = m0 + 4096, odd = p & 1;
    const LAS unsigned* src = (const LAS unsigned*)(hrb + odd * (HY_HRN * 2) + (p + odd) * 2);
    v4u w; w.x = src[0]; w.y = src[1]; w.z = src[2]; w.w = src[3];
    return __builtin_bit_cast(hbf16x8, w);
}
__device__ __forceinline__ void hy_fill_hr(const float* filtT_, int order, int c, LAS unsigned char* hrb, int tid) {
    const GAS bf16* filtT = (const GAS bf16*)filtT_;
    const GAS bf16* hf = filtT + (size_t)(order * 1024 + c) * SEQ; const GAS bf16* hb = filtT + (size_t)(order * 1024 + 512 + c) * SEQ;
    LAS bf16* c0 = (LAS bf16*)hrb; LAS bf16* c1 = c0 + HY_HRN;
    asm volatile("" : "+v"(tid));
    bf16 v[16];
#pragma unroll
    for (int k = 0; k < 16; ++k) { const int m = tid + 512 * k - 4096, am = m < 0 ? -m : m; v[k] = (m <= 0 ? hf : hb)[am > 4095 ? 4095 : am]; }
#pragma unroll
    for (int k = 0; k < 16; ++k) { const int q = tid + 512 * k; const bf16 v0 = q == 0 ? (bf16)0 : v[k]; c0[q] = v0; c1[q + 1] = v0; }
    if (tid < 8) { c0[8192 + tid] = 0; if (tid < 7) c1[8193 + tid] = 0; }
    if (tid == 0) c1[0] = 0;
}
__device__ __forceinline__ void hy_conv(LAS const unsigned char* zbb, LAS const unsigned char* hrb, int w, int lane, f32x4 (&acc)[8][2]) {
    const int n = lane & 15, b = n >> 1, il = n & 1, kq = lane >> 4, i = n;
#pragma unroll
    for (int p = 0; p < 8; ++p)
#pragma unroll
        for (int hh = 0; hh < 2; ++hh) acc[p][hh] = (f32x4){0.f, 0.f, 0.f, 0.f};
    const LAS unsigned char* zl = zbb + (b * HY_PITCH + HY_ZOFF + 32 * il + 8 * kq) * 2 - 64;
    const int mb = -32 * (16 * w + 1) - i + 8 * kq;
    hbf16x8 A[16][2];
#pragma unroll
    for (int d = 0; d <= 14; ++d) { A[(1 + d) & 15][0] = hy_afrag(hrb, mb - 32 * d); A[(1 + d) & 15][1] = hy_afrag(hrb, mb - 32 * d - 16); }
    hbf16x8 b0 = *(const LAS hbf16x8*)zl;
#pragma unroll 1
    for (int c = 0; c < 9; ++c) {
#pragma unroll
        for (int u = 0; u < 16; ++u) { const int s = 16 * c + u;
            if (s <= 128) {
                hbf16x8 nb0 = b0;
                if (s < 128) {
                    A[(16 - u) & 15][0] = hy_afrag(hrb, mb + 32 * (s + 1)); A[(16 - u) & 15][1] = hy_afrag(hrb, mb + 32 * (s + 1) - 16);
                    nb0 = *(const LAS hbf16x8*)(zl + (s + 1) * 64); }
#pragma unroll
                for (int hh = 0; hh < 2; ++hh)
#pragma unroll
                    for (int p = 0; p < 8; ++p) acc[p][hh] = __builtin_amdgcn_mfma_f32_16x16x32_bf16(A[(17 - u + 2 * p) & 15][hh], b0, acc[p][hh], 0, 0, 0);
                b0 = nb0; } }
    }
}
__device__ __forceinline__ v2u hy_conv4_fin(v2u v, bf16 l, bf16 r, int t0, float w0, float w1, float w2) {
    const float xl = t0 > 0 ? bf2f(l) : 0.f, xr = t0 < SEQ - 4 ? bf2f(r) : 0.f;
    const float x0 = bflo(v.x), x1 = bfhi(v.x), x2 = bflo(v.y), x3 = bfhi(v.y);
    v2u o; o.x = pk2(w0 * xl + w1 * x0 + w2 * x1, w0 * x0 + w1 * x1 + w2 * x2); o.y = pk2(w0 * x1 + w1 * x2 + w2 * x3, w0 * x2 + w1 * x3 + w2 * xr); return o;
}
__device__ __forceinline__ void hy_toeplitz_phase(const bf16* uT, const float* cw_, const float* filtT, const float* skip_, bf16* yT, LAS unsigned char* lds, int tid, int lane, int wave, int bid, int G) {
    const GAS float* skip = (const GAS float*)skip_; const GAS float* cw = (const GAS float*)cw_; const GAS bf16* ur = (const GAS bf16*)uT;
    LAS unsigned char* zbb = lds; LAS unsigned char* hrb = lds + HY_ZBYTES;
    for (int i = tid; i < HY_ZBYTES / 4; i += NTHR) ((LAS unsigned*)zbb)[i] = 0u;
    __syncthreads();
    const int w = wave;
    for (int c = bid; c < 512; c += G) {
        { const float w0 = cw[c], w1 = cw[1536 + c], w2 = cw[3072 + c];
#pragma unroll 8
          for (int bb = 0; bb < 8; ++bb) { const int q = tid; const GAS bf16* src = ur + (size_t)c * MTOK + bb * SEQ + q * 8;
              const v4u v = *(const GAS v4u*)src; const float xlr = bf2f(src[q > 0 ? -1 : 0]), xrr = bf2f(src[q < 511 ? 8 : 7]); const float xl = q > 0 ? xlr : 0.f, xr = q < 511 ? xrr : 0.f;
              const float x[10] = {xl, bflo(v.x), bfhi(v.x), bflo(v.y), bfhi(v.y), bflo(v.z), bfhi(v.z), bflo(v.w), bfhi(v.w), xr};
              v4u o; o.x = pk2(w0 * x[0] + w1 * x[1] + w2 * x[2], w0 * x[1] + w1 * x[2] + w2 * x[3]); o.y = pk2(w0 * x[2] + w1 * x[3] + w2 * x[4], w0 * x[3] + w1 * x[4] + w2 * x[5]);
              o.z = pk2(w0 * x[4] + w1 * x[5] + w2 * x[6], w0 * x[5] + w1 * x[6] + w2 * x[7]); o.w = pk2(w0 * x[6] + w1 * x[7] + w2 * x[8], w0 * x[7] + w1 * x[8] + w2 * x[9]);
              *(LAS v4u*)(zbb + (bb * HY_PITCH + HY_ZOFF + q * 8) * 2) = o; } }
        hy_fill_hr(filtT, 0, c, hrb, tid);
        __syncthreads();
        f32x4 acc[8][2];
        hy_conv(zbb, hrb, w, lane, acc);
        { unsigned zp[8][2][2];
        int ln = lane; asm volatile("" : "+v"(ln)); const int n = ln & 15, b = n >> 1, il = n & 1, kq = ln >> 4;
        { const float sk = skip[c]; const float a0 = cw[512 + c], a1 = cw[1536 + 512 + c], a2 = cw[3072 + 512 + c];
          const int tb = 32 * (16 * w + il) + 4 * kq; const GAS bf16* xb0 = ur + (size_t)(512 + c) * MTOK + b * SEQ + tb;
#pragma unroll
          for (int gh = 0; gh < 2; ++gh) { v2u rv[8]; bf16 rl[8], rr[8];
#pragma unroll
            for (int k = 0; k < 8; ++k) { const int off = 64 * (4 * gh + (k >> 1)) + 16 * (k & 1); rv[k] = *(const GAS v2u*)(xb0 + off); rl[k] = xb0[off - 1]; rr[k] = xb0[off + 4]; }
            asm volatile("" ::: "memory");
#pragma unroll
            for (int k = 0; k < 8; ++k) { const int g = 4 * gh + (k >> 1), rq = k & 1, t0 = tb + 64 * g + 16 * rq;
                const v2u xv = hy_conv4_fin(rv[k], rl[k], rr[k], t0, a0, a1, a2);
                const v2u vv = *(const LAS v2u*)(zbb + (b * HY_PITCH + HY_ZOFF + t0) * 2);
                const float z0 = bflo(xv.x) * (acc[g][rq][0] + bflo(vv.x) * sk), z1 = bfhi(xv.x) * (acc[g][rq][1] + bfhi(vv.x) * sk);
                const float z2 = bflo(xv.y) * (acc[g][rq][2] + bflo(vv.y) * sk), z3 = bfhi(xv.y) * (acc[g][rq][3] + bfhi(vv.y) * sk);
                zp[g][rq][0] = pk2(z0, z1); zp[g][rq][1] = pk2(z2, z3); } } }
        __syncthreads();
#pragma unroll
        for (int g = 0; g < 8; ++g)
#pragma unroll
            for (int rq = 0; rq < 2; ++rq) { const int t0 = 32 * (16 * w + 2 * g + il) + 16 * rq + 4 * kq;
                *(LAS v2u*)(zbb + (b * HY_PITCH + HY_ZOFF + t0) * 2) = (v2u){zp[g][rq][0], zp[g][rq][1]}; } }
        hy_fill_hr(filtT, 1, c, hrb, tid);
        __syncthreads();
        hy_conv(zbb, hrb, w, lane, acc);
        { int ln = lane; asm volatile("" : "+v"(ln)); const int n = ln & 15, b = n >> 1, il = n & 1, kq = ln >> 4; const float sk = skip[512 + c]; const float a0 = cw[1024 + c], a1 = cw[1536 + 1024 + c], a2 = cw[3072 + 1024 + c];
          const int tb = 32 * (16 * w + il) + 4 * kq; const GAS bf16* xb0 = ur + (size_t)(1024 + c) * MTOK + b * SEQ + tb;
#pragma unroll
          for (int gh = 0; gh < 2; ++gh) { v2u rv[8]; bf16 rl[8], rr[8];
#pragma unroll
            for (int k = 0; k < 8; ++k) { const int off = 64 * (4 * gh + (k >> 1)) + 16 * (k & 1); rv[k] = *(const GAS v2u*)(xb0 + off); rl[k] = xb0[off - 1]; rr[k] = xb0[off + 4]; }
            asm volatile("" ::: "memory");
#pragma unroll
            for (int k = 0; k < 8; ++k) { const int g = 4 * gh + (k >> 1), rq = k & 1, t0 = tb + 64 * g + 16 * rq;
                const v2u xv = hy_conv4_fin(rv[k], rl[k], rr[k], t0, a0, a1, a2);
                const v2u zv = *(const LAS v2u*)(zbb + (b * HY_PITCH + HY_ZOFF + t0) * 2);
                const float z0 = bflo(zv.x), z1 = bfhi(zv.x), z2 = bflo(zv.y), z3 = bfhi(zv.y);
                const float o0 = bflo(xv.x) * (acc[g][rq][0] + z0 * sk), o1 = bfhi(xv.x) * (acc[g][rq][1] + z1 * sk);
                const float o2 = bflo(xv.y) * (acc[g][rq][2] + z2 * sk), o3 = bfhi(xv.y) * (acc[g][rq][3] + z3 * sk);
                *(GAS v2u*)(yT + (size_t)c * MTOK + b * SEQ + t0) = (v2u){pk2(o0, o1), pk2(o2, o3)}; } } }
        __syncthreads();
    }
}
__device__ __forceinline__ void hy_transpose_out(const bf16* yT, const float* gC, bf16* mix, LAS unsigned char* lds, int tid, int lane, int wave, int bid, int G) {
    constexpr int TQ = 516;
    LAS bf16* T = (LAS bf16*)lds;
    const f32x4 g0 = *(const GAS f32x4*)(gC + lane * 8), g1 = *(const GAS f32x4*)(gC + lane * 8 + 4);
    for (int tile = bid; tile < MTOK / 64; tile += G) { const int tok0 = tile * 64;
        v4u rv[8];
#pragma unroll
        for (int pass = 0; pass < 8; ++pass) { const int c = (tid >> 3) + 64 * pass, sg = tid & 7; rv[pass] = *(const GAS v4u*)(yT + (size_t)c * MTOK + tok0 + 8 * sg); }
#pragma unroll
        for (int pass = 0; pass < 8; ++pass) { const int c = (tid >> 3) + 64 * pass, sg = tid & 7; const unsigned w[4] = {rv[pass].x, rv[pass].y, rv[pass].z, rv[pass].w};
#pragma unroll
            for (int e = 0; e < 8; ++e) T[(8 * sg + e) * TQ + c] = (bf16)((e & 1) ? (w[e >> 1] >> 16) : (w[e >> 1] & 0xffffu)); }
        __syncthreads();
#pragma unroll 1
        for (int k = 0; k < 8; ++k) { const int s = wave * 8 + k; float y[8]; float ss = 0.f;
            const v2u ya = *(const LAS v2u*)(T + s * TQ + lane * 8), yb = *(const LAS v2u*)(T + s * TQ + lane * 8 + 4);
            y[0] = bflo(ya.x); y[1] = bfhi(ya.x); y[2] = bflo(ya.y); y[3] = bfhi(ya.y); y[4] = bflo(yb.x); y[5] = bfhi(yb.x); y[6] = bflo(yb.y); y[7] = bfhi(yb.y);
#pragma unroll
            for (int e = 0; e < 8; ++e) ss += y[e] * y[e];
            const float rstd = rsqrtf(wave_sum(ss) * (1.f / 512.f) + EPS);
            v4u o; o.x = pk2(y[0] * rstd * g0.x, y[1] * rstd * g0.y); o.y = pk2(y[2] * rstd * g0.z, y[3] * rstd * g0.w);
            o.z = pk2(y[4] * rstd * g1.x, y[5] * rstd * g1.y); o.w = pk2(y[6] * rstd * g1.z, y[7] * rstd * g1.w);
            *(GAS v4u*)(mix + (size_t)(tok0 + s) * DM + 1024 + lane * 8) = o; }
        __syncthreads();
    }
}

__device__ __forceinline__ void phase_c_misc(const Params& P, unsigned char* ws, float* xres, int l, LAS unsigned char* lds, int tid, int lane, int wave, int bid, int G) {
    const bf16* proj = (const bf16*)(ws + WS_PROJ); bf16* mix = (bf16*)(ws + WS_MIX);
    { const bf16* FU2 = (const bf16*)(ws + WS_FU2); bf16* FE = (bf16*)(ws + WS_FE); bf16* FO = (bf16*)(ws + WS_FO); float* Y2K = (float*)(ws + WS_Y2K);
      const int gw = bid * NWAVES + wave, NGW = G * NWAVES;
      for (int col = gw; col < 4096; col += NGW) { const bf16* ur = FU2 + (size_t)col * 8192; const bf16* ui = ur + 4096; float alt = 0.f;
#pragma unroll
          for (int j = 0; j < 4; ++j) { const int t0 = 8 * (lane + 64 * j);
              const v4u a = *(const GAS v4u*)(ur + t0), c = *(const GAS v4u*)(ui + t0);
              const v4u ma = *(const GAS v4u*)(ur + 4096 - t0 - 8), mc = *(const GAS v4u*)(ui + 4096 - t0 - 8);
              const float m0rr = bf2f(ur[t0 ? 4096 - t0 : 0]), m0ir = bf2f(ui[t0 ? 4096 - t0 : 0]); const float m0r = t0 ? m0rr : 0.f, m0i = t0 ? m0ir : 0.f;
              float er[8], oi[8];
              const unsigned aw[4] = {a.x, a.y, a.z, a.w}, cw[4] = {c.x, c.y, c.z, c.w}, maw[4] = {ma.x, ma.y, ma.z, ma.w}, mcw[4] = {mc.x, mc.y, mc.z, mc.w};
#pragma unroll
              for (int e = 0; e < 8; ++e) { const float xr = (e & 1) ? bfhi(aw[e >> 1]) : bflo(aw[e >> 1]), xi = (e & 1) ? bfhi(cw[e >> 1]) : bflo(cw[e >> 1]);
                  float mr, mi; if (e == 0) { mr = m0r; mi = m0i; } else { const int q = 8 - e; mr = (q & 1) ? bfhi(maw[q >> 1]) : bflo(maw[q >> 1]); mi = (q & 1) ? bfhi(mcw[q >> 1]) : bflo(mcw[q >> 1]); }
                  er[e] = xr + mr; oi[e] = (t0 + e) ? xi - mi : 0.f; alt += (e & 1) ? -er[e] : er[e]; }
              v4u oe, oo; oe.x = pk2(er[0], er[1]); oe.y = pk2(er[2], er[3]); oe.z = pk2(er[4], er[5]); oe.w = pk2(er[6], er[7]);
              oo.x = pk2(oi[0], oi[1]); oo.y = pk2(oi[2], oi[3]); oo.z = pk2(oi[4], oi[5]); oo.w = pk2(oi[6], oi[7]);
              *(GAS v4u*)(FE + (size_t)col * FK1 + t0) = oe; *(GAS v4u*)(FO + (size_t)col * 2048 + t0) = oo; }
          const float e2k = bf2f(ur[2048]);
          if (lane < 16) { v4u z = (v4u){0u, 0u, 0u, 0u}; if (lane == 0) z.x = f2bf(e2k); *(GAS v4u*)(FE + (size_t)col * FK1 + 2048 + 8 * lane) = z; }
          alt = wave_sum(alt) + e2k;
          if (lane == 0) Y2K[col] = alt * 0.001381067932f; } }
    { const float* cw = pin(P, 16) + (size_t)l * 3 * 512; const float* gD = pin(P, 17) + (size_t)(l * 3 + 2) * 512;
      const int gw = bid * NWAVES + wave, NGW = G * NWAVES, c0 = lane * 8;
      float w0[8], w1[8], w2[8], gd[8];
#pragma unroll
      for (int e = 0; e < 8; ++e) { w0[e] = cw[c0 + e]; w1[e] = cw[512 + c0 + e]; w2[e] = cw[1024 + c0 + e]; gd[e] = gD[c0 + e]; }
      for (int tk0 = gw; tk0 < MTOK; tk0 += 2 * NGW) {
          v4u vb[2], vc[2], vh[2], vcm[2], vhm[2], vcp[2], vhp[2];
#pragma unroll
          for (int h = 0; h < 2; ++h) { const int tk = tk0 + h * NGW, token = tk < MTOK ? tk : MTOK - 1, t = token & (SEQ - 1);
              const bf16* p = proj + (size_t)token * NPROJ + PUS + c0; const int om = t > 0 ? -NPROJ : 0, op = t < SEQ - 1 ? NPROJ : 0;
              vb[h] = *(const GAS v4u*)p; vc[h] = *(const GAS v4u*)(p + 512); vh[h] = *(const GAS v4u*)(p + 1024);
              vcm[h] = *(const GAS v4u*)(p + 512 + om); vhm[h] = *(const GAS v4u*)(p + 1024 + om); vcp[h] = *(const GAS v4u*)(p + 512 + op); vhp[h] = *(const GAS v4u*)(p + 1024 + op); }
#pragma unroll
          for (int h = 0; h < 2; ++h) { const int token = tk0 + h * NGW, t = token & (SEQ - 1); const float km = t > 0 ? 1.f : 0.f, kp = t < SEQ - 1 ? 1.f : 0.f;
              float y[8]; float ss = 0.f;
#pragma unroll
              for (int e2 = 0; e2 < 4; ++e2) {
                  const float a0 = km * w0[2 * e2] * bflo(vcm[h][e2]) * bflo(vhm[h][e2]) + w1[2 * e2] * bflo(vc[h][e2]) * bflo(vh[h][e2]) + kp * w2[2 * e2] * bflo(vcp[h][e2]) * bflo(vhp[h][e2]);
                  const float a1 = km * w0[2 * e2 + 1] * bfhi(vcm[h][e2]) * bfhi(vhm[h][e2]) + w1[2 * e2 + 1] * bfhi(vc[h][e2]) * bfhi(vh[h][e2]) + kp * w2[2 * e2 + 1] * bfhi(vcp[h][e2]) * bfhi(vhp[h][e2]);
                  y[2 * e2] = bflo(vb[h][e2]) * a0; y[2 * e2 + 1] = bfhi(vb[h][e2]) * a1; ss += y[2 * e2] * y[2 * e2] + y[2 * e2 + 1] * y[2 * e2 + 1]; }
              const float rstd = rsqrtf(wave_sum(ss) * (1.f / 512.f) + EPS);
              v4u o; o.x = pk2(y[0] * rstd * gd[0], y[1] * rstd * gd[1]); o.y = pk2(y[2] * rstd * gd[2], y[3] * rstd * gd[3]); o.z = pk2(y[4] * rstd * gd[4], y[5] * rstd * gd[5]); o.w = pk2(y[6] * rstd * gd[6], y[7] * rstd * gd[7]);
              if (token < MTOK) *(GAS v4u*)(mix + (size_t)token * DM + 1536 + c0) = o; } } }
    __syncthreads();
    gla_g1(proj, pin(P, 4) + (size_t)l * 2 * 16 * 256, pin(P, 5) + (size_t)l * 512, (bf16*)(ws + WS_GU), (float*)(ws + WS_GD), lds, tid, lane, wave, bid, G);
}

__device__ __forceinline__ void phase_d(const Params& P, unsigned char* ws, float* xres, int l, LAS unsigned char* lds, int tid, int lane, int wave, int bid, int G) {
    if (!(P.pad1 & 2)) gla_g3((const bf16*)(ws + WS_PROJ), pin(P, 4) + (size_t)l * 2 * 16 * 256, pin(P, 5) + (size_t)l * 512, pin(P, 6) + (size_t)l * 128, (const bf16*)(ws + WS_GS), (bf16*)(ws + WS_MIX), lds, tid, lane, wave, bid, G);
}
__device__ __forceinline__ void phase_e(const Params& P, unsigned char* ws, float* xres, int l, LAS unsigned char* lds, int tid, int lane, int wave, int bid, int G) {
    hy_transpose_out((const bf16*)(ws + WS_YT), pin(P, 17) + (size_t)(l * 3 + 1) * 512, (bf16*)(ws + WS_MIX), lds, tid, lane, wave, bid, G);
    { const bf16* FY = (const bf16*)(ws + WS_FY); const float* gB = pin(P, 17) + (size_t)(l * 3 + 0) * 512; bf16* mix = (bf16*)(ws + WS_MIX);
      const int gw = bid * NWAVES + wave, NGW = G * NWAVES;
      const f32x4 g0 = *(const GAS f32x4*)(gB + lane * 8), g1 = *(const GAS f32x4*)(gB + lane * 8 + 4);
      const float* Y2K = (const float*)(ws + WS_Y2K);
      for (int it0 = gw; it0 < MTOK; it0 += 2 * NGW) {
          v4u ya[2], yb[2];
#pragma unroll
          for (int h = 0; h < 2; ++h) { const int i2 = it0 + h * NGW, it = i2 < MTOK ? i2 : MTOK - 1, b = it >> 12, sp = it & (SEQ - 1);
              const int sf = sp < 2048 ? sp : 4096 - sp, sfc = sf > 2047 ? 2047 : sf;
              const bf16* src = FY + (size_t)sfc * 4096 + b * 512 + lane * 8; const bf16* srb = src + (size_t)2048 * 4096;
              ya[h] = *(const GAS v4u*)src; yb[h] = *(const GAS v4u*)srb; }
#pragma unroll
          for (int h = 0; h < 2; ++h) { const int it = it0 + h * NGW, b = it >> 12, sp = it & (SEQ - 1); const float sg = sp < 2048 ? 1.f : -1.f;
              f32x4 a = (f32x4){bflo(ya[h].x), bfhi(ya[h].x), bflo(ya[h].y), bfhi(ya[h].y)} + (f32x4){bflo(yb[h].x), bfhi(yb[h].x), bflo(yb[h].y), bfhi(yb[h].y)} * sg;
              f32x4 c = (f32x4){bflo(ya[h].z), bfhi(ya[h].z), bflo(ya[h].w), bfhi(ya[h].w)} + (f32x4){bflo(yb[h].z), bfhi(yb[h].z), bflo(yb[h].w), bfhi(yb[h].w)} * sg;
              if (sp == 2048) { a = *(const GAS f32x4*)(Y2K + (b & 7) * 512 + lane * 8); c = *(const GAS f32x4*)(Y2K + (b & 7) * 512 + lane * 8 + 4); }
              const float ss = (a.x * a.x + a.y * a.y) + (a.z * a.z + a.w * a.w) + (c.x * c.x + c.y * c.y) + (c.z * c.z + c.w * c.w);
              const float rstd = rsqrtf(wave_sum(ss) * (1.f / 512.f) + EPS);
              v4u o; o.x = pk2(a.x * rstd * g0.x, a.y * rstd * g0.y); o.y = pk2(a.z * rstd * g0.z, a.w * rstd * g0.w); o.z = pk2(c.x * rstd * g1.x, c.y * rstd * g1.y); o.w = pk2(c.z * rstd * g1.z, c.w * rstd * g1.w);
              if (it < MTOK) *(GAS v4u*)(mix + (size_t)it * DM + 512 + lane * 8) = o; } } }
}
__device__ __forceinline__ void phase_softmax(const float* sc, bf16* Pm, int lane, int wave, int bid, int G) {
    const int gw = bid * NWAVES + wave, NGW = G * NWAVES;
    for (int it = gw; it < MTOK * 4; it += NGW) {
        const f32x4 v = *((const GAS f32x4*)(sc + (size_t)it * 256) + lane);
        const float m = wave_max(fmaxf(fmaxf(v.x, v.y), fmaxf(v.z, v.w)));
        const float e0 = __expf(v.x - m), e1 = __expf(v.y - m), e2 = __expf(v.z - m), e3 = __expf(v.w - m);
        const float inv = 1.0f / wave_sum((e0 + e1) + (e2 + e3));
        v2u w; w.x = pk2(e0 * inv, e1 * inv); w.y = pk2(e2 * inv, e3 * inv);
        *((GAS v2u*)(Pm + (size_t)it * 256) + lane) = w;
    }
}

#ifndef EPIRES_XB
#define EPIRES_XB (GAS bf16*)xb
#endif
#ifndef GEMM_ALIGN
#define GEMM_ALIGN false
#endif
#ifndef GEMM_SP2
#define GEMM_SP2 true
#endif
constexpr int NPH = 11, NSTEPS = NL * NPH + 1;
template <class Sched, bool COLS = false> __device__ __forceinline__ pg8::RstdTab build_rstd(const Sched& S, const float* RS, LAS float* tab, int tid) {
    pg8::RstdTab T; T.tab = tab; T.RS = (const GAS float*)RS; T.pm0 = T.pm1 = T.pm2 = T.pm3 = -1; int n = 0; pg8::Unit u;
    for (int i = 0; S.next(i, u); ++i) { const int pm = COLS ? u.pn : u.pm;
        if (pm != T.pm0 && pm != T.pm1 && pm != T.pm2 && pm != T.pm3) { if (n == 0) T.pm0 = pm; else if (n == 1) T.pm1 = pm; else if (n == 2) T.pm2 = pm; else if (n == 3) T.pm3 = pm; ++n; } }
    const int row = tid >> 1, half = tid & 1;
#pragma unroll
    for (int sl = 0; sl < 4; ++sl) { const int pm = sl == 0 ? T.pm0 : sl == 1 ? T.pm1 : sl == 2 ? T.pm2 : T.pm3;
        if (pm >= 0) { const GAS float* p = (const GAS float*)RS + (size_t)(pm * 256 + row) * 32 + half * 16;
            const f32x4 a = *(const GAS f32x4*)p, b = *(const GAS f32x4*)(p + 4), c = *(const GAS f32x4*)(p + 8), d = *(const GAS f32x4*)(p + 12);
            float t = (((a.x + a.y) + (a.z + a.w)) + ((b.x + b.y) + (b.z + b.w))) + (((c.x + c.y) + (c.z + c.w)) + ((d.x + d.y) + (d.z + d.w)));
            t += __shfl_xor(t, 1);
            if (half == 0) tab[sl * 256 + row] = rsqrtf(t * (1.0f / DM) + EPS); } }
    __syncthreads();
    return T;
}
#define IN(st) (lo <= (st) && (st) < hi)
#define SEAM(stp_) do { if ((stp_) + 1 < hi) { XcdBarrier b2_; b2_.bar = opaque_p(bar.bar); b2_.x = (unsigned)opaque_i((int)bar.x); b2_.st = bar.st; xcd_barrier(b2_, tid); } } while (0)
#define OPAQ() int tid = wave0 * 64 + (int)__builtin_amdgcn_mbcnt_hi(~0u, __builtin_amdgcn_mbcnt_lo(~0u, 0u)); asm volatile("" : "+v"(tid)); const int bid = opaque_i(bid0), G = opaque_i(G0); unsigned char* ws = opaque_p(ws0); float* xres = opaque_p(out0); const unsigned ldsa = (unsigned)opaque_i((int)(unsigned)(size_t)lds0)
#define LOCALS() OPAQ(); LAS unsigned char* lds = (LAS unsigned char*)(size_t)ldsa; const int lane = tid & 63, wave = __builtin_amdgcn_readfirstlane(tid >> 6); \
        bf16* xb = (bf16*)(ws + WS_XB); bf16* proj = (bf16*)(ws + WS_PROJ); bf16* mix = (bf16*)(ws + WS_MIX); (void)lds; (void)lane; (void)wave; (void)xb; (void)proj; (void)mix
template <int L> __device__ __forceinline__ void layer_body(const Params& P, const XcdBarrier& bar, int lo, int hi, int wave0, int bid0, int G0, unsigned char* ws0, float* out0, LAS unsigned char* lds0) {
    constexpr int l = L; const int s0 = l * NPH;
        if (s0 + NPH <= lo || s0 >= hi) return;
        if (IN(s0 + 0)) { LOCALS(); phase_a(P, ws, xres, l, lds, tid, lane, wave, bid, G); SEAM(s0 + 0); }
        if (IN(s0 + 1)) { LOCALS();
            { pg8::Gemm g{xb, (const bf16*)(ws + WS_WIN), DM, DM, DM}; pg8::TileOrder S; S.init(MTOK / 256, NPROJ / 256, G, bid, DM, DM);
            pg8::EpiBf16 E{(GAS bf16*)proj, NPROJ, build_rstd(S, (const float*)(ws + WS_RSS), (LAS float*)(lds + LDSCTL_OFF + 1024 + 8192), tid)}; pg8::gemm_phase<pg8::EpiBf16, pg8::TileOrder, GEMM_ALIGN, GEMM_SP2>(lds + RING_OFF, g, S, E, tid);
            }
            { pg8::Gemm g{(const bf16*)(ws + WS_MEMN), (const bf16*)(ws + WS_WKV), DM, DM, DM}; pg8::TileOrder S; S.init(NB * NMEM / 256, 2 * DM / 256, G, (bid + G / 2) % G, DM, DM);
            pg8::EpiBf16 E{(GAS bf16*)(ws + WS_KVB), 2 * DM, pg8::RstdTab{nullptr, nullptr, -1, -1, -1, -1}}; pg8::gemm_phase<pg8::EpiBf16, pg8::TileOrder, GEMM_ALIGN, GEMM_SP2>(lds + RING_OFF, g, S, E, tid); }
            { pg8::Gemm g{(const bf16*)(ws + WS_WIN) + (size_t)WUH * DM, xb, DM, DM, DM}; pg8::TileOrder S; S.init(1536 / 256, MTOK / 256, G, bid, DM, DM);
              pg8::EpiBf16T E{(GAS bf16*)(ws + WS_UT), MTOK, build_rstd<pg8::TileOrder, true>(S, (const float*)(ws + WS_RSS), (LAS float*)(lds + LDSCTL_OFF + 1024 + 8192), tid)};
              pg8::gemm_phase<pg8::EpiBf16T, pg8::TileOrder, GEMM_ALIGN, GEMM_SP2>(lds + RING_OFF, g, S, E, tid); }
            SEAM(s0 + 1); }
        if (IN(s0 + 2)) { LOCALS();
            { pg8::Gemm g{(const bf16*)(ws + WS_KVB), (const bf16*)(ws + WS_WQB), 2 * DM, DM, 512}; pg8::PairOrder<0> S{G, bid};
            pg8::EpiBf16 E{(GAS bf16*)(ws + WS_MT), DM, pg8::RstdTab{nullptr, nullptr, -1, -1, -1, -1}}; pg8::gemm_phase<pg8::EpiBf16, pg8::PairOrder<0>, GEMM_ALIGN, GEMM_SP2>(lds + RING_OFF, g, S, E, tid); }
            { pg8::Gemm g{(const bf16*)(ws + WS_WXO), (const bf16*)(ws + WS_KVB), DM, 2 * DM, 512}; pg8::PairOrder<1> S{G, bid};
            pg8::EpiBf16 E{(GAS bf16*)(ws + WS_VWO), 1024, pg8::RstdTab{nullptr, nullptr, -1, -1, -1, -1}}; pg8::gemm_phase<pg8::EpiBf16, pg8::PairOrder<1>, GEMM_ALIGN, GEMM_SP2>(lds + RING_OFF, g, S, E, tid); }
            { pg8::Gemm g{(const bf16*)(ws + WS_A1), proj, 256, NPROJ, 256}; pg8::FnetAOrder S{G, bid};
            pg8::EpiFnetA E{(GAS bf16*)(ws + WS_FU2)}; pg8::gemm_phase<pg8::EpiFnetA, pg8::FnetAOrder, GEMM_ALIGN, GEMM_SP2>(lds + RING_OFF, g, S, E, tid); }
            SEAM(s0 + 2); }
        if (IN(s0 + 3)) { LOCALS(); phase_c_misc(P, ws, xres, l, lds, tid, lane, wave, bid, G); SEAM(s0 + 3); }
        if (IN(s0 + 4)) { LOCALS();
            { pg8::Gemm g{(const bf16*)(ws + WS_C2), (const bf16*)(ws + WS_FE), FK1, FK1, FK1}; pg8::TileOrder S; S.init(8, 16, G, bid, FK1, FK1);
              pg8::EpiBf16 E{(GAS bf16*)(ws + WS_FY), 4096, pg8::RstdTab{nullptr, nullptr, -1, -1, -1, -1}}; pg8::gemm_phase<pg8::EpiBf16, pg8::TileOrder, GEMM_ALIGN, GEMM_SP2>(lds + RING_OFF, g, S, E, tid); }
            { pg8::Gemm g{(const bf16*)(ws + WS_S2), (const bf16*)(ws + WS_FO), 2048, 2048, 2048}; pg8::TileOrder S; S.init(8, 16, G, (bid + G / 2) % G, 2048, 2048);
              pg8::EpiBf16 E{(GAS bf16*)(ws + WS_FY) + (size_t)2048 * 4096, 4096, pg8::RstdTab{nullptr, nullptr, -1, -1, -1, -1}}; pg8::gemm_phase<pg8::EpiBf16, pg8::TileOrder, GEMM_ALIGN, GEMM_SP2>(lds + RING_OFF, g, S, E, tid); }
            gla_g2((const bf16*)(ws + WS_GU), (const float*)(ws + WS_GD), (bf16*)(ws + WS_GS), tid, bid, G);
            __syncthreads();
            hy_toeplitz_phase((const bf16*)(ws + WS_UT), pin(P, 7) + (size_t)l * 3 * 1536, (const float*)(ws + WS_FILT), pin(P, 15) + (size_t)l * 1024, (bf16*)(ws + WS_YT), lds, tid, lane, wave, bid, G);
            SEAM(s0 + 4); }
        if (IN(s0 + 5)) { LOCALS(); phase_d(P, ws, xres, l, lds, tid, lane, wave, bid, G); __syncthreads(); phase_e(P, ws, xres, l, lds, tid, lane, wave, bid, G); SEAM(s0 + 5); }
        if (IN(s0 + 6)) { LOCALS();
            pg8::Gemm g{mix, (const bf16*)(ws + WS_WOUT), DM, DM, DM}; pg8::TileOrder S; S.init(MTOK / 256, DM / 256, G, bid, DM, DM);
            pg8::EpiRes E{l == 0 ? (const GAS float*)pin(P, 0) : (const GAS float*)nullptr, DM, (GAS bf16*)xb, (GAS float*)(ws + WS_RSS)}; pg8::gemm_phase<pg8::EpiRes, pg8::TileOrder, GEMM_ALIGN, GEMM_SP2>(lds + RING_OFF, g, S, E, tid);
            SEAM(s0 + 6); }
        if (IN(s0 + 7)) { LOCALS();
            pg8::Gemm g{xb, (const bf16*)(ws + WS_MT), DM, DM, DM}; pg8::TileOrder S; S.init(MTOK / 256, 4, G, bid, DM, DM, 16, 4);
            pg8::EpiSoftmax E{(GAS bf16*)mix, 1024, (LAS float*)(lds + LDSCTL_OFF + 1024), (LAS float*)(lds + LDSCTL_OFF + 1024 + 4096), build_rstd(S, (const float*)(ws + WS_RSS), (LAS float*)(lds + LDSCTL_OFF + 1024 + 8192), tid)}; pg8::gemm_phase<pg8::EpiSoftmax, pg8::TileOrder, true, GEMM_SP2>(lds + RING_OFF, g, S, E, tid);
            SEAM(s0 + 7); }
        if (IN(s0 + 8)) { LOCALS();
            pg8::Gemm g{mix, (const bf16*)(ws + WS_VWO), 1024, 1024, 1024}; pg8::TileOrder S; S.init(MTOK / 256, DM / 256, G, bid, 1024, 1024, 16, 8);
            pg8::EpiRes E{(const GAS float*)nullptr, DM, (GAS bf16*)xb, (GAS float*)(ws + WS_RSS)}; pg8::gemm_phase<pg8::EpiRes, pg8::TileOrder, GEMM_ALIGN, GEMM_SP2>(lds + RING_OFF, g, S, E, tid);
            SEAM(s0 + 8); }
        if (IN(s0 + 9)) { LOCALS();
            pg8::Gemm g{xb, (const bf16*)(ws + WS_WGU), DM, DM, DM}; pg8::TileOrder S; S.init(MTOK / 256, 2 * DFF / 256, G, bid, DM, DM);
            pg8::EpiSwiglu E{(GAS bf16*)proj, DFF, build_rstd(S, (const float*)(ws + WS_RSS), (LAS float*)(lds + LDSCTL_OFF + 1024 + 8192), tid)}; pg8::gemm_phase<pg8::EpiSwiglu, pg8::TileOrder, GEMM_ALIGN, GEMM_SP2>(lds + RING_OFF, g, S, E, tid);
            SEAM(s0 + 9); }
        if (IN(s0 + 10)) { LOCALS();
            pg8::Gemm g{proj, (const bf16*)(ws + WS_WD), DFF, DFF, DFF}; pg8::TileOrder S; S.init(MTOK / 256, DM / 256, G, bid, DFF, DFF);
            pg8::EpiRes E{(const GAS float*)nullptr, DM, (GAS bf16*)xb, (GAS float*)(ws + WS_RSS)}; pg8::gemm_phase<pg8::EpiRes, pg8::TileOrder, GEMM_ALIGN, GEMM_SP2>(lds + RING_OFF, g, S, E, tid);
            SEAM(s0 + 10); }
    }
__global__ void __launch_bounds__(NTHR, 2) fwd_kernel(Params P) {
    extern __shared__ __attribute__((aligned(16))) unsigned char lds_raw[];
    LAS unsigned char* lds = (LAS unsigned char*)lds_raw; LAS unsigned char* const lds0 = lds;
    const int tid = threadIdx.x, lane = tid & 63, wave = __builtin_amdgcn_readfirstlane(tid >> 6), bid = blockIdx.x, G = gridDim.x;
    volatile LAS unsigned* MISC = (volatile LAS unsigned*)(lds + MISC_OFF);
    for (int u = tid; u < (LDS_BYTES - LDSCTL_OFF) / 4; u += NTHR) ((LAS unsigned*)(lds + LDSCTL_OFF))[u] = 0u;
    __syncthreads();
    unsigned char* ws = P.ws;
    XcdBarrier bar = xcd_barrier_post((unsigned*)(ws + WS_CTL) + CW_BAR + P.pad0 * XCD_BAR_WORDS, MISC + 8, tid);
    const int lo = P.step_lo, hi = P.step_hi;
    const int wave0 = wave, bid0 = bid, G0 = G; unsigned char* const ws0 = ws; float* const out0 = P.out;
    layer_body<0>(P, bar, lo, hi, wave0, bid0, G0, ws0, out0, lds0);
    layer_body<1>(P, bar, lo, hi, wave0, bid0, G0, ws0, out0, lds0);
    layer_body<2>(P, bar, lo, hi, wave0, bid0, G0, ws0, out0, lds0);
    layer_body<3>(P, bar, lo, hi, wave0, bid0, G0, ws0, out0, lds0);
    if (IN(NL * NPH)) { LOCALS(); const int gw = bid * NWAVES + wave, NGW = G * NWAVES;
        for (int m = gw; m < MTOK; m += NGW) final_norm_row(xb + (size_t)m * DM, xres + (size_t)m * DM, pin(P, 25), lane); }
#undef IN
#undef SEAM
}

#ifndef MK_SPLIT
#define MK_SPLIT 0
#endif
extern "C" void kernel_launch(void* const* d_in, const int* in_sizes, int n_in, void* d_out, int out_size, void* d_ws, size_t ws_size, hipStream_t stream) {
    static int grid = 0;
    if (grid == 0) {
        if (n_in != 26 || in_sizes[0] != MTOK * DM || out_size != MTOK * DM || ws_size < WS_END) { fprintf(stderr, "kernel_launch: unexpected shapes (n_in %d, in0 %d, out %d, ws %zu); nothing launched\n", n_in, n_in > 0 ? in_sizes[0] : -1, out_size, ws_size); grid = -1; return; }
        int dev = 0, cus = 0, per_cu = 0;
        if (hipGetDevice(&dev) != hipSuccess || hipDeviceGetAttribute(&cus, hipDeviceAttributeMultiprocessorCount, dev) != hipSuccess) { grid = -1; return; }
        if (hipFuncSetAttribute((const void*)fwd_kernel, hipFuncAttributeMaxDynamicSharedMemorySize, LDS_BYTES) != hipSuccess) { fprintf(stderr, "kernel_launch: hipFuncSetAttribute failed\n"); grid = -1; return; }
        if (hipOccupancyMaxActiveBlocksPerMultiprocessor(&per_cu, (const void*)fwd_kernel, NTHR, LDS_BYTES) != hipSuccess || per_cu < 1) { fprintf(stderr, "kernel_launch: occupancy query says %d\n", per_cu); }
        (void)hipGetLastError();
        grid = cus;
    }
    if (grid < 0) return;
    if (hipMemsetAsync((char*)d_ws + WS_CTL, 0, CTL_ZERO_BYTES, stream) != hipSuccess) return;
    Params p{};
    for (int i = 0; i < 26; ++i) p.in[i] = (const float*)d_in[i];
    p.out = (float*)d_out; p.ws = (unsigned char*)d_ws;
#if defined(PROBE_PH)
#ifndef PROBE_FLAGS
#define PROBE_FLAGS 0
#endif
    { int lo = 0; int li = 0;
      for (int l = 0; l < NL; ++l) { const int gk = l * NPH + PROBE_PH;
          p.pad0 = li++; p.step_lo = lo; p.step_hi = gk + 1; hipLaunchKernelGGL(fwd_kernel, dim3(grid), dim3(NTHR), LDS_BYTES, stream, p);
          p.pad0 = li++; p.step_lo = gk; p.step_hi = gk + 1; p.pad1 = PROBE_FLAGS; hipLaunchKernelGGL(fwd_kernel, dim3(grid), dim3(NTHR), LDS_BYTES, stream, p); p.pad1 = 0;
          lo = gk + 1; }
      p.pad0 = li++; p.step_lo = lo; p.step_hi = NSTEPS; hipLaunchKernelGGL(fwd_kernel, dim3(grid), dim3(NTHR), LDS_BYTES, stream, p); }
#elif MK_SPLIT
    for (int st = 0; st < NSTEPS; ++st) { p.pad0 = st; p.step_lo = st; p.step_hi = st + 1; hipLaunchKernelGGL(fwd_kernel, dim3(grid), dim3(NTHR), LDS_BYTES, stream, p); }
#else
    p.step_lo = 0; p.step_hi = NSTEPS; hipLaunchKernelGGL(fwd_kernel, dim3(grid), dim3(NTHR), LDS_BYTES, stream, p);
#endif
}
```

```cpp
#include <hip/hip_runtime.h>
#include <cstdio>
#include <cstdint>

namespace pg8 {
#define PG8_LAS __attribute__((address_space(3)))
#define PG8_GAS __attribute__((address_space(1)))
typedef unsigned short bf16_t;
typedef short bf16x8 __attribute__((ext_vector_type(8)));
typedef float f32x4 __attribute__((ext_vector_type(4)));
typedef unsigned u32x4 __attribute__((ext_vector_type(4)));
constexpr int BM = 256, BK = 64, HALF = 128, HTB = HALF * BK * 2  , STAGE_BYTES = 8 * HTB, NXCD = 8, WGM = 4;

__host__ __device__ __forceinline__ int lds_byte(int r, int c) { const int st = (r >> 4) * 2 + (c >> 5), rr = r & 15, cc = c & 31, ob = rr * 64 + cc * 2; return st * 1024 + (ob ^ (((ob >> 9) & 1) << 5)); }
__host__ __device__ __forceinline__ void stage_rc(int b, int& R, int& C) { const int st = b / 1024, sb = b % 1024, swz = sb ^ (((sb >> 9) & 1) << 5); R = (st >> 1) * 16 + swz / 64; C = (st & 1) * 32 + (swz % 64) / 2; }
__host__ __device__ __forceinline__ int perm32(int rho) { const int n = rho >> 4, i = rho & 15; return 8 * (i >> 2) + 4 * n + (i & 3); }

struct Unit { size_t aoff, boff; int pm, pn; };
struct Gemm { const bf16_t* A; const bf16_t* Bt; int lda, ldb, K; };

struct TileOrder {
    int nM, nN, nwg, G, c, bdiv, bmul; size_t atile, btile;
    __device__ void init(int nM_, int nN_, int G_, int c_, int lda, int ldb, int bdiv_ = 1 << 30, int bmul_ = 0) { nM = nM_; nN = nN_; nwg = nM * nN; G = G_; c = c_; bdiv = bdiv_; bmul = bmul_; atile = (size_t)BM * lda * 2; btile = (size_t)BM * ldb * 2; }
    __device__ bool next(int i, Unit& u) const {
        const long L = (long)i * G + c; if (L >= nwg) return false;
        int wgid = (int)L; { const int q = nwg / NXCD, r = nwg % NXCD, xcd = wgid % NXCD, off = wgid / NXCD; wgid = (xcd < r ? xcd * (q + 1) : r * (q + 1) + (xcd - r) * q) + off; }
        const int nig = WGM * nN, gid = wgid / nig, fm = gid * WGM, gsz = (nM - fm) < WGM ? (nM - fm) : WGM;
        u.pm = fm + ((wgid % nig) % gsz); u.pn = (wgid % nig) / gsz;
        u.aoff = (size_t)u.pm * atile; u.boff = (size_t)((u.pm / bdiv) * bmul + u.pn) * btile; return true;
    }
    __device__ __forceinline__ void a_ready(const Unit&) const {}
    __device__ __forceinline__ void done(const Unit&) const {}
};
template <int MODE> struct PairOrder {
    int G, c;
    __device__ bool next(int i, Unit& u) const {
        const long L = (long)i * G + c; if (L >= 256) return false;
        const int bh = (int)L >> 3, j = (int)L & 7, b = bh >> 2, h = bh & 3;
        if (MODE == 0) { u.aoff = ((size_t)(b * 256) * 4096 + h * 512) * 2; u.boff = ((size_t)(j * 256) * 2048 + h * 512) * 2; u.pm = b * 4 + h; u.pn = j; }
        else           { u.aoff = ((size_t)(j * 256) * 2048 + h * 512) * 2; u.boff = ((size_t)(b * 256) * 4096 + 2048 + h * 512) * 2; u.pm = b * 8 + j; u.pn = h; }
        return true;
    }
    __device__ __forceinline__ void a_ready(const Unit&) const {}
    __device__ __forceinline__ void done(const Unit&) const {}
};

struct FnetAOrder {
    int G, c;
    __device__ bool next(int i, Unit& u) const {
        const long L = (long)i * G + c; if (L >= 512) return false;
        const int combo = (int)L >> 5, rest = (int)L & 31, b = combo >> 1, gp = combo & 1, pml = rest >> 4, pn = rest & 15;
        u.aoff = (size_t)pml * 256 * 256 * 2; u.boff = ((size_t)(b * 4096 + pn * 256) * 3840 + 1792 + gp * 256) * 2; u.pm = b * 4 + gp * 2 + pml; u.pn = pn; return true;
    }
    __device__ __forceinline__ void a_ready(const Unit&) const {}
    __device__ __forceinline__ void done(const Unit&) const {}
};

__device__ __forceinline__ unsigned cvt_pk_bf16(float lo, float hi) { unsigned r; asm volatile("v_cvt_pk_bf16_f32 %0, %1, %2" : "=v"(r) : "v"(lo), "v"(hi)); return r; }

struct RstdTab { const PG8_LAS float* tab; const PG8_GAS float* RS; int pm0, pm1, pm2, pm3;
    __device__ __forceinline__ int slot(int pm) const { return !tab ? -2 : pm == pm0 ? 0 : pm == pm1 ? 1 : pm == pm2 ? 2 : pm == pm3 ? 3 : -1; }
    __device__ __forceinline__ void rows(const Unit& u, int wr, int fr, int fq, float (&rs)[2][4]) const {
        const int sl = slot(u.pm);
        if (sl == -2) {
#pragma unroll
            for (int ai = 0; ai < 2; ++ai)
#pragma unroll
                for (int m = 0; m < 4; ++m) rs[ai][m] = 1.0f;
        } else if (sl >= 0) {
#pragma unroll
            for (int ai = 0; ai < 2; ++ai)
#pragma unroll
                for (int m = 0; m < 4; ++m) rs[ai][m] = tab[sl * 256 + ai * HALF + wr * 64 + m * 16 + fr];
        } else {
#pragma unroll
            for (int ai = 0; ai < 2; ++ai)
#pragma unroll
                for (int m = 0; m < 4; ++m) { const PG8_GAS float* p = RS + (size_t)(u.pm * BM + ai * HALF + wr * 64 + m * 16 + fr) * 32 + fq * 8;
                    const f32x4 a = *(const PG8_GAS f32x4*)p, b = *(const PG8_GAS f32x4*)(p + 4);
                    float t = ((a[0] + a[1]) + (a[2] + a[3])) + ((b[0] + b[1]) + (b[2] + b[3])); t += __shfl_xor(t, 16); t += __shfl_xor(t, 32);
                    rs[ai][m] = rsqrtf(t * (1.0f / 2048.0f) + 1e-6f); }
        }
    }
};
struct EpiBf16 {
    static constexpr bool PERM = true, AFTER_DRAIN = false;
    PG8_GAS bf16_t* O; int ldc; RstdTab R;
    __device__ __forceinline__ void operator()(const f32x4 (&acc)[2][2][4][2], const Unit& u, int wr, int wc, int fr, int fq) const {
        const int row0 = u.pm * BM + wr * 64 + fr, col0 = u.pn * BM + wc * 32 + 8 * fq;
        float rs[2][4]; R.rows(u, wr, fr, fq, rs);
#pragma unroll
        for (int ai = 0; ai < 2; ++ai)
#pragma unroll
            for (int m = 0; m < 4; ++m) { PG8_GAS bf16_t* rowp = O + (size_t)(row0 + ai * HALF + m * 16) * ldc + col0;
#pragma unroll
                for (int bj = 0; bj < 2; ++bj) { const f32x4 v0 = acc[ai][bj][m][0] * rs[ai][m], v1 = acc[ai][bj][m][1] * rs[ai][m];
                    u32x4 w; w.x = cvt_pk_bf16(v0[0], v0[1]); w.y = cvt_pk_bf16(v0[2], v0[3]); w.z = cvt_pk_bf16(v1[0], v1[1]); w.w = cvt_pk_bf16(v1[2], v1[3]);
                    *(PG8_GAS u32x4*)(rowp + bj * HALF) = w; } }
    }
};
struct EpiBf16T {
    static constexpr bool PERM = true, AFTER_DRAIN = false;
    PG8_GAS bf16_t* O; int ldc; RstdTab R;
    __device__ __forceinline__ void operator()(const f32x4 (&acc)[2][2][4][2], const Unit& u, int wr, int wc, int fr, int fq) const {
        const int row0 = u.pm * BM + wr * 64 + fr, col0 = u.pn * BM + wc * 32 + 8 * fq;
        const int sl = R.slot(u.pn); f32x4 cs[2][2];
#pragma unroll
        for (int bj = 0; bj < 2; ++bj) { const int cl = bj * HALF + wc * 32 + 8 * fq;
            if (sl >= 0) { cs[bj][0] = *(const PG8_LAS f32x4*)(R.tab + sl * 256 + cl); cs[bj][1] = *(const PG8_LAS f32x4*)(R.tab + sl * 256 + cl + 4); }
            else {
#pragma unroll
                for (int e = 0; e < 8; ++e) { const PG8_GAS float* p = R.RS + (size_t)(u.pn * BM + cl + e) * 32; float t = 0.f;
#pragma unroll
                    for (int j = 0; j < 32; ++j) t += p[j];
                    cs[bj][e >> 2][e & 3] = rsqrtf(t * (1.0f / 2048.0f) + 1e-6f); } } }
#pragma unroll
        for (int ai = 0; ai < 2; ++ai)
#pragma unroll
            for (int m = 0; m < 4; ++m) { PG8_GAS bf16_t* rowp = O + (size_t)(row0 + ai * HALF + m * 16) * ldc + col0;
#pragma unroll
                for (int bj = 0; bj < 2; ++bj) { const f32x4 v0 = acc[ai][bj][m][0] * cs[bj][0], v1 = acc[ai][bj][m][1] * cs[bj][1];
                    u32x4 w; w.x = cvt_pk_bf16(v0[0], v0[1]); w.y = cvt_pk_bf16(v0[2], v0[3]); w.z = cvt_pk_bf16(v1[0], v1[1]); w.w = cvt_pk_bf16(v1[2], v1[3]);
                    *(PG8_GAS u32x4*)(rowp + bj * HALF) = w; } }
    }
};
struct EpiFnetA {
    static constexpr bool PERM = true, AFTER_DRAIN = false;
    PG8_GAS bf16_t* O;
    __device__ __forceinline__ void operator()(const f32x4 (&acc)[2][2][4][2], const Unit& u, int wr, int wc, int fr, int fq) const {
        const int col0 = u.pn * BM + wc * 32 + 8 * fq;
#pragma unroll
        for (int ai = 0; ai < 2; ++ai)
#pragma unroll
            for (int m = 0; m < 4; ++m) { PG8_GAS bf16_t* rowp = O + (size_t)(u.pm * 128 + wr * 64 + m * 16 + fr) * 8192 + ai * 4096 + col0;
#pragma unroll
                for (int bj = 0; bj < 2; ++bj) { const f32x4 v0 = acc[ai][bj][m][0], v1 = acc[ai][bj][m][1];
                    u32x4 w; w.x = cvt_pk_bf16(v0[0], v0[1]); w.y = cvt_pk_bf16(v0[2], v0[3]); w.z = cvt_pk_bf16(v1[0], v1[1]); w.w = cvt_pk_bf16(v1[2], v1[3]);
                    *(PG8_GAS u32x4*)(rowp + bj * HALF) = w; } }
    }
};
struct EpiF32 {
    static constexpr bool PERM = false, AFTER_DRAIN = false;
    PG8_GAS float* C; int ldc;
    __device__ __forceinline__ void operator()(const f32x4 (&acc)[2][2][4][2], const Unit& u, int wr, int wc, int fr, int fq) const {
        const int row0 = u.pm * BM + wr * 64 + fr, col0 = u.pn * BM + wc * 32 + 4 * fq;
#pragma unroll
        for (int ai = 0; ai < 2; ++ai)
#pragma unroll
            for (int m = 0; m < 4; ++m) { PG8_GAS float* rowp = C + (size_t)(row0 + ai * HALF + m * 16) * ldc + col0;
#pragma unroll
                for (int bj = 0; bj < 2; ++bj)
#pragma unroll
                    for (int n = 0; n < 2; ++n) *(PG8_GAS f32x4*)(rowp + bj * HALF + n * 16) = acc[ai][bj][m][n]; }
    }
};
struct EpiRes {
    static constexpr bool PERM = true, AFTER_DRAIN = false;
    const PG8_GAS float* Xs32; int ldc; PG8_GAS bf16_t* XB; PG8_GAS float* RS;
    __device__ __forceinline__ void operator()(const f32x4 (&acc)[2][2][4][2], const Unit& u, int wr, int wc, int fr, int fq) const {
        const int row0 = u.pm * BM + wr * 64 + fr, col0 = u.pn * BM + wc * 32 + 8 * fq;
#pragma unroll
        for (int ai = 0; ai < 2; ++ai) {
            f32x4 xv[4][2][2];
            if (Xs32) {
#pragma unroll
                for (int m = 0; m < 4; ++m) { const PG8_GAS float* rowp = Xs32 + (size_t)(row0 + ai * HALF + m * 16) * ldc + col0;
#pragma unroll
                    for (int bj = 0; bj < 2; ++bj)
#pragma unroll
                        for (int n = 0; n < 2; ++n) xv[m][bj][n] = __builtin_nontemporal_load((const PG8_GAS f32x4*)(rowp + bj * HALF + n * 4)); }
            } else {
                u32x4 xr[4][2];
#pragma unroll
                for (int m = 0; m < 4; ++m)
#pragma unroll
                    for (int bj = 0; bj < 2; ++bj) xr[m][bj] = *(const PG8_GAS u32x4*)(XB + (size_t)(row0 + ai * HALF + m * 16) * ldc + col0 + bj * HALF);
#pragma unroll
                for (int m = 0; m < 4; ++m)
#pragma unroll
                    for (int bj = 0; bj < 2; ++bj) { const u32x4 r = xr[m][bj];
                        xv[m][bj][0] = (f32x4){__builtin_bit_cast(float, r.x << 16), __builtin_bit_cast(float, r.x & 0xffff0000u), __builtin_bit_cast(float, r.y << 16), __builtin_bit_cast(float, r.y & 0xffff0000u)};
                        xv[m][bj][1] = (f32x4){__builtin_bit_cast(float, r.z << 16), __builtin_bit_cast(float, r.z & 0xffff0000u), __builtin_bit_cast(float, r.w << 16), __builtin_bit_cast(float, r.w & 0xffff0000u)}; }
            }
#pragma unroll
            for (int m = 0; m < 4; ++m) { const int row = row0 + ai * HALF + m * 16; float ss = 0.f;
#pragma unroll
                for (int bj = 0; bj < 2; ++bj) { const f32x4 y0 = xv[m][bj][0] + acc[ai][bj][m][0], y1 = xv[m][bj][1] + acc[ai][bj][m][1];
                    ss += ((y0[0] * y0[0] + y0[1] * y0[1]) + (y0[2] * y0[2] + y0[3] * y0[3])) + ((y1[0] * y1[0] + y1[1] * y1[1]) + (y1[2] * y1[2] + y1[3] * y1[3]));
                    u32x4 w; w.x = cvt_pk_bf16(y0[0], y0[1]); w.y = cvt_pk_bf16(y0[2], y0[3]); w.z = cvt_pk_bf16(y1[0], y1[1]); w.w = cvt_pk_bf16(y1[2], y1[3]);
                    *(PG8_GAS u32x4*)(XB + (size_t)row * ldc + col0 + bj * HALF) = w; }
                ss += __shfl_xor(ss, 16); ss += __shfl_xor(ss, 32); if (fq == 0) RS[(size_t)row * 32 + u.pn * 4 + wc] = ss; }
            asm volatile("" ::: "memory"); }
    }
};
struct EpiSoftmax {
    static constexpr bool PERM = true, AFTER_DRAIN = false;
    PG8_GAS bf16_t* O; int ldc; PG8_LAS float* T1; PG8_LAS float* T2; RstdTab R;
    typedef float f32x2 __attribute__((ext_vector_type(2)));
    static __device__ __forceinline__ f32x2 ex2(float x0, float x1, float c1, float m2) { const f32x2 t = (f32x2){x0, x1} * c1 - m2; f32x2 e; e.x = __builtin_amdgcn_exp2f(t.x); e.y = __builtin_amdgcn_exp2f(t.y); return e; }
    __device__ __forceinline__ void operator()(const f32x4 (&acc)[2][2][4][2], const Unit& u, int wr, int wc, int fr, int fq) const {
        const int row0 = u.pm * BM + wr * 64 + fr, col0 = u.pn * BM + wc * 32 + 8 * fq;
        float m2[2][4]; float rs[2][4]; R.rows(u, wr, fr, fq, rs);
#pragma unroll
        for (int ai = 0; ai < 2; ++ai)
#pragma unroll
            for (int m = 0; m < 4; ++m) { float a = -3.0e38f;
#pragma unroll
                for (int bj = 0; bj < 2; ++bj)
#pragma unroll
                    for (int n = 0; n < 2; ++n) { const f32x4 v = acc[ai][bj][m][n]; a = fmaxf(a, fmaxf(fmaxf(v[0], v[1]), fmaxf(v[2], v[3]))); }
                a = fmaxf(a, __shfl_xor(a, 16)); a = fmaxf(a, __shfl_xor(a, 32));
                if (fq == 0) T1[(ai * HALF + wr * 64 + m * 16 + fr) * 4 + wc] = a * rs[ai][m]; }
        asm volatile("s_waitcnt lgkmcnt(0)" ::: "memory"); __builtin_amdgcn_s_barrier(); asm volatile("" ::: "memory");
#pragma unroll
        for (int ai = 0; ai < 2; ++ai)
#pragma unroll
            for (int m = 0; m < 4; ++m) { const f32x4 t = *(const PG8_LAS f32x4*)(T1 + (ai * HALF + wr * 64 + m * 16 + fr) * 4); const float c1 = rs[ai][m] * 1.4426950408889634f;
                m2[ai][m] = fmaxf(fmaxf(t[0], t[1]), fmaxf(t[2], t[3])) * 1.4426950408889634f; f32x2 a2 = (f32x2){0.f, 0.f};
#pragma unroll
                for (int bj = 0; bj < 2; ++bj)
#pragma unroll
                    for (int n = 0; n < 2; ++n) { const f32x4 v = acc[ai][bj][m][n]; a2 += ex2(v[0], v[1], c1, m2[ai][m]) + ex2(v[2], v[3], c1, m2[ai][m]); }
                float a = a2.x + a2.y; a += __shfl_xor(a, 16); a += __shfl_xor(a, 32);
                if (fq == 0) T2[(ai * HALF + wr * 64 + m * 16 + fr) * 4 + wc] = a; }
        asm volatile("s_waitcnt lgkmcnt(0)" ::: "memory"); __builtin_amdgcn_s_barrier(); asm volatile("" ::: "memory");
#pragma unroll
        for (int ai = 0; ai < 2; ++ai)
#pragma unroll
            for (int m = 0; m < 4; ++m) { const f32x4 t = *(const PG8_LAS f32x4*)(T2 + (ai * HALF + wr * 64 + m * 16 + fr) * 4); const float inv = 1.0f / ((t[0] + t[1]) + (t[2] + t[3])), mm = m2[ai][m], c1 = rs[ai][m] * 1.4426950408889634f;
                PG8_GAS bf16_t* rowp = O + (size_t)(row0 + ai * HALF + m * 16) * ldc + col0;
#pragma unroll
                for (int bj = 0; bj < 2; ++bj) { const f32x4 v0 = acc[ai][bj][m][0], v1 = acc[ai][bj][m][1];
                    const f32x2 p0 = ex2(v0[0], v0[1], c1, mm) * inv, p1 = ex2(v0[2], v0[3], c1, mm) * inv, p2 = ex2(v1[0], v1[1], c1, mm) * inv, p3 = ex2(v1[2], v1[3], c1, mm) * inv;
                    u32x4 w; w.x = cvt_pk_bf16(p0.x, p0.y); w.y = cvt_pk_bf16(p1.x, p1.y); w.z = cvt_pk_bf16(p2.x, p2.y); w.w = cvt_pk_bf16(p3.x, p3.y);
                    *(PG8_GAS u32x4*)(rowp + bj * HALF) = w; } }
    }
};
__device__ __forceinline__ float silu_f(float g) { return g * __builtin_amdgcn_rcpf(1.0f + __expf(-g)); }
struct EpiSwiglu {
    static constexpr bool PERM = true, AFTER_DRAIN = false;
    PG8_GAS bf16_t* H; int ldc; RstdTab R;
    typedef float f32x2 __attribute__((ext_vector_type(2)));
    static __device__ __forceinline__ void quad(f32x4 G, f32x4 U, float a, float q, unsigned& w0, unsigned& w1) {
        const f32x2 G01 = (f32x2){G[0], G[1]}, G23 = (f32x2){G[2], G[3]}, U01 = (f32x2){U[0], U[1]}, U23 = (f32x2){U[2], U[3]};
        const f32x2 t01 = __builtin_elementwise_min(G01 * a, (f32x2){30.f, 30.f}), t23 = __builtin_elementwise_min(G23 * a, (f32x2){30.f, 30.f});
        f32x2 e01, e23; e01.x = __builtin_amdgcn_exp2f(t01.x); e01.y = __builtin_amdgcn_exp2f(t01.y); e23.x = __builtin_amdgcn_exp2f(t23.x); e23.y = __builtin_amdgcn_exp2f(t23.y);
        const f32x2 d01 = e01 + 1.0f, d23 = e23 + 1.0f, pp = d01 * d23;
        const float r = __builtin_amdgcn_rcpf(pp.x * pp.y);
        const f32x2 rp = (f32x2){pp.y, pp.x} * r;
        const f32x2 i01 = rp * d23, i23 = rp * d01;
        const f32x2 h01 = (G01 * U01) * (i01 * q), h23 = (G23 * U23) * (i23 * q);
        w0 = cvt_pk_bf16(h01.x, h01.y); w1 = cvt_pk_bf16(h23.x, h23.y);
    }
    __device__ __forceinline__ void operator()(const f32x4 (&acc)[2][2][4][2], const Unit& u, int wr, int wc, int fr, int fq) const {
        const int row0 = u.pm * BM + wr * 64 + fr, col0 = u.pn * HALF + wc * 32 + 8 * fq;
        float rs[2][4]; R.rows(u, wr, fr, fq, rs);
#pragma unroll
        for (int ai = 0; ai < 2; ++ai)
#pragma unroll
            for (int m = 0; m < 4; ++m) { PG8_GAS bf16_t* rowp = H + (size_t)(row0 + ai * HALF + m * 16) * ldc + col0;
                const float a = rs[ai][m] * -1.4426950408889634f, q = rs[ai][m] * rs[ai][m];
                const f32x4 g0 = acc[ai][0][m][0], g1 = acc[ai][0][m][1], u0 = acc[ai][1][m][0], u1 = acc[ai][1][m][1];
                u32x4 w; unsigned wa, wb, wc2, wd; quad(g0, u0, a, q, wa, wb); quad(g1, u1, a, q, wc2, wd); w.x = wa; w.y = wb; w.z = wc2; w.w = wd;
                *(PG8_GAS u32x4*)rowp = w; }
    }
};

template <class Epi, class Sched, bool ALIGN_EPI = false, bool SP2 = false>
__device__ __forceinline__ void gemm_phase(PG8_LAS unsigned char* lds, const Gemm g, const Sched& S, const Epi& E, int tid_in) {
    int tid = tid_in; asm volatile("" : "+v"(tid));
    const int wid = __builtin_amdgcn_readfirstlane(tid >> 6), lane = tid & 63, wr = wid >> 2, wc = wid & 3, fr = lane & 15, fq = lane >> 4;
    const int K = g.K, nt = K / BK;
    unsigned voffA[2], voffB[2];
#pragma unroll
    for (int i = 0; i < 2; ++i) { int R, C; stage_rc(tid * 16 + i * 8192, R, C); const int Rb = Epi::PERM ? ((R & ~31) + perm32(R & 31)) : R;
        voffA[i] = (unsigned)(R * g.lda + C) * 2u; voffB[i] = (unsigned)(Rb * g.ldb + C) * 2u; }
    const size_t kstep = (size_t)(BK * 2);
    const size_t hstepA = (size_t)HALF * g.lda * 2, hstepB = (size_t)HALF * g.ldb * 2;
    const unsigned ldsw = (unsigned)wid * 1024u;
    const int aoff = lds_byte(wr * 64 + fr, fq * 8), boff = lds_byte(wc * 32 + fr, fq * 8);
#define PG8_SA(b, h) (((b) * 2 + (h)) * HTB)
#define PG8_SB(b, h) ((4 + (b) * 2 + (h)) * HTB)
#define PG8_STAGE(bufoff, gbase, voff) do { _Pragma("unroll") for (int _i = 0; _i < 2; ++_i) \
        __builtin_amdgcn_global_load_lds((const unsigned*)((const char*)(gbase) + (voff)[_i]), (PG8_LAS unsigned*)(lds + (bufoff) + ldsw + _i * 8192), 16, 0, 0); } while (0)
#define PG8_LDA(dst, b, h) do { _Pragma("unroll") for (int m = 0; m < 4; ++m) _Pragma("unroll") for (int k = 0; k < 2; ++k) dst[m][k] = *(const PG8_LAS bf16x8*)(lds + PG8_SA(b, h) + aoff + m * 2048 + k * 1024); } while (0)
#define PG8_LDB(dst, b, h) do { _Pragma("unroll") for (int n = 0; n < 2; ++n) _Pragma("unroll") for (int k = 0; k < 2; ++k) dst[n][k] = *(const PG8_LAS bf16x8*)(lds + PG8_SB(b, h) + boff + n * 2048 + k * 1024); } while (0)
#define PG8_MMA(ai, bj, At, Bt) do { __builtin_amdgcn_s_setprio(1); _Pragma("unroll") for (int m = 0; m < 4; ++m) _Pragma("unroll") for (int n = 0; n < 2; ++n) _Pragma("unroll") for (int k = 0; k < 2; ++k) \
        acc[ai][bj][m][n] = __builtin_amdgcn_mfma_f32_16x16x32_bf16(Bt[n][k], At[m][k], acc[ai][bj][m][n], 0, 0, 0); __builtin_amdgcn_s_setprio(0); } while (0)
#define PG8_WAIT_V(n) asm volatile("s_waitcnt vmcnt(" #n ")" ::: "memory")
#define PG8_WAIT_L(n) asm volatile("s_waitcnt lgkmcnt(" #n ")" ::: "memory")
#define PG8_BAR __builtin_amdgcn_s_barrier()
#define PG8_SCHED __builtin_amdgcn_sched_barrier(0)
    Unit cur, nxt; int ui = 0;
    if (!S.next(0, cur)) return;
    f32x4 acc[2][2][4][2];
#pragma unroll
    for (int a = 0; a < 2; ++a)
#pragma unroll
        for (int b = 0; b < 2; ++b)
#pragma unroll
            for (int m = 0; m < 4; ++m)
#pragma unroll
                for (int n = 0; n < 2; ++n) acc[a][b][m][n] = (f32x4){0.f, 0.f, 0.f, 0.f};
    bf16x8 At[4][2], B0[2][2], B1[2][2];
    const char* cA = (const char*)g.A + cur.aoff; const char* cB = (const char*)g.Bt + cur.boff;
    S.a_ready(cur);
    if constexpr (SP2) {
        PG8_STAGE(PG8_SB(0, 0), cB, voffB); PG8_STAGE(PG8_SB(0, 1), cB + hstepB, voffB); PG8_STAGE(PG8_SA(0, 0), cA, voffA); PG8_STAGE(PG8_SA(0, 1), cA + hstepA, voffA);
        if (wr == 1) PG8_BAR;
        PG8_WAIT_V(2); PG8_BAR;
        PG8_STAGE(PG8_SB(1, 0), cB + kstep, voffB); PG8_STAGE(PG8_SA(1, 0), cA + kstep, voffA); PG8_STAGE(PG8_SB(1, 1), cB + hstepB + kstep, voffB);
        PG8_WAIT_V(6); PG8_BAR;
    } else {
        PG8_STAGE(PG8_SB(0, 0), cB, voffB); PG8_STAGE(PG8_SA(0, 0), cA, voffA); PG8_STAGE(PG8_SB(0, 1), cB + hstepB, voffB); PG8_STAGE(PG8_SA(0, 1), cA + hstepA, voffA);
        if (wr == 1) PG8_BAR;
        PG8_WAIT_V(4); PG8_BAR;
        PG8_STAGE(PG8_SB(1, 0), cB + kstep, voffB); PG8_STAGE(PG8_SA(1, 0), cA + kstep, voffA); PG8_STAGE(PG8_SB(1, 1), cB + hstepB + kstep, voffB);
        PG8_WAIT_V(6); PG8_BAR;
    }
    for (;;) {
        const bool has_next = S.next(ui + 1, nxt);
        const char* nA = has_next ? (const char*)g.A + nxt.aoff : cA; const char* nB = has_next ? (const char*)g.Bt + nxt.boff : cB;
        for (int t = 0; t < nt; t += 2) {
            const bool last = (t == nt - 2);
            const char* a1 = cA + (size_t)(t + 1) * kstep;
            const char* a2 = last ? nA : cA + (size_t)(t + 2) * kstep; const char* b2 = last ? nB : cB + (size_t)(t + 2) * kstep;
            const char* a3 = a2 + kstep; const char* b3 = b2 + kstep;
            if (last && has_next) S.a_ready(nxt);
            if constexpr (SP2) {
            PG8_LDB(B0, 0, 0); PG8_LDB(B1, 0, 1); PG8_SCHED; PG8_LDA(At, 0, 0); PG8_STAGE(PG8_SA(1, 1), a1 + hstepA, voffA);
            PG8_WAIT_V(8); PG8_WAIT_L(0); PG8_BAR; PG8_MMA(0, 0, At, B0); PG8_MMA(0, 1, At, B1); PG8_BAR; PG8_SCHED;
            PG8_LDA(At, 0, 1); PG8_STAGE(PG8_SB(0, 0), b2, voffB); PG8_STAGE(PG8_SB(0, 1), b2 + hstepB, voffB); PG8_STAGE(PG8_SA(0, 0), a2, voffA);
            PG8_WAIT_V(8); PG8_WAIT_L(0); PG8_BAR; PG8_MMA(1, 0, At, B0); PG8_MMA(1, 1, At, B1); PG8_BAR; PG8_SCHED;
            PG8_LDB(B0, 1, 0); PG8_LDB(B1, 1, 1); PG8_SCHED; PG8_LDA(At, 1, 0); PG8_STAGE(PG8_SA(0, 1), a2 + hstepA, voffA);
            PG8_WAIT_V(8); PG8_WAIT_L(0); PG8_BAR; PG8_MMA(0, 0, At, B0); PG8_MMA(0, 1, At, B1); PG8_BAR; PG8_SCHED;
            PG8_LDA(At, 1, 1); PG8_STAGE(PG8_SB(1, 0), b3, voffB); PG8_STAGE(PG8_SB(1, 1), b3 + hstepB, voffB); PG8_STAGE(PG8_SA(1, 0), a3, voffA);
            PG8_WAIT_V(8); PG8_WAIT_L(0); PG8_BAR; PG8_MMA(1, 0, At, B0); PG8_MMA(1, 1, At, B1); PG8_BAR; PG8_SCHED;
            } else {
            PG8_LDB(B0, 0, 0); PG8_SCHED; PG8_LDA(At, 0, 0); PG8_STAGE(PG8_SA(1, 1), a1 + hstepA, voffA);
            PG8_WAIT_L(8); PG8_BAR; PG8_WAIT_L(0); PG8_MMA(0, 0, At, B0); PG8_BAR; PG8_SCHED;
            PG8_LDB(B1, 0, 1); PG8_STAGE(PG8_SB(0, 0), b2, voffB);
            PG8_BAR; PG8_WAIT_L(0); PG8_MMA(0, 1, At, B1); PG8_BAR;
            PG8_LDA(At, 0, 1); PG8_STAGE(PG8_SA(0, 0), a2, voffA);
            PG8_BAR; PG8_WAIT_L(0); PG8_MMA(1, 0, At, B0); PG8_BAR; PG8_SCHED;
            PG8_STAGE(PG8_SB(0, 1), b2 + hstepB, voffB);
            PG8_WAIT_V(6); PG8_BAR; PG8_MMA(1, 1, At, B1); PG8_BAR;
            PG8_LDB(B0, 1, 0); PG8_SCHED; PG8_LDA(At, 1, 0); PG8_STAGE(PG8_SA(0, 1), a2 + hstepA, voffA);
            PG8_WAIT_L(8); PG8_BAR; PG8_WAIT_L(0); PG8_MMA(0, 0, At, B0); PG8_BAR; PG8_SCHED;
            PG8_LDB(B1, 1, 1); PG8_STAGE(PG8_SB(1, 0), b3, voffB);
            PG8_BAR; PG8_WAIT_L(0); PG8_MMA(0, 1, At, B1); PG8_BAR;
            PG8_LDA(At, 1, 1); PG8_STAGE(PG8_SA(1, 0), a3, voffA);
            PG8_BAR; PG8_WAIT_L(0); PG8_MMA(1, 0, At, B0); PG8_BAR; PG8_SCHED;
            PG8_STAGE(PG8_SB(1, 1), b3 + hstepB, voffB);
            PG8_WAIT_V(6); PG8_BAR; PG8_MMA(1, 1, At, B1); PG8_BAR;
            }
        }
        if constexpr (ALIGN_EPI) { if (wr == 0) PG8_BAR; }
        if constexpr (!Epi::AFTER_DRAIN) { E(acc, cur, wr, wc, fr, fq); S.done(cur); }
        if (!has_next) break;
#pragma unroll
        for (int a = 0; a < 2; ++a)
#pragma unroll
            for (int b = 0; b < 2; ++b)
#pragma unroll
                for (int m = 0; m < 4; ++m)
#pragma unroll
                    for (int n = 0; n < 2; ++n) acc[a][b][m][n] = (f32x4){0.f, 0.f, 0.f, 0.f};
        cur = nxt; cA = nA; cB = nB; ++ui;
        if constexpr (ALIGN_EPI) { if (wr == 1) PG8_BAR; }
    }
    PG8_WAIT_V(0);
    if constexpr (!ALIGN_EPI) { if (wr == 0) PG8_BAR; }
    PG8_BAR;
    if constexpr (Epi::AFTER_DRAIN) { E.fused(acc, cur, wr, wc, fr, fq, lds, wid, lane); S.done(cur); }
#undef PG8_SA
#undef PG8_SB
#undef PG8_STAGE
#undef PG8_LDA
#undef PG8_LDB
#undef PG8_MMA
#undef PG8_WAIT_V
#undef PG8_WAIT_L
#undef PG8_BAR
#undef PG8_SCHED
}
}

constexpr int NB = 8, SEQ = 4096, DM = 2048, NL = 4, MTOK = NB * SEQ, NMEM = 256;
constexpr int DIN = 5152, NPROJ = 3840, NWIN = 5376, DFF = 5632;
constexpr int PQ = 0, PK = 256, PV = 512, PG = 1024, PLR = 1536, PUF = 1792, PUS = 2304, WUH = 3840;
constexpr float EPS = 1e-6f;
constexpr int NWAVES = 8, NTHR = 512;

constexpr size_t MiB = 1u << 20;
constexpr size_t WS_CTL = 0, CTL_ZERO_BYTES = 1 * MiB;
constexpr size_t WS_WIN = 1 * MiB, WS_WOUT = 23 * MiB, WS_WQB = 31 * MiB, WS_WKV = 39 * MiB, WS_WXO = 55 * MiB, WS_WGU = 63 * MiB, WS_WD = 107 * MiB;
constexpr size_t WS_KVB = 129 * MiB, WS_MT = 145 * MiB, WS_VWO = 177 * MiB, WS_MEMN = 209 * MiB;
constexpr size_t WS_XB = 217 * MiB, WS_PROJ = 345 * MiB, WS_MIX = 697 * MiB, WS_OF = 825 * MiB, WS_FU = 889 * MiB, WS_FILT = 1017 * MiB, WS_UT = 1049 * MiB, WS_YT = 1145 * MiB;
constexpr size_t WS_FU2 = 889 * MiB, WS_FY = 953 * MiB, WS_C2 = 1177 * MiB, WS_S2 = 1186 * MiB, WS_FE = 1194 * MiB, WS_FO = 1211 * MiB, WS_Y2K = 1227 * MiB, WS_A1 = 1241 * MiB;
constexpr int FK1 = 2176;
constexpr size_t WS_GS = 1242 * MiB  , WS_GU = 1242 * MiB, WS_GD = 1370 * MiB;
constexpr size_t WS_RSS = 1371 * MiB;
constexpr size_t WS_END = 1375 * MiB;
constexpr int CW_BAR = 4096;

constexpr int RING_OFF = 0, RING_BYTES = 131072;
constexpr int LDSCTL_OFF = RING_BYTES, MISC_OFF = LDSCTL_OFF + 320;
constexpr int LDS_BYTES = 147456;

#define GAS __attribute__((address_space(1)))
#define LAS __attribute__((address_space(3)))
typedef unsigned short bf16;
typedef unsigned v4u __attribute__((ext_vector_type(4)));
typedef unsigned v2u __attribute__((ext_vector_type(2)));
typedef float f32x4 __attribute__((ext_vector_type(4)));
typedef GAS unsigned gu32;
#define LDS_WAIT() asm volatile("s_waitcnt lgkmcnt(0)" ::: "memory")
__device__ __forceinline__ unsigned f2bf(float f) { unsigned u = __builtin_bit_cast(unsigned, f); return (u + 0x7fffu + ((u >> 16) & 1u)) >> 16; }
__device__ __forceinline__ unsigned pk2(float lo, float hi) { return f2bf(lo) | (f2bf(hi) << 16); }
__device__ __forceinline__ float bf2f(bf16 h) { return __builtin_bit_cast(float, ((unsigned)h) << 16); }
__device__ __forceinline__ float bflo(unsigned w) { return __builtin_bit_cast(float, w << 16); }
__device__ __forceinline__ float bfhi(unsigned w) { return __builtin_bit_cast(float, w & 0xffff0000u); }

#define XB_TMO      128
#define XB_XCNT(j)  (256  + 64 * (j))
#define XB_XSUB(j)  (1280 + 64 * (j))
#define XB_XGEN(j)  (2304 + 64 * (j))
#define XB_TOP      3328
#define XB_TOPGEN   3392
#define XCD_BAR_WORDS 3456
#define XB_SPIN_CAP (1u << 18)

__device__ __forceinline__ unsigned xb_ld(unsigned* p)              { return __hip_atomic_load(p, __ATOMIC_RELAXED, __HIP_MEMORY_SCOPE_AGENT); }
__device__ __forceinline__ unsigned xb_add(unsigned* p, unsigned v) { return __hip_atomic_fetch_add(p, v, __ATOMIC_RELAXED, __HIP_MEMORY_SCOPE_AGENT); }
__device__ __forceinline__ unsigned xb_xcc_id() { return (unsigned)__builtin_amdgcn_s_getreg((3 << 11) | 20) & 0xFu; }
#define XB_SPIN(cond, bar) do { unsigned _sp = 0; while (cond) { __builtin_amdgcn_s_sleep(1); \
    if ((++_sp & 255u) == 0u) { if (xb_ld(&(bar)[XB_TMO])) break; if (_sp > XB_SPIN_CAP) { atomicAdd(&(bar)[XB_TMO], 1u); break; } } } } while (0)

struct XcdBarrier { unsigned* bar; unsigned x; volatile LAS unsigned* st; };

__device__ __forceinline__ XcdBarrier xcd_barrier_post(unsigned* bar, volatile LAS unsigned* st, int tid) {
    XcdBarrier b; b.bar = bar; b.x = xb_xcc_id(); b.st = st;
    if (tid == 0) (void)xb_add(&bar[XB_XCNT(b.x)], 1u);
    return b;
}
__device__ __forceinline__ void xcd_barrier_complete(unsigned* bar, unsigned x, unsigned& nloc, unsigned& nx) {
    const unsigned G = gridDim.x * gridDim.y * gridDim.z;
    unsigned sum, cnt, mine, sp = 0u;
    for (;;) {
        sum = 0u; cnt = 0u; mine = 0u;
#pragma unroll
        for (unsigned j = 0; j < 16; ++j) { const unsigned c = xb_ld(&bar[XB_XCNT(j)]); sum += c; cnt += (c > 0u) ? 1u : 0u; mine = (j == x) ? c : mine; }
        if (sum == G) break;
        __builtin_amdgcn_s_sleep(1);
        if ((++sp & 255u) == 0u) { if (xb_ld(&bar[XB_TMO])) break; if (sp > XB_SPIN_CAP) { atomicAdd(&bar[XB_TMO], 1u); break; } }
    }
    nloc = mine > 0u ? mine : 1u; nx = cnt > 0u ? cnt : 1u;
}
__device__ __forceinline__ void xcd_barrier(const XcdBarrier& b, int tid) {
    asm volatile("s_waitcnt vmcnt(0)" ::: "memory");
    __syncthreads();
    if (tid == 0) {
        unsigned* bar = b.bar;
        __builtin_amdgcn_s_waitcnt(0);
        unsigned nloc = b.st[0], nx = b.st[1];
        if (nloc == 0u) { xcd_barrier_complete(bar, b.x, nloc, nx); b.st[0] = nloc; b.st[1] = nx; }
        const unsigned old = xb_add(&bar[XB_XSUB(b.x)], 1u);
        const unsigned gen = old / nloc;
        if (old + 1u == (gen + 1u) * nloc) {
            __builtin_amdgcn_fence(__ATOMIC_RELEASE, "agent");
            asm volatile("s_waitcnt vmcnt(0)" ::: "memory");
            const unsigned og = xb_add(&bar[XB_TOP], 1u);
            const unsigned tg = og / nx;
            if (og + 1u == (tg + 1u) * nx) xb_add(&bar[XB_TOPGEN], 1u);
            else XB_SPIN(xb_ld(&bar[XB_TOPGEN]) == tg, bar);
            __builtin_amdgcn_fence(__ATOMIC_ACQUIRE, "agent");
            xb_add(&bar[XB_XGEN(b.x)], 1u);
            asm volatile("s_waitcnt vmcnt(0)" ::: "memory");
        } else {
            XB_SPIN(xb_ld(&bar[XB_XGEN(b.x)]) == gen, bar);
            __builtin_amdgcn_fence(__ATOMIC_ACQUIRE, "agent");
            asm volatile("s_waitcnt vmcnt(0)" ::: "memory");
        }
    }
    __syncthreads();
}

__device__ __forceinline__ float wave_sum(float v) {
#pragma unroll
    for (int o = 1; o < 64; o <<= 1) v += __shfl_xor(v, o);
    return v;
}
__device__ __forceinline__ float wave_max(float v) {
#pragma unroll
    for (int o = 1; o < 64; o <<= 1) v = fmaxf(v, __shfl_xor(v, o));
    return v;
}
__device__ __forceinline__ float block_sum(float v, LAS float* red, int wave, int lane) {
    v = wave_sum(v); if (lane == 0) red[wave] = v; __syncthreads();
    float s = 0.f;
#pragma unroll
    for (int i = 0; i < 8; ++i) s += red[i];
    __syncthreads(); return s;
}
__device__ __forceinline__ float log_sigmoid_f(float x) { return fminf(x, 0.f) - __logf(1.0f + __expf(-fabsf(x))); }

struct Params {
    const float* in[26]; float* out; unsigned char* ws;
    int step_lo, step_hi, pad0, pad1;
};
__device__ __forceinline__ int opaque_i(int x) { asm volatile("" : "+v"(x)); return __builtin_amdgcn_readfirstlane(x); }
template <class T> __device__ __forceinline__ T* opaque_p(T* p) { const unsigned long long v = (unsigned long long)p; const unsigned lo = (unsigned)opaque_i((int)(unsigned)v), hi = (unsigned)opaque_i((int)(unsigned)(v >> 32)); return (T*)(((unsigned long long)hi << 32) | lo); }
__device__ __forceinline__ const float* pin(const Params& P, int i) { return P.in[opaque_i(i)]; }

struct TrItem { const float* src; int ldsrc, nsrc0, k0, lddst, nd0; bf16* dst; const float* gain; float sc; };
__device__ __forceinline__ void tr_load(const TrItem& t, f32x4 (&v)[8], int lane) {
    const int lr = lane >> 3, lc = (lane & 7) * 4;
#pragma unroll
    for (int i = 0; i < 8; ++i) v[i] = *(const GAS f32x4*)(t.src + (size_t)(t.k0 + 8 * i + lr) * t.ldsrc + t.nsrc0 + lc);
}
__device__ __forceinline__ void tr_finish(const TrItem& t, const f32x4 (&v)[8], LAS float* scr, int lane) {
    const int lr = lane >> 3, lc = (lane & 7) * 4;
#pragma unroll
    for (int i = 0; i < 8; ++i) { const int kk = 8 * i + lr; const float gs = (t.gain ? t.gain[t.k0 + kk] : 1.f) * t.sc; LAS float* d = scr + kk * 33 + lc; d[0] = v[i].x * gs; d[1] = v[i].y * gs; d[2] = v[i].z * gs; d[3] = v[i].w * gs; }
    LDS_WAIT(); asm volatile("" ::: "memory");
    const int c = lane & 7;
#pragma unroll
    for (int j = 0; j < 4; ++j) { const int n = (lane >> 3) + 8 * j; const LAS float* s = scr + (8 * c) * 33 + n;
        v4u o; o.x = pk2(s[0 * 33], s[1 * 33]); o.y = pk2(s[2 * 33], s[3 * 33]); o.z = pk2(s[4 * 33], s[5 * 33]); o.w = pk2(s[6 * 33], s[7 * 33]);
        *(GAS v4u*)(t.dst + (size_t)(t.nd0 + n) * t.lddst + t.k0 + 8 * c) = o; }
    LDS_WAIT(); asm volatile("" ::: "memory");
}
__device__ __forceinline__ void norm_row(const float* xrow, bf16* orow, float* xcopy, int lane) {
    const GAS f32x4* xr = (const GAS f32x4*)xrow + lane;
    f32x4 v[8]; float s = 0.f;
#pragma unroll
    for (int j = 0; j < 8; ++j) { v[j] = xr[64 * j]; s += (v[j].x * v[j].x + v[j].y * v[j].y) + (v[j].z * v[j].z + v[j].w * v[j].w); }
    const float rstd = rsqrtf(wave_sum(s) * (1.f / DM) + EPS);
    GAS v2u* o8 = (GAS v2u*)orow + lane;
#pragma unroll
    for (int j = 0; j < 8; ++j) { v2u w; w.x = pk2(v[j].x * rstd, v[j].y * rstd); w.y = pk2(v[j].z * rstd, v[j].w * rstd); o8[64 * j] = w; }
    if (xcopy) { GAS f32x4* xc = (GAS f32x4*)xcopy + lane;
#pragma unroll
        for (int j = 0; j < 8; ++j) xc[64 * j] = v[j]; }
}
__device__ __forceinline__ void final_norm_row(const bf16* xrow, float* orow, const float* g, int lane) {
    const GAS v4u* xr = (const GAS v4u*)xrow + lane; float v[4][8]; float s = 0.f;
#pragma unroll
    for (int j = 0; j < 4; ++j) { const v4u r = xr[64 * j]; v[j][0] = bflo(r.x); v[j][1] = bfhi(r.x); v[j][2] = bflo(r.y); v[j][3] = bfhi(r.y); v[j][4] = bflo(r.z); v[j][5] = bfhi(r.z); v[j][6] = bflo(r.w); v[j][7] = bfhi(r.w);
#pragma unroll
        for (int e = 0; e < 8; ++e) s += v[j][e] * v[j][e]; }
    const float rstd = rsqrtf(wave_sum(s) * (1.f / DM) + EPS);
#pragma unroll
    for (int j = 0; j < 4; ++j) { const int c0 = (64 * j + lane) * 8; const f32x4 g0 = *(const GAS f32x4*)(g + c0), g1 = *(const GAS f32x4*)(g + c0 + 4);
        __builtin_nontemporal_store((f32x4){v[j][0] * rstd * g0.x, v[j][1] * rstd * g0.y, v[j][2] * rstd * g0.z, v[j][3] * rstd * g0.w}, (GAS f32x4*)(orow + c0));
        __builtin_nontemporal_store((f32x4){v[j][4] * rstd * g1.x, v[j][5] * rstd * g1.y, v[j][6] * rstd * g1.z, v[j][7] * rstd * g1.w}, (GAS f32x4*)(orow + c0 + 4)); }
}
__device__ __forceinline__ void norm_row_gain_f32(const float* xrow, float* orow, const float* g, int lane) {
    const GAS f32x4* xr = (const GAS f32x4*)xrow + lane; const GAS f32x4* gr = (const GAS f32x4*)g + lane;
    f32x4 v[8]; float s = 0.f;
#pragma unroll
    for (int j = 0; j < 8; ++j) { v[j] = xr[64 * j]; s += (v[j].x * v[j].x + v[j].y * v[j].y) + (v[j].z * v[j].z + v[j].w * v[j].w); }
    const float rstd = rsqrtf(wave_sum(s) * (1.f / DM) + EPS);
    GAS f32x4* o = (GAS f32x4*)orow + lane;
#pragma unroll
    for (int j = 0; j < 8; ++j) o[64 * j] = v[j] * rstd * gr[64 * j];
}
__device__ __forceinline__ void norm_row_gain_bf16(const float* xrow, bf16* orow, const float* g, int lane) {
    const GAS f32x4* xr = (const GAS f32x4*)xrow + lane; const GAS f32x4* gr = (const GAS f32x4*)g + lane;
    f32x4 v[8]; float s = 0.f;
#pragma unroll
    for (int j = 0; j < 8; ++j) { v[j] = xr[64 * j]; s += (v[j].x * v[j].x + v[j].y * v[j].y) + (v[j].z * v[j].z + v[j].w * v[j].w); }
    const float rstd = rsqrtf(wave_sum(s) * (1.f / DM) + EPS);
    GAS v2u* o8 = (GAS v2u*)orow + lane;
#pragma unroll
    for (int j = 0; j < 8; ++j) { const f32x4 y = v[j] * rstd * gr[64 * j]; v2u w; w.x = pk2(y.x, y.y); w.y = pk2(y.z, y.w); o8[64 * j] = w; }
}

__device__ __forceinline__ void phase_a(const Params& P, unsigned char* ws, float* xres, int l, LAS unsigned char* lds, int tid, int lane, int wave, int bid, int G) {
    bf16* WinT = (bf16*)(ws + WS_WIN); bf16* WoutT = (bf16*)(ws + WS_WOUT); bf16* WqB = (bf16*)(ws + WS_WQB); bf16* WkvT = (bf16*)(ws + WS_WKV);
    bf16* WxoT = (bf16*)(ws + WS_WXO); bf16* WguT = (bf16*)(ws + WS_WGU); bf16* WdT = (bf16*)(ws + WS_WD);
    const float* g0 = pin(P, 2) + (size_t)(l * 3 + 0) * DM; const float* g1 = g0 + DM; const float* g2 = g1 + DM;
    const float* w_in = pin(P, 3) + (size_t)l * DM * DIN;
    const float* w_out = pin(P, 18) + (size_t)l * DM * DM;
    const float* w_xq = pin(P, 20) + (size_t)l * DM * DM;
    const float* w_xkv = pin(P, 21) + (size_t)l * DM * 2 * DM;
    const float* w_xo = pin(P, 22) + (size_t)l * DM * DM;
    const float* w_gu = pin(P, 23) + (size_t)l * DM * 2 * DFF;
    const float* w_dn = pin(P, 24) + (size_t)l * DFF * DM;
    const int gw = bid * NWAVES + wave, NGW = G * NWAVES, gt = bid * NTHR + tid, NGT = G * NTHR;
    LAS float* scr = (LAS float*)(lds + wave * 16384);
    constexpr int I1 = 49 * 32, I2 = 112 * 32, I3 = 64 * 32, I4 = 128 * 32, I5 = 64 * 32, I6 = 352 * 32, I7 = 64 * 88, ITOT = I1 + I2 + I3 + I4 + I5 + I6 + I7;
    auto mk_item = [&](int it) -> TrItem {
        int r = it; TrItem t; t.gain = nullptr; t.sc = 1.f;
        if (r < I1) { const int kb = r / 49, nb = r % 49; t.src = w_in; t.ldsrc = DIN; t.nsrc0 = 32 * nb; t.k0 = 64 * kb; t.dst = WinT; t.lddst = DM; t.nd0 = 32 * nb; t.gain = g0; t.sc = nb < 8 ? 0.125f : 1.f; }
        else if ((r -= I1) < I2) { const int kb = r / 112, nb = r % 112; t.src = w_in; t.ldsrc = DIN; t.nsrc0 = 1568 + 32 * nb; t.k0 = 64 * kb; t.dst = WinT; t.lddst = DM; t.gain = g0; const int cc = 32 * nb;
            t.nd0 = cc < 512 ? PUF + cc : cc < 2048 ? WUH + (cc - 512) : PUS + (cc - 2048); }
        else if ((r -= I2) < I3) { const int kb = r / 64, nb = r % 64; t.src = w_out; t.ldsrc = DM; t.nsrc0 = 32 * nb; t.k0 = 64 * kb; t.dst = WoutT; t.lddst = DM; t.nd0 = 32 * nb; }
        else if ((r -= I3) < I4) { const int kb = r / 128, nb = r % 128; t.src = w_xkv; t.ldsrc = 2 * DM; t.nsrc0 = 32 * nb; t.k0 = 64 * kb; t.dst = WkvT; t.lddst = DM; t.nd0 = 32 * nb; }
        else if ((r -= I4) < I5) { const int kb = r / 64, nb = r % 64; t.src = w_xo; t.ldsrc = DM; t.nsrc0 = 32 * nb; t.k0 = 64 * kb; t.dst = WxoT; t.lddst = DM; t.nd0 = 32 * nb; }
        else if ((r -= I5) < I6) { const int kb = r / 352, nb = r % 352, c0 = 32 * nb; t.src = w_gu; t.ldsrc = 2 * DFF; t.nsrc0 = c0; t.k0 = 64 * kb; t.dst = WguT; t.lddst = DM; t.gain = g2;
            t.nd0 = c0 < DFF ? (c0 / 128) * 256 + (c0 % 128) : ((c0 - DFF) / 128) * 256 + 128 + ((c0 - DFF) % 128); }
        else { r -= I6; const int kb = r / 64, nb = r % 64; t.src = w_dn; t.ldsrc = DM; t.nsrc0 = 32 * nb; t.k0 = 64 * kb; t.dst = WdT; t.lddst = DFF; t.nd0 = 32 * nb; }
        return t; };
    { f32x4 va[8], vb[8]; int it = gw;
      if (it < ITOT) { TrItem ta = mk_item(it); tr_load(ta, va, lane);
          for (;;) { const int itb = it + NGW; const bool hb = itb < ITOT; TrItem tb = ta; if (hb) { tb = mk_item(itb); tr_load(tb, vb, lane); }
              tr_finish(ta, va, scr, lane); if (!hb) break;
              const int ita = itb + NGW; const bool ha = ita < ITOT; if (ha) { ta = mk_item(ita); tr_load(ta, va, lane); }
              tr_finish(tb, vb, scr, lane); if (!ha) break; it = ita; } } }
    for (int i = gt; i < DM * DM / 8; i += NGT) { const int k = i >> 8; const float s = g1[k] * 0.044194173824159216f;
        const f32x4 a = *(const GAS f32x4*)(w_xq + (size_t)i * 8), b = *(const GAS f32x4*)(w_xq + (size_t)i * 8 + 4);
        v4u o; o.x = pk2(a.x * s, a.y * s); o.y = pk2(a.z * s, a.w * s); o.z = pk2(b.x * s, b.y * s); o.w = pk2(b.z * s, b.w * s);
        *(GAS v4u*)(WqB + (size_t)i * 8) = o; }
    __syncthreads();
    { bf16* filtT = (bf16*)(ws + WS_FILT);
      const float* w1 = pin(P, 8) + (size_t)l * 33 * 64; const float* b1 = pin(P, 9) + l * 64; const float* w2 = pin(P, 10) + (size_t)l * 64 * 64; const float* b2 = pin(P, 11) + l * 64;
      const float* w3 = pin(P, 12) + (size_t)l * 64 * 2048; const float* fr = pin(P, 13) + l * 64; const float* dec = pin(P, 14) + (size_t)l * 2048;
      LAS float* ft = (LAS float*)lds; LAS float* h1 = ft + 16 * 34; LAS float* h2 = h1 + 16 * 64;
      LAS float* w1s = h2 + 16 * 64; LAS float* w2s = w1s + 33 * 64;
      for (int i = tid; i < 33 * 64; i += NTHR) w1s[i] = w1[i];
      for (int i = tid; i < 64 * 64; i += NTHR) w2s[i] = w2[i];
      __syncthreads();
      for (int pg = bid; pg < SEQ / 16; pg += G) {
          if (tid < 256) { const int p = tid >> 4, i = tid & 15; const float t = (float)(pg * 16 + p) * (1.0f / SEQ);
              const float f = 1e-4f + (float)i * ((15.0f - 1e-4f) / 15.0f); const float rev = t * f; ft[p * 34 + 1 + i] = __builtin_amdgcn_cosf(rev); ft[p * 34 + 17 + i] = -__builtin_amdgcn_sinf(rev);
              if (i == 0) ft[p * 34] = t; }
          __syncthreads();
#pragma unroll
          for (int e = 0; e < 2; ++e) { const int o = tid + 512 * e, p = o >> 6, j = o & 63; float a = b1[j];
#pragma unroll 11
              for (int i = 0; i < 33; ++i) a += ft[p * 34 + i] * w1s[i * 64 + j];
              h1[p * 64 + j] = __builtin_amdgcn_sinf(fr[j] * a * 0.15915494309189535f); }
          __syncthreads();
#pragma unroll
          for (int e = 0; e < 2; ++e) { const int o = tid + 512 * e, p = o >> 6, j = o & 63; float a = b2[j];
#pragma unroll 16
              for (int i = 0; i < 64; ++i) a += h1[p * 64 + i] * w2s[i * 64 + j];
              h2[j * 16 + p] = __builtin_amdgcn_sinf(fr[j] * a * 0.15915494309189535f); }
          __syncthreads();
#pragma unroll 1
          for (int q = 0; q < 4; ++q) { const int n = tid + 512 * q; float a[16];
#pragma unroll
              for (int p = 0; p < 16; ++p) a[p] = 0.f;
#pragma unroll 1
              for (int j0 = 0; j0 < 64; j0 += 16) { float wv[16];
#pragma unroll
                  for (int jj = 0; jj < 16; ++jj) wv[jj] = w3[(j0 + jj) * 2048 + n];
#pragma unroll
                  for (int jj = 0; jj < 16; ++jj) { const LAS f32x4* hp = (const LAS f32x4*)(h2 + (j0 + jj) * 16); const f32x4 ha = hp[0], hb = hp[1], hc = hp[2], hd = hp[3]; const float w = wv[jj];
                      a[0] += ha.x * w; a[1] += ha.y * w; a[2] += ha.z * w; a[3] += ha.w * w; a[4] += hb.x * w; a[5] += hb.y * w; a[6] += hb.z * w; a[7] += hb.w * w;
                      a[8] += hc.x * w; a[9] += hc.y * w; a[10] += hc.z * w; a[11] += hc.w * w; a[12] += hd.x * w; a[13] += hd.y * w; a[14] += hd.z * w; a[15] += hd.w * w; } }
              const float dc = fabsf(dec[n]);
#pragma unroll
              for (int p4 = 0; p4 < 4; ++p4) { f32x4 o;
                  o.x = a[4 * p4 + 0] * __expf(-(float)(pg * 16 + 4 * p4 + 0) * (1.0f / SEQ) * dc); o.y = a[4 * p4 + 1] * __expf(-(float)(pg * 16 + 4 * p4 + 1) * (1.0f / SEQ) * dc);
                  o.z = a[4 * p4 + 2] * __expf(-(float)(pg * 16 + 4 * p4 + 2) * (1.0f / SEQ) * dc); o.w = a[4 * p4 + 3] * __expf(-(float)(pg * 16 + 4 * p4 + 3) * (1.0f / SEQ) * dc);
                  *(GAS v2u*)(filtT + (size_t)n * SEQ + pg * 16 + 4 * p4) = (v2u){pk2(o.x, o.y), pk2(o.z, o.w)}; } }
          __syncthreads();
      } }
    if (l == 0) { bf16* xb = (bf16*)(ws + WS_XB); float* rss = (float*)(ws + WS_RSS); const float* xin = pin(P, 0);
      for (int m = gw; m < MTOK; m += NGW) { const GAS f32x4* xr = (const GAS f32x4*)(xin + (size_t)m * DM) + lane; f32x4 v[8]; float ss = 0.f;
#pragma unroll
          for (int j = 0; j < 8; ++j) { v[j] = xr[64 * j]; ss += (v[j].x * v[j].x + v[j].y * v[j].y) + (v[j].z * v[j].z + v[j].w * v[j].w); }
          ss = wave_sum(ss); GAS v2u* o8 = (GAS v2u*)(xb + (size_t)m * DM) + lane;
#pragma unroll
          for (int j = 0; j < 8; ++j) { v2u w; w.x = pk2(v[j].x, v[j].y); w.y = pk2(v[j].z, v[j].w); o8[64 * j] = w; }
          if (lane < 32) rss[(size_t)m * 32 + lane] = lane == 0 ? ss : 0.f; } }
    if (l == 0) {
        typedef float f32x2 __attribute__((ext_vector_type(2)));
        __syncthreads();
        LAS f32x2* tw = (LAS f32x2*)lds;
        for (int i = tid; i < 4096; i += NTHR) { const float rv = (float)i * (1.0f / 4096.0f); tw[i] = (f32x2){__builtin_amdgcn_cosf(rv) * 0.001381067932f, __builtin_amdgcn_sinf(rv) * 0.001381067932f}; }
        __syncthreads();
        bf16* C2 = (bf16*)(ws + WS_C2); bf16* S2 = (bf16*)(ws + WS_S2);
        for (int i = gt; i < 2048 * (FK1 / 8); i += NGT) { const int srow = i / (FK1 / 8), t0 = (i % (FK1 / 8)) * 8; float cv[8];
#pragma unroll
            for (int e = 0; e < 8; ++e) cv[e] = (t0 + e) <= 2048 ? tw[(srow * (t0 + e)) & 4095].x : 0.f;
            v4u oc; oc.x = pk2(cv[0], cv[1]); oc.y = pk2(cv[2], cv[3]); oc.z = pk2(cv[4], cv[5]); oc.w = pk2(cv[6], cv[7]);
            *(GAS v4u*)(C2 + (size_t)srow * FK1 + t0) = oc; }
        for (int i = gt; i < 2048 * 256; i += NGT) { const int srow = i >> 8, t0 = (i & 255) * 8; float sv[8];
#pragma unroll
            for (int e = 0; e < 8; ++e) sv[e] = tw[(srow * (t0 + e)) & 4095].y;
            v4u os; os.x = pk2(sv[0], sv[1]); os.y = pk2(sv[2], sv[3]); os.z = pk2(sv[4], sv[5]); os.w = pk2(sv[6], sv[7]);
            *(GAS v4u*)(S2 + (size_t)srow * 2048 + t0) = os; }
        bf16* A1 = (bf16*)(ws + WS_A1);
        for (int i = gt; i < 512 * 256; i += NGT) { const int r = i >> 8, k = i & 255, gl = r >> 8, ri = (r >> 7) & 1, cp = r & 127, kg = k >> 7, cc = k & 127;
            float v = 0.f; if (kg == gl) { const float rv = (float)((cc * cp) & 127) * (1.0f / 128.0f); v = ri == 0 ? __builtin_amdgcn_cosf(rv) : -__builtin_amdgcn_sinf(rv); }
            A1[i] = (bf16)f2bf(v); }
        __syncthreads();
    }
    if (l == 0) { bf16* memn = (bf16*)(ws + WS_MEMN);
      for (int m = gw; m < NB * NMEM; m += NGW) norm_row_gain_bf16(pin(P, 1) + (size_t)m * DM, memn + (size_t)m * DM, pin(P, 19), lane); }
}


typedef short gbf16x8 __attribute__((ext_vector_type(8)));
constexpr int GP = 72;
__device__ __forceinline__ f32x4 mma16(const LAS bf16* A, const LAS bf16* Bt, int K, int lane, f32x4 acc) {
    const int r = lane & 15, q = lane >> 4;
#pragma unroll
    for (int k0 = 0; k0 < 64; k0 += 32) { if (k0 < K) {
        const gbf16x8 a = *(const LAS gbf16x8*)(A + r * GP + k0 + 8 * q), b = *(const LAS gbf16x8*)(Bt + r * GP + k0 + 8 * q);
        acc = __builtin_amdgcn_mfma_f32_16x16x32_bf16(a, b, acc, 0, 0, 0); } }
    return acc;
}
constexpr int RP = 72;
__device__ __forceinline__ v4u gla_ld64(const bf16* proj, int tok0, int col0, int tid) { return *(const GAS v4u*)(proj + (size_t)(tok0 + (tid >> 3)) * NPROJ + col0 + (tid & 7) * 8); }
__device__ __forceinline__ v4u gla_ld128(const bf16* proj, int tok0, int col0, int id) { return *(const GAS v4u*)(proj + (size_t)(tok0 + (id >> 4)) * NPROJ + col0 + (id & 15) * 8); }
__device__ __forceinline__ void gla_st64(LAS bf16* raw, v4u v, int tid) { *(LAS v4u*)(raw + (tid >> 3) * RP + (tid & 7) * 8) = v; }
__device__ __forceinline__ void gla_st_vT(LAS bf16* vT, v4u v, int id) {
    const int i = id >> 4, c0 = (id & 15) * 8; const unsigned w[4] = {v.x, v.y, v.z, v.w};
#pragma unroll
    for (int e = 0; e < 8; ++e) vT[(c0 + e) * GP + i] = (bf16)((e & 1) ? (w[e >> 1] >> 16) : (w[e >> 1] & 0xffffu));
}
constexpr int LRP = 40;
__device__ __forceinline__ void gla_cumsum_lds(const LAS bf16* lrraw, const LAS float* gwl, const float* gkb_, int h, int dir, LAS float* bL, LAS float* tot, int tid) {
    const GAS float* gkb = (const GAS float*)gkb_;
    const int k = tid & 63, seg = tid >> 6;
    const float bias = gkb[dir * 256 + h * 64 + k];
    float w[16];
#pragma unroll
    for (int r = 0; r < 16; ++r) w[r] = gwl[(dir * 16 + r) * 64 + k];
    float c[8];
#pragma unroll
    for (int e = 0; e < 8; ++e) { const LAS v4u* lp = (const LAS v4u*)(lrraw + (8 * seg + e) * LRP + dir * 16); const v4u a = lp[0], b = lp[1];
        float pre = bias;
        pre += bflo(a.x) * w[0] + bfhi(a.x) * w[1] + bflo(a.y) * w[2] + bfhi(a.y) * w[3] + bflo(a.z) * w[4] + bfhi(a.z) * w[5] + bflo(a.w) * w[6] + bfhi(a.w) * w[7];
        pre += bflo(b.x) * w[8] + bfhi(b.x) * w[9] + bflo(b.y) * w[10] + bfhi(b.y) * w[11] + bflo(b.z) * w[12] + bfhi(b.z) * w[13] + bflo(b.w) * w[14] + bfhi(b.w) * w[15];
        c[e] = log_sigmoid_f(pre) * (1.f / 16.f); }
    if (dir == 0) {
#pragma unroll
        for (int e = 1; e < 8; ++e) c[e] += c[e - 1];
        tot[seg * 64 + k] = c[7];
    } else {
#pragma unroll
        for (int e = 6; e >= 0; --e) c[e] += c[e + 1];
        tot[seg * 64 + k] = c[0];
    }
    __syncthreads();
    float off = 0.f;
#pragma unroll
    for (int s2 = 0; s2 < 8; ++s2) { const float tv = tot[s2 * 64 + k]; if (dir == 0 ? (s2 < seg) : (s2 > seg)) off += tv; }
#pragma unroll
    for (int e = 0; e < 8; ++e) bL[(8 * seg + e) * 64 + k] = c[e] + off;
    __syncthreads();
}
__device__ __forceinline__ v4u gla_ld_lr(const bf16* proj, int tok0, int tid) { return *(const GAS v4u*)(proj + (size_t)(tok0 + ((tid & 255) >> 2)) * NPROJ + PLR + (tid & 3) * 8); }
__device__ __forceinline__ void gla_st_lr(LAS bf16* lrraw, v4u v, int tid) { if (tid < 256) *(LAS v4u*)(lrraw + (tid >> 2) * LRP + (tid & 3) * 8) = v; }
__device__ __forceinline__ void gla_stage_gkw(const float* gkw_, int h, LAS float* gwl, int tid) {
    const GAS float* gkw = (const GAS float*)gkw_;
#pragma unroll
    for (int e = 0; e < 4; ++e) { const int i = tid + 512 * e, dr = i >> 6, k = i & 63; gwl[i] = gkw[dr * 256 + h * 64 + k]; }
}
__device__ __forceinline__ void gla_g1(const bf16* proj, const float* gkw, const float* gkb, bf16* GU_, float* GD_, LAS unsigned char* lds, int tid, int lane, int wave, int bid, int G) {
    GAS bf16* GU = (GAS bf16*)GU_; GAS float* GD = (GAS float*)GD_;
    LAS bf16* vT = (LAS bf16*)lds; LAS bf16* kdT = (LAS bf16*)(lds + 18432); LAS float* bL = (LAS float*)(lds + 27648); LAS float* tot = (LAS float*)(lds + 44032);
    LAS bf16* kraw = (LAS bf16*)(lds + 46080); LAS bf16* lrraw = (LAS bf16*)(lds + 55296); LAS float* gwl = (LAS float*)(lds + 60416);
    int unit = bid; if (unit >= 2048) return;
    int hcur = -1; v4u rk, rlr, rv0, rv1;
    { const int bh = unit >> 6, n = unit & 63, h = bh & 3, tok0 = (bh >> 2) * SEQ + n * 64;
      rk = gla_ld64(proj, tok0, PK + h * 64, tid); rlr = gla_ld_lr(proj, tok0, tid);
      rv0 = gla_ld128(proj, tok0, PV + h * 128, tid); rv1 = gla_ld128(proj, tok0, PV + h * 128, tid + 512); }
    for (;;) { const int bh = unit >> 6, h = bh & 3;
        gla_st64(kraw, rk, tid); gla_st_lr(lrraw, rlr, tid); gla_st_vT(vT, rv0, tid); gla_st_vT(vT, rv1, tid + 512);
        if (h != hcur) { gla_stage_gkw(gkw, h, gwl, tid); hcur = h; }
        __syncthreads();
        const int nunit = unit + G; const bool more = nunit < 2048;
        if (more) { const int bh2 = nunit >> 6, n2 = nunit & 63, h2 = bh2 & 3, tok2 = (bh2 >> 2) * SEQ + n2 * 64;
            rk = gla_ld64(proj, tok2, PK + h2 * 64, tid); rlr = gla_ld_lr(proj, tok2, tid);
            rv0 = gla_ld128(proj, tok2, PV + h2 * 128, tid); rv1 = gla_ld128(proj, tok2, PV + h2 * 128, tid + 512); }
        for (int dir = 0; dir < 2; ++dir) {
            gla_cumsum_lds(lrraw, gwl, gkb, h, dir, bL, tot, tid);
            { const int k = tid & 63, seg = tid >> 6; const float bl = bL[(dir ? 0 : 63) * 64 + k]; unsigned w[4];
#pragma unroll
              for (int e = 0; e < 4; ++e) { const int i0 = 8 * seg + 2 * e;
                  const float k0 = bf2f(kraw[i0 * RP + k]) * __expf(bl - bL[i0 * 64 + k]);
                  const float k1 = bf2f(kraw[(i0 + 1) * RP + k]) * __expf(bl - bL[(i0 + 1) * 64 + k]);
                  w[e] = pk2(k0, k1); }
              *(LAS v4u*)(kdT + k * GP + 8 * seg) = (v4u){w[0], w[1], w[2], w[3]};
              if (seg == 0) GD[(size_t)(unit * 2 + dir) * 64 + k] = __expf(bl); }
            __syncthreads();
            { GAS bf16* U = GU + (size_t)(unit * 2 + dir) * 8192; const int r = lane & 15, q = lane >> 4;
#pragma unroll
              for (int kt = 0; kt < 4; ++kt) { f32x4 acc = (f32x4){0.f, 0.f, 0.f, 0.f};
                  acc = mma16(vT + 16 * wave * GP, kdT + 16 * kt * GP, 64, lane, acc);
#pragma unroll
                  for (int j = 0; j < 4; ++j) U[(16 * wave + 4 * q + j) * 64 + 16 * kt + r] = (bf16)f2bf(acc[j]); } }
            __syncthreads();
        }
        if (!more) break; unit = nunit;
    }
}
__device__ __forceinline__ void gla_g3(const bf16* proj, const float* gkw, const float* gkb, const float* gnorm_, const bf16* GS_, bf16* mix_, LAS unsigned char* lds, int tid, int lane, int wave, int bid, int G) {
    const GAS float* gnorm = (const GAS float*)gnorm_; const GAS bf16* GS = (const GAS bf16*)GS_; GAS bf16* mix = (GAS bf16*)mix_; const GAS bf16* gproj = (const GAS bf16*)proj;
    LAS bf16* vT = (LAS bf16*)lds; LAS bf16* ST = (LAS bf16*)(lds + 18432); LAS bf16* qd = (LAS bf16*)(lds + 36864); LAS bf16* kd = (LAS bf16*)(lds + 46080);
    LAS bf16* qb = (LAS bf16*)(lds + 55296); LAS bf16* Pm = (LAS bf16*)(lds + 64512); LAS float* bL = (LAS float*)(lds + 73728); LAS float* tot = (LAS float*)(lds + 90112); LAS float* rs = (LAS float*)(lds + 92160);
    LAS bf16* qraw = (LAS bf16*)(lds + 92672); LAS bf16* kraw = (LAS bf16*)(lds + 101888); LAS bf16* lrraw = (LAS bf16*)(lds + 111104); LAS float* gwl = (LAS float*)(lds + 116224);
    const int r = lane & 15, q = lane >> 4, wr = wave >> 1, wc = wave & 1;
    int unit = bid; if (unit >= 2048) return;
    int hcur = -1; v4u rq, rk, rlr, rv0, rv1, rs0a, rs0b, rs1a, rs1b; unsigned short rg[16];
#define G3_LOAD(UNIT) do { const int bh_ = (UNIT) >> 6, n_ = (UNIT) & 63, h_ = bh_ & 3, tok_ = (bh_ >> 2) * SEQ + n_ * 64; \
        rq = gla_ld64(proj, tok_, PQ + h_ * 64, tid); rk = gla_ld64(proj, tok_, PK + h_ * 64, tid); rlr = gla_ld_lr(proj, tok_, tid); \
        rv0 = gla_ld128(proj, tok_, PV + h_ * 128, tid); rv1 = gla_ld128(proj, tok_, PV + h_ * 128, tid + 512); \
        { const GAS bf16* S0_ = GS + (size_t)((UNIT) * 2) * 8192; rs0a = *(const GAS v4u*)(S0_ + tid * 8); rs0b = *(const GAS v4u*)(S0_ + 4096 + tid * 8); rs1a = *(const GAS v4u*)(S0_ + 8192 + tid * 8); rs1b = *(const GAS v4u*)(S0_ + 12288 + tid * 8); } \
        _Pragma("unroll") for (int j_ = 0; j_ < 4; ++j_) _Pragma("unroll") for (int ct_ = 0; ct_ < 4; ++ct_) rg[j_ * 4 + ct_] = gproj[(size_t)(tok_ + 16 * wr + 4 * q + j_) * NPROJ + PG + h_ * 128 + 64 * wc + 16 * ct_ + r]; } while (0)
    G3_LOAD(unit);
    for (;;) { const int bh = unit >> 6, n = unit & 63, bb = bh >> 2, h = bh & 3, tok0 = bb * SEQ + n * 64;
        gla_st64(qraw, rq, tid); gla_st64(kraw, rk, tid); gla_st_lr(lrraw, rlr, tid); gla_st_vT(vT, rv0, tid); gla_st_vT(vT, rv1, tid + 512);
        if (h != hcur) { gla_stage_gkw(gkw, h, gwl, tid); hcur = h; }
        const v4u s0a = rs0a, s0b = rs0b, s1a = rs1a, s1b = rs1b; unsigned short gcur[16];
#pragma unroll
        for (int e = 0; e < 16; ++e) gcur[e] = rg[e];
        __syncthreads();
        const int nunit = unit + G; const bool more = nunit < 2048;
        if (more) G3_LOAD(nunit);
        f32x4 acc[4];
#pragma unroll
        for (int ct = 0; ct < 4; ++ct) acc[ct] = (f32x4){0.f, 0.f, 0.f, 0.f};
        for (int dir = 0; dir < 2; ++dir) {
            gla_cumsum_lds(lrraw, gwl, gkb, h, dir, bL, tot, tid);
            { const int i = tid >> 3, kg = (tid & 7) * 8;
              const v4u qv = *(const LAS v4u*)(qraw + i * RP + kg), kv = *(const LAS v4u*)(kraw + i * RP + kg);
              const f32x4 b0 = *(const LAS f32x4*)(bL + i * 64 + kg), b1 = *(const LAS f32x4*)(bL + i * 64 + kg + 4), r0 = *(const LAS f32x4*)(bL + 32 * 64 + kg), r1 = *(const LAS f32x4*)(bL + 32 * 64 + kg + 4);
              const unsigned qw[4] = {qv.x, qv.y, qv.z, qv.w}, kw[4] = {kv.x, kv.y, kv.z, kv.w}; unsigned oqd[4], okd[4], oqb[4];
#pragma unroll
              for (int e2 = 0; e2 < 4; ++e2) { const float bva = e2 < 2 ? b0[2 * e2] : b1[2 * e2 - 4], bvb = e2 < 2 ? b0[2 * e2 + 1] : b1[2 * e2 - 3], bra = e2 < 2 ? r0[2 * e2] : r1[2 * e2 - 4], brb = e2 < 2 ? r0[2 * e2 + 1] : r1[2 * e2 - 3];
                  const float qa = bflo(qw[e2]), qbv = bfhi(qw[e2]), ka = bflo(kw[e2]), kb = bfhi(kw[e2]);
                  oqd[e2] = pk2(qa * __expf(bva - bra), qbv * __expf(bvb - brb)); okd[e2] = pk2(ka * __expf(bra - bva), kb * __expf(brb - bvb)); oqb[e2] = pk2(qa * __expf(bva), qbv * __expf(bvb)); }
              *(LAS v4u*)(qd + i * GP + kg) = (v4u){oqd[0], oqd[1], oqd[2], oqd[3]}; *(LAS v4u*)(kd + i * GP + kg) = (v4u){okd[0], okd[1], okd[2], okd[3]}; *(LAS v4u*)(qb + i * GP + kg) = (v4u){oqb[0], oqb[1], oqb[2], oqb[3]};
              *(LAS v4u*)(ST + (tid >> 3) * GP + (tid & 7) * 8) = dir ? s1a : s0a; *(LAS v4u*)(ST + (64 + (tid >> 3)) * GP + (tid & 7) * 8) = dir ? s1b : s0b; }
            __syncthreads();
#pragma unroll
            for (int e = 0; e < 2; ++e) { const int jt = wc * 2 + e; f32x4 s = (f32x4){0.f, 0.f, 0.f, 0.f};
                s = mma16(qd + 16 * wr * GP, kd + 16 * jt * GP, 64, lane, s);
#pragma unroll
                for (int j = 0; j < 4; ++j) { const int i = 16 * wr + 4 * q + j, jj = 16 * jt + r; const bool keep = dir == 0 ? (jj <= i) : (jj > i);
                    Pm[i * GP + jj] = (bf16)f2bf(keep ? s[j] : 0.f); } }
            __syncthreads();
#pragma unroll
            for (int ct = 0; ct < 4; ++ct) { const int v0 = 64 * wc + 16 * ct;
                acc[ct] = mma16(Pm + 16 * wr * GP, vT + v0 * GP, 64, lane, acc[ct]);
                acc[ct] = mma16(qb + 16 * wr * GP, ST + v0 * GP, 64, lane, acc[ct]); }
            __syncthreads();
        }
        float ss[4];
#pragma unroll
        for (int j = 0; j < 4; ++j) { float a = 0.f;
#pragma unroll
            for (int ct = 0; ct < 4; ++ct) a += acc[ct][j] * acc[ct][j];
            a += __shfl_xor(a, 1); a += __shfl_xor(a, 2); a += __shfl_xor(a, 4); a += __shfl_xor(a, 8); ss[j] = a; }
        if (r == 0) {
#pragma unroll
            for (int j = 0; j < 4; ++j) rs[(16 * wr + 4 * q + j) * 2 + wc] = ss[j]; }
        __syncthreads();
#pragma unroll
        for (int j = 0; j < 4; ++j) { const int i = 16 * wr + 4 * q + j; const float rstd = rsqrtf((rs[i * 2] + rs[i * 2 + 1]) * (1.f / 128.f) + EPS);
#pragma unroll
            for (int ct = 0; ct < 4; ++ct) { const int v = 64 * wc + 16 * ct + r; const float gate = bf2f(gcur[j * 4 + ct]);
                mix[(size_t)(tok0 + i) * DM + h * 128 + v] = (bf16)f2bf(acc[ct][j] * rstd * gnorm[v] * pg8::silu_f(gate)); } }
        __syncthreads();
        if (!more) break; unit = nunit;
    }
#undef G3_LOAD
}

__device__ __forceinline__ void gla_g2(const bf16* GU_, const float* GD_, bf16* GS_, int tid, int bid, int G) {
    typedef float f32x2 __attribute__((ext_vector_type(2)));
    const GAS unsigned* GU = (const GAS unsigned*)GU_; const GAS float* GD = (const GAS float*)GD_; GAS unsigned* GS = (GAS unsigned*)GS_;
    for (int it = bid * NTHR + tid; it < 32 * 2 * 4096; it += G * NTHR) { const int e2 = it & 4095, dir = (it >> 12) & 1, bh = it >> 13, k = (2 * e2) & 63;
        float S0 = 0.f, S1 = 0.f;
#pragma unroll 1
        for (int nb = 0; nb < 64; nb += 16) { unsigned u[16]; f32x2 d[16];
#pragma unroll
            for (int j = 0; j < 16; ++j) { const int nv = nb + j, n = dir ? 63 - nv : nv; const size_t ud = (size_t)((bh * 64 + n) * 2 + dir);
                u[j] = GU[ud * 4096 + e2]; d[j] = *(const GAS f32x2*)(GD + ud * 64 + k); }
            asm volatile("" ::: "memory");
#pragma unroll
            for (int j = 0; j < 16; ++j) { const int nv = nb + j, n = dir ? 63 - nv : nv; const size_t ud = (size_t)((bh * 64 + n) * 2 + dir);
                GS[ud * 4096 + e2] = pk2(S0, S1); S0 = S0 * d[j].x + bflo(u[j]); S1 = S1 * d[j].y + bfhi(u[j]); } }
    }
}
__device__ __forceinline__ float sconv3(const bf16* proj, int b, int t, int col, const float* w, int wld, int wc) {
    const bf16* p = proj + (size_t)(b * SEQ + t) * NPROJ + col;
    float a = w[wld + wc] * bf2f(p[0]);
    if (t > 0) a += w[wc] * bf2f(p[-NPROJ]);
    if (t < SEQ - 1) a += w[2 * wld + wc] * bf2f(p[NPROJ]);
    return a;
}


typedef float f32x16 __attribute__((ext_vector_type(16)));
typedef short hbf16x8 __attribute__((ext_vector_type(8)));
constexpr int HY_PITCH = 4360, HY_ZOFF = 96;
constexpr int HY_ZBYTES = 8 * HY_PITCH * 2;
constexpr int HY_HRN = 8200;
constexpr int HY_LDS_BYTES = HY_ZBYTES + 2 * HY_HRN * 2;

__device__ __forceinline__ hbf16x8 hy_afrag(LAS const unsigned char* hrb, int m0) {
    const int p = m0 + 4096, odd = p & 1;
    const LAS unsigned* src = (const LAS unsigned*)(hrb + odd * (HY_HRN * 2) + (p + odd) * 2);
    v4u w; w.x = src[0]; w.y = src[1]; w.z = src[2]; w.w = src[3];
    return __builtin_bit_cast(hbf16x8, w);
}
__device__ __forceinline__ void hy_fill_hr(const float* filtT_, int order, int c, LAS unsigned char* hrb, int tid) {
    const GAS bf16* filtT = (const GAS bf16*)filtT_;
    const GAS bf16* hf = filtT + (size_t)(order * 1024 + c) * SEQ; const GAS bf16* hb = filtT + (size_t)(order * 1024 + 512 + c) * SEQ;
    LAS bf16* c0 = (LAS bf16*)hrb; LAS bf16* c1 = c0 + HY_HRN;
    asm volatile("" : "+v"(tid));
    bf16 v[16];
#pragma unroll
    for (int k = 0; k < 16; ++k) { const int m = tid + 512 * k - 4096, am = m < 0 ? -m : m; v[k] = (m <= 0 ? hf : hb)[am > 4095 ? 4095 : am]; }
#pragma unroll
    for (int k = 0; k < 16; ++k) { const int q = tid + 512 * k; const bf16 v0 = q == 0 ? (bf16)0 : v[k]; c0[q] = v0; c1[q + 1] = v0; }
    if (tid < 8) { c0[8192 + tid] = 0; if (tid < 7) c1[8193 + tid] = 0; }
    if (tid == 0) c1[0] = 0;
}
__device__ __forceinline__ void hy_conv(LAS const unsigned char* zbb, LAS const unsigned char* hrb, int w, int lane, f32x4 (&acc)[8][2]) {
    const int n = lane & 15, b = n >> 1, il = n & 1, kq = lane >> 4, i = n;
#pragma unroll
    for (int p = 0; p < 8; ++p)
#pragma unroll
        for (int hh = 0; hh < 2; ++hh) acc[p][hh] = (f32x4){0.f, 0.f, 0.f, 0.f};
    const LAS unsigned char* zl = zbb + (b * HY_PITCH + HY_ZOFF + 32 * il + 8 * kq) * 2 - 64;
    const int mb = -32 * (16 * w + 1) - i + 8 * kq;
    hbf16x8 A[16][2];
#pragma unroll
    for (int d = 0; d <= 14; ++d) { A[(1 + d) & 15][0] = hy_afrag(hrb, mb - 32 * d); A[(1 + d) & 15][1] = hy_afrag(hrb, mb - 32 * d - 16); }
    hbf16x8 b0 = *(const LAS hbf16x8*)zl;
#pragma unroll 1
    for (int c = 0; c < 9; ++c) {
#pragma unroll
        for (int u = 0; u < 16; ++u) { const int s = 16 * c + u;
            if (s <= 128) {
                hbf16x8 nb0 = b0;
                if (s < 128) {
                    A[(16 - u) & 15][0] = hy_afrag(hrb, mb + 32 * (s + 1)); A[(16 - u) & 15][1] = hy_afrag(hrb, mb + 32 * (s + 1) - 16);
                    nb0 = *(const LAS hbf16x8*)(zl + (s + 1) * 64); }
#pragma unroll
                for (int hh = 0; hh < 2; ++hh)
#pragma unroll
                    for (int p = 0; p < 8; ++p) acc[p][hh] = __builtin_amdgcn_mfma_f32_16x16x32_bf16(A[(17 - u + 2 * p) & 15][hh], b0, acc[p][hh], 0, 0, 0);
                b0 = nb0; } }
    }
}
__device__ __forceinline__ v2u hy_conv4_fin(v2u v, bf16 l, bf16 r, int t0, float w0, float w1, float w2) {
    const float xl = t0 > 0 ? bf2f(l) : 0.f, xr = t0 < SEQ - 4 ? bf2f(r) : 0.f;
    const float x0 = bflo(v.x), x1 = bfhi(v.x), x2 = bflo(v.y), x3 = bfhi(v.y);
    v2u o; o.x = pk2(w0 * xl + w1 * x0 + w2 * x1, w0 * x0 + w1 * x1 + w2 * x2); o.y = pk2(w0 * x1 + w1 * x2 + w2 * x3, w0 * x2 + w1 * x3 + w2 * xr); return o;
}
__device__ __forceinline__ void hy_toeplitz_phase(const bf16* uT, const float* cw_, const float* filtT, const float* skip_, bf16* yT, LAS unsigned char* lds, int tid, int lane, int wave, int bid, int G) {
    const GAS float* skip = (const GAS float*)skip_; const GAS float* cw = (const GAS float*)cw_; const GAS bf16* ur = (const GAS bf16*)uT;
    LAS unsigned char* zbb = lds; LAS unsigned char* hrb = lds + HY_ZBYTES;
    for (int i = tid; i < HY_ZBYTES / 4; i += NTHR) ((LAS unsigned*)zbb)[i] = 0u;
    __syncthreads();
    const int w = wave;
    for (int c = bid; c < 512; c += G) {
        { const float w0 = cw[c], w1 = cw[1536 + c], w2 = cw[3072 + c];
#pragma unroll 8
          for (int bb = 0; bb < 8; ++bb) { const int q = tid; const GAS bf16* src = ur + (size_t)c * MTOK + bb * SEQ + q * 8;
              const v4u v = *(const GAS v4u*)src; const float xlr = bf2f(src[q > 0 ? -1 : 0]), xrr = bf2f(src[q < 511 ? 8 : 7]); const float xl = q > 0 ? xlr : 0.f, xr = q < 511 ? xrr : 0.f;
              const float x[10] = {xl, bflo(v.x), bfhi(v.x), bflo(v.y), bfhi(v.y), bflo(v.z), bfhi(v.z), bflo(v.w), bfhi(v.w), xr};
              v4u o; o.x = pk2(w0 * x[0] + w1 * x[1] + w2 * x[2], w0 * x[1] + w1 * x[2] + w2 * x[3]); o.y = pk2(w0 * x[2] + w1 * x[3] + w2 * x[4], w0 * x[3] + w1 * x[4] + w2 * x[5]);
              o.z = pk2(w0 * x[4] + w1 * x[5] + w2 * x[6], w0 * x[5] + w1 * x[6] + w2 * x[7]); o.w = pk2(w0 * x[6] + w1 * x[7] + w2 * x[8], w0 * x[7] + w1 * x[8] + w2 * x[9]);
              *(LAS v4u*)(zbb + (bb * HY_PITCH + HY_ZOFF + q * 8) * 2) = o; } }
        hy_fill_hr(filtT, 0, c, hrb, tid);
        __syncthreads();
        f32x4 acc[8][2];
        hy_conv(zbb, hrb, w, lane, acc);
        { unsigned zp[8][2][2];
        int ln = lane; asm volatile("" : "+v"(ln)); const int n = ln & 15, b = n >> 1, il = n & 1, kq = ln >> 4;
        { const float sk = skip[c]; const float a0 = cw[512 + c], a1 = cw[1536 + 512 + c], a2 = cw[3072 + 512 + c];
          const int tb = 32 * (16 * w + il) + 4 * kq; const GAS bf16* xb0 = ur + (size_t)(512 + c) * MTOK + b * SEQ + tb;
#pragma unroll
          for (int gh = 0; gh < 2; ++gh) { v2u rv[8]; bf16 rl[8], rr[8];
#pragma unroll
            for (int k = 0; k < 8; ++k) { const int off = 64 * (4 * gh + (k >> 1)) + 16 * (k & 1); rv[k] = *(const GAS v2u*)(xb0 + off); rl[k] = xb0[off - 1]; rr[k] = xb0[off + 4]; }
            asm volatile("" ::: "memory");
#pragma unroll
            for (int k = 0; k < 8; ++k) { const int g = 4 * gh + (k >> 1), rq = k & 1, t0 = tb + 64 * g + 16 * rq;
                const v2u xv = hy_conv4_fin(rv[k], rl[k], rr[k], t0, a0, a1, a2);
                const v2u vv = *(const LAS v2u*)(zbb + (b * HY_PITCH + HY_ZOFF + t0) * 2);
                const float z0 = bflo(xv.x) * (acc[g][rq][0] + bflo(vv.x) * sk), z1 = bfhi(xv.x) * (acc[g][rq][1] + bfhi(vv.x) * sk);
                const float z2 = bflo(xv.y) * (acc[g][rq][2] + bflo(vv.y) * sk), z3 = bfhi(xv.y) * (acc[g][rq][3] + bfhi(vv.y) * sk);
                zp[g][rq][0] = pk2(z0, z1); zp[g][rq][1] = pk2(z2, z3); } } }
        __syncthreads();
#pragma unroll
        for (int g = 0; g < 8; ++g)
#pragma unroll
            for (int rq = 0; rq < 2; ++rq) { const int t0 = 32 * (16 * w + 2 * g + il) + 16 * rq + 4 * kq;
                *(LAS v2u*)(zbb + (b * HY_PITCH + HY_ZOFF + t0) * 2) = (v2u){zp[g][rq][0], zp[g][rq][1]}; } }
        hy_fill_hr(filtT, 1, c, hrb, tid);
        __syncthreads();
        hy_conv(zbb, hrb, w, lane, acc);
        { int ln = lane; asm volatile("" : "+v"(ln)); const int n = ln & 15, b = n >> 1, il = n & 1, kq = ln >> 4; const float sk = skip[512 + c]; const float a0 = cw[1024 + c], a1 = cw[1536 + 1024 + c], a2 = cw[3072 + 1024 + c];
          const int tb = 32 * (16 * w + il) + 4 * kq; const GAS bf16* xb0 = ur + (size_t)(1024 + c) * MTOK + b * SEQ + tb;
#pragma unroll
          for (int gh = 0; gh < 2; ++gh) { v2u rv[8]; bf16 rl[8], rr[8];
#pragma unroll
            for (int k = 0; k < 8; ++k) { const int off = 64 * (4 * gh + (k >> 1)) + 16 * (k & 1); rv[k] = *(const GAS v2u*)(xb0 + off); rl[k] = xb0[off - 1]; rr[k] = xb0[off + 4]; }
            asm volatile("" ::: "memory");
#pragma unroll
            for (int k = 0; k < 8; ++k) { const int g = 4 * gh + (k >> 1), rq = k & 1, t0 = tb + 64 * g + 16 * rq;
                const v2u xv = hy_conv4_fin(rv[k], rl[k], rr[k], t0, a0, a1, a2);
                const v2u zv = *(const LAS v2u*)(zbb + (b * HY_PITCH + HY_ZOFF + t0) * 2);
                const float z0 = bflo(zv.x), z1 = bfhi(zv.x), z2 = bflo(zv.y), z3 = bfhi(zv.y);
                const float o0 = bflo(xv.x) * (acc[g][rq][0] + z0 * sk), o1 = bfhi(xv.x) * (acc[g][rq][1] + z1 * sk);
                const float o2 = bflo(xv.y) * (acc[g][rq][2] + z2 * sk), o3 = bfhi(xv.y) * (acc[g][rq][3] + z3 * sk);
                *(GAS v2u*)(yT + (size_t)c * MTOK + b * SEQ + t0) = (v2u){pk2(o0, o1), pk2(o2, o3)}; } } }
        __syncthreads();
    }
}
__device__ __forceinline__ void hy_transpose_out(const bf16* yT, const float* gC, bf16* mix, LAS unsigned char* lds, int tid, int lane, int wave, int bid, int G) {
    constexpr int TQ = 516;
    LAS bf16* T = (LAS bf16*)lds;
    const f32x4 g0 = *(const GAS f32x4*)(gC + lane * 8), g1 = *(const GAS f32x4*)(gC + lane * 8 + 4);
    for (int tile = bid; tile < MTOK / 64; tile += G) { const int tok0 = tile * 64;
        v4u rv[8];
#pragma unroll
        for (int pass = 0; pass < 8; ++pass) { const int c = (tid >> 3) + 64 * pass, sg = tid & 7; rv[pass] = *(const GAS v4u*)(yT + (size_t)c * MTOK + tok0 + 8 * sg); }
#pragma unroll
        for (int pass = 0; pass < 8; ++pass) { const int c = (tid >> 3) + 64 * pass, sg = tid & 7; const unsigned w[4] = {rv[pass].x, rv[pass].y, rv[pass].z, rv[pass].w};
#pragma unroll
            for (int e = 0; e < 8; ++e) T[(8 * sg + e) * TQ + c] = (bf16)((e & 1) ? (w[e >> 1] >> 16) : (w[e >> 1] & 0xffffu)); }
        __syncthreads();
#pragma unroll 1
        for (int k = 0; k < 8; ++k) { const int s = wave * 8 + k; float y[8]; float ss = 0.f;
            const v2u ya = *(const LAS v2u*)(T + s * TQ + lane * 8), yb = *(const LAS v2u*)(T + s * TQ + lane * 8 + 4);
            y[0] = bflo(ya.x); y[1] = bfhi(ya.x); y[2] = bflo(ya.y); y[3] = bfhi(ya.y); y[4] = bflo(yb.x); y[5] = bfhi(yb.x); y[6] = bflo(yb.y); y[7] = bfhi(yb.y);
#pragma unroll
            for (int e = 0; e < 8; ++e) ss += y[e] * y[e];
            const float rstd = rsqrtf(wave_sum(ss) * (1.f / 512.f) + EPS);
            v4u o; o.x = pk2(y[0] * rstd * g0.x, y[1] * rstd * g0.y); o.y = pk2(y[2] * rstd * g0.z, y[3] * rstd * g0.w);
            o.z = pk2(y[4] * rstd * g1.x, y[5] * rstd * g1.y); o.w = pk2(y[6] * rstd * g1.z, y[7] * rstd * g1.w);
            *(GAS v4u*)(mix + (size_t)(tok0 + s) * DM + 1024 + lane * 8) = o; }
        __syncthreads();
    }
}

__device__ __forceinline__ void phase_c_misc(const Params& P, unsigned char* ws, float* xres, int l, LAS unsigned char* lds, int tid, int lane, int wave, int bid, int G) {
    const bf16* proj = (const bf16*)(ws + WS_PROJ); bf16* mix = (bf16*)(ws + WS_MIX);
    { const bf16* FU2 = (const bf16*)(ws + WS_FU2); bf16* FE = (bf16*)(ws + WS_FE); bf16* FO = (bf16*)(ws + WS_FO); float* Y2K = (float*)(ws + WS_Y2K);
      const int gw = bid * NWAVES + wave, NGW = G * NWAVES;
      for (int col = gw; col < 4096; col += NGW) { const bf16* ur = FU2 + (size_t)col * 8192; const bf16* ui = ur + 4096; float alt = 0.f;
#pragma unroll
          for (int j = 0; j < 4; ++j) { const int t0 = 8 * (lane + 64 * j);
              const v4u a = *(const GAS v4u*)(ur + t0), c = *(const GAS v4u*)(ui + t0);
              const v4u ma = *(const GAS v4u*)(ur + 4096 - t0 - 8), mc = *(const GAS v4u*)(ui + 4096 - t0 - 8);
              const float m0rr = bf2f(ur[t0 ? 4096 - t0 : 0]), m0ir = bf2f(ui[t0 ? 4096 - t0 : 0]); const float m0r = t0 ? m0rr : 0.f, m0i = t0 ? m0ir : 0.f;
              float er[8], oi[8];
              const unsigned aw[4] = {a.x, a.y, a.z, a.w}, cw[4] = {c.x, c.y, c.z, c.w}, maw[4] = {ma.x, ma.y, ma.z, ma.w}, mcw[4] = {mc.x, mc.y, mc.z, mc.w};
#pragma unroll
              for (int e = 0; e < 8; ++e) { const float xr = (e & 1) ? bfhi(aw[e >> 1]) : bflo(aw[e >> 1]), xi = (e & 1) ? bfhi(cw[e >> 1]) : bflo(cw[e >> 1]);
                  float mr, mi; if (e == 0) { mr = m0r; mi = m0i; } else { const int q = 8 - e; mr = (q & 1) ? bfhi(maw[q >> 1]) : bflo(maw[q >> 1]); mi = (q & 1) ? bfhi(mcw[q >> 1]) : bflo(mcw[q >> 1]); }
                  er[e] = xr + mr; oi[e] = (t0 + e) ? xi - mi : 0.f; alt += (e & 1) ? -er[e] : er[e]; }
              v4u oe, oo; oe.x = pk2(er[0], er[1]); oe.y = pk2(er[2], er[3]); oe.z = pk2(er[4], er[5]); oe.w = pk2(er[6], er[7]);
              oo.x = pk2(oi[0], oi[1]); oo.y = pk2(oi[2], oi[3]); oo.z = pk2(oi[4], oi[5]); oo.w = pk2(oi[6], oi[7]);
              *(GAS v4u*)(FE + (size_t)col * FK1 + t0) = oe; *(GAS v4u*)(FO + (size_t)col * 2048 + t0) = oo; }
          const float e2k = bf2f(ur[2048]);
          if (lane < 16) { v4u z = (v4u){0u, 0u, 0u, 0u}; if (lane == 0) z.x = f2bf(e2k); *(GAS v4u*)(FE + (size_t)col * FK1 + 2048 + 8 * lane) = z; }
          alt = wave_sum(alt) + e2k;
          if (lane == 0) Y2K[col] = alt * 0.001381067932f; } }
    { const float* cw = pin(P, 16) + (size_t)l * 3 * 512; const float* gD = pin(P, 17) + (size_t)(l * 3 + 2) * 512;
      const int gw = bid * NWAVES + wave, NGW = G * NWAVES, c0 = lane * 8;
      float w0[8], w1[8], w2[8], gd[8];
#pragma unroll
      for (int e = 0; e < 8; ++e) { w0[e] = cw[c0 + e]; w1[e] = cw[512 + c0 + e]; w2[e] = cw[1024 + c0 + e]; gd[e] = gD[c0 + e]; }
      for (int tk0 = gw; tk0 < MTOK; tk0 += 2 * NGW) {
          v4u vb[2], vc[2], vh[2], vcm[2], vhm[2], vcp[2], vhp[2];
#pragma unroll
          for (int h = 0; h < 2; ++h) { const int tk = tk0 + h * NGW, token = tk < MTOK ? tk : MTOK - 1, t = token & (SEQ - 1);
              const bf16* p = proj + (size_t)token * NPROJ + PUS + c0; const int om = t > 0 ? -NPROJ : 0, op = t < SEQ - 1 ? NPROJ : 0;
              vb[h] = *(const GAS v4u*)p; vc[h] = *(const GAS v4u*)(p + 512); vh[h] = *(const GAS v4u*)(p + 1024);
              vcm[h] = *(const GAS v4u*)(p + 512 + om); vhm[h] = *(const GAS v4u*)(p + 1024 + om); vcp[h] = *(const GAS v4u*)(p + 512 + op); vhp[h] = *(const GAS v4u*)(p + 1024 + op); }
#pragma unroll
          for (int h = 0; h < 2; ++h) { const int token = tk0 + h * NGW, t = token & (SEQ - 1); const float km = t > 0 ? 1.f : 0.f, kp = t < SEQ - 1 ? 1.f : 0.f;
              float y[8]; float ss = 0.f;
#pragma unroll
              for (int e2 = 0; e2 < 4; ++e2) {
                  const float a0 = km * w0[2 * e2] * bflo(vcm[h][e2]) * bflo(vhm[h][e2]) + w1[2 * e2] * bflo(vc[h][e2]) * bflo(vh[h][e2]) + kp * w2[2 * e2] * bflo(vcp[h][e2]) * bflo(vhp[h][e2]);
                  const float a1 = km * w0[2 * e2 + 1] * bfhi(vcm[h][e2]) * bfhi(vhm[h][e2]) + w1[2 * e2 + 1] * bfhi(vc[h][e2]) * bfhi(vh[h][e2]) + kp * w2[2 * e2 + 1] * bfhi(vcp[h][e2]) * bfhi(vhp[h][e2]);
                  y[2 * e2] = bflo(vb[h][e2]) * a0; y[2 * e2 + 1] = bfhi(vb[h][e2]) * a1; ss += y[2 * e2] * y[2 * e2] + y[2 * e2 + 1] * y[2 * e2 + 1]; }
              const float rstd = rsqrtf(wave_sum(ss) * (1.f / 512.f) + EPS);
              v4u o; o.x = pk2(y[0] * rstd * gd[0], y[1] * rstd * gd[1]); o.y = pk2(y[2] * rstd * gd[2], y[3] * rstd * gd[3]); o.z = pk2(y[4] * rstd * gd[4], y[5] * rstd * gd[5]); o.w = pk2(y[6] * rstd * gd[6], y[7] * rstd * gd[7]);
              if (token < MTOK) *(GAS v4u*)(mix + (size_t)token * DM + 1536 + c0) = o; } } }
    __syncthreads();
    gla_g1(proj, pin(P, 4) + (size_t)l * 2 * 16 * 256, pin(P, 5) + (size_t)l * 512, (bf16*)(ws + WS_GU), (float*)(ws + WS_GD), lds, tid, lane, wave, bid, G);
}

__device__ __forceinline__ void phase_d(const Params& P, unsigned char* ws, float* xres, int l, LAS unsigned char* lds, int tid, int lane, int wave, int bid, int G) {
    if (!(P.pad1 & 2)) gla_g3((const bf16*)(ws + WS_PROJ), pin(P, 4) + (size_t)l * 2 * 16 * 256, pin(P, 5) + (size_t)l * 512, pin(P, 6) + (size_t)l * 128, (const bf16*)(ws + WS_GS), (bf16*)(ws + WS_MIX), lds, tid, lane, wave, bid, G);
}
__device__ __forceinline__ void phase_e(const Params& P, unsigned char* ws, float* xres, int l, LAS unsigned char* lds, int tid, int lane, int wave, int bid, int G) {
    hy_transpose_out((const bf16*)(ws + WS_YT), pin(P, 17) + (size_t)(l * 3 + 1) * 512, (bf16*)(ws + WS_MIX), lds, tid, lane, wave, bid, G);
    { const bf16* FY = (const bf16*)(ws + WS_FY); const float* gB = pin(P, 17) + (size_t)(l * 3 + 0) * 512; bf16* mix = (bf16*)(ws + WS_MIX);
      const int gw = bid * NWAVES + wave, NGW = G * NWAVES;
      const f32x4 g0 = *(const GAS f32x4*)(gB + lane * 8), g1 = *(const GAS f32x4*)(gB + lane * 8 + 4);
      const float* Y2K = (const float*)(ws + WS_Y2K);
      for (int it0 = gw; it0 < MTOK; it0 += 2 * NGW) {
          v4u ya[2], yb[2];
#pragma unroll
          for (int h = 0; h < 2; ++h) { const int i2 = it0 + h * NGW, it = i2 < MTOK ? i2 : MTOK - 1, b = it >> 12, sp = it & (SEQ - 1);
              const int sf = sp < 2048 ? sp : 4096 - sp, sfc = sf > 2047 ? 2047 : sf;
              const bf16* src = FY + (size_t)sfc * 4096 + b * 512 + lane * 8; const bf16* srb = src + (size_t)2048 * 4096;
              ya[h] = *(const GAS v4u*)src; yb[h] = *(const GAS v4u*)srb; }
#pragma unroll
          for (int h = 0; h < 2; ++h) { const int it = it0 + h * NGW, b = it >> 12, sp = it & (SEQ - 1); const float sg = sp < 2048 ? 1.f : -1.f;
              f32x4 a = (f32x4){bflo(ya[h].x), bfhi(ya[h].x), bflo(ya[h].y), bfhi(ya[h].y)} + (f32x4){bflo(yb[h].x), bfhi(yb[h].x), bflo(yb[h].y), bfhi(yb[h].y)} * sg;
              f32x4 c = (f32x4){bflo(ya[h].z), bfhi(ya[h].z), bflo(ya[h].w), bfhi(ya[h].w)} + (f32x4){bflo(yb[h].z), bfhi(yb[h].z), bflo(yb[h].w), bfhi(yb[h].w)} * sg;
              if (sp == 2048) { a = *(const GAS f32x4*)(Y2K + (b & 7) * 512 + lane * 8); c = *(const GAS f32x4*)(Y2K + (b & 7) * 512 + lane * 8 + 4); }
              const float ss = (a.x * a.x + a.y * a.y) + (a.z * a.z + a.w * a.w) + (c.x * c.x + c.y * c.y) + (c.z * c.z + c.w * c.w);
              const float rstd = rsqrtf(wave_sum(ss) * (1.f / 512.f) + EPS);
              v4u o; o.x = pk2(a.x * rstd * g0.x, a.y * rstd * g0.y); o.y = pk2(a.z * rstd * g0.z, a.w * rstd * g0.w); o.z = pk2(c.x * rstd * g1.x, c.y * rstd * g1.y); o.w = pk2(c.z * rstd * g1.z, c.w * rstd * g1.w);
              if (it < MTOK) *(GAS v4u*)(mix + (size_t)it * DM + 512 + lane * 8) = o; } } }
}
__device__ __forceinline__ void phase_softmax(const float* sc, bf16* Pm, int lane, int wave, int bid, int G) {
    const int gw = bid * NWAVES + wave, NGW = G * NWAVES;
    for (int it = gw; it < MTOK * 4; it += NGW) {
        const f32x4 v = *((const GAS f32x4*)(sc + (size_t)it * 256) + lane);
        const float m = wave_max(fmaxf(fmaxf(v.x, v.y), fmaxf(v.z, v.w)));
        const float e0 = __expf(v.x - m), e1 = __expf(v.y - m), e2 = __expf(v.z - m), e3 = __expf(v.w - m);
        const float inv = 1.0f / wave_sum((e0 + e1) + (e2 + e3));
        v2u w; w.x = pk2(e0 * inv, e1 * inv); w.y = pk2(e2 * inv, e3 * inv);
        *((GAS v2u*)(Pm + (size_t)it * 256) + lane) = w;
    }
}

#ifndef EPIRES_XB
#define EPIRES_XB (GAS bf16*)xb
#endif
#ifndef GEMM_ALIGN
#define GEMM_ALIGN false
#endif
#ifndef GEMM_SP2
#define GEMM_SP2 true
#endif
constexpr int NPH = 11, NSTEPS = NL * NPH + 1;
template <class Sched, bool COLS = false> __device__ __forceinline__ pg8::RstdTab build_rstd(const Sched& S, const float* RS, LAS float* tab, int tid) {
    pg8::RstdTab T; T.tab = tab; T.RS = (const GAS float*)RS; T.pm0 = T.pm1 = T.pm2 = T.pm3 = -1; int n = 0; pg8::Unit u;
    for (int i = 0; S.next(i, u); ++i) { const int pm = COLS ? u.pn : u.pm;
        if (pm != T.pm0 && pm != T.pm1 && pm != T.pm2 && pm != T.pm3) { if (n == 0) T.pm0 = pm; else if (n == 1) T.pm1 = pm; else if (n == 2) T.pm2 = pm; else if (n == 3) T.pm3 = pm; ++n; } }
    const int row = tid >> 1, half = tid & 1;
#pragma unroll
    for (int sl = 0; sl < 4; ++sl) { const int pm = sl == 0 ? T.pm0 : sl == 1 ? T.pm1 : sl == 2 ? T.pm2 : T.pm3;
        if (pm >= 0) { const GAS float* p = (const GAS float*)RS + (size_t)(pm * 256 + row) * 32 + half * 16;
            const f32x4 a = *(const GAS f32x4*)p, b = *(const GAS f32x4*)(p + 4), c = *(const GAS f32x4*)(p + 8), d = *(const GAS f32x4*)(p + 12);
            float t = (((a.x + a.y) + (a.z + a.w)) + ((b.x + b.y) + (b.z + b.w))) + (((c.x + c.y) + (c.z + c.w)) + ((d.x + d.y) + (d.z + d.w)));
            t += __shfl_xor(t, 1);
            if (half == 0) tab[sl * 256 + row] = rsqrtf(t * (1.0f / DM) + EPS); } }
    __syncthreads();
    return T;
}
#define IN(st) (lo <= (st) && (st) < hi)
#define SEAM(stp_) do { if ((stp_) + 1 < hi) { XcdBarrier b2_; b2_.bar = opaque_p(bar.bar); b2_.x = (unsigned)opaque_i((int)bar.x); b2_.st = bar.st; xcd_barrier(b2_, tid); } } while (0)
#define OPAQ() int tid = wave0 * 64 + (int)__builtin_amdgcn_mbcnt_hi(~0u, __builtin_amdgcn_mbcnt_lo(~0u, 0u)); asm volatile("" : "+v"(tid)); const int bid = opaque_i(bid0), G = opaque_i(G0); unsigned char* ws = opaque_p(ws0); float* xres = opaque_p(out0); const unsigned ldsa = (unsigned)opaque_i((int)(unsigned)(size_t)lds0)
#define LOCALS() OPAQ(); LAS unsigned char* lds = (LAS unsigned char*)(size_t)ldsa; const int lane = tid & 63, wave = __builtin_amdgcn_readfirstlane(tid >> 6); \
        bf16* xb = (bf16*)(ws + WS_XB); bf16* proj = (bf16*)(ws + WS_PROJ); bf16* mix = (bf16*)(ws + WS_MIX); (void)lds; (void)lane; (void)wave; (void)xb; (void)proj; (void)mix
template <int L> __device__ __forceinline__ void layer_body(const Params& P, const XcdBarrier& bar, int lo, int hi, int wave0, int bid0, int G0, unsigned char* ws0, float* out0, LAS unsigned char* lds0) {
    constexpr int l = L; const int s0 = l * NPH;
        if (s0 + NPH <= lo || s0 >= hi) return;
        if (IN(s0 + 0)) { LOCALS(); phase_a(P, ws, xres, l, lds, tid, lane, wave, bid, G); SEAM(s0 + 0); }
        if (IN(s0 + 1)) { LOCALS();
            { pg8::Gemm g{xb, (const bf16*)(ws + WS_WIN), DM, DM, DM}; pg8::TileOrder S; S.init(MTOK / 256, NPROJ / 256, G, bid, DM, DM);
            pg8::EpiBf16 E{(GAS bf16*)proj, NPROJ, build_rstd(S, (const float*)(ws + WS_RSS), (LAS float*)(lds + LDSCTL_OFF + 1024 + 8192), tid)}; pg8::gemm_phase<pg8::EpiBf16, pg8::TileOrder, GEMM_ALIGN, GEMM_SP2>(lds + RING_OFF, g, S, E, tid);
            }
            { pg8::Gemm g{(const bf16*)(ws + WS_MEMN), (const bf16*)(ws + WS_WKV), DM, DM, DM}; pg8::TileOrder S; S.init(NB * NMEM / 256, 2 * DM / 256, G, (bid + G / 2) % G, DM, DM);
            pg8::EpiBf16 E{(GAS bf16*)(ws + WS_KVB), 2 * DM, pg8::RstdTab{nullptr, nullptr, -1, -1, -1, -1}}; pg8::gemm_phase<pg8::EpiBf16, pg8::TileOrder, GEMM_ALIGN, GEMM_SP2>(lds + RING_OFF, g, S, E, tid); }
            { pg8::Gemm g{(const bf16*)(ws + WS_WIN) + (size_t)WUH * DM, xb, DM, DM, DM}; pg8::TileOrder S; S.init(1536 / 256, MTOK / 256, G, bid, DM, DM);
              pg8::EpiBf16T E{(GAS bf16*)(ws + WS_UT), MTOK, build_rstd<pg8::TileOrder, true>(S, (const float*)(ws + WS_RSS), (LAS float*)(lds + LDSCTL_OFF + 1024 + 8192), tid)};
              pg8::gemm_phase<pg8::EpiBf16T, pg8::TileOrder, GEMM_ALIGN, GEMM_SP2>(lds + RING_OFF, g, S, E, tid); }
            SEAM(s0 + 1); }
        if (IN(s0 + 2)) { LOCALS();
            { pg8::Gemm g{(const bf16*)(ws + WS_KVB), (const bf16*)(ws + WS_WQB), 2 * DM, DM, 512}; pg8::PairOrder<0> S{G, bid};
            pg8::EpiBf16 E{(GAS bf16*)(ws + WS_MT), DM, pg8::RstdTab{nullptr, nullptr, -1, -1, -1, -1}}; pg8::gemm_phase<pg8::EpiBf16, pg8::PairOrder<0>, GEMM_ALIGN, GEMM_SP2>(lds + RING_OFF, g, S, E, tid); }
            { pg8::Gemm g{(const bf16*)(ws + WS_WXO), (const bf16*)(ws + WS_KVB), DM, 2 * DM, 512}; pg8::PairOrder<1> S{G, bid};
            pg8::EpiBf16 E{(GAS bf16*)(ws + WS_VWO), 1024, pg8::RstdTab{nullptr, nullptr, -1, -1, -1, -1}}; pg8::gemm_phase<pg8::EpiBf16, pg8::PairOrder<1>, GEMM_ALIGN, GEMM_SP2>(lds + RING_OFF, g, S, E, tid); }
            { pg8::Gemm g{(const bf16*)(ws + WS_A1), proj, 256, NPROJ, 256}; pg8::FnetAOrder S{G, bid};
            pg8::EpiFnetA E{(GAS bf16*)(ws + WS_FU2)}; pg8::gemm_phase<pg8::EpiFnetA, pg8::FnetAOrder, GEMM_ALIGN, GEMM_SP2>(lds + RING_OFF, g, S, E, tid); }
            SEAM(s0 + 2); }
        if (IN(s0 + 3)) { LOCALS(); phase_c_misc(P, ws, xres, l, lds, tid, lane, wave, bid, G); SEAM(s0 + 3); }
        if (IN(s0 + 4)) { LOCALS();
            { pg8::Gemm g{(const bf16*)(ws + WS_C2), (const bf16*)(ws + WS_FE), FK1, FK1, FK1}; pg8::TileOrder S; S.init(8, 16, G, bid, FK1, FK1);
              pg8::EpiBf16 E{(GAS bf16*)(ws + WS_FY), 4096, pg8::RstdTab{nullptr, nullptr, -1, -1, -1, -1}}; pg8::gemm_phase<pg8::EpiBf16, pg8::TileOrder, GEMM_ALIGN, GEMM_SP2>(lds + RING_OFF, g, S, E, tid); }
            { pg8::Gemm g{(const bf16*)(ws + WS_S2), (const bf16*)(ws + WS_FO), 2048, 2048, 2048}; pg8::TileOrder S; S.init(8, 16, G, (bid + G / 2) % G, 2048, 2048);
              pg8::EpiBf16 E{(GAS bf16*)(ws + WS_FY) + (size_t)2048 * 4096, 4096, pg8::RstdTab{nullptr, nullptr, -1, -1, -1, -1}}; pg8::gemm_phase<pg8::EpiBf16, pg8::TileOrder, GEMM_ALIGN, GEMM_SP2>(lds + RING_OFF, g, S, E, tid); }
            gla_g2((const bf16*)(ws + WS_GU), (const float*)(ws + WS_GD), (bf16*)(ws + WS_GS), tid, bid, G);
            __syncthreads();
            hy_toeplitz_phase((const bf16*)(ws + WS_UT), pin(P, 7) + (size_t)l * 3 * 1536, (const float*)(ws + WS_FILT), pin(P, 15) + (size_t)l * 1024, (bf16*)(ws + WS_YT), lds, tid, lane, wave, bid, G);
            SEAM(s0 + 4); }
        if (IN(s0 + 5)) { LOCALS(); phase_d(P, ws, xres, l, lds, tid, lane, wave, bid, G); __syncthreads(); phase_e(P, ws, xres, l, lds, tid, lane, wave, bid, G); SEAM(s0 + 5); }
        if (IN(s0 + 6)) { LOCALS();
            pg8::Gemm g{mix, (const bf16*)(ws + WS_WOUT), DM, DM, DM}; pg8::TileOrder S; S.init(MTOK / 256, DM / 256, G, bid, DM, DM);
            pg8::EpiRes E{l == 0 ? (const GAS float*)pin(P, 0) : (const GAS float*)nullptr, DM, (GAS bf16*)xb, (GAS float*)(ws + WS_RSS)}; pg8::gemm_phase<pg8::EpiRes, pg8::TileOrder, GEMM_ALIGN, GEMM_SP2>(lds + RING_OFF, g, S, E, tid);
            SEAM(s0 + 6); }
        if (IN(s0 + 7)) { LOCALS();
            pg8::Gemm g{xb, (const bf16*)(ws + WS_MT), DM, DM, DM}; pg8::TileOrder S; S.init(MTOK / 256, 4, G, bid, DM, DM, 16, 4);
            pg8::EpiSoftmax E{(GAS bf16*)mix, 1024, (LAS float*)(lds + LDSCTL_OFF + 1024), (LAS float*)(lds + LDSCTL_OFF + 1024 + 4096), build_rstd(S, (const float*)(ws + WS_RSS), (LAS float*)(lds + LDSCTL_OFF + 1024 + 8192), tid)}; pg8::gemm_phase<pg8::EpiSoftmax, pg8::TileOrder, true, GEMM_SP2>(lds + RING_OFF, g, S, E, tid);
            SEAM(s0 + 7); }
        if (IN(s0 + 8)) { LOCALS();
            pg8::Gemm g{mix, (const bf16*)(ws + WS_VWO), 1024, 1024, 1024}; pg8::TileOrder S; S.init(MTOK / 256, DM / 256, G, bid, 1024, 1024, 16, 8);
            pg8::EpiRes E{(const GAS float*)nullptr, DM, (GAS bf16*)xb, (GAS float*)(ws + WS_RSS)}; pg8::gemm_phase<pg8::EpiRes, pg8::TileOrder, GEMM_ALIGN, GEMM_SP2>(lds + RING_OFF, g, S, E, tid);
            SEAM(s0 + 8); }
        if (IN(s0 + 9)) { LOCALS();
            pg8::Gemm g{xb, (const bf16*)(ws + WS_WGU), DM, DM, DM}; pg8::TileOrder S; S.init(MTOK / 256, 2 * DFF / 256, G, bid, DM, DM);
            pg8::EpiSwiglu E{(GAS bf16*)proj, DFF, build_rstd(S, (const float*)(ws + WS_RSS), (LAS float*)(lds + LDSCTL_OFF + 1024 + 8192), tid)}; pg8::gemm_phase<pg8::EpiSwiglu, pg8::TileOrder, GEMM_ALIGN, GEMM_SP2>(lds + RING_OFF, g, S, E, tid);
            SEAM(s0 + 9); }
        if (IN(s0 + 10)) { LOCALS();
            pg8::Gemm g{proj, (const bf16*)(ws + WS_WD), DFF, DFF, DFF}; pg8::TileOrder S; S.init(MTOK / 256, DM / 256, G, bid, DFF, DFF);
            pg8::EpiRes E{(const GAS float*)nullptr, DM, (GAS bf16*)xb, (GAS float*)(ws + WS_RSS)}; pg8::gemm_phase<pg8::EpiRes, pg8::TileOrder, GEMM_ALIGN, GEMM_SP2>(lds + RING_OFF, g, S, E, tid);
            SEAM(s0 + 10); }
    }
__global__ void __launch_bounds__(NTHR, 2) fwd_kernel(Params P) {
    extern __shared__ __attribute__((aligned(16))) unsigned char lds_raw[];
    LAS unsigned char* lds = (LAS unsigned char*)lds_raw; LAS unsigned char* const lds0 = lds;
    const int tid = threadIdx.x, lane = tid & 63, wave = __builtin_amdgcn_readfirstlane(tid >> 6), bid = blockIdx.x, G = gridDim.x;
    volatile LAS unsigned* MISC = (volatile LAS unsigned*)(lds + MISC_OFF);
    for (int u = tid; u < (LDS_BYTES - LDSCTL_OFF) / 4; u += NTHR) ((LAS unsigned*)(lds + LDSCTL_OFF))[u] = 0u;
    __syncthreads();
    unsigned char* ws = P.ws;
    XcdBarrier bar = xcd_barrier_post((unsigned*)(ws + WS_CTL) + CW_BAR + P.pad0 * XCD_BAR_WORDS, MISC + 8, tid);
    const int lo = P.step_lo, hi = P.step_hi;
    const int wave0 = wave, bid0 = bid, G0 = G; unsigned char* const ws0 = ws; float* const out0 = P.out;
    layer_body<0>(P, bar, lo, hi, wave0, bid0, G0, ws0, out0, lds0);
    layer_body<1>(P, bar, lo, hi, wave0, bid0, G0, ws0, out0, lds0);
    layer_body<2>(P, bar, lo, hi, wave0, bid0, G0, ws0, out0, lds0);
    layer_body<3>(P, bar, lo, hi, wave0, bid0, G0, ws0, out0, lds0);
    if (IN(NL * NPH)) { LOCALS(); const int gw = bid * NWAVES + wave, NGW = G * NWAVES;
        for (int m = gw; m < MTOK; m += NGW) final_norm_row(xb + (size_t)m * DM, xres + (size_t)m * DM, pin(P, 25), lane); }
#undef IN
#undef SEAM
}

#ifndef MK_SPLIT
#define MK_SPLIT 0
#endif
extern "C" void kernel_launch(void* const* d_in, const int* in_sizes, int n_in, void* d_out, int out_size, void* d_ws, size_t ws_size, hipStream_t stream) {
    static int grid = 0;
    if (grid == 0) {
        if (n_in != 26 || in_sizes[0] != MTOK * DM || out_size != MTOK * DM || ws_size < WS_END) { fprintf(stderr, "kernel_launch: unexpected shapes (n_in %d, in0 %d, out %d, ws %zu); nothing launched\n", n_in, n_in > 0 ? in_sizes[0] : -1, out_size, ws_size); grid = -1; return; }
        int dev = 0, cus = 0, per_cu = 0;
        if (hipGetDevice(&dev) != hipSuccess || hipDeviceGetAttribute(&cus, hipDeviceAttributeMultiprocessorCount, dev) != hipSuccess) { grid = -1; return; }
        if (hipFuncSetAttribute((const void*)fwd_kernel, hipFuncAttributeMaxDynamicSharedMemorySize, LDS_BYTES) != hipSuccess) { fprintf(stderr, "kernel_launch: hipFuncSetAttribute failed\n"); grid = -1; return; }
        if (hipOccupancyMaxActiveBlocksPerMultiprocessor(&per_cu, (const void*)fwd_kernel, NTHR, LDS_BYTES) != hipSuccess || per_cu < 1) { fprintf(stderr, "kernel_launch: occupancy query says %d\n", per_cu); }
        (void)hipGetLastError();
        grid = cus;
    }
    if (grid < 0) return;
    if (hipMemsetAsync((char*)d_ws + WS_CTL, 0, CTL_ZERO_BYTES, stream) != hipSuccess) return;
    Params p{};
    for (int i = 0; i < 26; ++i) p.in[i] = (const float*)d_in[i];
    p.out = (float*)d_out; p.ws = (unsigned char*)d_ws;
#if defined(PROBE_PH)
#ifndef PROBE_FLAGS
#define PROBE_FLAGS 0
#endif
    { int lo = 0; int li = 0;
      for (int l = 0; l < NL; ++l) { const int gk = l * NPH + PROBE_PH;
          p.pad0 = li++; p.step_lo = lo; p.step_hi = gk + 1; hipLaunchKernelGGL(fwd_kernel, dim3(grid), dim3(NTHR), LDS_BYTES, stream, p);
          p.pad0 = li++; p.step_lo = gk; p.step_hi = gk + 1; p.pad1 = PROBE_FLAGS; hipLaunchKernelGGL(fwd_kernel, dim3(grid), dim3(NTHR), LDS_BYTES, stream, p); p.pad1 = 0;
          lo = gk + 1; }
      p.pad0 = li++; p.step_lo = lo; p.step_hi = NSTEPS; hipLaunchKernelGGL(fwd_kernel, dim3(grid), dim3(NTHR), LDS_BYTES, stream, p); }
#elif MK_SPLIT
    for (int st = 0; st < NSTEPS; ++st) { p.pad0 = st; p.step_lo = st; p.step_hi = st + 1; hipLaunchKernelGGL(fwd_kernel, dim3(grid), dim3(NTHR), LDS_BYTES, stream, p); }
#else
    p.step_lo = 0; p.step_hi = NSTEPS; hipLaunchKernelGGL(fwd_kernel, dim3(grid), dim3(NTHR), LDS_BYTES, stream, p);
#endif
}
```
